# Optimizing an MI355X kernel written in HIP

```python
import math
import jax, jax.numpy as jnp
from jax import lax
import numpy as np


D_MODEL = 1024
BATCH = 4
SEQ = 8192
DEPTH = 1

N_GLA_HEADS = 4
GLA_DK = 64
GLA_DV = 128
GLA_GATE_RANK = 16
GLA_GATE_NORM = 16.0
GLA_CHUNK = 64
N_DIFF_HEADS = 4
DIFF_DQK = 64
DIFF_DV = 128
Q_BLOCK = 128
NUM_BUCKETS = 32
MAX_DISTANCE = 128
N_EXPERTS = 32
TOP_K = 4
D_FF = D_MODEL
SWIGLU_LIMIT = 7.0
SWIGLU_ALPHA = 1.702
MOE_BLOCK = 256
EPS = 1e-6

GLA_QK_W = N_GLA_HEADS * GLA_DK
GLA_V_W = N_GLA_HEADS * GLA_DV
DIFF_QK_W = N_DIFF_HEADS * 2 * DIFF_DQK
DIFF_V_W = N_DIFF_HEADS * DIFF_DV
MIX_W = GLA_V_W + DIFF_V_W
IN_SPLITS = (GLA_QK_W, GLA_QK_W, GLA_V_W, GLA_V_W, GLA_GATE_RANK, DIFF_QK_W, DIFF_QK_W, DIFF_V_W)
IN_OFFSETS = tuple(int(v) for v in np.cumsum(IN_SPLITS)[:-1])
IN_W = int(sum(IN_SPLITS))

kernel_name = 'hybrid_gla_diffattn_moe_block'


def _rmsnorm(x, g):
    xf = x.astype(jnp.float32)
    y = xf * lax.rsqrt(jnp.mean(xf * xf, axis=-1, keepdims=True) + EPS)
    return (y * g.astype(jnp.float32)).astype(x.dtype)


def _modulate(h, shift, scale):
    return h * (1 + scale[:, None, :]) + shift[:, None, :]


def _t5_bucket(n):
    max_exact = NUM_BUCKETS // 2
    nf = jnp.maximum(n, 1).astype(jnp.float32)
    large = max_exact + (jnp.log(nf / max_exact) / math.log(MAX_DISTANCE / max_exact)
                         * (NUM_BUCKETS - max_exact)).astype(jnp.int32)
    large = jnp.minimum(large, NUM_BUCKETS - 1)
    return jnp.where(n < max_exact, n, large)


def _gla_chunked(q, k, v, g):
    B, H, S, dk = q.shape
    dv = v.shape[-1]
    n = S // GLA_CHUNK
    f32 = jnp.float32
    q, k, v, g = (t.astype(f32).reshape(B, H, n, GLA_CHUNK, t.shape[-1]) for t in (q, k, v, g))
    gc = jnp.cumsum(g, axis=3)
    g_last = gc[:, :, :, -1:, :]
    q_e = q * jnp.exp(gc)
    k_e = k * jnp.exp(-gc)
    causal = jnp.tril(jnp.ones((GLA_CHUNK, GLA_CHUNK), dtype=bool))
    a = jnp.where(causal, jnp.einsum('bhncd,bhnjd->bhncj', q_e, k_e), 0.0)
    o_intra = jnp.einsum('bhncj,bhnje->bhnce', a, v)
    k_s = k * jnp.exp(g_last - gc)
    u = jnp.einsum('bhncd,bhnce->bhnde', k_s, v)
    decay = jnp.exp(g_last[:, :, :, 0, :])

    def step(state, xs):
        u_n, d_n = xs
        return state * d_n[..., None] + u_n, state

    _, s_prev = lax.scan(step, jnp.zeros((B, H, dk, dv), f32),
                         (jnp.moveaxis(u, 2, 0), jnp.moveaxis(decay, 2, 0)))
    s_prev = jnp.moveaxis(s_prev, 0, 2)
    o_inter = jnp.einsum('bhncd,bhnde->bhnce', q_e, s_prev)
    return (o_intra + o_inter).reshape(B, H, S, dv)


def _diff_attention(q, k, v, lam, bias_by_dist):
    B, H, _, S, dqk = q.shape
    nqb = S // Q_BLOCK
    qb = jnp.moveaxis(q.reshape(B, H, 2, nqb, Q_BLOCK, dqk), 3, 0)
    k_pos = jnp.arange(S, dtype=jnp.int32)

    def block(args):
        q_blk, i = args
        q_pos = i * Q_BLOCK + jnp.arange(Q_BLOCK, dtype=jnp.int32)
        dist = q_pos[:, None] - k_pos[None, :]
        bias = bias_by_dist[jnp.clip(dist, 0, S - 1)].astype(jnp.float32)
        bias = bias.reshape(Q_BLOCK, S, H, 2).transpose(2, 3, 0, 1)
        s = jnp.einsum('bhmqd,bhmkd->bhmqk', q_blk, k).astype(jnp.float32) + bias
        s = jnp.where(dist >= 0, s, -jnp.inf)
        p = jax.nn.softmax(s, axis=-1)
        a = p[:, :, 0] - lam * p[:, :, 1]
        return jnp.einsum('bhqk,bhke->bhqe', a.astype(v.dtype), v)

    out = lax.map(block, (qb, jnp.arange(nqb, dtype=jnp.int32)))
    return jnp.moveaxis(out, 0, 2).reshape(B, H, S, v.shape[-1])


def _token_mixer(h, w_in, w_gk_up, b_gk_up, g_gla_out, g_qnorm, g_knorm, lq1, lk1, lq2, lk2,
                 g_subln, w_out, bias_by_dist, lambda_init):
    B, S, _ = h.shape
    f32 = jnp.float32
    proj = h @ w_in
    q_g, k_g, v_g, r_g, gk_lo, q_d, k_d, v_d = jnp.split(proj, IN_OFFSETS, axis=-1)

    def heads(t, nh):
        return t.reshape(B, S, nh, -1).transpose(0, 2, 1, 3)

    gk = jax.nn.log_sigmoid((gk_lo @ w_gk_up + b_gk_up).astype(f32)) / GLA_GATE_NORM
    o_g = _gla_chunked(heads(q_g, N_GLA_HEADS) * (GLA_DK ** -0.5), heads(k_g, N_GLA_HEADS),
                       heads(v_g, N_GLA_HEADS), heads(gk, N_GLA_HEADS))
    o_g = _rmsnorm(o_g, g_gla_out).transpose(0, 2, 1, 3).reshape(B, S, GLA_V_W).astype(h.dtype)
    o_g = o_g * jax.nn.silu(r_g)

    q_d = _rmsnorm(q_d.reshape(B, S, N_DIFF_HEADS, 2, DIFF_DQK), g_qnorm).transpose(0, 2, 3, 1, 4)
    q_d = q_d * (DIFF_DQK ** -0.5)
    k_d = _rmsnorm(k_d.reshape(B, S, N_DIFF_HEADS, 2, DIFF_DQK), g_knorm).transpose(0, 2, 3, 1, 4)
    lam = (jnp.exp(jnp.sum(lq1.astype(f32) * lk1.astype(f32)))
           - jnp.exp(jnp.sum(lq2.astype(f32) * lk2.astype(f32))) + lambda_init)
    o_d = _diff_attention(q_d, k_d, heads(v_d, N_DIFF_HEADS), lam, bias_by_dist)
    o_d = (_rmsnorm(o_d, g_subln) * (1.0 - lambda_init)).transpose(0, 2, 1, 3).reshape(B, S, DIFF_V_W)

    return jnp.concatenate([o_g, o_d.astype(h.dtype)], axis=-1) @ w_out


def _moe(h, w_router, b_router, w_gate_up, b_gate_up, w_down, b_down):
    B, S, D = h.shape
    T = B * S
    A = T * TOP_K
    hf = h.reshape(T, D)
    logits = (hf @ w_router + b_router).astype(jnp.float32)
    top_v, top_e = lax.top_k(logits, TOP_K)
    top_w = jax.nn.softmax(top_v, axis=-1)
    e_flat = top_e.reshape(A).astype(jnp.int32)
    w_flat = top_w.reshape(A)
    tok_flat = jnp.arange(A, dtype=jnp.int32) // TOP_K
    order = jnp.argsort(e_flat, stable=True)
    e_sorted = e_flat[order]
    counts = jnp.zeros((N_EXPERTS,), jnp.int32).at[e_flat].add(1)
    starts = jnp.cumsum(counts) - counts
    padded = ((counts + MOE_BLOCK - 1) // MOE_BLOCK) * MOE_BLOCK
    p_ends = jnp.cumsum(padded)
    p_starts = p_ends - padded
    dest = p_starts[e_sorted] + (jnp.arange(A, dtype=jnp.int32) - starts[e_sorted])
    n_blocks = -(-A // MOE_BLOCK) + N_EXPERTS
    P = n_blocks * MOE_BLOCK
    buf_tok = jnp.zeros((P,), jnp.int32).at[dest].set(tok_flat[order])
    buf_w = jnp.zeros((P,), jnp.float32).at[dest].set(w_flat[order])
    block_e = jnp.minimum(jnp.searchsorted(p_ends, jnp.arange(n_blocks, dtype=jnp.int32) * MOE_BLOCK,
                                           side='right'), N_EXPERTS - 1).astype(jnp.int32)

    def expert_block(args):
        tok_b, w_b, e = args
        xb = hf[tok_b]
        gu = xb @ w_gate_up[e] + b_gate_up[e]
        gate = jnp.minimum(gu[:, :D_FF], SWIGLU_LIMIT)
        up = jnp.clip(gu[:, D_FF:], -SWIGLU_LIMIT, SWIGLU_LIMIT)
        y = (up + 1) * (gate * jax.nn.sigmoid(SWIGLU_ALPHA * gate))
        out = y @ w_down[e] + b_down[e]
        return out * w_b[:, None].astype(out.dtype)

    ys = lax.map(expert_block, (buf_tok.reshape(n_blocks, MOE_BLOCK),
                                buf_w.reshape(n_blocks, MOE_BLOCK), block_e))
    out = jnp.zeros((T, D), h.dtype).at[buf_tok].add(ys.reshape(P, D).astype(h.dtype))
    return out.reshape(B, S, D)


def setup_inputs(seed: int = 0) -> dict:
    key = jax.random.key(seed)
    ks = jax.random.split(key, 26)
    f32 = jnp.float32
    nrm = lambda k, shape, s: jax.random.normal(k, shape, f32) * s
    D, L, E, F = D_MODEL, DEPTH, N_EXPERTS, D_FF
    return {
        'x': nrm(ks[0], (BATCH, SEQ, D), 1.0),
        'c': nrm(ks[1], (BATCH, D), 1.0),
        'rel_bias_table': nrm(ks[2], (NUM_BUCKETS, 2 * N_DIFF_HEADS), 0.5),
        'w_ada': nrm(ks[3], (L, D, 6 * D), 0.5 * D ** -0.5),
        'b_ada': nrm(ks[4], (L, 6 * D), 0.02),
        'g_norm1': 1.0 + nrm(ks[5], (L, D), 0.02),
        'w_in': nrm(ks[6], (L, D, IN_W), D ** -0.5),
        'w_gk_up': nrm(ks[7], (L, GLA_GATE_RANK, GLA_QK_W), GLA_GATE_RANK ** -0.5),
        'b_gk_up': nrm(ks[8], (L, GLA_QK_W), 0.1),
        'g_gla_out': 1.0 + nrm(ks[9], (L, GLA_DV), 0.02),
        'g_qnorm': 1.0 + nrm(ks[10], (L, DIFF_DQK), 0.02),
        'g_knorm': 1.0 + nrm(ks[11], (L, DIFF_DQK), 0.02),
        'lambda_q1': nrm(ks[12], (L, DIFF_DQK), 0.1),
        'lambda_k1': nrm(ks[13], (L, DIFF_DQK), 0.1),
        'lambda_q2': nrm(ks[14], (L, DIFF_DQK), 0.1),
        'lambda_k2': nrm(ks[15], (L, DIFF_DQK), 0.1),
        'g_subln': 1.0 + nrm(ks[16], (L, DIFF_DV), 0.02),
        'w_out': nrm(ks[17], (L, MIX_W, D), MIX_W ** -0.5),
        'g_norm2': 1.0 + nrm(ks[18], (L, D), 0.02),
        'w_router': nrm(ks[19], (L, D, E), D ** -0.5),
        'b_router': nrm(ks[20], (L, E), 0.01),
        'w_gate_up': nrm(ks[21], (L, E, D, 2 * F), D ** -0.5),
        'b_gate_up': nrm(ks[22], (L, E, 2 * F), 0.02),
        'w_down': nrm(ks[23], (L, E, F, D), F ** -0.5),
        'b_down': nrm(ks[24], (L, E, D), 0.02),
    }


def reference(x, c, rel_bias_table, w_ada, b_ada, g_norm1, w_in, w_gk_up, b_gk_up, g_gla_out,
              g_qnorm, g_knorm, lambda_q1, lambda_k1, lambda_q2, lambda_k2, g_subln, w_out,
              g_norm2, w_router, b_router, w_gate_up, b_gate_up, w_down, b_down):
    S = x.shape[1]
    bias_by_dist = rel_bias_table[_t5_bucket(jnp.arange(S, dtype=jnp.int32))]
    cond = jax.nn.silu(c)
    for l in range(DEPTH):
        lambda_init = 0.8 - 0.6 * math.exp(-0.3 * l)
        mod = cond @ w_ada[l] + b_ada[l]
        sh1, sc1, gt1, sh2, sc2, gt2 = jnp.split(mod, 6, axis=-1)
        h = _modulate(_rmsnorm(x, g_norm1[l]), sh1, sc1)
        x = x + gt1[:, None, :] * _token_mixer(
            h, w_in[l], w_gk_up[l], b_gk_up[l], g_gla_out[l], g_qnorm[l], g_knorm[l],
            lambda_q1[l], lambda_k1[l], lambda_q2[l], lambda_k2[l], g_subln[l], w_out[l],
            bias_by_dist, lambda_init)
        h = _modulate(_rmsnorm(x, g_norm2[l]), sh2, sc2)
        x = x + gt2[:, None, :] * _moe(h, w_router[l], b_router[l], w_gate_up[l], b_gate_up[l],
                                       w_down[l], b_down[l])
    return x
```

```cpp
#include <hip/hip_runtime.h>
#include <cstdio>
#include <cstdint>

#ifndef MK_N_LAUNCHES
#define MK_N_LAUNCHES 1
#endif

namespace pg8 {
#define PG8_LAS __attribute__((address_space(3)))
typedef unsigned short bf16_t;
typedef short bf16x8 __attribute__((ext_vector_type(8)));
typedef float f32x4 __attribute__((ext_vector_type(4)));
typedef unsigned u32x4 __attribute__((ext_vector_type(4)));
constexpr int BM = 256, BK = 64, HALF = 128, HTB = HALF * BK * 2, STAGE_BYTES = 8 * HTB, NXCD = 8, WGM = 8;

__host__ __device__ __forceinline__ int lds_byte(int r, int c) { const int st = (r >> 4) * 2 + (c >> 5), rr = r & 15, cc = c & 31, ob = rr * 64 + cc * 2; return st * 1024 + (ob ^ (((ob >> 9) & 1) << 5)); }
__host__ __device__ __forceinline__ void stage_rc(int b, int& R, int& C) { const int st = b / 1024, sb = b % 1024, swz = sb ^ (((sb >> 9) & 1) << 5); R = (st >> 1) * 16 + swz / 64; C = (st & 1) * 32 + (swz % 64) / 2; }
__host__ __device__ __forceinline__ int perm32(int rho) { const int n = rho >> 4, i = rho & 15; return 8 * (i >> 2) + 4 * n + (i & 3); }

struct Unit { int pm, pn, e; };
struct Gemm { const bf16_t* A; const bf16_t* Bt; int M, N, K; size_t estride; };

struct StaticOrder {
    int nM, nN, nwg, G, c; const PG8_LAS unsigned char* tile_e;
    __device__ void init(int nM_, int nN_, int G_, int c_, const PG8_LAS unsigned char* te) { nM = nM_; nN = nN_; nwg = nM * nN; G = G_; c = c_; tile_e = te; }
    __device__ bool next(int i, Unit& u) const {
        const long L = (long)i * G + c; if (L >= nwg) return false;
        int wgid = (int)L; { const int q = nwg / NXCD, r = nwg % NXCD, xcd = wgid % NXCD, off = wgid / NXCD; wgid = (xcd < r ? xcd * (q + 1) : r * (q + 1) + (xcd - r) * q) + off; }
        const int nig = WGM * nN, gid = wgid / nig, fm = gid * WGM, gsz = (nM - fm) < WGM ? (nM - fm) : WGM;
        u.pm = fm + ((wgid % nig) % gsz); u.pn = (wgid % nig) / gsz; u.e = tile_e ? (int)tile_e[u.pm] : 0; return true;
    }
};

__device__ __forceinline__ unsigned cvt_pk_bf16(float lo, float hi) { unsigned r; asm volatile("v_cvt_pk_bf16_f32 %0, %1, %2" : "=v"(r) : "v"(lo), "v"(hi)); return r; }

template <class Epi, class Sched>
__device__ __forceinline__ void gemm_phase(PG8_LAS unsigned char* lds, const Gemm g, const Sched& S, const Epi& E) {
    const int tid = threadIdx.x, wid = __builtin_amdgcn_readfirstlane(tid >> 6), lane = tid & 63, wr = wid >> 2, wc = wid & 3, fr = lane & 15, fq = lane >> 4;
    const int K = g.K, nt = K / BK;
    unsigned voffA[2], voffB[2];
#pragma unroll
    for (int i = 0; i < 2; ++i) { int R, C; stage_rc(tid * 16 + i * 8192, R, C); const int Rb = Epi::PERM ? ((R & ~31) + perm32(R & 31)) : R;
        voffA[i] = (unsigned)(R * K + C) * 2u; voffB[i] = (unsigned)(Rb * K + C) * 2u; }
    const size_t kstep = (size_t)(BK * 2);
    const size_t hstep = (size_t)HALF * K * 2;
    const size_t tstep = 2 * hstep;
    const size_t estep = g.estride * 2;
    const unsigned ldsw = (unsigned)wid * 1024u;
    const int aoff = lds_byte(wr * 64 + fr, fq * 8), boff = lds_byte(wc * 32 + fr, fq * 8);
#define PG8_SA(b, h) (((b) * 2 + (h)) * HTB)
#define PG8_SB(b, h) ((4 + (b) * 2 + (h)) * HTB)
#define PG8_STAGE(bufoff, gbase, voff) do { _Pragma("unroll") for (int _i = 0; _i < 2; ++_i) \
        __builtin_amdgcn_global_load_lds((const unsigned*)((const char*)(gbase) + (voff)[_i]), (PG8_LAS unsigned*)(lds + (bufoff) + ldsw + _i * 8192), 16, 0, 0); } while (0)
#define PG8_LDA(dst, b, h) do { _Pragma("unroll") for (int m = 0; m < 4; ++m) _Pragma("unroll") for (int k = 0; k < 2; ++k) dst[m][k] = *(const PG8_LAS bf16x8*)(lds + PG8_SA(b, h) + aoff + m * 2048 + k * 1024); } while (0)
#define PG8_LDB(dst, b, h) do { _Pragma("unroll") for (int n = 0; n < 2; ++n) _Pragma("unroll") for (int k = 0; k < 2; ++k) dst[n][k] = *(const PG8_LAS bf16x8*)(lds + PG8_SB(b, h) + boff + n * 2048 + k * 1024); } while (0)
#define PG8_MMA(ai, bj, At, Bt) do { __builtin_amdgcn_s_setprio(1); _Pragma("unroll") for (int m = 0; m < 4; ++m) _Pragma("unroll") for (int n = 0; n < 2; ++n) _Pragma("unroll") for (int k = 0; k < 2; ++k) \
        acc[ai][bj][m][n] = __builtin_amdgcn_mfma_f32_16x16x32_bf16(Bt[n][k], At[m][k], acc[ai][bj][m][n], 0, 0, 0); __builtin_amdgcn_s_setprio(0); } while (0)
#define PG8_WAIT_V(n) asm volatile("s_waitcnt vmcnt(" #n ")" ::: "memory")
#define PG8_WAIT_L(n) asm volatile("s_waitcnt lgkmcnt(" #n ")" ::: "memory")
#define PG8_BAR __builtin_amdgcn_s_barrier()
#define PG8_SCHED __builtin_amdgcn_sched_barrier(0)
    Unit cur, nxt; int ui = 0;
    if (!S.next(0, cur)) return;
    f32x4 acc[2][2][4][2];
#pragma unroll
    for (int a = 0; a < 2; ++a)
#pragma unroll
        for (int b = 0; b < 2; ++b)
#pragma unroll
            for (int m = 0; m < 4; ++m)
#pragma unroll
                for (int n = 0; n < 2; ++n) acc[a][b][m][n] = (f32x4){0.f, 0.f, 0.f, 0.f};
    bf16x8 At[4][2], B0[2][2], B1[2][2];
    const char* cA = (const char*)g.A + (size_t)cur.pm * tstep; const char* cB = (const char*)g.Bt + (size_t)cur.e * estep + (size_t)cur.pn * tstep;
    PG8_STAGE(PG8_SB(0, 0), cB, voffB); PG8_STAGE(PG8_SB(0, 1), cB + hstep, voffB); PG8_STAGE(PG8_SA(0, 0), cA, voffA); PG8_STAGE(PG8_SA(0, 1), cA + hstep, voffA);
    if (wr == 1) PG8_BAR;
    PG8_WAIT_V(2); PG8_BAR;
    PG8_STAGE(PG8_SB(1, 0), cB + kstep, voffB); PG8_STAGE(PG8_SA(1, 0), cA + kstep, voffA); PG8_STAGE(PG8_SB(1, 1), cB + hstep + kstep, voffB);
    PG8_WAIT_V(6); PG8_BAR;
    for (;;) {
        const bool has_next = S.next(ui + 1, nxt);
        const char* nA = has_next ? (const char*)g.A + (size_t)nxt.pm * tstep : cA; const char* nB = has_next ? (const char*)g.Bt + (size_t)nxt.e * estep + (size_t)nxt.pn * tstep : cB;
        for (int t = 0; t < nt; t += 2) {
            const bool last = (t == nt - 2);
            const char* a1 = cA + (size_t)(t + 1) * kstep;
            const char* a2 = last ? nA : cA + (size_t)(t + 2) * kstep; const char* b2 = last ? nB : cB + (size_t)(t + 2) * kstep;
            const char* a3 = a2 + kstep; const char* b3 = b2 + kstep;
            PG8_LDB(B0, 0, 0); PG8_LDB(B1, 0, 1); PG8_SCHED; PG8_LDA(At, 0, 0); PG8_STAGE(PG8_SA(1, 1), a1 + hstep, voffA);
            PG8_WAIT_V(8); PG8_WAIT_L(0); PG8_BAR; PG8_MMA(0, 0, At, B0); PG8_MMA(0, 1, At, B1); PG8_BAR; PG8_SCHED;
            PG8_LDA(At, 0, 1); PG8_STAGE(PG8_SB(0, 0), b2, voffB); PG8_STAGE(PG8_SB(0, 1), b2 + hstep, voffB); PG8_STAGE(PG8_SA(0, 0), a2, voffA);
            PG8_WAIT_V(8); PG8_WAIT_L(0); PG8_BAR; PG8_MMA(1, 0, At, B0); PG8_MMA(1, 1, At, B1); PG8_BAR; PG8_SCHED;
            PG8_LDB(B0, 1, 0); PG8_LDB(B1, 1, 1); PG8_SCHED; PG8_LDA(At, 1, 0); PG8_STAGE(PG8_SA(0, 1), a2 + hstep, voffA);
            PG8_WAIT_V(8); PG8_WAIT_L(0); PG8_BAR; PG8_MMA(0, 0, At, B0); PG8_MMA(0, 1, At, B1); PG8_BAR; PG8_SCHED;
            PG8_LDA(At, 1, 1); PG8_STAGE(PG8_SB(1, 0), b3, voffB); PG8_STAGE(PG8_SB(1, 1), b3 + hstep, voffB); PG8_STAGE(PG8_SA(1, 0), a3, voffA);
            PG8_WAIT_V(8); PG8_WAIT_L(0); PG8_BAR; PG8_MMA(1, 0, At, B0); PG8_MMA(1, 1, At, B1); PG8_BAR; PG8_SCHED;
        }
        if (wr == 0) PG8_BAR;
        E(acc, cur, wr, wc, fr, fq);
        if (!has_next) break;
#pragma unroll
        for (int a = 0; a < 2; ++a)
#pragma unroll
            for (int b = 0; b < 2; ++b)
#pragma unroll
                for (int m = 0; m < 4; ++m)
#pragma unroll
                    for (int n = 0; n < 2; ++n) acc[a][b][m][n] = (f32x4){0.f, 0.f, 0.f, 0.f};
        cur = nxt; cA = nA; cB = nB; ++ui;
        if (wr == 1) PG8_BAR;
    }
    PG8_WAIT_V(0);
    PG8_BAR;
#undef PG8_SA
#undef PG8_SB
#undef PG8_STAGE
#undef PG8_LDA
#undef PG8_LDB
#undef PG8_MMA
#undef PG8_WAIT_V
#undef PG8_WAIT_L
#undef PG8_BAR
#undef PG8_SCHED
}
}

constexpr int NWAVES = 8;
constexpr int BATCH = 4, SEQ = 8192, D = 1024, T = BATCH * SEQ;
constexpr int INW = 3088, NIN = 3072;
constexpr int NE = 32, TOPK = 4, FF = 1024;
constexpr int PMAX = (T * TOPK / 256 + NE) * 256;
constexpr int NCHUNK = BATCH * 4 * (SEQ / 64);
constexpr float EPS = 1e-6f;
constexpr float LOG2E = 1.4426950408889634f;
constexpr float C2 = 0.125f * LOG2E;

constexpr size_t MiB = 1u << 20;
constexpr size_t WS_CTL = 0, CTL_ZERO_BYTES = 1 * MiB;
constexpr size_t WS_MODP = 1 * MiB;
constexpr size_t WS_MOD = 2 * MiB;
constexpr size_t WS_TOPE = 3 * MiB;
constexpr size_t WS_TOPW = 3 * MiB + 512 * 1024;
constexpr size_t WS_POS = 4 * MiB;
constexpr size_t WS_ROWW = 4 * MiB + 512 * 1024;
constexpr size_t WS_DEC = 6 * MiB;
constexpr size_t WS_WGU = 8 * MiB;
constexpr size_t WS_WD = 136 * MiB;
constexpr size_t WS_XN = 200 * MiB;
constexpr size_t WS_WIN = 264 * MiB;
constexpr size_t WS_WOUT = 270 * MiB;
constexpr size_t WS_GK = 272 * MiB;
constexpr size_t WS_QG = 304 * MiB;
constexpr size_t WS_KG = 320 * MiB;
constexpr size_t WS_VG = 336 * MiB;
constexpr size_t WS_RG = 368 * MiB;
constexpr size_t WS_QD = 400 * MiB;
constexpr size_t WS_KD = 432 * MiB;
constexpr size_t WS_VD = 464 * MiB;
constexpr size_t WS_UT = 496 * MiB;
constexpr size_t WS_SP = 560 * MiB;
constexpr size_t WS_OI = 592 * MiB;
constexpr size_t WS_QE = 656 * MiB;
constexpr size_t WS_A2 = 672 * MiB;
constexpr size_t WS_STASH = 736 * MiB;
constexpr size_t WS_XS = 264 * MiB;
constexpr size_t WS_Y = 536 * MiB;
constexpr size_t WS_END = 808 * MiB;
static_assert(WS_XS + (size_t)PMAX * 1024 * 2 <= WS_Y && WS_Y + (size_t)PMAX * 1024 * 2 <= WS_END, "ws map");
constexpr int CW_BAR = 4096;
constexpr int CW_CNT = 16384;
constexpr int CW_FILL = 16384 + 64;

constexpr int RING_BYTES = 131072;
constexpr int LDSCTL_OFF = RING_BYTES, MISC_OFF = LDSCTL_OFF + 320;
constexpr int TILEE_OFF = MISC_OFF + 128;
constexpr int HIST_OFF = TILEE_OFF + 1024;
constexpr int LDS_BYTES = 147456;
static_assert(HIST_OFF + 512 <= LDS_BYTES, "LDS map");

#define GAS __attribute__((address_space(1)))
#define LAS __attribute__((address_space(3)))
typedef unsigned short bf16;
typedef unsigned v4u __attribute__((ext_vector_type(4)));
typedef unsigned v2u __attribute__((ext_vector_type(2)));
typedef float f32x4 __attribute__((ext_vector_type(4)));
typedef float f32x16 __attribute__((ext_vector_type(16)));
typedef short bf16x8 __attribute__((ext_vector_type(8)));
typedef short s16x4 __attribute__((ext_vector_type(4)));
typedef GAS unsigned gu32;
#define RLX_AGENT __ATOMIC_RELAXED, __HIP_MEMORY_SCOPE_AGENT
#define LDS_WAIT() asm volatile("s_waitcnt lgkmcnt(0)" ::: "memory")
#define VM_WAIT() asm volatile("s_waitcnt vmcnt(0)" ::: "memory")
__device__ __forceinline__ unsigned f2bf(float f) { unsigned u = __builtin_bit_cast(unsigned, f); return (u + 0x7fffu + ((u >> 16) & 1u)) >> 16; }
__device__ __forceinline__ unsigned pk2(float lo, float hi) { return f2bf(lo) | (f2bf(hi) << 16); }
__device__ __forceinline__ float bf2f(unsigned short h) { return __builtin_bit_cast(float, (unsigned)h << 16); }
__device__ __forceinline__ float bflo(unsigned u) { return __builtin_bit_cast(float, u << 16); }
__device__ __forceinline__ float bfhi(unsigned u) { return __builtin_bit_cast(float, u & 0xffff0000u); }
__device__ __forceinline__ float wave_sum(float v) {
#pragma unroll
    for (int o = 1; o < 64; o <<= 1) v += __shfl_xor(v, o);
    return v;
}
__device__ __forceinline__ float sigmoidf_(float x) { return 1.f / (1.f + __expf(-x)); }

#define XB_TMO      128
#define XB_XCNT(j)  (256  + 64 * (j))
#define XB_XSUB(j)  (1280 + 64 * (j))
#define XB_XGEN(j)  (2304 + 64 * (j))
#define XB_TOP      3328
#define XB_TOPGEN   3392
#define XCD_BAR_WORDS 3456
#define XB_SPIN_CAP (1u << 18)
__device__ __forceinline__ unsigned xb_ld(unsigned* p)              { return __hip_atomic_load(p, __ATOMIC_RELAXED, __HIP_MEMORY_SCOPE_AGENT); }
__device__ __forceinline__ unsigned xb_add(unsigned* p, unsigned v) { return __hip_atomic_fetch_add(p, v, __ATOMIC_RELAXED, __HIP_MEMORY_SCOPE_AGENT); }
__device__ __forceinline__ unsigned xb_xcc_id() { return (unsigned)__builtin_amdgcn_s_getreg((3 << 11) | 20) & 0xFu; }
#define XB_SPIN(cond, bar) do { unsigned _sp = 0; while (cond) { __builtin_amdgcn_s_sleep(1); \
    if ((++_sp & 255u) == 0u) { if (xb_ld(&(bar)[XB_TMO])) break; if (_sp > XB_SPIN_CAP) { atomicAdd(&(bar)[XB_TMO], 1u); break; } } } } while (0)
struct XcdBarrier { unsigned* bar; unsigned x; volatile LAS unsigned* st; };
__device__ __forceinline__ XcdBarrier xcd_barrier_post(unsigned* bar, volatile LAS unsigned* st) {
    XcdBarrier b; b.bar = bar; b.x = xb_xcc_id(); b.st = st;
    if (threadIdx.x == 0) (void)xb_add(&bar[XB_XCNT(b.x)], 1u);
    return b;
}
__device__ __forceinline__ void xcd_barrier_complete(unsigned* bar, unsigned x, unsigned& nloc, unsigned& nx) {
    const unsigned G = gridDim.x * gridDim.y * gridDim.z;
    unsigned sum, cnt, mine, sp = 0u;
    for (;;) {
        sum = 0u; cnt = 0u; mine = 0u;
#pragma unroll
        for (unsigned j = 0; j < 16; ++j) { const unsigned c = xb_ld(&bar[XB_XCNT(j)]); sum += c; cnt += (c > 0u) ? 1u : 0u; mine = (j == x) ? c : mine; }
        if (sum == G) break;
        __builtin_amdgcn_s_sleep(1);
        if ((++sp & 255u) == 0u) { if (xb_ld(&bar[XB_TMO])) break; if (sp > XB_SPIN_CAP) { atomicAdd(&bar[XB_TMO], 1u); break; } }
    }
    nloc = mine > 0u ? mine : 1u; nx = cnt > 0u ? cnt : 1u;
}
__device__ __forceinline__ void xcd_barrier(const XcdBarrier& b) {
    asm volatile("s_waitcnt vmcnt(0)" ::: "memory");
    __syncthreads();
    if (threadIdx.x == 0) {
        unsigned* bar = b.bar;
        __builtin_amdgcn_s_waitcnt(0);
        unsigned nloc = b.st[0], nx = b.st[1];
        if (nloc == 0u) { xcd_barrier_complete(bar, b.x, nloc, nx); b.st[0] = nloc; b.st[1] = nx; }
        const unsigned old = xb_add(&bar[XB_XSUB(b.x)], 1u);
        const unsigned gen = old / nloc;
        if (old + 1u == (gen + 1u) * nloc) {
            __builtin_amdgcn_fence(__ATOMIC_RELEASE, "agent");
            asm volatile("s_waitcnt vmcnt(0)" ::: "memory");
            const unsigned og = xb_add(&bar[XB_TOP], 1u);
            const unsigned tg = og / nx;
            if (og + 1u == (tg + 1u) * nx) xb_add(&bar[XB_TOPGEN], 1u);
            else XB_SPIN(xb_ld(&bar[XB_TOPGEN]) == tg, bar);
            __builtin_amdgcn_fence(__ATOMIC_ACQUIRE, "agent");
            xb_add(&bar[XB_XGEN(b.x)], 1u);
            asm volatile("s_waitcnt vmcnt(0)" ::: "memory");
        } else {
            XB_SPIN(xb_ld(&bar[XB_XGEN(b.x)]) == gen, bar);
            __builtin_amdgcn_fence(__ATOMIC_ACQUIRE, "agent");
            asm volatile("s_waitcnt vmcnt(0)" ::: "memory");
        }
    }
    __syncthreads();
}

struct Frame {
    LAS unsigned char* lds;
    volatile LAS unsigned* MISC;
    gu32* ctl;
    int tid, lane, wave;
    int vcu, G;
    unsigned char* ws;
    const float *x, *c, *rel_bias, *w_ada, *b_ada, *g_norm1, *w_in, *w_gk_up, *b_gk_up, *g_gla_out, *g_qnorm, *g_knorm, *lq1, *lk1, *lq2, *lk2, *g_subln, *w_out,
                *g_norm2, *w_router, *b_router, *w_gate_up, *b_gate_up, *w_down, *b_down;
    float* out;
};
template <class Tp> __device__ __forceinline__ Tp* wsp(const Frame& F, size_t off) { return (Tp*)(F.ws + off); }

__device__ __forceinline__ void tr_item(const float* W, int ldw, int k0, int src0, bf16* WT, int K, int drow0, LAS float* scr, int lane) {
#pragma unroll 8
    for (int i = 0; i < 32; ++i) { const int kk = 2 * i + (lane >> 5); scr[kk * 33 + (lane & 31)] = W[(size_t)(k0 + kk) * ldw + src0 + (lane & 31)]; }
    LDS_WAIT(); asm volatile("" ::: "memory");
    const int c = lane & 7;
#pragma unroll
    for (int j = 0; j < 4; ++j) { const int n = (lane >> 3) + 8 * j; const LAS float* s = scr + (8 * c) * 33 + n;
        v4u o; o.x = pk2(s[0 * 33], s[1 * 33]); o.y = pk2(s[2 * 33], s[3 * 33]); o.z = pk2(s[4 * 33], s[5 * 33]); o.w = pk2(s[6 * 33], s[7 * 33]);
        *(GAS v4u*)(WT + (size_t)(drow0 + n) * K + k0 + 8 * c) = o; }
    LDS_WAIT(); asm volatile("" ::: "memory");
}
__device__ __forceinline__ int win_src0(int ng) {
    const int pn = ng >> 3, gi = ng & 7, bj = gi >> 2, wc = gi & 3;
    if (pn < 6) return pn * 256 + gi * 32;
    if (pn < 10) { const int base = (pn < 8) ? 1552 : 2064; const int gq = 4 * ((pn - 6) & 1) + wc; return base + 64 * gq + 32 * bj; }
    return 2576 + (pn - 10) * 256 + gi * 32;
}
__device__ __forceinline__ void p0_phase(Frame& F) {
    LAS float* scr = (LAS float*)(F.lds + F.wave * 16384);
    const int gw = F.vcu * NWAVES + F.wave, NGW = F.G * NWAVES, lane = F.lane;
    for (int it = gw; it < 768; it += NGW) {
        const int cg = it % 96, ks = it / 96, j = cg * 64 + lane;
#pragma unroll
        for (int q = 0; q < 8; ++q) { const int idx = q * 64 + lane, b = idx >> 7, kk = idx & 127; const float cv = F.c[b * 1024 + ks * 128 + kk]; scr[idx] = cv * sigmoidf_(cv); }
        LDS_WAIT(); asm volatile("" ::: "memory");
        float a0 = 0.f, a1 = 0.f, a2 = 0.f, a3 = 0.f;
        const float* wp = F.w_ada + (size_t)(ks * 128) * 6144 + j;
#pragma unroll 16
        for (int kk = 0; kk < 128; ++kk) { const float w = wp[(size_t)kk * 6144]; a0 += scr[kk] * w; a1 += scr[128 + kk] * w; a2 += scr[256 + kk] * w; a3 += scr[384 + kk] * w; }
        float* mp = wsp<float>(F, WS_MODP) + (size_t)(ks * 4) * 6144 + j;
        mp[0] = a0; mp[6144] = a1; mp[2 * 6144] = a2; mp[3 * 6144] = a3;
        LDS_WAIT(); asm volatile("" ::: "memory");
    }
    constexpr int I_IN = 96 * 16, I_OUT = 32 * 16, I_GU = 32 * 64 * 16, I_D = 32 * 32 * 16;
    constexpr int NITEMS = I_IN + I_OUT + I_GU + I_D;
    for (int it = gw; it < NITEMS; it += NGW) {
        int r = it;
        if (r < I_IN) { const int kb = r / 96, ng = r % 96; tr_item(F.w_in, INW, kb * 64, win_src0(ng), wsp<bf16>(F, WS_WIN), 1024, ng * 32, scr, lane); continue; } r -= I_IN;
        if (r < I_OUT) { const int kb = r / 32, ng = r % 32; tr_item(F.w_out, 1024, kb * 64, ng * 32, wsp<bf16>(F, WS_WOUT), 1024, ng * 32, scr, lane); continue; } r -= I_OUT;
        if (r < I_GU) { const int e = r / 1024, q = r % 1024, kb = q / 64, dg = q % 64, pn = dg >> 3, gi = dg & 7, bj = gi >> 2, j32 = gi & 3;
            tr_item(F.w_gate_up + (size_t)e * 1024 * 2048, 2048, kb * 64, bj * 1024 + pn * 128 + j32 * 32, wsp<bf16>(F, WS_WGU) + (size_t)e * 2048 * 1024, 1024, dg * 32, scr, lane); continue; } r -= I_GU;
        { const int e = r / 512, q = r % 512, kb = q / 32, ng = q % 32;
            tr_item(F.w_down + (size_t)e * 1024 * 1024, 1024, kb * 64, ng * 32, wsp<bf16>(F, WS_WD) + (size_t)e * 1024 * 1024, 1024, ng * 32, scr, lane); }
    }
}

__device__ __forceinline__ f32x4 mod_from_partials(const Frame& F, int b, int col) {
    const float* mp = wsp<const float>(F, WS_MODP) + (size_t)b * 6144 + col;
    f32x4 s = *(const f32x4*)(F.b_ada + col);
#pragma unroll
    for (int ks = 0; ks < 8; ++ks) s += *(const f32x4*)(mp + (size_t)ks * 4 * 6144);
    return s;
}
__device__ __forceinline__ void p1_phase(Frame& F) {
    const int tid = F.tid, lane = F.lane;
    LAS float* wlo = (LAS float*)(F.lds);
    LAS float* wup = (LAS float*)(F.lds + 65536);
    LAS float* bup = (LAS float*)(F.lds + 65536 + 16384);
    for (int idx = tid; idx < 16384; idx += 512) { const int k = idx >> 4, r = idx & 15; wlo[r * 1024 + k] = F.w_in[(size_t)k * INW + 1536 + r]; }
    for (int idx = tid; idx < 4096; idx += 512) wup[idx] = F.w_gk_up[idx];
    if (tid < 256) bup[tid] = F.b_gk_up[tid];
    { const int gt = F.vcu * 512 + tid; if (gt < 4 * 6144 / 4) { const int i = gt * 4, b = i / 6144, col = i % 6144; *(f32x4*)(wsp<float>(F, WS_MOD) + i) = mod_from_partials(F, b, col); } }
    __syncthreads();
    const int gw = F.vcu * NWAVES + F.wave, NGW = F.G * NWAVES;
    const int rpw = (T + NGW - 1) / NGW;
    int curb = -1; f32x4 gsc[4], shv[4];
    for (int i = 0; i < rpw; ++i) {
        const int m = gw * rpw + i; if (m >= T) break;
        const int b = m / SEQ;
        if (b != curb) { curb = b;
#pragma unroll
            for (int j = 0; j < 4; ++j) { const int col = 256 * j + 4 * lane; const f32x4 g = *(const f32x4*)(F.g_norm1 + col);
                shv[j] = mod_from_partials(F, b, col); gsc[j] = g * (mod_from_partials(F, b, 1024 + col) + 1.0f); } }
        const GAS f32x4* xr = (const GAS f32x4*)(F.x + (size_t)m * D) + lane;
        f32x4 v[4]; float s = 0.f;
#pragma unroll
        for (int j = 0; j < 4; ++j) { v[j] = xr[64 * j]; s += (v[j].x * v[j].x + v[j].y * v[j].y) + (v[j].z * v[j].z + v[j].w * v[j].w); }
        const float rstd = rsqrtf(wave_sum(s) * (1.f / D) + EPS);
        GAS v2u* o8 = (GAS v2u*)(wsp<bf16>(F, WS_XN) + (size_t)m * D) + lane;
#pragma unroll
        for (int j = 0; j < 4; ++j) { v[j] = v[j] * rstd * gsc[j] + shv[j]; v2u o; o.x = pk2(v[j].x, v[j].y); o.y = pk2(v[j].z, v[j].w); o8[64 * j] = o; }
        float part[16];
#pragma unroll
        for (int r = 0; r < 16; ++r) { float a = 0.f;
#pragma unroll
            for (int j = 0; j < 4; ++j) { const f32x4 w = *(const LAS f32x4*)(wlo + r * 1024 + 256 * j + 4 * lane); a += (v[j].x * w.x + v[j].y * w.y) + (v[j].z * w.z + v[j].w * w.w); }
            part[r] = wave_sum(a); }
        f32x4 z = *(const LAS f32x4*)(bup + 4 * lane);
#pragma unroll
        for (int r = 0; r < 16; ++r) z += *(const LAS f32x4*)(wup + r * 256 + 4 * lane) * part[r];
        f32x4 gk;
#pragma unroll
        for (int q = 0; q < 4; ++q) { const float zz = z[q]; gk[q] = (fminf(zz, 0.f) - log1pf(__expf(-fabsf(zz)))) * (1.f / 16.f); }
        *(GAS f32x4*)(wsp<float>(F, WS_GK) + (size_t)m * 256 + 4 * lane) = gk;
    }
}

using pg8::Unit;
typedef pg8::f32x4 af4;
struct EpiInProj {
    static constexpr bool PERM = true;
    bf16 *QG, *KG, *VG, *RG, *QD, *KD, *VD; const float *gq, *gk;
    __device__ __forceinline__ void operator()(const af4 (&acc)[2][2][4][2], const Unit& u, int wr, int wc, int fr, int fq) const {
        const int pn = u.pn; const int row0 = u.pm * 256 + wr * 64 + fr;
        if (pn >= 6 && pn < 10) {
            const bool isq = pn < 8; bf16* base = isq ? QD : KD; const float* g = isq ? gq : gk; const float sc = isq ? C2 : 1.f;
            const int grp = 4 * ((pn - 6) & 1) + wc;
            af4 gv[2][2];
#pragma unroll
            for (int bj = 0; bj < 2; ++bj)
#pragma unroll
                for (int n = 0; n < 2; ++n) gv[bj][n] = *(const af4*)(g + 32 * bj + 8 * fq + 4 * n) * sc;
#pragma unroll
            for (int ai = 0; ai < 2; ++ai)
#pragma unroll
                for (int m = 0; m < 4; ++m) {
                    float ss = 0.f;
#pragma unroll
                    for (int bj = 0; bj < 2; ++bj)
#pragma unroll
                        for (int n = 0; n < 2; ++n) { const af4 v = acc[ai][bj][m][n]; ss += (v[0] * v[0] + v[1] * v[1]) + (v[2] * v[2] + v[3] * v[3]); }
                    ss += __shfl_xor(ss, 16); ss += __shfl_xor(ss, 32);
                    const float rs = rsqrtf(ss * (1.f / 64.f) + EPS);
                    bf16* rowp = base + (size_t)(row0 + ai * 128 + m * 16) * 512 + grp * 64 + 8 * fq;
#pragma unroll
                    for (int bj = 0; bj < 2; ++bj) { const af4 v0 = acc[ai][bj][m][0] * rs * gv[bj][0], v1 = acc[ai][bj][m][1] * rs * gv[bj][1];
                        pg8::u32x4 w; w.x = pg8::cvt_pk_bf16(v0[0], v0[1]); w.y = pg8::cvt_pk_bf16(v0[2], v0[3]); w.z = pg8::cvt_pk_bf16(v1[0], v1[1]); w.w = pg8::cvt_pk_bf16(v1[2], v1[3]);
                        *(pg8::u32x4*)(rowp + 32 * bj) = w; }
                }
        } else {
            bf16* base; int pitch, colt; int act = 0;
            if (pn == 0) { base = QG; pitch = 256; colt = 0; act = 1; }
            else if (pn == 1) { base = KG; pitch = 256; colt = 0; }
            else if (pn < 4) { base = VG; pitch = 512; colt = (pn - 2) * 256; }
            else if (pn < 6) { base = RG; pitch = 512; colt = (pn - 4) * 256; act = 2; }
            else { base = VD; pitch = 512; colt = (pn - 10) * 256; }
            const int col0 = colt + wc * 32 + 8 * fq;
#pragma unroll
            for (int ai = 0; ai < 2; ++ai)
#pragma unroll
                for (int m = 0; m < 4; ++m) { bf16* rowp = base + (size_t)(row0 + ai * 128 + m * 16) * pitch + col0;
#pragma unroll
                    for (int bj = 0; bj < 2; ++bj) { af4 v0 = acc[ai][bj][m][0], v1 = acc[ai][bj][m][1];
                        if (act == 1) { v0 = v0 * 0.125f; v1 = v1 * 0.125f; }
                        if (act == 2) {
#pragma unroll
                            for (int q = 0; q < 4; ++q) { v0[q] = v0[q] * sigmoidf_(v0[q]); v1[q] = v1[q] * sigmoidf_(v1[q]); } }
                        pg8::u32x4 w; w.x = pg8::cvt_pk_bf16(v0[0], v0[1]); w.y = pg8::cvt_pk_bf16(v0[2], v0[3]); w.z = pg8::cvt_pk_bf16(v1[0], v1[1]); w.w = pg8::cvt_pk_bf16(v1[2], v1[3]);
                        *(pg8::u32x4*)(rowp + bj * 128) = w; } }
        }
    }
};
struct EpiOutProj {
    static constexpr bool PERM = false;
    const float* x; float* out; const float* mod;
    __device__ __forceinline__ void operator()(const af4 (&acc)[2][2][4][2], const Unit& u, int wr, int wc, int fr, int fq) const {
        const int b = (u.pm * 256) / SEQ; const int col0 = u.pn * 256 + wc * 32 + 4 * fq;
        af4 gt[2][2];
#pragma unroll
        for (int bj = 0; bj < 2; ++bj)
#pragma unroll
            for (int n = 0; n < 2; ++n) gt[bj][n] = *(const af4*)(mod + (size_t)b * 6144 + 2048 + col0 + bj * 128 + n * 16);
#pragma unroll
        for (int ai = 0; ai < 2; ++ai)
#pragma unroll
            for (int m = 0; m < 4; ++m) { const size_t off = (size_t)(u.pm * 256 + ai * 128 + wr * 64 + m * 16 + fr) * D + col0;
#pragma unroll
                for (int bj = 0; bj < 2; ++bj)
#pragma unroll
                    for (int n = 0; n < 2; ++n) { const af4 xv = *(const af4*)(x + off + bj * 128 + n * 16); *(af4*)(out + off + bj * 128 + n * 16) = xv + gt[bj][n] * acc[ai][bj][m][n]; }
                if (m & 1) asm volatile("" ::: "memory"); }
    }
};
struct EpiSwiGLU {
    static constexpr bool PERM = true;
    bf16* Y; const float* bgu;
    __device__ __forceinline__ void operator()(const af4 (&acc)[2][2][4][2], const Unit& u, int wr, int wc, int fr, int fq) const {
        const int f0 = u.pn * 128 + wc * 32 + 8 * fq; const float* bb = bgu + (size_t)u.e * 2048 + f0;
        af4 bg[2], bu[2];
#pragma unroll
        for (int n = 0; n < 2; ++n) { bg[n] = *(const af4*)(bb + 4 * n); bu[n] = *(const af4*)(bb + 1024 + 4 * n); }
#pragma unroll
        for (int ai = 0; ai < 2; ++ai)
#pragma unroll
            for (int m = 0; m < 4; ++m) { bf16* rowp = Y + (size_t)(u.pm * 256 + ai * 128 + wr * 64 + m * 16 + fr) * FF + f0;
                af4 y[2];
#pragma unroll
                for (int n = 0; n < 2; ++n) { const af4 g = acc[ai][0][m][n] + bg[n], up = acc[ai][1][m][n] + bu[n];
#pragma unroll
                    for (int q = 0; q < 4; ++q) { const float gg = fminf(g[q], 7.f), uu = fminf(fmaxf(up[q], -7.f), 7.f); y[n][q] = (uu + 1.f) * gg * sigmoidf_(1.702f * gg); } }
                pg8::u32x4 w; w.x = pg8::cvt_pk_bf16(y[0][0], y[0][1]); w.y = pg8::cvt_pk_bf16(y[0][2], y[0][3]); w.z = pg8::cvt_pk_bf16(y[1][0], y[1][1]); w.w = pg8::cvt_pk_bf16(y[1][2], y[1][3]);
                *(pg8::u32x4*)rowp = w; }
    }
};
struct EpiDown {
    static constexpr bool PERM = true;
    bf16* Cn; const float* bd; const float* roww;
    __device__ __forceinline__ void operator()(const af4 (&acc)[2][2][4][2], const Unit& u, int wr, int wc, int fr, int fq) const {
        const int col0 = u.pn * 256 + wc * 32 + 8 * fq; const float* bb = bd + (size_t)u.e * 1024 + col0;
        af4 bv[2][2];
#pragma unroll
        for (int bj = 0; bj < 2; ++bj)
#pragma unroll
            for (int n = 0; n < 2; ++n) bv[bj][n] = *(const af4*)(bb + bj * 128 + 4 * n);
#pragma unroll
        for (int ai = 0; ai < 2; ++ai)
#pragma unroll
            for (int m = 0; m < 4; ++m) { const int row = u.pm * 256 + ai * 128 + wr * 64 + m * 16 + fr; const float rw = roww[row]; bf16* rowp = Cn + (size_t)row * 1024 + col0;
#pragma unroll
                for (int bj = 0; bj < 2; ++bj) { const af4 v0 = (acc[ai][bj][m][0] + bv[bj][0]) * rw, v1 = (acc[ai][bj][m][1] + bv[bj][1]) * rw;
                    pg8::u32x4 w; w.x = pg8::cvt_pk_bf16(v0[0], v0[1]); w.y = pg8::cvt_pk_bf16(v0[2], v0[3]); w.z = pg8::cvt_pk_bf16(v1[0], v1[1]); w.w = pg8::cvt_pk_bf16(v1[2], v1[3]);
                    *(pg8::u32x4*)(rowp + bj * 128) = w; } }
    }
};

typedef float cf4 __attribute__((ext_vector_type(4)));
#define MFMA16(a, b, c) __builtin_amdgcn_mfma_f32_16x16x32_bf16((a), (b), (c), 0, 0, 0)
constexpr int GP = 72;
__device__ __forceinline__ void gla_a_unit(Frame& F, int chunk) {
    const int tid = F.tid, lane = F.lane, w = F.wave;
    const int bh = chunk >> 7, n = chunk & 127, b = bh >> 2, h = bh & 3;
    const size_t R0 = (size_t)b * SEQ + (size_t)n * 64;
    LAS float* gc = (LAS float*)F.lds;
    LAS float* segt = (LAS float*)(F.lds + 16384);
    LAS bf16* QEs = (LAS bf16*)(F.lds + 18432);
    LAS bf16* KEs = (LAS bf16*)(F.lds + 18432 + 9216);
    LAS bf16* KST = (LAS bf16*)(F.lds + 18432 + 2 * 9216);
    LAS bf16* VT = (LAS bf16*)(F.lds + 18432 + 3 * 9216);
    LAS bf16* AM = (LAS bf16*)(F.lds + 18432 + 3 * 9216 + 18432);
    const float* GK = wsp<const float>(F, WS_GK);
    { const int r = tid >> 3, d0 = (tid & 7) * 8; const float* gp = GK + (R0 + r) * 256 + h * 64 + d0;
      *(LAS f32x4*)(gc + r * 64 + d0) = *(const f32x4*)gp; *(LAS f32x4*)(gc + r * 64 + d0 + 4) = *(const f32x4*)(gp + 4); }
    __syncthreads();
    { const int seg = tid >> 6, d = tid & 63; float run = 0.f;
#pragma unroll
      for (int i = 0; i < 8; ++i) { run += gc[(seg * 8 + i) * 64 + d]; gc[(seg * 8 + i) * 64 + d] = run; }
      segt[seg * 64 + d] = run; }
    __syncthreads();
    { const int seg = tid >> 6, d = tid & 63; float off = 0.f;
      for (int s2 = 0; s2 < seg; ++s2) off += segt[s2 * 64 + d];
#pragma unroll
      for (int i = 0; i < 8; ++i) gc[(seg * 8 + i) * 64 + d] += off; }
    __syncthreads();
    { const int r = tid >> 3, d0 = (tid & 7) * 8;
      const v4u qv = *(const v4u*)(wsp<const bf16>(F, WS_QG) + (R0 + r) * 256 + h * 64 + d0);
      const v4u kv = *(const v4u*)(wsp<const bf16>(F, WS_KG) + (R0 + r) * 256 + h * 64 + d0);
      float qf[8], kf[8];
#pragma unroll
      for (int i = 0; i < 4; ++i) { qf[2 * i] = bflo(qv[i]); qf[2 * i + 1] = bfhi(qv[i]); kf[2 * i] = bflo(kv[i]); kf[2 * i + 1] = bfhi(kv[i]); }
      float qe[8], ke[8];
#pragma unroll
      for (int i = 0; i < 8; ++i) { const float g = gc[r * 64 + d0 + i], gl = gc[63 * 64 + d0 + i];
          qe[i] = qf[i] * __expf(g); ke[i] = kf[i] * __expf(-g); KST[(d0 + i) * GP + r] = (bf16)f2bf(kf[i] * __expf(gl - g)); }
      v4u qo, ko;
#pragma unroll
      for (int i = 0; i < 4; ++i) { qo[i] = pk2(qe[2 * i], qe[2 * i + 1]); ko[i] = pk2(ke[2 * i], ke[2 * i + 1]); }
      *(LAS v4u*)(QEs + r * GP + d0) = qo; *(LAS v4u*)(KEs + r * GP + d0) = ko;
      *(v4u*)(wsp<bf16>(F, WS_QE) + (R0 + r) * 256 + h * 64 + d0) = qo;
      const int e0 = (tid & 7) * 16;
      const v4u va = *(const v4u*)(wsp<const bf16>(F, WS_VG) + (R0 + r) * 512 + h * 128 + e0);
      const v4u vb = *(const v4u*)(wsp<const bf16>(F, WS_VG) + (R0 + r) * 512 + h * 128 + e0 + 8);
#pragma unroll
      for (int i = 0; i < 4; ++i) { VT[(e0 + 2 * i) * GP + r] = (bf16)(va[i] & 0xffffu); VT[(e0 + 2 * i + 1) * GP + r] = (bf16)(va[i] >> 16);
                                    VT[(e0 + 8 + 2 * i) * GP + r] = (bf16)(vb[i] & 0xffffu); VT[(e0 + 8 + 2 * i + 1) * GP + r] = (bf16)(vb[i] >> 16); }
      if (tid < 64) wsp<float>(F, WS_DEC)[(size_t)chunk * 64 + tid] = __expf(gc[63 * 64 + tid]);
    }
    __syncthreads();
    const int l15 = lane & 15, l4 = lane >> 4;
#pragma unroll
    for (int q = 0; q < 2; ++q) { const int tile = 2 * w + q, ti = tile >> 2, tj = tile & 3;
        cf4 a = {0.f, 0.f, 0.f, 0.f};
        if (tj <= ti) {
#pragma unroll
            for (int kk = 0; kk < 2; ++kk) { const bf16x8 fa = *(const LAS bf16x8*)(QEs + (16 * ti + l15) * GP + kk * 32 + 8 * l4); const bf16x8 fb = *(const LAS bf16x8*)(KEs + (16 * tj + l15) * GP + kk * 32 + 8 * l4); a = MFMA16(fa, fb, a); } }
#pragma unroll
        for (int r = 0; r < 4; ++r) { const int cr = 16 * ti + 4 * l4 + r, cj = 16 * tj + l15; AM[cr * GP + cj] = (bf16)f2bf(cj <= cr ? a[r] : 0.f); } }
    { float* UT = wsp<float>(F, WS_UT) + (size_t)chunk * 8192;
#pragma unroll
      for (int td = 0; td < 4; ++td) { cf4 a = {0.f, 0.f, 0.f, 0.f};
#pragma unroll
          for (int kk = 0; kk < 2; ++kk) { const bf16x8 fa = *(const LAS bf16x8*)(VT + (16 * w + l15) * GP + kk * 32 + 8 * l4); const bf16x8 fb = *(const LAS bf16x8*)(KST + (16 * td + l15) * GP + kk * 32 + 8 * l4); a = MFMA16(fa, fb, a); }
#pragma unroll
          for (int r = 0; r < 4; ++r) UT[(16 * w + 4 * l4 + r) * 64 + 16 * td + l15] = a[r]; } }
    __syncthreads();
    { float* OI = wsp<float>(F, WS_OI);
#pragma unroll
      for (int tc = 0; tc < 4; ++tc) { cf4 a = {0.f, 0.f, 0.f, 0.f};
#pragma unroll
          for (int kk = 0; kk < 2; ++kk) { const bf16x8 fa = *(const LAS bf16x8*)(AM + (16 * tc + l15) * GP + kk * 32 + 8 * l4); const bf16x8 fb = *(const LAS bf16x8*)(VT + (16 * w + l15) * GP + kk * 32 + 8 * l4); a = MFMA16(fa, fb, a); }
#pragma unroll
          for (int r = 0; r < 4; ++r) OI[(R0 + 16 * tc + 4 * l4 + r) * 512 + h * 128 + 16 * w + l15] = a[r]; } }
    __syncthreads();
}
__device__ __forceinline__ void gla_b_phase(Frame& F) {
    const float* UT = wsp<const float>(F, WS_UT); const float* DEC = wsp<const float>(F, WS_DEC); bf16* SP = wsp<bf16>(F, WS_SP);
    for (int gt = F.vcu * 512 + F.tid; gt < 16 * 8192; gt += F.G * 512) {
        const int bh = gt >> 13, ed = gt & 8191, d = gt & 63; float S = 0.f;
#pragma unroll 8
        for (int n = 0; n < 128; ++n) { const size_t ch = (size_t)bh * 128 + n; const float u = UT[ch * 8192 + ed], dc = DEC[ch * 64 + d]; SP[ch * 8192 + ed] = (bf16)f2bf(S); S = S * dc + u; }
    }
}
__device__ __forceinline__ void gla_c_unit(Frame& F, int unit) {
    const int tid = F.tid, lane = F.lane, w = F.wave;
    const int bh = unit >> 6, n2 = unit & 63, b = bh >> 2, h = bh & 3;
    const size_t R0 = (size_t)b * SEQ + (size_t)n2 * 128;
    LAS bf16* QEs = (LAS bf16*)F.lds;
    LAS bf16* SPs = (LAS bf16*)(F.lds + 18432);
    { const int r = tid >> 2, d0 = (tid & 3) * 16; const bf16* src = wsp<const bf16>(F, WS_QE) + (R0 + r) * 256 + h * 64 + d0;
      *(LAS v4u*)(QEs + r * GP + d0) = *(const v4u*)src; *(LAS v4u*)(QEs + r * GP + d0 + 8) = *(const v4u*)(src + 8);
      const bf16* sp = wsp<const bf16>(F, WS_SP) + ((size_t)bh * 128 + 2 * n2) * 8192;
      const int row = tid >> 1, dd = (tid & 1) * 32;
#pragma unroll
      for (int i = 0; i < 4; ++i) *(LAS v4u*)(SPs + row * GP + dd + 8 * i) = *(const v4u*)(sp + (size_t)row * 64 + dd + 8 * i); }
    __syncthreads();
    const int l15 = lane & 15, l4 = lane >> 4, c2 = w >> 2, tc = w & 3;
    cf4 a[8];
#pragma unroll
    for (int te = 0; te < 8; ++te) { a[te] = (cf4){0.f, 0.f, 0.f, 0.f};
#pragma unroll
        for (int kk = 0; kk < 2; ++kk) { const bf16x8 fa = *(const LAS bf16x8*)(QEs + (64 * c2 + 16 * tc + l15) * GP + kk * 32 + 8 * l4); const bf16x8 fb = *(const LAS bf16x8*)(SPs + (128 * c2 + 16 * te + l15) * GP + kk * 32 + 8 * l4); a[te] = MFMA16(fa, fb, a[te]); } }
    const float* OI = wsp<const float>(F, WS_OI); const bf16* RG = wsp<const bf16>(F, WS_RG); bf16* A2 = wsp<bf16>(F, WS_A2);
    float gg[8];
#pragma unroll
    for (int te = 0; te < 8; ++te) gg[te] = F.g_gla_out[16 * te + l15];
#pragma unroll
    for (int r = 0; r < 4; ++r) { const size_t row = R0 + 64 * c2 + 16 * tc + 4 * l4 + r; float ss = 0.f; float o[8];
#pragma unroll
        for (int te = 0; te < 8; ++te) { o[te] = a[te][r] + OI[row * 512 + h * 128 + 16 * te + l15]; ss += o[te] * o[te]; }
        ss += __shfl_xor(ss, 1); ss += __shfl_xor(ss, 2); ss += __shfl_xor(ss, 4); ss += __shfl_xor(ss, 8);
        const float rs = rsqrtf(ss * (1.f / 128.f) + EPS);
#pragma unroll
        for (int te = 0; te < 8; ++te) { const int e = 16 * te + l15; A2[row * 1024 + h * 128 + e] = (bf16)f2bf(o[te] * rs * gg[te] * bf2f(RG[row * 512 + h * 128 + e])); } }
    __syncthreads();
}

namespace att {
constexpr int KSLOT = 8192, VSLOT = 16384, NSLOT = 3;
constexpr int LDS_K = 0, LDS_V = NSLOT * KSLOT, LDS_TBL = LDS_V + NSLOT * VSLOT, LDS_WS = LDS_TBL + 1024, LDS_END = LDS_WS + 8 * 256;
__device__ __forceinline__ int crow(int r, int hi) { return (r & 3) + 8 * (r >> 2) + 4 * hi; }
__device__ __forceinline__ void glds16(const void* gsrc, unsigned lds_dst) { unsigned keep;
    asm volatile("s_mov_b32 %0, m0\n\ts_mov_b32 m0, %2\n\ts_nop 0\n\tglobal_load_lds_dwordx4 %1, off\n\ts_mov_b32 m0, %0" : "=&s"(keep) : "v"(gsrc), "s"(lds_dst) : "memory"); }
typedef float f32x2_t __attribute__((ext_vector_type(2))); typedef __bf16 bf16x2_t __attribute__((ext_vector_type(2)));
__device__ __forceinline__ unsigned cvtpk_s(float lo, float hi) { f32x2_t v = {lo, hi}; bf16x2_t b = __builtin_convertvector(v, bf16x2_t); return __builtin_bit_cast(unsigned, b); }
typedef short v4i16_t __attribute__((ext_vector_type(4)));
typedef LAS const char* lds_cptr;
__device__ __forceinline__ s16x4 vtr(lds_cptr p) { return __builtin_bit_cast(s16x4, __builtin_amdgcn_ds_read_tr16_b64_v4i16((LAS v4i16_t*)p)); }
#define MFMA32(a, b, c) __builtin_amdgcn_mfma_f32_32x32x16_bf16((a), (b), (c), 0, 0, 0)
#define ATT_WAIT_BAR(N) asm volatile("s_waitcnt vmcnt(" #N ") lgkmcnt(0)\n\ts_barrier" ::: "memory")

__device__ __forceinline__ void attn_map(f32x16 (&o)[4], int b, int h, int m, int qb, const bf16* QD, const bf16* KD, const bf16* VD, LAS unsigned char* shm) {
    const int tid = threadIdx.x, lane = tid & 63, r32 = lane & 31, hi = lane >> 5; const int wid = __builtin_amdgcn_readfirstlane(tid >> 6);
    const size_t rowbase = (size_t)b * SEQ; const int q0 = qb * 256;
    const bf16* Qw = QD + (rowbase + q0 + wid * 32) * 512 + (h * 2 + m) * 64;
    const bf16* Kh = KD + rowbase * 512 + (h * 2 + m) * 64; const bf16* Vh = VD + rowbase * 512 + h * 128;
    const unsigned lds0 = (unsigned)(uintptr_t)shm;
    const LAS float* tbl = (const LAS float*)(shm + LDS_TBL) + m * 128;
    LAS float* wsf = (LAS float*)(shm + LDS_WS) + wid * 64;
    const bf16* ksrc = Kh + (size_t)lane * 512 + wid * 8;
    const bf16* vsrc = Vh + (size_t)(16 * (wid & 3) + (lane >> 2)) * 512 + (wid >> 2) * 32 + (lane & 3) * 8;
    const unsigned kdst = lds0 + LDS_K + wid * 1024, vdst = lds0 + LDS_V + wid * 1024;
#define DMA_KV(t, slot) do { glds16(ksrc + (size_t)(t) * 64 * 512, (unsigned)__builtin_amdgcn_readfirstlane(kdst + (slot) * KSLOT)); \
        glds16(vsrc + (size_t)(t) * 64 * 512, (unsigned)__builtin_amdgcn_readfirstlane(vdst + (slot) * VSLOT)); \
        glds16(vsrc + (size_t)(t) * 64 * 512 + 64, (unsigned)__builtin_amdgcn_readfirstlane(vdst + (slot) * VSLOT + 8192)); } while (0)
    const int NT = 4 * qb + 4;
    VM_WAIT();
    DMA_KV(0, 0); DMA_KV(1, 1);
    bf16x8 qr[4];
#pragma unroll
    for (int d0 = 0; d0 < 4; ++d0) qr[d0] = *(const bf16x8*)(Qw + (size_t)r32 * 512 + d0 * 16 + hi * 8);
    asm volatile("s_waitcnt vmcnt(0)" : "+v"(qr[0]), "+v"(qr[1]), "+v"(qr[2]), "+v"(qr[3]) :: "memory");
#pragma unroll
    for (int d0 = 0; d0 < 4; ++d0) o[d0] = (f32x16){};
    float lsum = 0.f;
    const int qw0 = q0 + wid * 32, qabs = qw0 + r32;
    const lds_cptr shm3 = (lds_cptr)shm;
    const lds_cptr kp0 = shm3 + LDS_K + hi * 1024 + r32 * 16;
    const lds_cptr vp0 = shm3 + LDS_V + ((lane >> 4) & 1) * 32 + (lane & 3) * 8 + (4 * hi + ((lane & 15) >> 2)) * 64;
    int slot = 0;
    for (int t = 0; t < NT; ++t) {
        if (t + 1 < NT) { ATT_WAIT_BAR(3); } else { ATT_WAIT_BAR(0); }
        if (t + 2 < NT) { const int s2 = (slot == 0) ? 2 : slot - 1; DMA_KV(t + 2, s2); }
        const lds_cptr kp = kp0 + slot * KSLOT; const lds_cptr vp = vp0 + slot * VSLOT;
        f32x16 p0 = (f32x16){}, p1 = (f32x16){};
#pragma unroll
        for (int d0 = 0; d0 < 4; ++d0) { const bf16x8 b0 = *(const LAS bf16x8*)(kp + d0 * 2048); const bf16x8 b1 = *(const LAS bf16x8*)(kp + d0 * 2048 + 512);
            p0 = MFMA32(b0, qr[d0], p0); p1 = MFMA32(b1, qr[d0], p1); }
        const int kvb = t * 64;
        if (kvb + 191 > qw0) {
            int dbase = qabs - kvb - 4 * hi; asm volatile("" : "+v"(dbase));
#pragma unroll
            for (int r = 0; r < 16; ++r) { const int d0_ = dbase - ((r & 3) + 8 * (r >> 2)); const int d1_ = d0_ - 32;
                p0[r] = d0_ < 0 ? -INFINITY : p0[r] + tbl[d0_ > 127 ? 127 : d0_];
                p1[r] = d1_ < 0 ? -INFINITY : p1[r] + tbl[d1_ > 127 ? 127 : d1_]; }
        }
        float sacc = 0.f;
#pragma unroll
        for (int r = 0; r < 16; ++r) { p0[r] = __builtin_amdgcn_exp2f(p0[r]); p1[r] = __builtin_amdgcn_exp2f(p1[r]); sacc += p0[r] + p1[r]; }
        lsum += sacc;
        v4u pw[4];
#pragma unroll
        for (int i = 0; i < 4; ++i) { pw[0][i] = cvtpk_s(p0[2 * i], p0[2 * i + 1]); pw[1][i] = cvtpk_s(p0[8 + 2 * i], p0[9 + 2 * i]); pw[2][i] = cvtpk_s(p1[2 * i], p1[2 * i + 1]); pw[3][i] = cvtpk_s(p1[8 + 2 * i], p1[9 + 2 * i]); }
        __builtin_amdgcn_sched_barrier(0);
#pragma unroll
        for (int d0 = 0; d0 < 4; ++d0) {
            bf16x8 vf[4];
#pragma unroll
            for (int ks = 0; ks < 4; ++ks) { const s16x4 lo = vtr(vp + d0 * 4096 + ks * 1024), hh = vtr(vp + d0 * 4096 + ks * 1024 + 512);
                vf[ks] = (bf16x8){lo[0], lo[1], lo[2], lo[3], hh[0], hh[1], hh[2], hh[3]}; }
#pragma unroll
            for (int ks = 0; ks < 4; ++ks) o[d0] = MFMA32(__builtin_bit_cast(bf16x8, pw[ks]), vf[ks], o[d0]);
            __builtin_amdgcn_sched_barrier(0);
        }
        slot = (slot == 2) ? 0 : slot + 1;
    }
    { auto rr = __builtin_amdgcn_permlane32_swap(__float_as_uint(lsum), __float_as_uint(lsum), false, false); lsum = __uint_as_float(rr[0]) + __uint_as_float(rr[1]); }
    if (hi == 0) wsf[r32] = lsum;
    LDS_WAIT();
#pragma unroll
    for (int r = 0; r < 16; ++r) { const float rl = 1.0f / wsf[crow(r, hi)];
#pragma unroll
        for (int d0 = 0; d0 < 4; ++d0) o[d0][r] *= rl; }
    ATT_WAIT_BAR(0);
#undef DMA_KV
}
__device__ __forceinline__ int t5_bucket(int n) {
    if (n < 16) return n;
    const float nf = (float)n; int large = 16 + (int)(logf(nf / 16.f) / logf(8.f) * 16.f);
    return large < 31 ? large : 31;
}
__device__ __forceinline__ void attn_unit(Frame& F, int b, int h, int qb, float lam) {
    LAS unsigned char* shm = F.lds;
    const int tid = F.tid, lane = F.lane, r32 = lane & 31, hi = lane >> 5, wid = F.wave;
    if (tid < 256) { const int m = tid >> 7, d = tid & 127; const int col = h * 2 + m;
        ((LAS float*)(shm + LDS_TBL))[tid] = (F.rel_bias[t5_bucket(d) * 8 + col] - F.rel_bias[31 * 8 + col]) * LOG2E; }
    __syncthreads();
    const bf16* QD = wsp<const bf16>(F, WS_QD); const bf16* KD = wsp<const bf16>(F, WS_KD); const bf16* VD = wsp<const bf16>(F, WS_VD);
    float* stash = wsp<float>(F, WS_STASH) + (size_t)F.vcu * 32768 + tid * 64;
    f32x16 o[4];
    attn_map(o, b, h, 0, qb, QD, KD, VD, shm);
#pragma unroll
    for (int d0 = 0; d0 < 4; ++d0)
#pragma unroll
        for (int r = 0; r < 16; r += 4) *(f32x4*)(stash + d0 * 16 + r) = (f32x4){o[d0][r], o[d0][r + 1], o[d0][r + 2], o[d0][r + 3]};
    attn_map(o, b, h, 1, qb, QD, KD, VD, shm);
    float ss[16];
#pragma unroll
    for (int r = 0; r < 16; ++r) ss[r] = 0.f;
#pragma unroll
    for (int d0 = 0; d0 < 4; ++d0)
#pragma unroll
        for (int r4 = 0; r4 < 16; r4 += 4) { const f32x4 sv = *(const f32x4*)(stash + d0 * 16 + r4);
#pragma unroll
            for (int q = 0; q < 4; ++q) { const int r = r4 + q; const float v = sv[q] - lam * o[d0][r]; o[d0][r] = v; ss[r] += v * v; } }
    float gs[4];
#pragma unroll
    for (int d0 = 0; d0 < 4; ++d0) gs[d0] = F.g_subln[32 * d0 + r32] * 0.8f;
    bf16* A2 = wsp<bf16>(F, WS_A2);
    const size_t rowb = (size_t)b * SEQ + (size_t)qb * 256 + wid * 32;
    bf16* a2b = A2 + (rowb + 4 * hi) * 1024 + 512 + h * 128 + r32; asm volatile("" : "+v"(a2b));
#pragma unroll
    for (int r = 0; r < 16; ++r) { float s = ss[r];
        s += __shfl_xor(s, 1); s += __shfl_xor(s, 2); s += __shfl_xor(s, 4); s += __shfl_xor(s, 8); s += __shfl_xor(s, 16);
        const float rs = rsqrtf(s * (1.f / 128.f) + EPS);
        bf16* rowp = a2b + (size_t)((r & 3) + 8 * (r >> 2)) * 1024;
#pragma unroll
        for (int d0 = 0; d0 < 4; ++d0) rowp[32 * d0] = (bf16)f2bf(o[d0][r] * rs * gs[d0]); }
    __syncthreads();
}
}

__device__ __forceinline__ void p7_phase(Frame& F) {
    const int tid = F.tid, lane = F.lane;
    LAS float* wr = (LAS float*)F.lds;
    LAS unsigned* hist = (LAS unsigned*)(F.lds + HIST_OFF);
    for (int idx = tid; idx < 32768; idx += 512) { const int k = idx >> 5, e = idx & 31; wr[e * 1024 + k] = F.w_router[idx]; }
    if (tid < 32) hist[tid] = 0u;
    __syncthreads();
    const float* MOD = wsp<const float>(F, WS_MOD);
    const int gw = F.vcu * NWAVES + F.wave, NGW = F.G * NWAVES; const int rpw = (T + NGW - 1) / NGW;
    int curb = -1; f32x4 gsc[4], shv[4];
    for (int i = 0; i < rpw; ++i) {
        const int m = gw * rpw + i; if (m >= T) break;
        const int b = m / SEQ;
        if (b != curb) { curb = b;
#pragma unroll
            for (int j = 0; j < 4; ++j) { const int col = 256 * j + 4 * lane; const f32x4 g = *(const f32x4*)(F.g_norm2 + col);
                shv[j] = *(const f32x4*)(MOD + (size_t)b * 6144 + 3072 + col); gsc[j] = g * (*(const f32x4*)(MOD + (size_t)b * 6144 + 4096 + col) + 1.0f); } }
        const GAS f32x4* xr = (const GAS f32x4*)(F.out + (size_t)m * D) + lane;
        f32x4 v[4]; float s = 0.f;
#pragma unroll
        for (int j = 0; j < 4; ++j) { v[j] = xr[64 * j]; s += (v[j].x * v[j].x + v[j].y * v[j].y) + (v[j].z * v[j].z + v[j].w * v[j].w); }
        const float rstd = rsqrtf(wave_sum(s) * (1.f / D) + EPS);
        GAS v2u* o8 = (GAS v2u*)(wsp<bf16>(F, WS_XN) + (size_t)m * D) + lane;
#pragma unroll
        for (int j = 0; j < 4; ++j) { v[j] = v[j] * rstd * gsc[j] + shv[j]; v2u o; o.x = pk2(v[j].x, v[j].y); o.y = pk2(v[j].z, v[j].w); o8[64 * j] = o; }
        float lg[32];
#pragma unroll
        for (int e = 0; e < 32; ++e) { float a = 0.f;
#pragma unroll
            for (int j = 0; j < 4; ++j) { const f32x4 w = *(const LAS f32x4*)(wr + e * 1024 + 256 * j + 4 * lane); a += (v[j].x * w.x + v[j].y * w.y) + (v[j].z * w.z + v[j].w * w.w); }
            lg[e] = wave_sum(a) + F.b_router[e]; }
        int te[4]; float tv[4];
#pragma unroll
        for (int k = 0; k < 4; ++k) { float bv = -INFINITY; int bi = 0;
#pragma unroll
            for (int e = 0; e < 32; ++e) { const bool c = lg[e] > bv; bv = c ? lg[e] : bv; bi = c ? e : bi; }
            te[k] = bi; tv[k] = bv;
#pragma unroll
            for (int e = 0; e < 32; ++e) lg[e] = (e == bi) ? -INFINITY : lg[e]; }
        float ex[4], es = 0.f;
#pragma unroll
        for (int k = 0; k < 4; ++k) { ex[k] = __expf(tv[k] - tv[0]); es += ex[k]; }
        if (lane < 4) { const int e = lane == 0 ? te[0] : lane == 1 ? te[1] : lane == 2 ? te[2] : te[3]; const float w = (lane == 0 ? ex[0] : lane == 1 ? ex[1] : lane == 2 ? ex[2] : ex[3]) / es;
            wsp<int>(F, WS_TOPE)[(size_t)m * 4 + lane] = e; wsp<float>(F, WS_TOPW)[(size_t)m * 4 + lane] = w; __hip_atomic_fetch_add(hist + e, 1u, __ATOMIC_RELAXED, __HIP_MEMORY_SCOPE_WORKGROUP); }
    }
    __syncthreads();
    if (tid < 32) __hip_atomic_fetch_add(F.ctl + CW_CNT + tid, hist[tid], RLX_AGENT);
}
__device__ __forceinline__ void moe_tables(Frame& F, int& nMt) {
    LAS unsigned char* te = F.lds + TILEE_OFF;
    if (F.tid == 0) { int t0 = 0;
        for (int e = 0; e < NE; ++e) { const int c = (int)__hip_atomic_load(F.ctl + CW_CNT + e, RLX_AGENT); const int nt = (c + 255) >> 8; for (int j = 0; j < nt; ++j) te[t0 + j] = (unsigned char)e; t0 += nt; }
        F.MISC[16] = (unsigned)t0; }
    __syncthreads();
    nMt = (int)F.MISC[16];
}
__device__ __forceinline__ void p8_phase(Frame& F) {
    const int tid = F.tid, lane = F.lane;
    LAS unsigned* hist = (LAS unsigned*)(F.lds + HIST_OFF);
    if (tid < 96) hist[tid] = 0u;
    __syncthreads();
    const int gw = F.vcu * NWAVES + F.wave, NGW = F.G * NWAVES; const int rpw = (T + NGW - 1) / NGW;
    const int* TOPE = wsp<const int>(F, WS_TOPE); const float* TOPW = wsp<const float>(F, WS_TOPW);
    for (int i = 0; i < rpw; ++i) { const int m = gw * rpw + i; if (m >= T) break; if (lane < 4) __hip_atomic_fetch_add(hist + TOPE[(size_t)m * 4 + lane], 1u, __ATOMIC_RELAXED, __HIP_MEMORY_SCOPE_WORKGROUP); }
    __syncthreads();
    if (tid < 32) { unsigned pstart = 0; for (int e = 0; e < tid; ++e) { const unsigned c = __hip_atomic_load(F.ctl + CW_CNT + e, RLX_AGENT); pstart += (c + 255u) & ~255u; }
        hist[32 + tid] = pstart + __hip_atomic_fetch_add(F.ctl + CW_FILL + tid, hist[tid], RLX_AGENT); }
    __syncthreads();
    const bf16* H2 = wsp<const bf16>(F, WS_XN); bf16* XS = wsp<bf16>(F, WS_XS);
    for (int i = 0; i < rpw; ++i) { const int m = gw * rpw + i; if (m >= T) break;
        int pos = 0;
        if (lane < 4) { const int e = TOPE[(size_t)m * 4 + lane]; pos = (int)(hist[32 + e] + __hip_atomic_fetch_add(hist + 64 + e, 1u, __ATOMIC_RELAXED, __HIP_MEMORY_SCOPE_WORKGROUP));
            wsp<int>(F, WS_POS)[(size_t)m * 4 + lane] = pos; wsp<float>(F, WS_ROWW)[pos] = TOPW[(size_t)m * 4 + lane]; }
        const v4u a = *(const v4u*)(H2 + (size_t)m * D + lane * 16), c = *(const v4u*)(H2 + (size_t)m * D + lane * 16 + 8);
#pragma unroll
        for (int k = 0; k < 4; ++k) { const int p = __shfl(pos, k); *(v4u*)(XS + (size_t)p * D + lane * 16) = a; *(v4u*)(XS + (size_t)p * D + lane * 16 + 8) = c; }
    }
}
__device__ __forceinline__ void p11_phase(Frame& F) {
    const int lane = F.lane;
    const float* MOD = wsp<const float>(F, WS_MOD); const bf16* CN = wsp<const bf16>(F, WS_XS); const int* POS = wsp<const int>(F, WS_POS);
    const int gw = F.vcu * NWAVES + F.wave, NGW = F.G * NWAVES; const int rpw = (T + NGW - 1) / NGW;
    for (int i = 0; i < rpw; ++i) { const int m = gw * rpw + i; if (m >= T) break;
        const int b = m / SEQ;
        float acc[16];
#pragma unroll
        for (int q = 0; q < 16; ++q) acc[q] = 0.f;
#pragma unroll
        for (int k = 0; k < 4; ++k) { const int p = POS[(size_t)m * 4 + k];
            const v4u a = *(const v4u*)(CN + (size_t)p * D + lane * 16), c = *(const v4u*)(CN + (size_t)p * D + lane * 16 + 8);
#pragma unroll
            for (int q = 0; q < 4; ++q) { acc[2 * q] += bflo(a[q]); acc[2 * q + 1] += bfhi(a[q]); acc[8 + 2 * q] += bflo(c[q]); acc[8 + 2 * q + 1] += bfhi(c[q]); } }
        float* orow = F.out + (size_t)m * D + lane * 16; const float* gt = MOD + (size_t)b * 6144 + 5120 + lane * 16;
#pragma unroll
        for (int q = 0; q < 4; ++q) { const f32x4 xv = *(const f32x4*)(orow + 4 * q), g = *(const f32x4*)(gt + 4 * q); const f32x4 av = {acc[4 * q], acc[4 * q + 1], acc[4 * q + 2], acc[4 * q + 3]};
            *(f32x4*)(orow + 4 * q) = xv + g * av; }
    }
}

constexpr int NPHASE = 12;
struct Args { const float* in[25]; float* out; unsigned char* ws; int ph_lo, ph_hi; };
__global__ void __launch_bounds__(NWAVES * 64, 2) fwd_kernel(Args args) {
    extern __shared__ __attribute__((aligned(16))) unsigned char lds[];
    Frame F;
    F.lds = (LAS unsigned char*)lds;
    F.MISC = (volatile LAS unsigned*)(F.lds + MISC_OFF);
    F.tid = threadIdx.x; F.lane = F.tid & 63; F.wave = __builtin_amdgcn_readfirstlane(F.tid >> 6);
    F.G = gridDim.x; { const int bx = blockIdx.x; F.vcu = (F.G % 8 == 0) ? (bx % 8) * (F.G / 8) + bx / 8 : bx; }
    F.ws = args.ws; F.ctl = (gu32*)(args.ws + WS_CTL); F.out = args.out;
    F.x = args.in[0]; F.c = args.in[1]; F.rel_bias = args.in[2]; F.w_ada = args.in[3]; F.b_ada = args.in[4]; F.g_norm1 = args.in[5]; F.w_in = args.in[6];
    F.w_gk_up = args.in[7]; F.b_gk_up = args.in[8]; F.g_gla_out = args.in[9]; F.g_qnorm = args.in[10]; F.g_knorm = args.in[11];
    F.lq1 = args.in[12]; F.lk1 = args.in[13]; F.lq2 = args.in[14]; F.lk2 = args.in[15]; F.g_subln = args.in[16]; F.w_out = args.in[17];
    F.g_norm2 = args.in[18]; F.w_router = args.in[19]; F.b_router = args.in[20]; F.w_gate_up = args.in[21]; F.b_gate_up = args.in[22]; F.w_down = args.in[23]; F.b_down = args.in[24];
    for (int u = F.tid; u < (LDS_BYTES - LDSCTL_OFF) / 4; u += NWAVES * 64) ((LAS unsigned*)(F.lds + LDSCTL_OFF))[u] = 0u;
    __syncthreads();
    const int lo = args.ph_lo, hi = args.ph_hi;
    const bool multi = (hi - lo) > 1;
    XcdBarrier bar; bar.bar = (unsigned*)(F.ctl + CW_BAR); bar.x = 0; bar.st = nullptr;
    if (multi) bar = xcd_barrier_post((unsigned*)(F.ctl + CW_BAR), F.MISC + 8);
#ifndef PHMASK
#define PHMASK 0xFFF
#endif
#define IN(k) (((PHMASK >> (k)) & 1) && lo <= (k) && (k) < hi)
#define SEAM(k) do { if (IN((k) + 1)) xcd_barrier(bar); } while (0)

    if (IN(0)) { p0_phase(F); SEAM(0); }
    if (IN(1)) { p1_phase(F); SEAM(1); }
    if (IN(2)) {
        pg8::Gemm g{wsp<const bf16>(F, WS_XN), wsp<const bf16>(F, WS_WIN), T, NIN, D, 0};
        pg8::StaticOrder S; S.init(T / 256, NIN / 256, F.G, (int)blockIdx.x, nullptr);
        EpiInProj E{wsp<bf16>(F, WS_QG), wsp<bf16>(F, WS_KG), wsp<bf16>(F, WS_VG), wsp<bf16>(F, WS_RG), wsp<bf16>(F, WS_QD), wsp<bf16>(F, WS_KD), wsp<bf16>(F, WS_VD), F.g_qnorm, F.g_knorm};
        pg8::gemm_phase<EpiInProj, pg8::StaticOrder>(F.lds, g, S, E);
        SEAM(2);
    }
    if (IN(3)) { for (int c = F.vcu; c < NCHUNK; c += F.G) gla_a_unit(F, c); SEAM(3); }
    if (IN(4)) { gla_b_phase(F); SEAM(4); }
    if (IN(5)) {
#ifndef NO_GLAC
        for (int u = F.vcu; u < NCHUNK / 2; u += F.G) gla_c_unit(F, u);
#endif
        float lam;
        { float a1 = F.lq1[F.lane] * F.lk1[F.lane], a2 = F.lq2[F.lane] * F.lk2[F.lane]; a1 = wave_sum(a1); a2 = wave_sum(a2); lam = __expf(a1) - __expf(a2) + 0.2f; }
#ifndef NO_ATT
        for (int p = F.vcu; p < 256; p += F.G) { const int bh = p >> 4, s = p & 15;
            att::attn_unit(F, bh >> 2, bh & 3, 31 - s, lam); att::attn_unit(F, bh >> 2, bh & 3, s, lam); }
#endif
        SEAM(5);
    }
    if (IN(6)) {
        pg8::Gemm g{wsp<const bf16>(F, WS_A2), wsp<const bf16>(F, WS_WOUT), T, D, D, 0};
        pg8::StaticOrder S; S.init(T / 256, D / 256, F.G, (int)blockIdx.x, nullptr);
        EpiOutProj E{F.x, F.out, wsp<const float>(F, WS_MOD)};
        pg8::gemm_phase<EpiOutProj, pg8::StaticOrder>(F.lds, g, S, E);
        SEAM(6);
    }
    if (IN(7)) { p7_phase(F); SEAM(7); }
    if (IN(8)) { p8_phase(F); SEAM(8); }
    if (IN(9)) {
        int nMt; moe_tables(F, nMt);
        pg8::Gemm g{wsp<const bf16>(F, WS_XS), wsp<const bf16>(F, WS_WGU), PMAX, 2048, D, (size_t)2048 * 1024};
        pg8::StaticOrder S; S.init(nMt, 8, F.G, (int)blockIdx.x, F.lds + TILEE_OFF);
        EpiSwiGLU E{wsp<bf16>(F, WS_Y), F.b_gate_up};
        pg8::gemm_phase<EpiSwiGLU, pg8::StaticOrder>(F.lds, g, S, E);
        SEAM(9);
    }
    if (IN(10)) {
        int nMt; moe_tables(F, nMt);
        pg8::Gemm g{wsp<const bf16>(F, WS_Y), wsp<const bf16>(F, WS_WD), PMAX, 1024, FF, (size_t)1024 * 1024};
        pg8::StaticOrder S; S.init(nMt, 4, F.G, (int)blockIdx.x, F.lds + TILEE_OFF);
        EpiDown E{wsp<bf16>(F, WS_XS), F.b_down, wsp<const float>(F, WS_ROWW)};
        pg8::gemm_phase<EpiDown, pg8::StaticOrder>(F.lds, g, S, E);
        SEAM(10);
    }
    if (IN(11)) { p11_phase(F); }
#undef IN
#undef SEAM
}

extern "C" void kernel_launch(void* const* d_in, const int* in_sizes, int n_in, void* d_out, int out_size, void* d_ws, size_t ws_size, hipStream_t stream) {
    static int grid = 0;
    if (grid == 0) {
        if (n_in != 25 || in_sizes[0] != T * D || out_size != T * D || ws_size < WS_END) { fprintf(stderr, "kernel_launch: unexpected shapes (n_in %d, in0 %d, out %d, ws %zu); nothing launched\n", n_in, n_in > 0 ? in_sizes[0] : -1, out_size, ws_size); grid = -1; return; }
        int dev = 0, cus = 0, per_cu = 0;
        if (hipGetDevice(&dev) != hipSuccess || hipDeviceGetAttribute(&cus, hipDeviceAttributeMultiprocessorCount, dev) != hipSuccess) { grid = -1; return; }
        if (hipFuncSetAttribute((const void*)fwd_kernel, hipFuncAttributeMaxDynamicSharedMemorySize, LDS_BYTES) != hipSuccess) { fprintf(stderr, "kernel_launch: hipFuncSetAttribute failed\n"); grid = -1; return; }
        if (hipOccupancyMaxActiveBlocksPerMultiprocessor(&per_cu, (const void*)fwd_kernel, NWAVES * 64, LDS_BYTES) != hipSuccess || per_cu < 1)
            fprintf(stderr, "kernel_launch: note: occupancy query reports %d workgroups per CU\n", per_cu);
        (void)hipGetLastError();
        grid = cus;
    }
    if (grid < 0) return;
    if (hipMemsetAsync((char*)d_ws + WS_CTL, 0, CTL_ZERO_BYTES, stream) != hipSuccess) { fprintf(stderr, "kernel_launch: memset failed\n"); return; }
    Args a{};
    for (int i = 0; i < 25; ++i) a.in[i] = (const float*)d_in[i];
    a.out = (float*)d_out; a.ws = (unsigned char*)d_ws;
#if MK_N_LAUNCHES == 1
    a.ph_lo = 0; a.ph_hi = NPHASE;
    hipLaunchKernelGGL(fwd_kernel, dim3(grid), dim3(NWAVES * 64), LDS_BYTES, stream, a);
#else
    for (int p = 0; p < NPHASE; ++p) { a.ph_lo = p; a.ph_hi = p + 1; hipLaunchKernelGGL(fwd_kernel, dim3(grid), dim3(NWAVES * 64), LDS_BYTES, stream, a); }
#endif
    const hipError_t le = hipPeekAtLastError();
    if (le != hipSuccess) fprintf(stderr, "kernel_launch: launch failed: %s\n", hipGetErrorName(le));
}
```

```cpp
#include <hip/hip_runtime.h>
#include <cstdio>
#include <cstdint>

#ifndef MK_N_LAUNCHES
#define MK_N_LAUNCHES 1
#endif

namespace pg8 {
#define PG8_LAS __attribute__((address_space(3)))
typedef unsigned short bf16_t;
typedef short bf16x8 __attribute__((ext_vector_type(8)));
typedef float f32x4 __attribute__((ext_vector_type(4)));
typedef unsigned u32x4 __attribute__((ext_vector_type(4)));
typedef int i32x4 __attribute__((ext_vector_type(4)));
typedef int i32x8 __attribute__((ext_vector_type(8)));
typedef float f32x16 __attribute__((ext_vector_type(16)));
constexpr int BM = 256, BK = 64, HALF = 128, HTB = HALF * BK * 2, STAGE_BYTES = 8 * HTB, NXCD = 8, WGM = 8;

__host__ __device__ __forceinline__ int lds_byte(int r, int c) { const int st = (r >> 4) * 2 + (c >> 5), rr = r & 15, cc = c & 31, ob = rr * 64 + cc * 2; return st * 1024 + (ob ^ (((ob >> 9) & 1) << 5)); }
__host__ __device__ __forceinline__ void stage_rc(int b, int& R, int& C) { const int st = b / 1024, sb = b % 1024, swz = sb ^ (((sb >> 9) & 1) << 5); R = (st >> 1) * 16 + swz / 64; C = (st & 1) * 32 + (swz % 64) / 2; }
__host__ __device__ __forceinline__ int perm32(int rho) { const int n = rho >> 4, i = rho & 15; return 8 * (i >> 2) + 4 * n + (i & 3); }

struct Unit { int pm, pn, e; };
struct Gemm { const bf16_t* A; const bf16_t* Bt; int M, N, K; size_t estride; };

struct StaticOrder {
    int nM, nN, nwg, G, c, rep; const PG8_LAS unsigned char* tile_e;
    __device__ void init(int nM_, int nN_, int G_, int c_, const PG8_LAS unsigned char* te, int rep_ = 1) { nM = nM_; nN = nN_; nwg = nM * nN; G = G_; c = c_; tile_e = te; rep = rep_; }
    __device__ bool next(int i, Unit& u) const {
        long L = (long)i * G + c; if (L >= (long)nwg * rep) return false; if (rep > 1) L %= nwg;
        int wgid = (int)L; { const int q = nwg / NXCD, r = nwg % NXCD, xcd = wgid % NXCD, off = wgid / NXCD; wgid = (xcd < r ? xcd * (q + 1) : r * (q + 1) + (xcd - r) * q) + off; }
        const int nig = WGM * nN, gid = wgid / nig, fm = gid * WGM, gsz = (nM - fm) < WGM ? (nM - fm) : WGM;
        u.pm = fm + ((wgid % nig) % gsz); u.pn = (wgid % nig) / gsz; u.e = tile_e ? __builtin_amdgcn_readfirstlane((int)tile_e[u.pm]) : 0; return true;
    }
};

__device__ __forceinline__ unsigned cvt_pk_bf16(float lo, float hi) { unsigned r; asm volatile("v_cvt_pk_bf16_f32 %0, %1, %2" : "=v"(r) : "v"(lo), "v"(hi)); return r; }

template <class Epi, class Sched, bool FP8 = false>
__device__ __forceinline__ void gemm_phase(PG8_LAS unsigned char* lds, const Gemm g, const Sched& S, const Epi& E) {
    const int tid = threadIdx.x, wid = __builtin_amdgcn_readfirstlane(tid >> 6), lane = tid & 63, wr = wid >> 2, wc = wid & 3, fr = lane & 15, fq = lane >> 4;
    const int K = g.K, nt = K / BK;
    unsigned voffA[2], voffB[2];
#pragma unroll
    for (int i = 0; i < 2; ++i) { int R, C; stage_rc(tid * 16 + i * 8192, R, C); const int Rb = Epi::PERM ? ((R & ~31) + perm32(R & 31)) : R;
        voffA[i] = (unsigned)(R * K + C) * 2u; voffB[i] = (unsigned)(Rb * K + C) * 2u; }
    const size_t kstep = (size_t)(BK * 2);
    const size_t hstep = (size_t)HALF * K * 2;
    const size_t tstep = 2 * hstep;
    const size_t estep = g.estride * 2;
    const unsigned ldsw = (unsigned)wid * 1024u;
    const int aoff = lds_byte(wr * 64 + fr, fq * 8), boff = lds_byte(wc * 32 + fr, fq * 8);
#define PG8_SA(b, h) (((b) * 2 + (h)) * HTB)
#define PG8_SB(b, h) ((4 + (b) * 2 + (h)) * HTB)
#define PG8_STAGE(bufoff, gbase, voff) do { _Pragma("unroll") for (int _i = 0; _i < 2; ++_i) \
        __builtin_amdgcn_global_load_lds((const unsigned*)((const char*)(gbase) + (voff)[_i]), (PG8_LAS unsigned*)(lds + (bufoff) + ldsw + _i * 8192), 16, 0, 0); } while (0)
#define PG8_LDA(dst, b, h) do { _Pragma("unroll") for (int m = 0; m < 4; ++m) dst[m] = PG8_CAT2(*(const PG8_LAS i32x4*)(lds + PG8_SA(b, h) + aoff + m * 2048), *(const PG8_LAS i32x4*)(lds + PG8_SA(b, h) + aoff + m * 2048 + 1024)); } while (0)
#define PG8_LDB(dst, b, h) do { _Pragma("unroll") for (int n = 0; n < 2; ++n) dst[n] = PG8_CAT2(*(const PG8_LAS i32x4*)(lds + PG8_SB(b, h) + boff + n * 2048), *(const PG8_LAS i32x4*)(lds + PG8_SB(b, h) + boff + n * 2048 + 1024)); } while (0)
#define PG8_CAT2(x, y) __builtin_shufflevector((x), (y), 0, 1, 2, 3, 4, 5, 6, 7)
#define PG8_LO(x) __builtin_bit_cast(bf16x8, __builtin_shufflevector((x), (x), 0, 1, 2, 3))
#define PG8_HI(x) __builtin_bit_cast(bf16x8, __builtin_shufflevector((x), (x), 4, 5, 6, 7))
#define PG8_X4(v, m) ((f32x4){(v)[4 * (m)], (v)[4 * (m) + 1], (v)[4 * (m) + 2], (v)[4 * (m) + 3]})
#define PG8_INS(v, r, m) do { (v)[4 * (m)] = (r)[0]; (v)[4 * (m) + 1] = (r)[1]; (v)[4 * (m) + 2] = (r)[2]; (v)[4 * (m) + 3] = (r)[3]; } while (0)
#define PG8_MMA(ai, bj, At, Bt) do { __builtin_amdgcn_s_setprio(1); _Pragma("unroll") for (int m = 0; m < 4; ++m) _Pragma("unroll") for (int n = 0; n < 2; ++n) { \
        if constexpr (FP8) { const f32x4 r_ = __builtin_amdgcn_mfma_scale_f32_16x16x128_f8f6f4(Bt[n], At[m], PG8_X4(acc16[ai][bj][n], m), 0, 0, 0, 0x7F7F7F7F, 0, 0x7F7F7F7F); PG8_INS(acc16[ai][bj][n], r_, m); } \
        else { acc[ai][bj][m][n] = __builtin_amdgcn_mfma_f32_16x16x32_bf16(PG8_LO(Bt[n]), PG8_LO(At[m]), acc[ai][bj][m][n], 0, 0, 0); \
               acc[ai][bj][m][n] = __builtin_amdgcn_mfma_f32_16x16x32_bf16(PG8_HI(Bt[n]), PG8_HI(At[m]), acc[ai][bj][m][n], 0, 0, 0); } } \
        __builtin_amdgcn_s_setprio(0); } while (0)
#define PG8_WAIT_V(n) asm volatile("s_waitcnt vmcnt(" #n ")" ::: "memory")
#define PG8_WAIT_L(n) asm volatile("s_waitcnt lgkmcnt(" #n ")" ::: "memory")
#define PG8_BAR __builtin_amdgcn_s_barrier()
#define PG8_SCHED __builtin_amdgcn_sched_barrier(0)
    Unit cur, nxt; int ui = 0;
    if (!S.next(0, cur)) return;
    f32x4 acc[2][2][4][2];
#pragma unroll
    for (int a = 0; a < 2; ++a)
#pragma unroll
        for (int b = 0; b < 2; ++b)
#pragma unroll
            for (int m = 0; m < 4; ++m)
#pragma unroll
                for (int n = 0; n < 2; ++n) acc[a][b][m][n] = (f32x4){0.f, 0.f, 0.f, 0.f};
    f32x16 acc16[2][2][2];
#pragma unroll
    for (int a = 0; a < 2; ++a)
#pragma unroll
        for (int b = 0; b < 2; ++b)
#pragma unroll
            for (int n = 0; n < 2; ++n) acc16[a][b][n] = (f32x16){};
    i32x8 At[4], B0[2], B1[2];
    const char* cA = (const char*)g.A + (size_t)cur.pm * tstep; const char* cB = (const char*)g.Bt + (size_t)cur.e * estep + (size_t)cur.pn * tstep;
    PG8_STAGE(PG8_SB(0, 0), cB, voffB); PG8_STAGE(PG8_SB(0, 1), cB + hstep, voffB); PG8_STAGE(PG8_SA(0, 0), cA, voffA); PG8_STAGE(PG8_SA(0, 1), cA + hstep, voffA);
    if (wr == 1) PG8_BAR;
    PG8_WAIT_V(2); PG8_BAR;
    PG8_STAGE(PG8_SB(1, 0), cB + kstep, voffB); PG8_STAGE(PG8_SA(1, 0), cA + kstep, voffA); PG8_STAGE(PG8_SB(1, 1), cB + hstep + kstep, voffB);
    PG8_WAIT_V(6); PG8_BAR;
    for (;;) {
        const bool has_next = S.next(ui + 1, nxt);
        const char* nA = has_next ? (const char*)g.A + (size_t)nxt.pm * tstep : cA; const char* nB = has_next ? (const char*)g.Bt + (size_t)nxt.e * estep + (size_t)nxt.pn * tstep : cB;
#pragma nounroll
        for (int t = 0; t < nt; t += 2) {
            const bool last = (t == nt - 2);
            const char* a1 = cA + (size_t)(t + 1) * kstep;
            const char* a2 = last ? nA : cA + (size_t)(t + 2) * kstep; const char* b2 = last ? nB : cB + (size_t)(t + 2) * kstep;
            const char* a3 = a2 + kstep; const char* b3 = b2 + kstep;
            PG8_LDB(B0, 0, 0); PG8_LDB(B1, 0, 1); PG8_SCHED; PG8_LDA(At, 0, 0); PG8_STAGE(PG8_SA(1, 1), a1 + hstep, voffA);
            PG8_WAIT_V(8); PG8_WAIT_L(0); PG8_BAR; PG8_MMA(0, 0, At, B0); PG8_MMA(0, 1, At, B1); PG8_BAR; PG8_SCHED;
            PG8_LDA(At, 0, 1); PG8_STAGE(PG8_SB(0, 0), b2, voffB); PG8_STAGE(PG8_SB(0, 1), b2 + hstep, voffB); PG8_STAGE(PG8_SA(0, 0), a2, voffA);
            PG8_WAIT_V(8); PG8_WAIT_L(0); PG8_BAR; PG8_MMA(1, 0, At, B0); PG8_MMA(1, 1, At, B1); PG8_BAR; PG8_SCHED;
            PG8_LDB(B0, 1, 0); PG8_LDB(B1, 1, 1); PG8_SCHED; PG8_LDA(At, 1, 0); PG8_STAGE(PG8_SA(0, 1), a2 + hstep, voffA);
            PG8_WAIT_V(8); PG8_WAIT_L(0); PG8_BAR; PG8_MMA(0, 0, At, B0); PG8_MMA(0, 1, At, B1); PG8_BAR; PG8_SCHED;
            PG8_LDA(At, 1, 1); PG8_STAGE(PG8_SB(1, 0), b3, voffB); PG8_STAGE(PG8_SB(1, 1), b3 + hstep, voffB); PG8_STAGE(PG8_SA(1, 0), a3, voffA);
            PG8_WAIT_V(8); PG8_WAIT_L(0); PG8_BAR; PG8_MMA(1, 0, At, B0); PG8_MMA(1, 1, At, B1); PG8_BAR; PG8_SCHED;
        }
        if (wr == 0) PG8_BAR;
        if constexpr (FP8) {
#pragma unroll
            for (int a = 0; a < 2; ++a)
#pragma unroll
                for (int b = 0; b < 2; ++b)
#pragma unroll
                    for (int m = 0; m < 4; ++m)
#pragma unroll
                        for (int n = 0; n < 2; ++n) acc[a][b][m][n] = PG8_X4(acc16[a][b][n], m);
        }
        { int t2 = threadIdx.x; asm volatile("" : "+v"(t2)); E(acc, cur, wr, wc, t2 & 15, (t2 >> 4) & 3); }
        if (!has_next) break;
#pragma unroll
        for (int a = 0; a < 2; ++a)
#pragma unroll
            for (int b = 0; b < 2; ++b)
#pragma unroll
                for (int m = 0; m < 4; ++m)
#pragma unroll
                    for (int n = 0; n < 2; ++n) acc[a][b][m][n] = (f32x4){0.f, 0.f, 0.f, 0.f};
        if constexpr (FP8) {
#pragma unroll
            for (int a = 0; a < 2; ++a)
#pragma unroll
                for (int b = 0; b < 2; ++b)
#pragma unroll
                    for (int n = 0; n < 2; ++n) acc16[a][b][n] = (f32x16){};
        }
        cur = nxt; cA = nA; cB = nB; ++ui;
        if (wr == 1) PG8_BAR;
    }
    PG8_WAIT_V(0);
    PG8_BAR;
#undef PG8_SA
#undef PG8_SB
#undef PG8_STAGE
#undef PG8_LDA
#undef PG8_LDB
#undef PG8_MMA
#undef PG8_X4
#undef PG8_INS
#undef PG8_CAT2
#undef PG8_LO
#undef PG8_HI
#undef PG8_WAIT_V
#undef PG8_WAIT_L
#undef PG8_BAR
#undef PG8_SCHED
}
}

constexpr int NWAVES = 8;
constexpr int BATCH = 4, SEQ = 8192, D = 1024, T = BATCH * SEQ;
constexpr int INW = 3088, NIN = 3072;
constexpr int NE = 32, TOPK = 4, FF = 1024;
constexpr int PMAX = (T * TOPK / 256 + NE) * 256;
constexpr int NCHUNK = BATCH * 4 * (SEQ / 64);
constexpr float EPS = 1e-6f;
constexpr float LOG2E = 1.4426950408889634f;
constexpr float C2 = 0.125f * LOG2E;
constexpr float WSCALE = 32.f, WSCALE_INV = 1.f / 32.f;

constexpr size_t MiB = 1u << 20;
constexpr size_t WS_CTL = 0, CTL_ZERO_BYTES = 1 * MiB;
constexpr size_t WS_MODP = 1 * MiB;
constexpr size_t WS_MOD = 2 * MiB;
constexpr size_t WS_TOPE = 3 * MiB;
constexpr size_t WS_TOPW = 3 * MiB + 512 * 1024;
constexpr size_t WS_POS = 4 * MiB;
constexpr size_t WS_ROWW = 4 * MiB + 512 * 1024;
constexpr size_t WS_DEC = 6 * MiB;
constexpr size_t WS_WGU = 8 * MiB;
constexpr size_t WS_WD = 136 * MiB;
constexpr size_t WS_XN = 200 * MiB;
constexpr size_t WS_WIN = 264 * MiB;
constexpr size_t WS_WOUT = 270 * MiB;
constexpr size_t WS_GK = 272 * MiB;
constexpr size_t WS_QG = 304 * MiB;
constexpr size_t WS_KG = 320 * MiB;
constexpr size_t WS_VG = 336 * MiB;
constexpr size_t WS_RG = 368 * MiB;
constexpr size_t WS_QD = 400 * MiB;
constexpr size_t WS_KD = 432 * MiB;
constexpr size_t WS_VD = 464 * MiB;
constexpr size_t WS_UT = 496 * MiB;
constexpr size_t WS_SP = 560 * MiB;
constexpr size_t WS_OI = 592 * MiB;
constexpr size_t WS_QE = 656 * MiB;
constexpr size_t WS_A2 = 672 * MiB;
constexpr size_t WS_STASH = 736 * MiB;
constexpr size_t WS_XS = 264 * MiB;
constexpr size_t WS_Y = 400 * MiB;
constexpr size_t WS_CN = 536 * MiB;
constexpr size_t WS_END = 808 * MiB;
static_assert(WS_XS + (size_t)PMAX * 1024 <= WS_Y && WS_Y + (size_t)PMAX * 1024 <= WS_CN && WS_CN + (size_t)PMAX * 1024 * 2 <= WS_END, "ws map");
constexpr int CW_BAR = 4096;
constexpr int CW_CNT = 16384;
constexpr int CW_FILL = 16384 + 64;

constexpr int RING_BYTES = 131072;
constexpr int LDSCTL_OFF = RING_BYTES, MISC_OFF = LDSCTL_OFF + 320;
constexpr int TILEE_OFF = MISC_OFF + 128;
constexpr int HIST_OFF = TILEE_OFF + 1024;
constexpr int LDS_BYTES = 147456;
static_assert(HIST_OFF + 512 <= LDS_BYTES, "LDS map");

#define GAS __attribute__((address_space(1)))
#define LAS __attribute__((address_space(3)))
typedef unsigned short bf16;
typedef unsigned v4u __attribute__((ext_vector_type(4)));
typedef unsigned v2u __attribute__((ext_vector_type(2)));
typedef float f32x4 __attribute__((ext_vector_type(4)));
typedef float f32x16 __attribute__((ext_vector_type(16)));
typedef short bf16x8 __attribute__((ext_vector_type(8)));
typedef short s16x4 __attribute__((ext_vector_type(4)));
typedef GAS unsigned gu32;
#define RLX_AGENT __ATOMIC_RELAXED, __HIP_MEMORY_SCOPE_AGENT
#define LDS_WAIT() asm volatile("s_waitcnt lgkmcnt(0)" ::: "memory")
#define VM_WAIT() asm volatile("s_waitcnt vmcnt(0)" ::: "memory")
__device__ __forceinline__ unsigned f2bf(float f) { unsigned u = __builtin_bit_cast(unsigned, f); return (u + 0x7fffu + ((u >> 16) & 1u)) >> 16; }
__device__ __forceinline__ unsigned pk2(float lo, float hi) { return f2bf(lo) | (f2bf(hi) << 16); }
__device__ __forceinline__ float bf2f(unsigned short h) { return __builtin_bit_cast(float, (unsigned)h << 16); }
__device__ __forceinline__ float bflo(unsigned u) { return __builtin_bit_cast(float, u << 16); }
__device__ __forceinline__ float bfhi(unsigned u) { return __builtin_bit_cast(float, u & 0xffff0000u); }
__device__ __forceinline__ float wave_sum(float v) {
#pragma unroll
    for (int o = 1; o < 64; o <<= 1) v += __shfl_xor(v, o);
    return v;
}
__device__ __forceinline__ float sigmoidf_(float x) { return 1.f / (1.f + __expf(-x)); }

#define XB_TMO      128
#define XB_XCNT(j)  (256  + 64 * (j))
#define XB_XSUB(j)  (1280 + 64 * (j))
#define XB_XGEN(j)  (2304 + 64 * (j))
#define XB_TOP      3328
#define XB_TOPGEN   3392
#define XCD_BAR_WORDS 3456
#define XB_SPIN_CAP (1u << 18)
__device__ __forceinline__ unsigned xb_ld(unsigned* p)              { return __hip_atomic_load(p, __ATOMIC_RELAXED, __HIP_MEMORY_SCOPE_AGENT); }
__device__ __forceinline__ unsigned xb_add(unsigned* p, unsigned v) { return __hip_atomic_fetch_add(p, v, __ATOMIC_RELAXED, __HIP_MEMORY_SCOPE_AGENT); }
__device__ __forceinline__ unsigned xb_xcc_id() { return (unsigned)__builtin_amdgcn_s_getreg((3 << 11) | 20) & 0xFu; }
#define XB_SPIN(cond, bar) do { unsigned _sp = 0; while (cond) { __builtin_amdgcn_s_sleep(1); \
    if ((++_sp & 255u) == 0u) { if (xb_ld(&(bar)[XB_TMO])) break; if (_sp > XB_SPIN_CAP) { atomicAdd(&(bar)[XB_TMO], 1u); break; } } } } while (0)
struct XcdBarrier { unsigned* bar; unsigned x; volatile LAS unsigned* st; };
__device__ __forceinline__ XcdBarrier xcd_barrier_post(unsigned* bar, volatile LAS unsigned* st) {
    XcdBarrier b; b.bar = bar; b.x = xb_xcc_id(); b.st = st;
    if (threadIdx.x == 0) (void)xb_add(&bar[XB_XCNT(b.x)], 1u);
    return b;
}
__device__ __forceinline__ void xcd_barrier_complete(unsigned* bar, unsigned x, unsigned& nloc, unsigned& nx) {
    const unsigned G = gridDim.x * gridDim.y * gridDim.z;
    unsigned sum, cnt, mine, sp = 0u;
    for (;;) {
        sum = 0u; cnt = 0u; mine = 0u;
#pragma unroll
        for (unsigned j = 0; j < 16; ++j) { const unsigned c = xb_ld(&bar[XB_XCNT(j)]); sum += c; cnt += (c > 0u) ? 1u : 0u; mine = (j == x) ? c : mine; }
        if (sum == G) break;
        __builtin_amdgcn_s_sleep(1);
        if ((++sp & 255u) == 0u) { if (xb_ld(&bar[XB_TMO])) break; if (sp > XB_SPIN_CAP) { atomicAdd(&bar[XB_TMO], 1u); break; } }
    }
    nloc = mine > 0u ? mine : 1u; nx = cnt > 0u ? cnt : 1u;
}
__device__ __forceinline__ void xcd_barrier(const XcdBarrier& b) {
    asm volatile("s_waitcnt vmcnt(0)" ::: "memory");
    __syncthreads();
    if (threadIdx.x == 0) {
        unsigned* bar = b.bar;
        __builtin_amdgcn_s_waitcnt(0);
        unsigned nloc = b.st[0], nx = b.st[1];
        if (nloc == 0u) { xcd_barrier_complete(bar, b.x, nloc, nx); b.st[0] = nloc; b.st[1] = nx; }
        const unsigned old = xb_add(&bar[XB_XSUB(b.x)], 1u);
        const unsigned gen = old / nloc;
        if (old + 1u == (gen + 1u) * nloc) {
            __builtin_amdgcn_fence(__ATOMIC_RELEASE, "agent");
            asm volatile("s_waitcnt vmcnt(0)" ::: "memory");
            const unsigned og = xb_add(&bar[XB_TOP], 1u);
            const unsigned tg = og / nx;
            if (og + 1u == (tg + 1u) * nx) xb_add(&bar[XB_TOPGEN], 1u);
            else XB_SPIN(xb_ld(&bar[XB_TOPGEN]) == tg, bar);
            __builtin_amdgcn_fence(__ATOMIC_ACQUIRE, "agent");
            xb_add(&bar[XB_XGEN(b.x)], 1u);
            asm volatile("s_waitcnt vmcnt(0)" ::: "memory");
        } else {
            XB_SPIN(xb_ld(&bar[XB_XGEN(b.x)]) == gen, bar);
            __builtin_amdgcn_fence(__ATOMIC_ACQUIRE, "agent");
            asm volatile("s_waitcnt vmcnt(0)" ::: "memory");
        }
    }
    __syncthreads();
}

struct Frame {
    LAS unsigned char* lds;
    volatile LAS unsigned* MISC;
    gu32* ctl;
    int tid, lane, wave;
    int vcu, G;
    unsigned char* ws;
    const float *x, *c, *rel_bias, *w_ada, *b_ada, *g_norm1, *w_in, *w_gk_up, *b_gk_up, *g_gla_out, *g_qnorm, *g_knorm, *lq1, *lk1, *lq2, *lk2, *g_subln, *w_out,
                *g_norm2, *w_router, *b_router, *w_gate_up, *b_gate_up, *w_down, *b_down;
    float* out;
};
template <class Tp> __device__ __forceinline__ Tp* wsp(const Frame& F, size_t off) { return (Tp*)(F.ws + off); }

__device__ __forceinline__ void tr_item(const float* W, int ldw, int k0, int src0, bf16* WT, int K, int drow0, LAS float* scr, int lane) {
#pragma unroll 8
    for (int i = 0; i < 32; ++i) { const int kk = 2 * i + (lane >> 5); scr[kk * 33 + (lane & 31)] = W[(size_t)(k0 + kk) * ldw + src0 + (lane & 31)]; }
    LDS_WAIT(); asm volatile("" ::: "memory");
    const int c = lane & 7;
#pragma unroll
    for (int j = 0; j < 4; ++j) { const int n = (lane >> 3) + 8 * j; const LAS float* s = scr + (8 * c) * 33 + n;
        v4u o; o.x = pk2(s[0 * 33], s[1 * 33]); o.y = pk2(s[2 * 33], s[3 * 33]); o.z = pk2(s[4 * 33], s[5 * 33]); o.w = pk2(s[6 * 33], s[7 * 33]);
        *(GAS v4u*)(WT + (size_t)(drow0 + n) * K + k0 + 8 * c) = o; }
    LDS_WAIT(); asm volatile("" ::: "memory");
}
__device__ __forceinline__ unsigned pk4_fp8(float a, float b, float c, float d) { int p = __builtin_amdgcn_cvt_pk_fp8_f32(a, b, 0, false); p = __builtin_amdgcn_cvt_pk_fp8_f32(c, d, p, true); return (unsigned)p; }
__device__ __forceinline__ void tr_item_fp8(const float* W, int ldw, int k0, int src0, unsigned char* WT, int K, int drow0, float sc, LAS float* scr, int lane) {
#pragma unroll 8
    for (int i = 0; i < 32; ++i) { const int kk = 2 * i + (lane >> 5); scr[kk * 33 + (lane & 31)] = W[(size_t)(k0 + kk) * ldw + src0 + (lane & 31)] * sc; }
    LDS_WAIT(); asm volatile("" ::: "memory");
    const int c = lane & 3;
#pragma unroll
    for (int j = 0; j < 2; ++j) { const int n = (lane >> 2) + 16 * j; const LAS float* s = scr + (16 * c) * 33 + n;
        v4u o;
#pragma unroll
        for (int q = 0; q < 4; ++q) o[q] = pk4_fp8(s[(4 * q) * 33], s[(4 * q + 1) * 33], s[(4 * q + 2) * 33], s[(4 * q + 3) * 33]);
        *(GAS v4u*)(WT + (size_t)(drow0 + n) * K + k0 + 16 * c) = o; }
    LDS_WAIT(); asm volatile("" ::: "memory");
}
__device__ __forceinline__ int win_src0(int ng) {
    const int pn = ng >> 3, gi = ng & 7, bj = gi >> 2, wc = gi & 3;
    if (pn < 6) return pn * 256 + gi * 32;
    if (pn < 10) { const int base = (pn < 8) ? 1552 : 2064; const int gq = 4 * ((pn - 6) & 1) + wc; return base + 64 * gq + 32 * bj; }
    return 2576 + (pn - 10) * 256 + gi * 32;
}
__device__ __forceinline__ void p0_phase(Frame& F) {
    LAS float* scr = (LAS float*)(F.lds + F.wave * 16384);
    const int gw = F.vcu * NWAVES + F.wave, NGW = F.G * NWAVES, lane = F.lane;
    for (int it = gw; it < 768; it += NGW) {
        const int cg = it % 96, ks = it / 96, j = cg * 64 + lane;
#pragma unroll
        for (int q = 0; q < 8; ++q) { const int idx = q * 64 + lane, b = idx >> 7, kk = idx & 127; const float cv = F.c[b * 1024 + ks * 128 + kk]; scr[idx] = cv * sigmoidf_(cv); }
        LDS_WAIT(); asm volatile("" ::: "memory");
        float a0 = 0.f, a1 = 0.f, a2 = 0.f, a3 = 0.f;
        const float* wp = F.w_ada + (size_t)(ks * 128) * 6144 + j;
#pragma unroll 16
        for (int kk = 0; kk < 128; ++kk) { const float w = wp[(size_t)kk * 6144]; a0 += scr[kk] * w; a1 += scr[128 + kk] * w; a2 += scr[256 + kk] * w; a3 += scr[384 + kk] * w; }
        float* mp = wsp<float>(F, WS_MODP) + (size_t)(ks * 4) * 6144 + j;
        mp[0] = a0; mp[6144] = a1; mp[2 * 6144] = a2; mp[3 * 6144] = a3;
        LDS_WAIT(); asm volatile("" ::: "memory");
    }
    constexpr int I_IN = 96 * 16, I_OUT = 32 * 16, I_GU = 32 * 64 * 16, I_D = 32 * 32 * 16;
    constexpr int NITEMS = I_IN + I_OUT + I_GU + I_D;
    for (int it = gw; it < NITEMS; it += NGW) {
        int r = it;
        if (r < I_IN) { const int kb = r / 96, ng = r % 96; tr_item(F.w_in, INW, kb * 64, win_src0(ng), wsp<bf16>(F, WS_WIN), 1024, ng * 32, scr, lane); continue; } r -= I_IN;
        if (r < I_OUT) { const int kb = r / 32, ng = r % 32; tr_item(F.w_out, 1024, kb * 64, ng * 32, wsp<bf16>(F, WS_WOUT), 1024, ng * 32, scr, lane); continue; } r -= I_OUT;
        if (r < I_GU) { const int e = r / 1024, q = r % 1024, kb = q / 64, dg = q % 64, pn = dg >> 3, gi = dg & 7, bj = gi >> 2, j32 = gi & 3;
            tr_item_fp8(F.w_gate_up + (size_t)e * 1024 * 2048, 2048, kb * 64, bj * 1024 + pn * 128 + j32 * 32, wsp<unsigned char>(F, WS_WGU) + (size_t)e * 2048 * 1024, 1024, dg * 32, WSCALE, scr, lane); continue; } r -= I_GU;
        { const int e = r / 512, q = r % 512, kb = q / 32, ng = q % 32;
            tr_item_fp8(F.w_down + (size_t)e * 1024 * 1024, 1024, kb * 64, ng * 32, wsp<unsigned char>(F, WS_WD) + (size_t)e * 1024 * 1024, 1024, ng * 32, WSCALE, scr, lane); }
    }
}

__device__ __forceinline__ f32x4 mod_from_partials(const Frame& F, int b, int col) {
    const float* mp = wsp<const float>(F, WS_MODP) + (size_t)b * 6144 + col;
    f32x4 s = *(const f32x4*)(F.b_ada + col);
#pragma unroll
    for (int ks = 0; ks < 8; ++ks) s += *(const f32x4*)(mp + (size_t)ks * 4 * 6144);
    return s;
}
__device__ __forceinline__ void p1_phase(Frame& F) {
    const int tid = F.tid, lane = F.lane;
    LAS float* wlo = (LAS float*)(F.lds);
    LAS float* wup = (LAS float*)(F.lds + 65536);
    LAS float* bup = (LAS float*)(F.lds + 65536 + 16384);
    for (int idx = tid; idx < 16384; idx += 512) { const int k = idx >> 4, r = idx & 15; wlo[r * 1024 + k] = F.w_in[(size_t)k * INW + 1536 + r]; }
    for (int idx = tid; idx < 4096; idx += 512) wup[idx] = F.w_gk_up[idx];
    if (tid < 256) bup[tid] = F.b_gk_up[tid];
    { const int gt = F.vcu * 512 + tid; if (gt < 4 * 6144 / 4) { const int i = gt * 4, b = i / 6144, col = i % 6144; *(f32x4*)(wsp<float>(F, WS_MOD) + i) = mod_from_partials(F, b, col); } }
    __syncthreads();
    const int gw = F.vcu * NWAVES + F.wave, NGW = F.G * NWAVES;
    const int rpw = (T + NGW - 1) / NGW;
    int curb = -1; f32x4 gsc[4], shv[4];
    for (int i = 0; i < rpw; ++i) {
        const int m = gw * rpw + i; if (m >= T) break;
        const int b = m / SEQ;
        if (b != curb) { curb = b;
#pragma unroll
            for (int j = 0; j < 4; ++j) { const int col = 256 * j + 4 * lane; const f32x4 g = *(const f32x4*)(F.g_norm1 + col);
                shv[j] = mod_from_partials(F, b, col); gsc[j] = g * (mod_from_partials(F, b, 1024 + col) + 1.0f); } }
        const GAS f32x4* xr = (const GAS f32x4*)(F.x + (size_t)m * D) + lane;
        f32x4 v[4]; float s = 0.f;
#pragma unroll
        for (int j = 0; j < 4; ++j) { v[j] = xr[64 * j]; s += (v[j].x * v[j].x + v[j].y * v[j].y) + (v[j].z * v[j].z + v[j].w * v[j].w); }
        const float rstd = rsqrtf(wave_sum(s) * (1.f / D) + EPS);
        GAS v2u* o8 = (GAS v2u*)(wsp<bf16>(F, WS_XN) + (size_t)m * D) + lane;
#pragma unroll
        for (int j = 0; j < 4; ++j) { v[j] = v[j] * rstd * gsc[j] + shv[j]; v2u o; o.x = pk2(v[j].x, v[j].y); o.y = pk2(v[j].z, v[j].w); o8[64 * j] = o; }
        float part[16];
#pragma unroll
        for (int r = 0; r < 16; ++r) { float a = 0.f;
#pragma unroll
            for (int j = 0; j < 4; ++j) { const f32x4 w = *(const LAS f32x4*)(wlo + r * 1024 + 256 * j + 4 * lane); a += (v[j].x * w.x + v[j].y * w.y) + (v[j].z * w.z + v[j].w * w.w); }
            part[r] = wave_sum(a); }
        f32x4 z = *(const LAS f32x4*)(bup + 4 * lane);
#pragma unroll
        for (int r = 0; r < 16; ++r) z += *(const LAS f32x4*)(wup + r * 256 + 4 * lane) * part[r];
        f32x4 gk;
#pragma unroll
        for (int q = 0; q < 4; ++q) { const float zz = z[q]; gk[q] = (fminf(zz, 0.f) - log1pf(__expf(-fabsf(zz)))) * (1.f / 16.f); }
        *(GAS f32x4*)(wsp<float>(F, WS_GK) + (size_t)m * 256 + 4 * lane) = gk;
    }
}

using pg8::Unit;
typedef pg8::f32x4 af4;
struct EpiInProj {
    static constexpr bool PERM = true;
    bf16 *QG, *KG, *VG, *RG, *QD, *KD, *VD; const float *gq, *gk;
    __device__ __forceinline__ void operator()(const af4 (&acc)[2][2][4][2], const Unit& u, int wr, int wc, int fr, int fq) const {
        const int pn = u.pn; const int row0 = u.pm * 256 + wr * 64 + fr;
        if (pn >= 6 && pn < 10) {
            const bool isq = pn < 8; bf16* base = isq ? QD : KD; const float* g = isq ? gq : gk; const float sc = isq ? C2 : 1.f;
            const int grp = 4 * ((pn - 6) & 1) + wc;
            af4 gv[2][2];
#pragma unroll
            for (int bj = 0; bj < 2; ++bj)
#pragma unroll
                for (int n = 0; n < 2; ++n) gv[bj][n] = *(const af4*)(g + 32 * bj + 8 * fq + 4 * n) * sc;
#pragma unroll
            for (int ai = 0; ai < 2; ++ai)
#pragma unroll
                for (int m = 0; m < 4; ++m) {
                    float ss = 0.f;
#pragma unroll
                    for (int bj = 0; bj < 2; ++bj)
#pragma unroll
                        for (int n = 0; n < 2; ++n) { const af4 v = acc[ai][bj][m][n]; ss += (v[0] * v[0] + v[1] * v[1]) + (v[2] * v[2] + v[3] * v[3]); }
                    ss += __shfl_xor(ss, 16); ss += __shfl_xor(ss, 32);
                    const float rs = rsqrtf(ss * (1.f / 64.f) + EPS);
                    bf16* rowp = base + (size_t)(row0 + ai * 128 + m * 16) * 512 + grp * 64 + 8 * fq;
#pragma unroll
                    for (int bj = 0; bj < 2; ++bj) { const af4 v0 = acc[ai][bj][m][0] * rs * gv[bj][0], v1 = acc[ai][bj][m][1] * rs * gv[bj][1];
                        pg8::u32x4 w; w.x = pg8::cvt_pk_bf16(v0[0], v0[1]); w.y = pg8::cvt_pk_bf16(v0[2], v0[3]); w.z = pg8::cvt_pk_bf16(v1[0], v1[1]); w.w = pg8::cvt_pk_bf16(v1[2], v1[3]);
                        *(pg8::u32x4*)(rowp + 32 * bj) = w; }
                }
        } else {
            bf16* base; int pitch, colt; int act = 0;
            if (pn == 0) { base = QG; pitch = 256; colt = 0; act = 1; }
            else if (pn == 1) { base = KG; pitch = 256; colt = 0; }
            else if (pn < 4) { base = VG; pitch = 512; colt = (pn - 2) * 256; }
            else if (pn < 6) { base = RG; pitch = 512; colt = (pn - 4) * 256; act = 2; }
            else { base = VD; pitch = 512; colt = (pn - 10) * 256; }
            const int col0 = colt + wc * 32 + 8 * fq;
#pragma unroll
            for (int ai = 0; ai < 2; ++ai)
#pragma unroll
                for (int m = 0; m < 4; ++m) { bf16* rowp = base + (size_t)(row0 + ai * 128 + m * 16) * pitch + col0;
#pragma unroll
                    for (int bj = 0; bj < 2; ++bj) { af4 v0 = acc[ai][bj][m][0], v1 = acc[ai][bj][m][1];
                        if (act == 1) { v0 = v0 * 0.125f; v1 = v1 * 0.125f; }
                        if (act == 2) {
#pragma unroll
                            for (int q = 0; q < 4; ++q) { v0[q] = v0[q] * sigmoidf_(v0[q]); v1[q] = v1[q] * sigmoidf_(v1[q]); } }
                        pg8::u32x4 w; w.x = pg8::cvt_pk_bf16(v0[0], v0[1]); w.y = pg8::cvt_pk_bf16(v0[2], v0[3]); w.z = pg8::cvt_pk_bf16(v1[0], v1[1]); w.w = pg8::cvt_pk_bf16(v1[2], v1[3]);
                        *(pg8::u32x4*)(rowp + bj * 128) = w; } }
        }
    }
};
struct EpiOutProj {
    static constexpr bool PERM = false;
    const float* x; float* out; const float* mod;
    __device__ __forceinline__ void operator()(const af4 (&acc)[2][2][4][2], const Unit& u, int wr, int wc, int fr, int fq) const {
        const int b = (u.pm * 256) / SEQ; const int col0 = u.pn * 256 + wc * 32 + 4 * fq;
        af4 gt[2][2];
#pragma unroll
        for (int bj = 0; bj < 2; ++bj)
#pragma unroll
            for (int n = 0; n < 2; ++n) gt[bj][n] = *(const af4*)(mod + (size_t)b * 6144 + 2048 + col0 + bj * 128 + n * 16);
#pragma unroll
        for (int ai = 0; ai < 2; ++ai)
#pragma unroll
            for (int m = 0; m < 4; ++m) { const size_t off = (size_t)(u.pm * 256 + ai * 128 + wr * 64 + m * 16 + fr) * D + col0;
#pragma unroll
                for (int bj = 0; bj < 2; ++bj)
#pragma unroll
                    for (int n = 0; n < 2; ++n) { const af4 xv = *(const af4*)(x + off + bj * 128 + n * 16); *(af4*)(out + off + bj * 128 + n * 16) = xv + gt[bj][n] * acc[ai][bj][m][n]; }
                if (m & 1) asm volatile("" ::: "memory"); }
    }
};
struct EpiSwiGLU {
    static constexpr bool PERM = false;
    unsigned char* Y; const float* bgu;
    __device__ __forceinline__ void operator()(const af4 (&acc)[2][2][4][2], const Unit& u, int wr, int wc, int fr, int fq) const {
        const int f0 = u.pn * 128 + wc * 32 + 4 * fq; const float* bb = bgu + (size_t)u.e * 2048 + f0;
        af4 bg[2], bu[2];
#pragma unroll
        for (int n = 0; n < 2; ++n) { bg[n] = *(const af4*)(bb + 16 * n); bu[n] = *(const af4*)(bb + 1024 + 16 * n); }
#pragma unroll
        for (int ai = 0; ai < 2; ++ai)
#pragma unroll
            for (int m = 0; m < 4; ++m) { unsigned char* rowp = Y + (size_t)(u.pm * 256 + ai * 128 + wr * 64 + m * 16 + fr) * FF + f0;
#pragma unroll
                for (int n = 0; n < 2; ++n) { const af4 g = acc[ai][0][m][n] * WSCALE_INV + bg[n], up = acc[ai][1][m][n] * WSCALE_INV + bu[n]; af4 y;
#pragma unroll
                    for (int q = 0; q < 4; ++q) { const float gg = fminf(g[q], 7.f), uu = fminf(fmaxf(up[q], -7.f), 7.f); y[q] = (uu + 1.f) * gg * sigmoidf_(1.702f * gg); }
                    *(unsigned*)(rowp + 16 * n) = pk4_fp8(y[0], y[1], y[2], y[3]); } }
    }
};
struct EpiDown {
    static constexpr bool PERM = false;
    bf16* Cn; const float* bd; const float* roww;
    __device__ __forceinline__ void operator()(const af4 (&acc)[2][2][4][2], const Unit& u, int wr, int wc, int fr, int fq) const {
        const int col0 = u.pn * 256 + wc * 32 + 4 * fq; const float* bb = bd + (size_t)u.e * 1024 + col0;
        af4 bv[2][2];
#pragma unroll
        for (int bj = 0; bj < 2; ++bj)
#pragma unroll
            for (int n = 0; n < 2; ++n) bv[bj][n] = *(const af4*)(bb + bj * 128 + 16 * n);
#pragma unroll
        for (int ai = 0; ai < 2; ++ai)
#pragma unroll
            for (int m = 0; m < 4; ++m) { const int row = u.pm * 256 + ai * 128 + wr * 64 + m * 16 + fr; const float rw = roww[row]; bf16* rowp = Cn + (size_t)row * 1024 + col0;
#pragma unroll
                for (int bj = 0; bj < 2; ++bj)
#pragma unroll
                    for (int n = 0; n < 2; ++n) { const af4 v = (acc[ai][bj][m][n] * WSCALE_INV + bv[bj][n]) * rw;
                        v2u w; w.x = pg8::cvt_pk_bf16(v[0], v[1]); w.y = pg8::cvt_pk_bf16(v[2], v[3]); *(v2u*)(rowp + bj * 128 + 16 * n) = w; } }
    }
};

typedef float cf4 __attribute__((ext_vector_type(4)));
#define MFMA16(a, b, c) __builtin_amdgcn_mfma_f32_16x16x32_bf16((a), (b), (c), 0, 0, 0)
constexpr int GP = 72;
__device__ __forceinline__ void gla_a_unit(Frame& F, int chunk) {
    const int tid = F.tid, lane = F.lane, w = F.wave;
    const int bh = chunk >> 7, n = chunk & 127, b = bh >> 2, h = bh & 3;
    const size_t R0 = (size_t)b * SEQ + (size_t)n * 64;
    LAS float* gc = (LAS float*)F.lds;
    LAS float* segt = (LAS float*)(F.lds + 16384);
    LAS bf16* QEs = (LAS bf16*)(F.lds + 18432);
    LAS bf16* KEs = (LAS bf16*)(F.lds + 18432 + 9216);
    LAS bf16* KST = (LAS bf16*)(F.lds + 18432 + 2 * 9216);
    LAS bf16* VT = (LAS bf16*)(F.lds + 18432 + 3 * 9216);
    LAS bf16* AM = (LAS bf16*)(F.lds + 18432 + 3 * 9216 + 18432);
    const float* GK = wsp<const float>(F, WS_GK);
    { const int r = tid >> 3, d0 = (tid & 7) * 8; const float* gp = GK + (R0 + r) * 256 + h * 64 + d0;
      *(LAS f32x4*)(gc + r * 64 + d0) = *(const f32x4*)gp; *(LAS f32x4*)(gc + r * 64 + d0 + 4) = *(const f32x4*)(gp + 4); }
    __syncthreads();
    { const int seg = tid >> 6, d = tid & 63; float run = 0.f;
#pragma unroll
      for (int i = 0; i < 8; ++i) { run += gc[(seg * 8 + i) * 64 + d]; gc[(seg * 8 + i) * 64 + d] = run; }
      segt[seg * 64 + d] = run; }
    __syncthreads();
    { const int seg = tid >> 6, d = tid & 63; float off = 0.f;
      for (int s2 = 0; s2 < seg; ++s2) off += segt[s2 * 64 + d];
#pragma unroll
      for (int i = 0; i < 8; ++i) gc[(seg * 8 + i) * 64 + d] += off; }
    __syncthreads();
    { const int r = tid >> 3, d0 = (tid & 7) * 8;
      const v4u qv = *(const v4u*)(wsp<const bf16>(F, WS_QG) + (R0 + r) * 256 + h * 64 + d0);
      const v4u kv = *(const v4u*)(wsp<const bf16>(F, WS_KG) + (R0 + r) * 256 + h * 64 + d0);
      float qf[8], kf[8];
#pragma unroll
      for (int i = 0; i < 4; ++i) { qf[2 * i] = bflo(qv[i]); qf[2 * i + 1] = bfhi(qv[i]); kf[2 * i] = bflo(kv[i]); kf[2 * i + 1] = bfhi(kv[i]); }
      float qe[8], ke[8];
#pragma unroll
      for (int i = 0; i < 8; ++i) { const float g = gc[r * 64 + d0 + i], gl = gc[63 * 64 + d0 + i];
          qe[i] = qf[i] * __expf(g); ke[i] = kf[i] * __expf(-g); KST[(d0 + i) * GP + r] = (bf16)f2bf(kf[i] * __expf(gl - g)); }
      v4u qo, ko;
#pragma unroll
      for (int i = 0; i < 4; ++i) { qo[i] = pk2(qe[2 * i], qe[2 * i + 1]); ko[i] = pk2(ke[2 * i], ke[2 * i + 1]); }
      *(LAS v4u*)(QEs + r * GP + d0) = qo; *(LAS v4u*)(KEs + r * GP + d0) = ko;
      *(v4u*)(wsp<bf16>(F, WS_QE) + (R0 + r) * 256 + h * 64 + d0) = qo;
      const int e0 = (tid & 7) * 16;
      const v4u va = *(const v4u*)(wsp<const bf16>(F, WS_VG) + (R0 + r) * 512 + h * 128 + e0);
      const v4u vb = *(const v4u*)(wsp<const bf16>(F, WS_VG) + (R0 + r) * 512 + h * 128 + e0 + 8);
#pragma unroll
      for (int i = 0; i < 4; ++i) { VT[(e0 + 2 * i) * GP + r] = (bf16)(va[i] & 0xffffu); VT[(e0 + 2 * i + 1) * GP + r] = (bf16)(va[i] >> 16);
                                    VT[(e0 + 8 + 2 * i) * GP + r] = (bf16)(vb[i] & 0xffffu); VT[(e0 + 8 + 2 * i + 1) * GP + r] = (bf16)(vb[i] >> 16); }
      if (tid < 64) wsp<float>(F, WS_DEC)[(size_t)chunk * 64 + tid] = __expf(gc[63 * 64 + tid]);
    }
    __syncthreads();
    const int l15 = lane & 15, l4 = lane >> 4;
#pragma unroll
    for (int q = 0; q < 2; ++q) { const int tile = 2 * w + q, ti = tile >> 2, tj = tile & 3;
        cf4 a = {0.f, 0.f, 0.f, 0.f};
        if (tj <= ti) {
#pragma unroll
            for (int kk = 0; kk < 2; ++kk) { const bf16x8 fa = *(const LAS bf16x8*)(QEs + (16 * ti + l15) * GP + kk * 32 + 8 * l4); const bf16x8 fb = *(const LAS bf16x8*)(KEs + (16 * tj + l15) * GP + kk * 32 + 8 * l4); a = MFMA16(fa, fb, a); } }
#pragma unroll
        for (int r = 0; r < 4; ++r) { const int cr = 16 * ti + 4 * l4 + r, cj = 16 * tj + l15; AM[cr * GP + cj] = (bf16)f2bf(cj <= cr ? a[r] : 0.f); } }
    { float* UT = wsp<float>(F, WS_UT) + (size_t)chunk * 8192;
#pragma unroll
      for (int td = 0; td < 4; ++td) { cf4 a = {0.f, 0.f, 0.f, 0.f};
#pragma unroll
          for (int kk = 0; kk < 2; ++kk) { const bf16x8 fa = *(const LAS bf16x8*)(VT + (16 * w + l15) * GP + kk * 32 + 8 * l4); const bf16x8 fb = *(const LAS bf16x8*)(KST + (16 * td + l15) * GP + kk * 32 + 8 * l4); a = MFMA16(fa, fb, a); }
#pragma unroll
          for (int r = 0; r < 4; ++r) UT[(16 * w + 4 * l4 + r) * 64 + 16 * td + l15] = a[r]; } }
    __syncthreads();
    { float* OI = wsp<float>(F, WS_OI);
#pragma unroll
      for (int tc = 0; tc < 4; ++tc) { cf4 a = {0.f, 0.f, 0.f, 0.f};
#pragma unroll
          for (int kk = 0; kk < 2; ++kk) { const bf16x8 fa = *(const LAS bf16x8*)(AM + (16 * tc + l15) * GP + kk * 32 + 8 * l4); const bf16x8 fb = *(const LAS bf16x8*)(VT + (16 * w + l15) * GP + kk * 32 + 8 * l4); a = MFMA16(fa, fb, a); }
#pragma unroll
          for (int r = 0; r < 4; ++r) OI[(R0 + 16 * tc + 4 * l4 + r) * 512 + h * 128 + 16 * w + l15] = a[r]; } }
    __syncthreads();
}
__device__ __forceinline__ void gla_b_phase(Frame& F) {
    const float* UT = wsp<const float>(F, WS_UT); const float* DEC = wsp<const float>(F, WS_DEC); bf16* SP = wsp<bf16>(F, WS_SP);
    for (int gt = F.vcu * 512 + F.tid; gt < 16 * 8192; gt += F.G * 512) {
        const int bh = gt >> 13, ed = gt & 8191, d = gt & 63; float S = 0.f;
#pragma unroll 8
        for (int n = 0; n < 128; ++n) { const size_t ch = (size_t)bh * 128 + n; const float u = UT[ch * 8192 + ed], dc = DEC[ch * 64 + d]; SP[ch * 8192 + ed] = (bf16)f2bf(S); S = S * dc + u; }
    }
}
__device__ __forceinline__ void gla_c_unit(Frame& F, int unit) {
    const int tid = F.tid, lane = F.lane, w = F.wave;
    const int bh = unit >> 6, n2 = unit & 63, b = bh >> 2, h = bh & 3;
    const size_t R0 = (size_t)b * SEQ + (size_t)n2 * 128;
    LAS bf16* QEs = (LAS bf16*)F.lds;
    LAS bf16* SPs = (LAS bf16*)(F.lds + 18432);
    { const int r = tid >> 2, d0 = (tid & 3) * 16; const bf16* src = wsp<const bf16>(F, WS_QE) + (R0 + r) * 256 + h * 64 + d0;
      *(LAS v4u*)(QEs + r * GP + d0) = *(const v4u*)src; *(LAS v4u*)(QEs + r * GP + d0 + 8) = *(const v4u*)(src + 8);
      const bf16* sp = wsp<const bf16>(F, WS_SP) + ((size_t)bh * 128 + 2 * n2) * 8192;
      const int row = tid >> 1, dd = (tid & 1) * 32;
#pragma unroll
      for (int i = 0; i < 4; ++i) *(LAS v4u*)(SPs + row * GP + dd + 8 * i) = *(const v4u*)(sp + (size_t)row * 64 + dd + 8 * i); }
    __syncthreads();
    const int l15 = lane & 15, l4 = lane >> 4, c2 = w >> 2, tc = w & 3;
    cf4 a[8];
#pragma unroll
    for (int te = 0; te < 8; ++te) { a[te] = (cf4){0.f, 0.f, 0.f, 0.f};
#pragma unroll
        for (int kk = 0; kk < 2; ++kk) { const bf16x8 fa = *(const LAS bf16x8*)(QEs + (64 * c2 + 16 * tc + l15) * GP + kk * 32 + 8 * l4); const bf16x8 fb = *(const LAS bf16x8*)(SPs + (128 * c2 + 16 * te + l15) * GP + kk * 32 + 8 * l4); a[te] = MFMA16(fa, fb, a[te]); } }
    const float* OI = wsp<const float>(F, WS_OI); const bf16* RG = wsp<const bf16>(F, WS_RG); bf16* A2 = wsp<bf16>(F, WS_A2);
    float gg[8];
#pragma unroll
    for (int te = 0; te < 8; ++te) gg[te] = F.g_gla_out[16 * te + l15];
#pragma unroll
    for (int r = 0; r < 4; ++r) { const size_t row = R0 + 64 * c2 + 16 * tc + 4 * l4 + r; float ss = 0.f; float o[8];
#pragma unroll
        for (int te = 0; te < 8; ++te) { o[te] = a[te][r] + OI[row * 512 + h * 128 + 16 * te + l15]; ss += o[te] * o[te]; }
        ss += __shfl_xor(ss, 1); ss += __shfl_xor(ss, 2); ss += __shfl_xor(ss, 4); ss += __shfl_xor(ss, 8);
        const float rs = rsqrtf(ss * (1.f / 128.f) + EPS);
#pragma unroll
        for (int te = 0; te < 8; ++te) { const int e = 16 * te + l15; A2[row * 1024 + h * 128 + e] = (bf16)f2bf(o[te] * rs * gg[te] * bf2f(RG[row * 512 + h * 128 + e])); } }
    __syncthreads();
}

namespace att {
constexpr int KSLOT = 8192, VSLOT = 16384, NSLOT = 3;
constexpr int LDS_K = 0, LDS_V = NSLOT * KSLOT, LDS_TBL = LDS_V + NSLOT * VSLOT, LDS_WS = LDS_TBL + 1024, LDS_Q = LDS_WS + 8 * 256, LDS_END = LDS_Q + 8 * 4096;
static_assert(LDS_END <= RING_BYTES, "attention LDS");
__device__ __forceinline__ int crow(int r, int hi) { return (r & 3) + 8 * (r >> 2) + 4 * hi; }
__device__ __forceinline__ void glds16(const void* gsrc, unsigned lds_dst) { unsigned keep;
    asm volatile("s_mov_b32 %0, m0\n\ts_mov_b32 m0, %2\n\ts_nop 0\n\tglobal_load_lds_dwordx4 %1, off\n\ts_mov_b32 m0, %0" : "=&s"(keep) : "v"(gsrc), "s"(lds_dst) : "memory"); }
typedef float f32x2_t __attribute__((ext_vector_type(2))); typedef __bf16 bf16x2_t __attribute__((ext_vector_type(2)));
__device__ __forceinline__ unsigned cvtpk_s(float lo, float hi) { f32x2_t v = {lo, hi}; bf16x2_t b = __builtin_convertvector(v, bf16x2_t); return __builtin_bit_cast(unsigned, b); }
typedef short v4i16_t __attribute__((ext_vector_type(4)));
typedef LAS const char* lds_cptr;
__device__ __forceinline__ s16x4 vtr(lds_cptr p) { return __builtin_bit_cast(s16x4, __builtin_amdgcn_ds_read_tr16_b64_v4i16((LAS v4i16_t*)p)); }
#define MFMA32(a, b, c) __builtin_amdgcn_mfma_f32_32x32x16_bf16((a), (b), (c), 0, 0, 0)
#define ATT_WAIT_BAR(N) asm volatile("s_waitcnt vmcnt(" #N ") lgkmcnt(0)\n\ts_barrier" ::: "memory")

__device__ __forceinline__ void attn_map(f32x16 (&o)[4], int b, int h, int m, int qb, const bf16* QD, const bf16* KD, const bf16* VD, LAS unsigned char* shm) {
    int lane = threadIdx.x & 63; asm volatile("" : "+v"(lane));
    const int tid = threadIdx.x, r32 = lane & 31, hi = lane >> 5; const int wid = __builtin_amdgcn_readfirstlane(tid >> 6);
    const size_t rowbase = (size_t)b * SEQ; const int q0 = qb * 256;
    const bf16* Qw = QD + (rowbase + q0 + wid * 32) * 512 + (h * 2 + m) * 64;
    const bf16* Kh = KD + rowbase * 512 + (h * 2 + m) * 64; const bf16* Vh = VD + rowbase * 512 + h * 128;
    const unsigned lds0 = (unsigned)(uintptr_t)shm;
    const LAS float* tbl = (const LAS float*)(shm + LDS_TBL) + m * 128;
    LAS float* wsf = (LAS float*)(shm + LDS_WS) + wid * 64;
    const bf16* ksrc = Kh + (size_t)lane * 512 + wid * 8;
    const bf16* vsrc = Vh + (size_t)(16 * (wid & 3) + (lane >> 2)) * 512 + (wid >> 2) * 32 + (lane & 3) * 8;
    const unsigned kdst = lds0 + LDS_K + wid * 1024, vdst = lds0 + LDS_V + wid * 1024;
#define DMA_K(t, slot) glds16(ksrc + (size_t)(t) * 64 * 512, (unsigned)__builtin_amdgcn_readfirstlane(kdst + (slot) * KSLOT))
#define DMA_V(t, slot) do { glds16(vsrc + (size_t)(t) * 64 * 512, (unsigned)__builtin_amdgcn_readfirstlane(vdst + (slot) * VSLOT)); \
        glds16(vsrc + (size_t)(t) * 64 * 512 + 64, (unsigned)__builtin_amdgcn_readfirstlane(vdst + (slot) * VSLOT + 8192)); } while (0)
    const int NT = 4 * qb + 4;
    VM_WAIT();
    DMA_K(0, 0); DMA_V(0, 0); DMA_K(1, 1); DMA_K(2, 2);
    const lds_cptr qlds = (lds_cptr)shm + LDS_Q + wid * 4096 + lane * 16;
    { bf16x8 qr[4];
#pragma unroll
      for (int d0 = 0; d0 < 4; ++d0) qr[d0] = *(const bf16x8*)(Qw + (size_t)r32 * 512 + d0 * 16 + hi * 8);
      asm volatile("s_waitcnt vmcnt(0)" : "+v"(qr[0]), "+v"(qr[1]), "+v"(qr[2]), "+v"(qr[3]) :: "memory");
#pragma unroll
      for (int d0 = 0; d0 < 4; ++d0) *(LAS bf16x8*)(shm + LDS_Q + wid * 4096 + lane * 16 + d0 * 1024) = qr[d0]; }
#pragma unroll
    for (int d0 = 0; d0 < 4; ++d0) o[d0] = (f32x16){};
    float lsum = 0.f;
    const int qw0 = q0 + wid * 32, qabs = qw0 + r32;
    const lds_cptr shm3 = (lds_cptr)shm;
    const lds_cptr kp0 = shm3 + LDS_K + hi * 1024 + r32 * 16;
    const lds_cptr vp0 = shm3 + LDS_V + ((lane >> 4) & 1) * 32 + (lane & 3) * 8 + (4 * hi + ((lane & 15) >> 2)) * 64;
#define QK_TILE(C0, C1, kp) do { C0 = (f32x16){}; C1 = (f32x16){}; \
        _Pragma("unroll") for (int d0 = 0; d0 < 4; ++d0) { if (d0 == 2) __builtin_amdgcn_sched_barrier(0); const bf16x8 b0 = *(const LAS bf16x8*)((kp) + d0 * 2048); const bf16x8 b1 = *(const LAS bf16x8*)((kp) + d0 * 2048 + 512); \
            const bf16x8 qf_ = *(const LAS bf16x8*)(qlds + d0 * 1024); C0 = MFMA32(b0, qf_, C0); C1 = MFMA32(b1, qf_, C1); } } while (0)
#define MASK_BIAS(C0, C1, t) do { const int kvb_ = (t) * 64; if (kvb_ + 191 > qw0) { int dbase = qabs - kvb_ - 4 * hi; asm volatile("" : "+v"(dbase)); \
        _Pragma("unroll") for (int r = 0; r < 16; ++r) { const int d0_ = dbase - ((r & 3) + 8 * (r >> 2)); const int d1_ = d0_ - 32; \
            C0[r] = d0_ < 0 ? -INFINITY : C0[r] + tbl[d0_ > 127 ? 127 : d0_]; C1[r] = d1_ < 0 ? -INFINITY : C1[r] + tbl[d1_ > 127 ? 127 : d1_]; } } } while (0)
#define VLOAD(vf, vp, d0) do { _Pragma("unroll") for (int ks = 0; ks < 4; ++ks) { const s16x4 lo_ = vtr((vp) + (d0) * 4096 + ks * 1024), hh_ = vtr((vp) + (d0) * 4096 + ks * 1024 + 512); \
            vf[ks] = (bf16x8){lo_[0], lo_[1], lo_[2], lo_[3], hh_[0], hh_[1], hh_[2], hh_[3]}; } } while (0)
#define PV4(d0, vf) do { _Pragma("unroll") for (int ks = 0; ks < 4; ++ks) o[d0] = MFMA32(__builtin_bit_cast(bf16x8, pw[ks]), vf[ks], o[d0]); } while (0)
#define PACK_SUM(P0, P1) do { float sacc = 0.f; _Pragma("unroll") for (int r = 0; r < 16; ++r) sacc += P0[r] + P1[r]; lsum += sacc; \
        _Pragma("unroll") for (int i = 0; i < 4; ++i) { pw[0][i] = cvtpk_s(P0[2 * i], P0[2 * i + 1]); pw[1][i] = cvtpk_s(P0[8 + 2 * i], P0[9 + 2 * i]); pw[2][i] = cvtpk_s(P1[2 * i], P1[2 * i + 1]); pw[3][i] = cvtpk_s(P1[8 + 2 * i], P1[9 + 2 * i]); } } while (0)
#define EXP_PACK(C, pwa, pwb) do { float sacc = 0.f; _Pragma("unroll") for (int r = 0; r < 16; ++r) { C[r] = __builtin_amdgcn_exp2f(C[r]); sacc += C[r]; } lsum += sacc; \
        _Pragma("unroll") for (int i = 0; i < 4; ++i) { pwa[i] = cvtpk_s(C[2 * i], C[2 * i + 1]); pwb[i] = cvtpk_s(C[8 + 2 * i], C[9 + 2 * i]); } } while (0)
#define KLOAD(kf, kp) do { _Pragma("unroll") for (int d0 = 0; d0 < 4; ++d0) { kf[2 * d0] = *(const LAS bf16x8*)((kp) + d0 * 2048); kf[2 * d0 + 1] = *(const LAS bf16x8*)((kp) + d0 * 2048 + 512); } } while (0)
#define QLOAD(qf) do { _Pragma("unroll") for (int d0 = 0; d0 < 4; ++d0) qf[d0] = *(const LAS bf16x8*)(qlds + d0 * 1024); } while (0)
#define QK8(C0, C1, kf, qf) do { C0 = (f32x16){}; C1 = (f32x16){}; _Pragma("unroll") for (int d0 = 0; d0 < 4; ++d0) { C0 = MFMA32(kf[2 * d0], qf[d0], C0); C1 = MFMA32(kf[2 * d0 + 1], qf[d0], C1); } } while (0)
#define SB() __builtin_amdgcn_sched_barrier(0)
    f32x16 C0, C1; v4u pw[4], pwn[4]; bf16x8 va[4], vb[4], kf[8], qf[4];
    ATT_WAIT_BAR(0);
    KLOAD(kf, kp0); QLOAD(qf);
    ATT_WAIT_BAR(0);
    if (3 < NT) DMA_K(3, 0);
    DMA_V(1, 1);
    QK8(C0, C1, kf, qf);
    MASK_BIAS(C0, C1, 0);
    EXP_PACK(C0, pw[0], pw[1]); EXP_PACK(C1, pw[2], pw[3]);
    KLOAD(kf, kp0 + KSLOT);
    int ks_cur = 1, vs_prev = 0;
    for (int t = 1; t < NT; ++t) {
        if (t + 2 < NT) { ATT_WAIT_BAR(3); } else { ATT_WAIT_BAR(2); }
        { const int vs_new = (vs_prev == 0) ? 2 : vs_prev - 1;
          if (t + 3 < NT) DMA_K(t + 3, ks_cur);
          if (t + 1 < NT) DMA_V(t + 1, vs_new); }
        const int ks_next = (ks_cur == 2) ? 0 : ks_cur + 1;
        const lds_cptr vp = vp0 + vs_prev * VSLOT;
        SB();
        VLOAD(va, vp, 0); VLOAD(vb, vp, 1); QLOAD(qf);
        SB();
        QK8(C0, C1, kf, qf);
        SB();
        MASK_BIAS(C0, C1, t);
        SB();
        PV4(0, va); PV4(1, vb);
        SB();
        VLOAD(va, vp, 2); VLOAD(vb, vp, 3);
        KLOAD(kf, kp0 + ks_next * KSLOT);
        SB();
        EXP_PACK(C0, pwn[0], pwn[1]);
        SB();
        PV4(2, va); PV4(3, vb);
        EXP_PACK(C1, pwn[2], pwn[3]);
        SB();
#pragma unroll
        for (int i = 0; i < 4; ++i) pw[i] = pwn[i];
        ks_cur = ks_next; vs_prev = (vs_prev == 2) ? 0 : vs_prev + 1;
    }
    ATT_WAIT_BAR(0);
    { const lds_cptr vp = vp0 + vs_prev * VSLOT;
      VLOAD(va, vp, 0); VLOAD(vb, vp, 1); PV4(0, va); PV4(1, vb);
      VLOAD(va, vp, 2); VLOAD(vb, vp, 3); PV4(2, va); PV4(3, vb); }
    { auto rr = __builtin_amdgcn_permlane32_swap(__float_as_uint(lsum), __float_as_uint(lsum), false, false); lsum = __uint_as_float(rr[0]) + __uint_as_float(rr[1]); }
    if (hi == 0) wsf[r32] = lsum;
    LDS_WAIT();
#pragma unroll
    for (int r = 0; r < 16; ++r) { const float rl = 1.0f / wsf[crow(r, hi)];
#pragma unroll
        for (int d0 = 0; d0 < 4; ++d0) o[d0][r] *= rl; }
    ATT_WAIT_BAR(0);
#undef DMA_K
#undef DMA_V
#undef QK_TILE
#undef MASK_BIAS
#undef VLOAD
#undef PV4
#undef PACK_SUM
#undef EXP_PACK
#undef KLOAD
#undef QLOAD
#undef QK8
#undef SB
}
__device__ __forceinline__ int t5_bucket(int n) {
    if (n < 16) return n;
    const float nf = (float)n; int large = 16 + (int)(logf(nf / 16.f) / logf(8.f) * 16.f);
    return large < 31 ? large : 31;
}
__device__ __forceinline__ void attn_unit(Frame& F, int b, int h, int qb, float lam) {
    LAS unsigned char* shm = F.lds;
    int tid = F.tid; asm volatile("" : "+v"(tid));
    const int lane = tid & 63, r32 = lane & 31, hi = lane >> 5, wid = F.wave;
    if (tid < 256) { const int m = tid >> 7, d = tid & 127; const int col = h * 2 + m;
        ((LAS float*)(shm + LDS_TBL))[tid] = (F.rel_bias[t5_bucket(d) * 8 + col] - F.rel_bias[31 * 8 + col]) * LOG2E; }
    __syncthreads();
    const bf16* QD = wsp<const bf16>(F, WS_QD); const bf16* KD = wsp<const bf16>(F, WS_KD); const bf16* VD = wsp<const bf16>(F, WS_VD);
    float* stash = wsp<float>(F, WS_STASH) + (size_t)F.vcu * 32768 + tid * 64;
    f32x16 o[4];
#pragma nounroll
    for (int m = 0; m < 2; ++m) {
        attn_map(o, b, h, m, qb, QD, KD, VD, shm);
        if (m == 0) {
#pragma unroll
            for (int d0 = 0; d0 < 4; ++d0)
#pragma unroll
                for (int r = 0; r < 16; r += 4) *(f32x4*)(stash + d0 * 16 + r) = (f32x4){o[d0][r], o[d0][r + 1], o[d0][r + 2], o[d0][r + 3]};
        } else {
            float ss[16];
#pragma unroll
            for (int r = 0; r < 16; ++r) ss[r] = 0.f;
#pragma unroll
            for (int d0 = 0; d0 < 4; ++d0)
#pragma unroll
                for (int r4 = 0; r4 < 16; r4 += 4) { const f32x4 sv = *(const f32x4*)(stash + d0 * 16 + r4);
#pragma unroll
                    for (int q = 0; q < 4; ++q) { const int r = r4 + q; const float v = sv[q] - lam * o[d0][r]; o[d0][r] = v; ss[r] += v * v; } }
            float gs[4];
#pragma unroll
            for (int d0 = 0; d0 < 4; ++d0) gs[d0] = F.g_subln[32 * d0 + r32] * 0.8f;
            bf16* A2 = wsp<bf16>(F, WS_A2);
            const size_t rowb = (size_t)b * SEQ + (size_t)qb * 256 + wid * 32;
            bf16* a2b = A2 + (rowb + 4 * hi) * 1024 + 512 + h * 128 + r32; asm volatile("" : "+v"(a2b));
#pragma unroll
            for (int r = 0; r < 16; ++r) { float s = ss[r];
                s += __shfl_xor(s, 1); s += __shfl_xor(s, 2); s += __shfl_xor(s, 4); s += __shfl_xor(s, 8); s += __shfl_xor(s, 16);
                const float rs = rsqrtf(s * (1.f / 128.f) + EPS);
                bf16* rowp = a2b + (size_t)((r & 3) + 8 * (r >> 2)) * 1024;
#pragma unroll
                for (int d0 = 0; d0 < 4; ++d0) rowp[32 * d0] = (bf16)f2bf(o[d0][r] * rs * gs[d0]); }
        }
    }
    __syncthreads();
}
}

__device__ __forceinline__ void p7_phase(Frame& F) {
    const int tid = F.tid, lane = F.lane;
    LAS float* wr = (LAS float*)F.lds;
    LAS unsigned* hist = (LAS unsigned*)(F.lds + HIST_OFF);
    for (int idx = tid; idx < 32768; idx += 512) { const int k = idx >> 5, e = idx & 31; wr[e * 1024 + k] = F.w_router[idx]; }
    if (tid < 32) hist[tid] = 0u;
    __syncthreads();
    const float* MOD = wsp<const float>(F, WS_MOD);
    const int gw = F.vcu * NWAVES + F.wave, NGW = F.G * NWAVES; const int rpw = (T + NGW - 1) / NGW;
    int curb = -1; f32x4 gsc[4], shv[4];
    for (int i = 0; i < rpw; ++i) {
        const int m = gw * rpw + i; if (m >= T) break;
        const int b = m / SEQ;
        if (b != curb) { curb = b;
#pragma unroll
            for (int j = 0; j < 4; ++j) { const int col = 256 * j + 4 * lane; const f32x4 g = *(const f32x4*)(F.g_norm2 + col);
                shv[j] = *(const f32x4*)(MOD + (size_t)b * 6144 + 3072 + col); gsc[j] = g * (*(const f32x4*)(MOD + (size_t)b * 6144 + 4096 + col) + 1.0f); } }
        const GAS f32x4* xr = (const GAS f32x4*)(F.out + (size_t)m * D) + lane;
        f32x4 v[4]; float s = 0.f;
#pragma unroll
        for (int j = 0; j < 4; ++j) { v[j] = xr[64 * j]; s += (v[j].x * v[j].x + v[j].y * v[j].y) + (v[j].z * v[j].z + v[j].w * v[j].w); }
        const float rstd = rsqrtf(wave_sum(s) * (1.f / D) + EPS);
        GAS unsigned* o4 = (GAS unsigned*)(wsp<unsigned char>(F, WS_XN) + (size_t)m * D) + lane;
#pragma unroll
        for (int j = 0; j < 4; ++j) { v[j] = v[j] * rstd * gsc[j] + shv[j]; o4[64 * j] = pk4_fp8(v[j].x, v[j].y, v[j].z, v[j].w); }
        float lg[32];
#pragma unroll
        for (int e = 0; e < 32; ++e) { float a = 0.f;
#pragma unroll
            for (int j = 0; j < 4; ++j) { const f32x4 w = *(const LAS f32x4*)(wr + e * 1024 + 256 * j + 4 * lane); a += (v[j].x * w.x + v[j].y * w.y) + (v[j].z * w.z + v[j].w * w.w); }
            lg[e] = wave_sum(a) + F.b_router[e]; }
        int te[4]; float tv[4];
#pragma unroll
        for (int k = 0; k < 4; ++k) { float bv = -INFINITY; int bi = 0;
#pragma unroll
            for (int e = 0; e < 32; ++e) { const bool c = lg[e] > bv; bv = c ? lg[e] : bv; bi = c ? e : bi; }
            te[k] = bi; tv[k] = bv;
#pragma unroll
            for (int e = 0; e < 32; ++e) lg[e] = (e == bi) ? -INFINITY : lg[e]; }
        float ex[4], es = 0.f;
#pragma unroll
        for (int k = 0; k < 4; ++k) { ex[k] = __expf(tv[k] - tv[0]); es += ex[k]; }
        if (lane < 4) { const int e = lane == 0 ? te[0] : lane == 1 ? te[1] : lane == 2 ? te[2] : te[3]; const float w = (lane == 0 ? ex[0] : lane == 1 ? ex[1] : lane == 2 ? ex[2] : ex[3]) / es;
            wsp<int>(F, WS_TOPE)[(size_t)m * 4 + lane] = e; wsp<float>(F, WS_TOPW)[(size_t)m * 4 + lane] = w; __hip_atomic_fetch_add(hist + e, 1u, __ATOMIC_RELAXED, __HIP_MEMORY_SCOPE_WORKGROUP); }
    }
    __syncthreads();
    if (tid < 32) __hip_atomic_fetch_add(F.ctl + CW_CNT + tid, hist[tid], RLX_AGENT);
}
__device__ __forceinline__ void moe_tables(Frame& F, int& nMt) {
    LAS unsigned char* te = F.lds + TILEE_OFF;
    if (F.tid == 0) { int t0 = 0;
        for (int e = 0; e < NE; ++e) { const int c = (int)__hip_atomic_load(F.ctl + CW_CNT + e, RLX_AGENT); const int nt = (c + 255) >> 8; for (int j = 0; j < nt; ++j) te[t0 + j] = (unsigned char)e; t0 += nt; }
        F.MISC[16] = (unsigned)t0; }
    __syncthreads();
    nMt = __builtin_amdgcn_readfirstlane((int)F.MISC[16]);
}
__device__ __forceinline__ void p8_phase(Frame& F) {
    const int tid = F.tid, lane = F.lane;
    LAS unsigned* hist = (LAS unsigned*)(F.lds + HIST_OFF);
    if (tid < 96) hist[tid] = 0u;
    __syncthreads();
    const int gw = F.vcu * NWAVES + F.wave, NGW = F.G * NWAVES; const int rpw = (T + NGW - 1) / NGW;
    const int* TOPE = wsp<const int>(F, WS_TOPE); const float* TOPW = wsp<const float>(F, WS_TOPW);
    for (int i = 0; i < rpw; ++i) { const int m = gw * rpw + i; if (m >= T) break; if (lane < 4) __hip_atomic_fetch_add(hist + TOPE[(size_t)m * 4 + lane], 1u, __ATOMIC_RELAXED, __HIP_MEMORY_SCOPE_WORKGROUP); }
    __syncthreads();
    if (tid < 32) { unsigned pstart = 0; for (int e = 0; e < tid; ++e) { const unsigned c = __hip_atomic_load(F.ctl + CW_CNT + e, RLX_AGENT); pstart += (c + 255u) & ~255u; }
        hist[32 + tid] = pstart + __hip_atomic_fetch_add(F.ctl + CW_FILL + tid, hist[tid], RLX_AGENT); }
    __syncthreads();
    const unsigned char* H2 = wsp<const unsigned char>(F, WS_XN); unsigned char* XS = wsp<unsigned char>(F, WS_XS);
    for (int i = 0; i < rpw; ++i) { const int m = gw * rpw + i; if (m >= T) break;
        int pos = 0;
        if (lane < 4) { const int e = TOPE[(size_t)m * 4 + lane]; pos = (int)(hist[32 + e] + __hip_atomic_fetch_add(hist + 64 + e, 1u, __ATOMIC_RELAXED, __HIP_MEMORY_SCOPE_WORKGROUP));
            wsp<int>(F, WS_POS)[(size_t)m * 4 + lane] = pos; wsp<float>(F, WS_ROWW)[pos] = TOPW[(size_t)m * 4 + lane]; }
        const v4u a = *(const v4u*)(H2 + (size_t)m * D + lane * 16);
#pragma unroll
        for (int k = 0; k < 4; ++k) { const int p = __shfl(pos, k); *(v4u*)(XS + (size_t)p * D + lane * 16) = a; }
    }
}
__device__ __forceinline__ void p11_phase(Frame& F) {
    const int lane = F.lane;
    const float* MOD = wsp<const float>(F, WS_MOD); const bf16* CN = wsp<const bf16>(F, WS_CN); const int* POS = wsp<const int>(F, WS_POS);
    const int gw = F.vcu * NWAVES + F.wave, NGW = F.G * NWAVES; const int rpw = (T + NGW - 1) / NGW;
    for (int i = 0; i < rpw; ++i) { const int m = gw * rpw + i; if (m >= T) break;
        const int b = m / SEQ;
        float acc[16];
#pragma unroll
        for (int q = 0; q < 16; ++q) acc[q] = 0.f;
#pragma unroll
        for (int k = 0; k < 4; ++k) { const int p = POS[(size_t)m * 4 + k];
            const v4u a = *(const v4u*)(CN + (size_t)p * D + lane * 16), c = *(const v4u*)(CN + (size_t)p * D + lane * 16 + 8);
#pragma unroll
            for (int q = 0; q < 4; ++q) { acc[2 * q] += bflo(a[q]); acc[2 * q + 1] += bfhi(a[q]); acc[8 + 2 * q] += bflo(c[q]); acc[8 + 2 * q + 1] += bfhi(c[q]); } }
        float* orow = F.out + (size_t)m * D + lane * 16; const float* gt = MOD + (size_t)b * 6144 + 5120 + lane * 16;
#pragma unroll
        for (int q = 0; q < 4; ++q) { const f32x4 xv = *(const f32x4*)(orow + 4 * q), g = *(const f32x4*)(gt + 4 * q); const f32x4 av = {acc[4 * q], acc[4 * q + 1], acc[4 * q + 2], acc[4 * q + 3]};
            *(f32x4*)(orow + 4 * q) = xv + g * av; }
    }
}

constexpr int NPHASE = 12;
struct Args { const float* in[25]; float* out; unsigned char* ws; int ph_lo, ph_hi; };
__global__ void __launch_bounds__(NWAVES * 64, 2) fwd_kernel(Args args) {
    extern __shared__ __attribute__((aligned(16))) unsigned char lds[];
    Frame F;
    F.lds = (LAS unsigned char*)lds;
    F.MISC = (volatile LAS unsigned*)(F.lds + MISC_OFF);
    F.tid = threadIdx.x; F.lane = F.tid & 63; F.wave = __builtin_amdgcn_readfirstlane(F.tid >> 6);
    F.G = gridDim.x; { const int bx = blockIdx.x; F.vcu = (F.G % 8 == 0) ? (bx % 8) * (F.G / 8) + bx / 8 : bx; }
    F.ws = args.ws; F.ctl = (gu32*)(args.ws + WS_CTL); F.out = args.out;
    F.x = args.in[0]; F.c = args.in[1]; F.rel_bias = args.in[2]; F.w_ada = args.in[3]; F.b_ada = args.in[4]; F.g_norm1 = args.in[5]; F.w_in = args.in[6];
    F.w_gk_up = args.in[7]; F.b_gk_up = args.in[8]; F.g_gla_out = args.in[9]; F.g_qnorm = args.in[10]; F.g_knorm = args.in[11];
    F.lq1 = args.in[12]; F.lk1 = args.in[13]; F.lq2 = args.in[14]; F.lk2 = args.in[15]; F.g_subln = args.in[16]; F.w_out = args.in[17];
    F.g_norm2 = args.in[18]; F.w_router = args.in[19]; F.b_router = args.in[20]; F.w_gate_up = args.in[21]; F.b_gate_up = args.in[22]; F.w_down = args.in[23]; F.b_down = args.in[24];
    for (int u = F.tid; u < (LDS_BYTES - LDSCTL_OFF) / 4; u += NWAVES * 64) ((LAS unsigned*)(F.lds + LDSCTL_OFF))[u] = 0u;
    __syncthreads();
    const int lo = args.ph_lo, hi = args.ph_hi;
    const bool multi = (hi - lo) > 1;
    XcdBarrier bar; bar.bar = (unsigned*)(F.ctl + CW_BAR); bar.x = 0; bar.st = nullptr;
    if (multi) bar = xcd_barrier_post((unsigned*)(F.ctl + CW_BAR), F.MISC + 8);
#ifndef PHMASK
#define PHMASK 0xFFF
#endif
#define IN(k) (((PHMASK >> (k)) & 1) && lo <= (k) && (k) < hi)
#define SEAM(k) do { if (IN((k) + 1)) xcd_barrier(bar); } while (0)
#ifndef REPEAT_PH
#define REPEAT_PH 0
#endif
#define REPS(k) (((REPEAT_PH >> (k)) & 1) ? 2 : 1)

    if (IN(0)) { for (int rep_ = 0; rep_ < REPS(0); ++rep_) { if (rep_) xcd_barrier(bar); p0_phase(F); } SEAM(0); }
    if (IN(1)) { for (int rep_ = 0; rep_ < REPS(1); ++rep_) { if (rep_) xcd_barrier(bar); p1_phase(F); } SEAM(1); }
    if (IN(2)) {
        pg8::Gemm g{wsp<const bf16>(F, WS_XN), wsp<const bf16>(F, WS_WIN), T, NIN, D, 0};
        pg8::StaticOrder S; S.init(T / 256, NIN / 256, F.G, (int)blockIdx.x, nullptr, REPS(2));
        EpiInProj E{wsp<bf16>(F, WS_QG), wsp<bf16>(F, WS_KG), wsp<bf16>(F, WS_VG), wsp<bf16>(F, WS_RG), wsp<bf16>(F, WS_QD), wsp<bf16>(F, WS_KD), wsp<bf16>(F, WS_VD), F.g_qnorm, F.g_knorm};
        pg8::gemm_phase<EpiInProj, pg8::StaticOrder>(F.lds, g, S, E);
        SEAM(2);
    }
    if (IN(3)) { for (int rep_ = 0; rep_ < REPS(3); ++rep_) { if (rep_) xcd_barrier(bar); for (int c = F.vcu; c < NCHUNK; c += F.G) gla_a_unit(F, c); } SEAM(3); }
    if (IN(4)) { for (int rep_ = 0; rep_ < REPS(4); ++rep_) { if (rep_) xcd_barrier(bar); gla_b_phase(F); } SEAM(4); }
    if (IN(5)) for (int rep_ = 0; rep_ < REPS(5); ++rep_) { if (rep_) xcd_barrier(bar);
#ifndef NO_GLAC
        for (int u = F.vcu; u < NCHUNK / 2; u += F.G) gla_c_unit(F, u);
#endif
        float lam;
        { float a1 = F.lq1[F.lane] * F.lk1[F.lane], a2 = F.lq2[F.lane] * F.lk2[F.lane]; a1 = wave_sum(a1); a2 = wave_sum(a2); lam = __expf(a1) - __expf(a2) + 0.2f; }
#ifndef NO_ATT
        for (int p = F.vcu; p < 256; p += F.G) { const int bh = p >> 4, s = p & 15;
#pragma nounroll
            for (int j = 0; j < 2; ++j) att::attn_unit(F, bh >> 2, bh & 3, j ? s : 31 - s, lam); }
#endif
        SEAM(5);
    }
    if (IN(6)) {
        pg8::Gemm g{wsp<const bf16>(F, WS_A2), wsp<const bf16>(F, WS_WOUT), T, D, D, 0};
        pg8::StaticOrder S; S.init(T / 256, D / 256, F.G, (int)blockIdx.x, nullptr, REPS(6));
        EpiOutProj E{F.x, F.out, wsp<const float>(F, WS_MOD)};
        pg8::gemm_phase<EpiOutProj, pg8::StaticOrder>(F.lds, g, S, E);
        SEAM(6);
    }
    if (IN(7)) { p7_phase(F); SEAM(7); }
    if (IN(8)) { p8_phase(F); SEAM(8); }
    if (IN(9)) {
        int nMt; moe_tables(F, nMt);
        pg8::Gemm g{wsp<const bf16>(F, WS_XS), wsp<const bf16>(F, WS_WGU), PMAX, 2048, D / 2, (size_t)2048 * 512};
        pg8::StaticOrder S; S.init(nMt, 8, F.G, (int)blockIdx.x, F.lds + TILEE_OFF, REPS(9));
        EpiSwiGLU E{wsp<unsigned char>(F, WS_Y), F.b_gate_up};
        pg8::gemm_phase<EpiSwiGLU, pg8::StaticOrder, true>(F.lds, g, S, E);
        SEAM(9);
    }
    if (IN(10)) {
        int nMt; moe_tables(F, nMt);
        pg8::Gemm g{wsp<const bf16>(F, WS_Y), wsp<const bf16>(F, WS_WD), PMAX, 1024, FF / 2, (size_t)1024 * 512};
        pg8::StaticOrder S; S.init(nMt, 4, F.G, (int)blockIdx.x, F.lds + TILEE_OFF, REPS(10));
        EpiDown E{wsp<bf16>(F, WS_CN), F.b_down, wsp<const float>(F, WS_ROWW)};
        pg8::gemm_phase<EpiDown, pg8::StaticOrder, true>(F.lds, g, S, E);
        SEAM(10);
    }
    if (IN(11)) { p11_phase(F); }
#undef IN
#undef SEAM
}

extern "C" void kernel_launch(void* const* d_in, const int* in_sizes, int n_in, void* d_out, int out_size, void* d_ws, size_t ws_size, hipStream_t stream) {
    static int grid = 0;
    if (grid == 0) {
        if (n_in != 25 || in_sizes[0] != T * D || out_size != T * D || ws_size < WS_END) { fprintf(stderr, "kernel_launch: unexpected shapes (n_in %d, in0 %d, out %d, ws %zu); nothing launched\n", n_in, n_in > 0 ? in_sizes[0] : -1, out_size, ws_size); grid = -1; return; }
        int dev = 0, cus = 0, per_cu = 0;
        if (hipGetDevice(&dev) != hipSuccess || hipDeviceGetAttribute(&cus, hipDeviceAttributeMultiprocessorCount, dev) != hipSuccess) { grid = -1; return; }
        if (hipFuncSetAttribute((const void*)fwd_kernel, hipFuncAttributeMaxDynamicSharedMemorySize, LDS_BYTES) != hipSuccess) { fprintf(stderr, "kernel_launch: hipFuncSetAttribute failed\n"); grid = -1; return; }
        if (hipOccupancyMaxActiveBlocksPerMultiprocessor(&per_cu, (const void*)fwd_kernel, NWAVES * 64, LDS_BYTES) != hipSuccess || per_cu < 1)
            fprintf(stderr, "kernel_launch: note: occupancy query reports %d workgroups per CU\n", per_cu);
        (void)hipGetLastError();
        grid = cus;
    }
    if (grid < 0) return;
    if (hipMemsetAsync((char*)d_ws + WS_CTL, 0, CTL_ZERO_BYTES, stream) != hipSuccess) { fprintf(stderr, "kernel_launch: memset failed\n"); return; }
    Args a{};
    for (int i = 0; i < 25; ++i) a.in[i] = (const float*)d_in[i];
    a.out = (float*)d_out; a.ws = (unsigned char*)d_ws;
#if MK_N_LAUNCHES == 1
    a.ph_lo = 0; a.ph_hi = NPHASE;
    hipLaunchKernelGGL(fwd_kernel, dim3(grid), dim3(NWAVES * 64), LDS_BYTES, stream, a);
#else
    for (int p = 0; p < NPHASE; ++p) { a.ph_lo = p; a.ph_hi = p + 1; hipLaunchKernelGGL(fwd_kernel, dim3(grid), dim3(NWAVES * 64), LDS_BYTES, stream, a); }
#endif
    const hipError_t le = hipPeekAtLastError();
    if (le != hipSuccess) fprintf(stderr, "kernel_launch: launch failed: %s\n", hipGetErrorName(le));
}
```

```cpp
#include <hip/hip_runtime.h>
#include <cstdio>
#include <cstdint>

#ifndef MK_N_LAUNCHES
#define MK_N_LAUNCHES 1
#endif

namespace pg8 {
#define PG8_LAS __attribute__((address_space(3)))
typedef unsigned short bf16_t;
typedef short bf16x8 __attribute__((ext_vector_type(8)));
typedef float f32x4 __attribute__((ext_vector_type(4)));
typedef unsigned u32x4 __attribute__((ext_vector_type(4)));
typedef int i32x4 __attribute__((ext_vector_type(4)));
typedef int i32x8 __attribute__((ext_vector_type(8)));
typedef float f32x16 __attribute__((ext_vector_type(16)));
constexpr int BM = 256, BK = 64, HALF = 128, HTB = HALF * BK * 2, STAGE_BYTES = 8 * HTB, NXCD = 8, WGM = 8;

__host__ __device__ __forceinline__ int lds_byte(int r, int c) { const int st = (r >> 4) * 2 + (c >> 5), rr = r & 15, cc = c & 31, ob = rr * 64 + cc * 2; return st * 1024 + (ob ^ (((ob >> 9) & 1) << 5)); }
__host__ __device__ __forceinline__ void stage_rc(int b, int& R, int& C) { const int st = b / 1024, sb = b % 1024, swz = sb ^ (((sb >> 9) & 1) << 5); R = (st >> 1) * 16 + swz / 64; C = (st & 1) * 32 + (swz % 64) / 2; }
__host__ __device__ __forceinline__ int perm32(int rho) { const int n = rho >> 4, i = rho & 15; return 8 * (i >> 2) + 4 * n + (i & 3); }

struct Unit { int pm, pn, e; };
struct Gemm { const bf16_t* A; const bf16_t* Bt; int M, N, K; size_t estride; };

struct StaticOrder {
    int nM, nN, nwg, G, c, rep; const PG8_LAS unsigned char* tile_e;
    __device__ void init(int nM_, int nN_, int G_, int c_, const PG8_LAS unsigned char* te, int rep_ = 1) { nM = nM_; nN = nN_; nwg = nM * nN; G = G_; c = c_; tile_e = te; rep = rep_; }
    __device__ bool next(int i, Unit& u) const {
        long L = (long)i * G + c; if (L >= (long)nwg * rep) return false; if (rep > 1) L %= nwg;
        int wgid = (int)L; { const int q = nwg / NXCD, r = nwg % NXCD, xcd = wgid % NXCD, off = wgid / NXCD; wgid = (xcd < r ? xcd * (q + 1) : r * (q + 1) + (xcd - r) * q) + off; }
        const int nig = WGM * nN, gid = wgid / nig, fm = gid * WGM, gsz = (nM - fm) < WGM ? (nM - fm) : WGM;
        u.pm = fm + ((wgid % nig) % gsz); u.pn = (wgid % nig) / gsz; u.e = tile_e ? __builtin_amdgcn_readfirstlane((int)tile_e[u.pm]) : 0; return true;
    }
};

__device__ __forceinline__ unsigned cvt_pk_bf16(float lo, float hi) { unsigned r; asm volatile("v_cvt_pk_bf16_f32 %0, %1, %2" : "=v"(r) : "v"(lo), "v"(hi)); return r; }

template <class Epi, class Sched, bool FP8 = false>
__device__ __forceinline__ void gemm_phase(PG8_LAS unsigned char* lds, const Gemm g, const Sched& S, const Epi& E) {
    const int tid = threadIdx.x, wid = __builtin_amdgcn_readfirstlane(tid >> 6), lane = tid & 63, wr = wid >> 2, wc = wid & 3, fr = lane & 15, fq = lane >> 4;
    const int K = g.K, nt = K / BK;
    unsigned voffA[2], voffB[2];
#pragma unroll
    for (int i = 0; i < 2; ++i) { int R, C; stage_rc(tid * 16 + i * 8192, R, C); const int Rb = Epi::PERM ? ((R & ~31) + perm32(R & 31)) : R;
        voffA[i] = (unsigned)(R * K + C) * 2u; voffB[i] = (unsigned)(Rb * K + C) * 2u; }
    const size_t kstep = (size_t)(BK * 2);
    const size_t hstep = (size_t)HALF * K * 2;
    const size_t tstep = 2 * hstep;
    const size_t estep = g.estride * 2;
    const unsigned ldsw = (unsigned)wid * 1024u;
    const int aoff = lds_byte(wr * 64 + fr, fq * 8), boff = lds_byte(wc * 32 + fr, fq * 8);
#define PG8_SA(b, h) (((b) * 2 + (h)) * HTB)
#define PG8_SB(b, h) ((4 + (b) * 2 + (h)) * HTB)
#define PG8_STAGE(bufoff, gbase, voff) do { _Pragma("unroll") for (int _i = 0; _i < 2; ++_i) \
        __builtin_amdgcn_global_load_lds((const unsigned*)((const char*)(gbase) + (voff)[_i]), (PG8_LAS unsigned*)(lds + (bufoff) + ldsw + _i * 8192), 16, 0, 0); } while (0)
#define PG8_LDA(dst, b, h) do { _Pragma("unroll") for (int m = 0; m < 4; ++m) dst[m] = PG8_CAT2(*(const PG8_LAS i32x4*)(lds + PG8_SA(b, h) + aoff + m * 2048), *(const PG8_LAS i32x4*)(lds + PG8_SA(b, h) + aoff + m * 2048 + 1024)); } while (0)
#define PG8_LDB(dst, b, h) do { _Pragma("unroll") for (int n = 0; n < 2; ++n) dst[n] = PG8_CAT2(*(const PG8_LAS i32x4*)(lds + PG8_SB(b, h) + boff + n * 2048), *(const PG8_LAS i32x4*)(lds + PG8_SB(b, h) + boff + n * 2048 + 1024)); } while (0)
#define PG8_CAT2(x, y) __builtin_shufflevector((x), (y), 0, 1, 2, 3, 4, 5, 6, 7)
#define PG8_LO(x) __builtin_bit_cast(bf16x8, __builtin_shufflevector((x), (x), 0, 1, 2, 3))
#define PG8_HI(x) __builtin_bit_cast(bf16x8, __builtin_shufflevector((x), (x), 4, 5, 6, 7))
#define PG8_X4(v, m) ((f32x4){(v)[4 * (m)], (v)[4 * (m) + 1], (v)[4 * (m) + 2], (v)[4 * (m) + 3]})
#define PG8_INS(v, r, m) do { (v)[4 * (m)] = (r)[0]; (v)[4 * (m) + 1] = (r)[1]; (v)[4 * (m) + 2] = (r)[2]; (v)[4 * (m) + 3] = (r)[3]; } while (0)
#define PG8_MMA(ai, bj, At, Bt) do { __builtin_amdgcn_s_setprio(1); _Pragma("unroll") for (int m = 0; m < 4; ++m) _Pragma("unroll") for (int n = 0; n < 2; ++n) { \
        if constexpr (FP8) { const f32x4 r_ = __builtin_amdgcn_mfma_scale_f32_16x16x128_f8f6f4(Bt[n], At[m], PG8_X4(acc16[ai][bj][n], m), 0, 0, 0, 0x7F7F7F7F, 0, 0x7F7F7F7F); PG8_INS(acc16[ai][bj][n], r_, m); } \
        else { acc[ai][bj][m][n] = __builtin_amdgcn_mfma_f32_16x16x32_bf16(PG8_LO(Bt[n]), PG8_LO(At[m]), acc[ai][bj][m][n], 0, 0, 0); \
               acc[ai][bj][m][n] = __builtin_amdgcn_mfma_f32_16x16x32_bf16(PG8_HI(Bt[n]), PG8_HI(At[m]), acc[ai][bj][m][n], 0, 0, 0); } } \
        __builtin_amdgcn_s_setprio(0); } while (0)
#define PG8_WAIT_V(n) asm volatile("s_waitcnt vmcnt(" #n ")" ::: "memory")
#define PG8_WAIT_L(n) asm volatile("s_waitcnt lgkmcnt(" #n ")" ::: "memory")
#define PG8_BAR __builtin_amdgcn_s_barrier()
#define PG8_SCHED __builtin_amdgcn_sched_barrier(0)
    Unit cur, nxt; int ui = 0;
    if (!S.next(0, cur)) return;
    f32x4 acc[2][2][4][2];
#pragma unroll
    for (int a = 0; a < 2; ++a)
#pragma unroll
        for (int b = 0; b < 2; ++b)
#pragma unroll
            for (int m = 0; m < 4; ++m)
#pragma unroll
                for (int n = 0; n < 2; ++n) acc[a][b][m][n] = (f32x4){0.f, 0.f, 0.f, 0.f};
    f32x16 acc16[2][2][2];
#pragma unroll
    for (int a = 0; a < 2; ++a)
#pragma unroll
        for (int b = 0; b < 2; ++b)
#pragma unroll
            for (int n = 0; n < 2; ++n) acc16[a][b][n] = (f32x16){};
    i32x8 At[4], B0[2], B1[2];
    const char* cA = (const char*)g.A + (size_t)cur.pm * tstep; const char* cB = (const char*)g.Bt + (size_t)cur.e * estep + (size_t)cur.pn * tstep;
    PG8_STAGE(PG8_SB(0, 0), cB, voffB); PG8_STAGE(PG8_SB(0, 1), cB + hstep, voffB); PG8_STAGE(PG8_SA(0, 0), cA, voffA); PG8_STAGE(PG8_SA(0, 1), cA + hstep, voffA);
    if (wr == 1) PG8_BAR;
    PG8_WAIT_V(2); PG8_BAR;
    PG8_STAGE(PG8_SB(1, 0), cB + kstep, voffB); PG8_STAGE(PG8_SA(1, 0), cA + kstep, voffA); PG8_STAGE(PG8_SB(1, 1), cB + hstep + kstep, voffB);
    PG8_WAIT_V(6); PG8_BAR;
    for (;;) {
        const bool has_next = S.next(ui + 1, nxt);
        const char* nA = has_next ? (const char*)g.A + (size_t)nxt.pm * tstep : cA; const char* nB = has_next ? (const char*)g.Bt + (size_t)nxt.e * estep + (size_t)nxt.pn * tstep : cB;
#pragma nounroll
        for (int t = 0; t < nt; t += 2) {
            const bool last = (t == nt - 2);
            const char* a1 = cA + (size_t)(t + 1) * kstep;
            const char* a2 = last ? nA : cA + (size_t)(t + 2) * kstep; const char* b2 = last ? nB : cB + (size_t)(t + 2) * kstep;
            const char* a3 = a2 + kstep; const char* b3 = b2 + kstep;
            PG8_LDB(B0, 0, 0); PG8_LDB(B1, 0, 1); PG8_SCHED; PG8_LDA(At, 0, 0); PG8_STAGE(PG8_SA(1, 1), a1 + hstep, voffA);
            PG8_WAIT_V(8); PG8_WAIT_L(0); PG8_BAR; PG8_MMA(0, 0, At, B0); PG8_MMA(0, 1, At, B1); PG8_BAR; PG8_SCHED;
            PG8_LDA(At, 0, 1); PG8_STAGE(PG8_SB(0, 0), b2, voffB); PG8_STAGE(PG8_SB(0, 1), b2 + hstep, voffB); PG8_STAGE(PG8_SA(0, 0), a2, voffA);
            PG8_WAIT_V(8); PG8_WAIT_L(0); PG8_BAR; PG8_MMA(1, 0, At, B0); PG8_MMA(1, 1, At, B1); PG8_BAR; PG8_SCHED;
            PG8_LDB(B0, 1, 0); PG8_LDB(B1, 1, 1); PG8_SCHED; PG8_LDA(At, 1, 0); PG8_STAGE(PG8_SA(0, 1), a2 + hstep, voffA);
            PG8_WAIT_V(8); PG8_WAIT_L(0); PG8_BAR; PG8_MMA(0, 0, At, B0); PG8_MMA(0, 1, At, B1); PG8_BAR; PG8_SCHED;
            PG8_LDA(At, 1, 1); PG8_STAGE(PG8_SB(1, 0), b3, voffB); PG8_STAGE(PG8_SB(1, 1), b3 + hstep, voffB); PG8_STAGE(PG8_SA(1, 0), a3, voffA);
            PG8_WAIT_V(8); PG8_WAIT_L(0); PG8_BAR; PG8_MMA(1, 0, At, B0); PG8_MMA(1, 1, At, B1); PG8_BAR; PG8_SCHED;
        }
        if (wr == 0) PG8_BAR;
        if constexpr (FP8) {
#pragma unroll
            for (int a = 0; a < 2; ++a)
#pragma unroll
                for (int b = 0; b < 2; ++b)
#pragma unroll
                    for (int m = 0; m < 4; ++m)
#pragma unroll
                        for (int n = 0; n < 2; ++n) acc[a][b][m][n] = PG8_X4(acc16[a][b][n], m);
        }
        { int t2 = threadIdx.x; asm volatile("" : "+v"(t2)); E(acc, cur, wr, wc, t2 & 15, (t2 >> 4) & 3); }
        if (!has_next) break;
#pragma unroll
        for (int a = 0; a < 2; ++a)
#pragma unroll
            for (int b = 0; b < 2; ++b)
#pragma unroll
                for (int m = 0; m < 4; ++m)
#pragma unroll
                    for (int n = 0; n < 2; ++n) acc[a][b][m][n] = (f32x4){0.f, 0.f, 0.f, 0.f};
        if constexpr (FP8) {
#pragma unroll
            for (int a = 0; a < 2; ++a)
#pragma unroll
                for (int b = 0; b < 2; ++b)
#pragma unroll
                    for (int n = 0; n < 2; ++n) acc16[a][b][n] = (f32x16){};
        }
        cur = nxt; cA = nA; cB = nB; ++ui;
        if (wr == 1) PG8_BAR;
    }
    PG8_WAIT_V(0);
    PG8_BAR;
#undef PG8_SA
#undef PG8_SB
#undef PG8_STAGE
#undef PG8_LDA
#undef PG8_LDB
#undef PG8_MMA
#undef PG8_X4
#undef PG8_INS
#undef PG8_CAT2
#undef PG8_LO
#undef PG8_HI
#undef PG8_WAIT_V
#undef PG8_WAIT_L
#undef PG8_BAR
#undef PG8_SCHED
}
}

constexpr int NWAVES = 8;
constexpr int BATCH = 4, SEQ = 8192, D = 1024, T = BATCH * SEQ;
constexpr int INW = 3088, NIN = 3072;
constexpr int NE = 32, TOPK = 4, FF = 1024;
constexpr int PMAX = (T * TOPK / 256 + NE) * 256;
constexpr int NCHUNK = BATCH * 4 * (SEQ / 64);
constexpr float EPS = 1e-6f;
constexpr float LOG2E = 1.4426950408889634f;
constexpr float C2 = 0.125f * LOG2E;
constexpr float WSCALE = 32.f, WSCALE_INV = 1.f / 32.f;

constexpr size_t MiB = 1u << 20;
constexpr size_t WS_CTL = 0, CTL_ZERO_BYTES = 1 * MiB;
constexpr size_t WS_MODP = 1 * MiB;
constexpr size_t WS_MOD = 2 * MiB;
constexpr size_t WS_TOPE = 3 * MiB;
constexpr size_t WS_TOPW = 3 * MiB + 512 * 1024;
constexpr size_t WS_POS = 4 * MiB;
constexpr size_t WS_ROWW = 4 * MiB + 512 * 1024;
constexpr size_t WS_DEC = 6 * MiB;
constexpr size_t WS_WGU = 8 * MiB;
constexpr size_t WS_WD = 136 * MiB;
constexpr size_t WS_XN = 200 * MiB;
constexpr size_t WS_WIN = 264 * MiB;
constexpr size_t WS_WOUT = 270 * MiB;
constexpr size_t WS_GK = 272 * MiB;
constexpr size_t WS_QG = 304 * MiB;
constexpr size_t WS_KG = 320 * MiB;
constexpr size_t WS_VG = 336 * MiB;
constexpr size_t WS_RG = 368 * MiB;
constexpr size_t WS_QD = 400 * MiB;
constexpr size_t WS_KD = 432 * MiB;
constexpr size_t WS_VD = 464 * MiB;
constexpr size_t WS_UT = 496 * MiB;
constexpr size_t WS_SP = 560 * MiB;
constexpr size_t WS_OI = 592 * MiB;
constexpr size_t WS_QE = 656 * MiB;
constexpr size_t WS_A2 = 672 * MiB;
constexpr size_t WS_STASH = 736 * MiB;
constexpr size_t WS_XS = 264 * MiB;
constexpr size_t WS_Y = 400 * MiB;
constexpr size_t WS_CN = 536 * MiB;
constexpr size_t WS_END = 808 * MiB;
static_assert(WS_XS + (size_t)PMAX * 1024 <= WS_Y && WS_Y + (size_t)PMAX * 1024 <= WS_CN && WS_CN + (size_t)PMAX * 1024 * 2 <= WS_END, "ws map");
constexpr int CW_BAR = 4096;
constexpr int CW_CNT = 16384;
constexpr int CW_FILL = 16384 + 64;

constexpr int RING_BYTES = 131072;
constexpr int LDSCTL_OFF = RING_BYTES, MISC_OFF = LDSCTL_OFF + 320;
constexpr int TILEE_OFF = MISC_OFF + 128;
constexpr int HIST_OFF = TILEE_OFF + 1024;
constexpr int LDS_BYTES = 147456;
static_assert(HIST_OFF + 512 <= LDS_BYTES, "LDS map");

#define GAS __attribute__((address_space(1)))
#define LAS __attribute__((address_space(3)))
typedef unsigned short bf16;
typedef unsigned v4u __attribute__((ext_vector_type(4)));
typedef unsigned v2u __attribute__((ext_vector_type(2)));
typedef float f32x4 __attribute__((ext_vector_type(4)));
typedef float f32x16 __attribute__((ext_vector_type(16)));
typedef short bf16x8 __attribute__((ext_vector_type(8)));
typedef short s16x4 __attribute__((ext_vector_type(4)));
typedef GAS unsigned gu32;
#define RLX_AGENT __ATOMIC_RELAXED, __HIP_MEMORY_SCOPE_AGENT
#define LDS_WAIT() asm volatile("s_waitcnt lgkmcnt(0)" ::: "memory")
#define VM_WAIT() asm volatile("s_waitcnt vmcnt(0)" ::: "memory")
__device__ __forceinline__ unsigned f2bf(float f) { unsigned u = __builtin_bit_cast(unsigned, f); return (u + 0x7fffu + ((u >> 16) & 1u)) >> 16; }
__device__ __forceinline__ unsigned pk2(float lo, float hi) { return f2bf(lo) | (f2bf(hi) << 16); }
__device__ __forceinline__ float bf2f(unsigned short h) { return __builtin_bit_cast(float, (unsigned)h << 16); }
__device__ __forceinline__ float bflo(unsigned u) { return __builtin_bit_cast(float, u << 16); }
__device__ __forceinline__ float bfhi(unsigned u) { return __builtin_bit_cast(float, u & 0xffff0000u); }
__device__ __forceinline__ float wave_sum(float v) {
#pragma unroll
    for (int o = 1; o < 64; o <<= 1) v += __shfl_xor(v, o);
    return v;
}
__device__ __forceinline__ float sigmoidf_(float x) { return 1.f / (1.f + __expf(-x)); }
template <int CNT, int S, int N> __device__ __forceinline__ void xreduce_step(float (&v)[N], int lane) {
    if constexpr (CNT > 1) { constexpr int half = CNT / 2; const bool up = (lane & S) != 0;
#pragma unroll
        for (int i = 0; i < half; ++i) { const float send = up ? v[i] : v[i + half], keep = up ? v[i + half] : v[i]; v[i] = keep + __shfl_xor(send, S); }
        xreduce_step<half, S / 2, N>(v, lane); }
}
template <int S> __device__ __forceinline__ float xreduce_tail(float r) { if constexpr (S >= 1) { r += __shfl_xor(r, S); return xreduce_tail<S / 2>(r); } else return r; }
template <int N> __device__ __forceinline__ float xreduce(float (&v)[N], int lane) {
    xreduce_step<N, 32, N>(v, lane);
    return xreduce_tail<(N == 32 ? 1 : N == 16 ? 2 : N == 8 ? 4 : 8)>(v[0]);
}
__device__ __forceinline__ float lane_bcast(float v, int l) { return __builtin_bit_cast(float, __builtin_amdgcn_readlane(__builtin_bit_cast(int, v), l)); }

#define XB_TMO      128
#define XB_XCNT(j)  (256  + 64 * (j))
#define XB_XSUB(j)  (1280 + 64 * (j))
#define XB_XGEN(j)  (2304 + 64 * (j))
#define XB_TOP      3328
#define XB_TOPGEN   3392
#define XCD_BAR_WORDS 3456
#define XB_SPIN_CAP (1u << 18)
__device__ __forceinline__ unsigned xb_ld(unsigned* p)              { return __hip_atomic_load(p, __ATOMIC_RELAXED, __HIP_MEMORY_SCOPE_AGENT); }
__device__ __forceinline__ unsigned xb_add(unsigned* p, unsigned v) { return __hip_atomic_fetch_add(p, v, __ATOMIC_RELAXED, __HIP_MEMORY_SCOPE_AGENT); }
__device__ __forceinline__ unsigned xb_xcc_id() { return (unsigned)__builtin_amdgcn_s_getreg((3 << 11) | 20) & 0xFu; }
#define XB_SPIN(cond, bar) do { unsigned _sp = 0; while (cond) { __builtin_amdgcn_s_sleep(1); \
    if ((++_sp & 255u) == 0u) { if (xb_ld(&(bar)[XB_TMO])) break; if (_sp > XB_SPIN_CAP) { atomicAdd(&(bar)[XB_TMO], 1u); break; } } } } while (0)
struct XcdBarrier { unsigned* bar; unsigned x; volatile LAS unsigned* st; };
__device__ __forceinline__ XcdBarrier xcd_barrier_post(unsigned* bar, volatile LAS unsigned* st) {
    XcdBarrier b; b.bar = bar; b.x = xb_xcc_id(); b.st = st;
    if (threadIdx.x == 0) (void)xb_add(&bar[XB_XCNT(b.x)], 1u);
    return b;
}
__device__ __forceinline__ void xcd_barrier_complete(unsigned* bar, unsigned x, unsigned& nloc, unsigned& nx) {
    const unsigned G = gridDim.x * gridDim.y * gridDim.z;
    unsigned sum, cnt, mine, sp = 0u;
    for (;;) {
        sum = 0u; cnt = 0u; mine = 0u;
#pragma unroll
        for (unsigned j = 0; j < 16; ++j) { const unsigned c = xb_ld(&bar[XB_XCNT(j)]); sum += c; cnt += (c > 0u) ? 1u : 0u; mine = (j == x) ? c : mine; }
        if (sum == G) break;
        __builtin_amdgcn_s_sleep(1);
        if ((++sp & 255u) == 0u) { if (xb_ld(&bar[XB_TMO])) break; if (sp > XB_SPIN_CAP) { atomicAdd(&bar[XB_TMO], 1u); break; } }
    }
    nloc = mine > 0u ? mine : 1u; nx = cnt > 0u ? cnt : 1u;
}
__device__ __forceinline__ void xcd_barrier(const XcdBarrier& b) {
    asm volatile("s_waitcnt vmcnt(0)" ::: "memory");
    __syncthreads();
    if (threadIdx.x == 0) {
        unsigned* bar = b.bar;
        __builtin_amdgcn_s_waitcnt(0);
        unsigned nloc = b.st[0], nx = b.st[1];
        if (nloc == 0u) { xcd_barrier_complete(bar, b.x, nloc, nx); b.st[0] = nloc; b.st[1] = nx; }
        const unsigned old = xb_add(&bar[XB_XSUB(b.x)], 1u);
        const unsigned gen = old / nloc;
        if (old + 1u == (gen + 1u) * nloc) {
            __builtin_amdgcn_fence(__ATOMIC_RELEASE, "agent");
            asm volatile("s_waitcnt vmcnt(0)" ::: "memory");
            const unsigned og = xb_add(&bar[XB_TOP], 1u);
            const unsigned tg = og / nx;
            if (og + 1u == (tg + 1u) * nx) xb_add(&bar[XB_TOPGEN], 1u);
            else XB_SPIN(xb_ld(&bar[XB_TOPGEN]) == tg, bar);
            __builtin_amdgcn_fence(__ATOMIC_ACQUIRE, "agent");
            xb_add(&bar[XB_XGEN(b.x)], 1u);
            asm volatile("s_waitcnt vmcnt(0)" ::: "memory");
        } else {
            XB_SPIN(xb_ld(&bar[XB_XGEN(b.x)]) == gen, bar);
            __builtin_amdgcn_fence(__ATOMIC_ACQUIRE, "agent");
            asm volatile("s_waitcnt vmcnt(0)" ::: "memory");
        }
    }
    __syncthreads();
}

struct Frame {
    LAS unsigned char* lds;
    volatile LAS unsigned* MISC;
    gu32* ctl;
    int tid, lane, wave;
    int vcu, G;
    unsigned char* ws;
    const float *x, *c, *rel_bias, *w_ada, *b_ada, *g_norm1, *w_in, *w_gk_up, *b_gk_up, *g_gla_out, *g_qnorm, *g_knorm, *lq1, *lk1, *lq2, *lk2, *g_subln, *w_out,
                *g_norm2, *w_router, *b_router, *w_gate_up, *b_gate_up, *w_down, *b_down;
    float* out;
};
template <class Tp> __device__ __forceinline__ Tp* wsp(const Frame& F, size_t off) { return (Tp*)(F.ws + off); }

__device__ __forceinline__ void tr_item(const float* W, int ldw, int k0, int src0, bf16* WT, int K, int drow0, LAS float* scr, int lane) {
#pragma unroll 8
    for (int i = 0; i < 32; ++i) { const int kk = 2 * i + (lane >> 5); scr[kk * 33 + (lane & 31)] = W[(size_t)(k0 + kk) * ldw + src0 + (lane & 31)]; }
    LDS_WAIT(); asm volatile("" ::: "memory");
    const int c = lane & 7;
#pragma unroll
    for (int j = 0; j < 4; ++j) { const int n = (lane >> 3) + 8 * j; const LAS float* s = scr + (8 * c) * 33 + n;
        v4u o; o.x = pk2(s[0 * 33], s[1 * 33]); o.y = pk2(s[2 * 33], s[3 * 33]); o.z = pk2(s[4 * 33], s[5 * 33]); o.w = pk2(s[6 * 33], s[7 * 33]);
        *(GAS v4u*)(WT + (size_t)(drow0 + n) * K + k0 + 8 * c) = o; }
    LDS_WAIT(); asm volatile("" ::: "memory");
}
__device__ __forceinline__ unsigned pk4_fp8(float a, float b, float c, float d) { int p = __builtin_amdgcn_cvt_pk_fp8_f32(a, b, 0, false); p = __builtin_amdgcn_cvt_pk_fp8_f32(c, d, p, true); return (unsigned)p; }
__device__ __forceinline__ void tr_item_fp8(const float* W, int ldw, int k0, int src0, unsigned char* WT, int K, int drow0, float sc, LAS float* scr, int lane) {
#pragma unroll 8
    for (int i = 0; i < 32; ++i) { const int kk = 2 * i + (lane >> 5); scr[kk * 33 + (lane & 31)] = W[(size_t)(k0 + kk) * ldw + src0 + (lane & 31)] * sc; }
    LDS_WAIT(); asm volatile("" ::: "memory");
    const int c = lane & 3;
#pragma unroll
    for (int j = 0; j < 2; ++j) { const int n = (lane >> 2) + 16 * j; const LAS float* s = scr + (16 * c) * 33 + n;
        v4u o;
#pragma unroll
        for (int q = 0; q < 4; ++q) o[q] = pk4_fp8(s[(4 * q) * 33], s[(4 * q + 1) * 33], s[(4 * q + 2) * 33], s[(4 * q + 3) * 33]);
        *(GAS v4u*)(WT + (size_t)(drow0 + n) * K + k0 + 16 * c) = o; }
    LDS_WAIT(); asm volatile("" ::: "memory");
}
__device__ __forceinline__ int win_src0(int ng) {
    const int pn = ng >> 3, gi = ng & 7, bj = gi >> 2, wc = gi & 3;
    if (pn < 6) return pn * 256 + gi * 32;
    if (pn < 10) { const int base = (pn < 8) ? 1552 : 2064; const int gq = 4 * ((pn - 6) & 1) + wc; return base + 64 * gq + 32 * bj; }
    return 2576 + (pn - 10) * 256 + gi * 32;
}
__device__ __forceinline__ void p0_phase(Frame& F) {
    LAS float* scr = (LAS float*)(F.lds + F.wave * 16384);
    const int gw = F.vcu * NWAVES + F.wave, NGW = F.G * NWAVES, lane = F.lane;
    for (int it = gw; it < 768; it += NGW) {
        const int cg = it % 96, ks = it / 96, j = cg * 64 + lane;
#pragma unroll
        for (int q = 0; q < 8; ++q) { const int idx = q * 64 + lane, b = idx >> 7, kk = idx & 127; const float cv = F.c[b * 1024 + ks * 128 + kk]; scr[idx] = cv * sigmoidf_(cv); }
        LDS_WAIT(); asm volatile("" ::: "memory");
        float a0 = 0.f, a1 = 0.f, a2 = 0.f, a3 = 0.f;
        const float* wp = F.w_ada + (size_t)(ks * 128) * 6144 + j;
#pragma unroll 16
        for (int kk = 0; kk < 128; ++kk) { const float w = wp[(size_t)kk * 6144]; a0 += scr[kk] * w; a1 += scr[128 + kk] * w; a2 += scr[256 + kk] * w; a3 += scr[384 + kk] * w; }
        float* mp = wsp<float>(F, WS_MODP) + (size_t)(ks * 4) * 6144 + j;
        mp[0] = a0; mp[6144] = a1; mp[2 * 6144] = a2; mp[3 * 6144] = a3;
        LDS_WAIT(); asm volatile("" ::: "memory");
    }
    constexpr int I_IN = 96 * 16, I_OUT = 32 * 16, I_GU = 32 * 64 * 16, I_D = 32 * 32 * 16;
    constexpr int NITEMS = I_IN + I_OUT + I_GU + I_D;
    for (int it = gw; it < NITEMS; it += NGW) {
        int r = it;
        if (r < I_IN) { const int kb = r / 96, ng = r % 96; tr_item(F.w_in, INW, kb * 64, win_src0(ng), wsp<bf16>(F, WS_WIN), 1024, ng * 32, scr, lane); continue; } r -= I_IN;
        if (r < I_OUT) { const int kb = r / 32, ng = r % 32; tr_item(F.w_out, 1024, kb * 64, ng * 32, wsp<bf16>(F, WS_WOUT), 1024, ng * 32, scr, lane); continue; } r -= I_OUT;
        if (r < I_GU) { const int e = r / 1024, q = r % 1024, kb = q / 64, dg = q % 64, pn = dg >> 3, gi = dg & 7, bj = gi >> 2, j32 = gi & 3;
            tr_item_fp8(F.w_gate_up + (size_t)e * 1024 * 2048, 2048, kb * 64, bj * 1024 + pn * 128 + j32 * 32, wsp<unsigned char>(F, WS_WGU) + (size_t)e * 2048 * 1024, 1024, dg * 32, WSCALE, scr, lane); continue; } r -= I_GU;
        { const int e = r / 512, q = r % 512, kb = q / 32, ng = q % 32;
            tr_item_fp8(F.w_down + (size_t)e * 1024 * 1024, 1024, kb * 64, ng * 32, wsp<unsigned char>(F, WS_WD) + (size_t)e * 1024 * 1024, 1024, ng * 32, WSCALE, scr, lane); }
    }
}

__device__ __forceinline__ f32x4 mod_from_partials(const Frame& F, int b, int col) {
    const float* mp = wsp<const float>(F, WS_MODP) + (size_t)b * 6144 + col;
    f32x4 s = *(const f32x4*)(F.b_ada + col);
#pragma unroll
    for (int ks = 0; ks < 8; ++ks) s += *(const f32x4*)(mp + (size_t)ks * 4 * 6144);
    return s;
}
__device__ __forceinline__ void p1_phase(Frame& F) {
    const int tid = F.tid, lane = F.lane;
    LAS float* wlo = (LAS float*)(F.lds);
    LAS float* wup = (LAS float*)(F.lds + 65536);
    LAS float* bup = (LAS float*)(F.lds + 65536 + 16384);
    for (int idx = tid; idx < 16384; idx += 512) { const int k = idx >> 4, r = idx & 15; wlo[r * 1024 + k] = F.w_in[(size_t)k * INW + 1536 + r]; }
    for (int idx = tid; idx < 4096; idx += 512) wup[idx] = F.w_gk_up[idx];
    if (tid < 256) bup[tid] = F.b_gk_up[tid];
    { const int gt = F.vcu * 512 + tid; if (gt < 4 * 6144 / 4) { const int i = gt * 4, b = i / 6144, col = i % 6144; *(f32x4*)(wsp<float>(F, WS_MOD) + i) = mod_from_partials(F, b, col); } }
    __syncthreads();
    const int gw = F.vcu * NWAVES + F.wave, NGW = F.G * NWAVES;
    const int rpw = (T + NGW - 1) / NGW;
    int curb = -1; f32x4 gsc[4], shv[4], nx[4];
    { const int m0 = (gw * rpw < T) ? gw * rpw : 0; const GAS f32x4* xr = (const GAS f32x4*)(F.x + (size_t)m0 * D) + lane;
#pragma unroll
      for (int j = 0; j < 4; ++j) nx[j] = xr[64 * j]; }
#pragma nounroll
    for (int i = 0; i < rpw; ++i) {
        const int m = gw * rpw + i; if (m >= T) break;
        const int b = m / SEQ;
        if (b != curb) { curb = b;
#pragma unroll
            for (int j = 0; j < 4; ++j) { const int col = 256 * j + 4 * lane; const f32x4 g = *(const f32x4*)(F.g_norm1 + col);
                shv[j] = mod_from_partials(F, b, col); gsc[j] = g * (mod_from_partials(F, b, 1024 + col) + 1.0f); } }
        f32x4 v[4]; float s = 0.f;
#pragma unroll
        for (int j = 0; j < 4; ++j) { v[j] = nx[j]; s += (v[j].x * v[j].x + v[j].y * v[j].y) + (v[j].z * v[j].z + v[j].w * v[j].w); }
        { const int m2 = (m + 1 < T) ? m + 1 : m; const GAS f32x4* xr = (const GAS f32x4*)(F.x + (size_t)m2 * D) + lane;
#pragma unroll
          for (int j = 0; j < 4; ++j) nx[j] = xr[64 * j]; }
        const float rstd = rsqrtf(wave_sum(s) * (1.f / D) + EPS);
        GAS v2u* o8 = (GAS v2u*)(wsp<bf16>(F, WS_XN) + (size_t)m * D) + lane;
#pragma unroll
        for (int j = 0; j < 4; ++j) { v[j] = v[j] * rstd * gsc[j] + shv[j]; v2u o; o.x = pk2(v[j].x, v[j].y); o.y = pk2(v[j].z, v[j].w); o8[64 * j] = o; }
        float part[16];
#pragma unroll
        for (int r = 0; r < 16; ++r) { float a = 0.f;
#pragma unroll
            for (int j = 0; j < 4; ++j) { const f32x4 w = *(const LAS f32x4*)(wlo + r * 1024 + 256 * j + 4 * lane); a += (v[j].x * w.x + v[j].y * w.y) + (v[j].z * w.z + v[j].w * w.w); }
            part[r] = a; if ((r & 3) == 3) asm volatile("" ::: "memory"); }
        const float tot = xreduce<16>(part, lane);
        f32x4 z = *(const LAS f32x4*)(bup + 4 * lane);
#pragma unroll
        for (int r = 0; r < 16; ++r) z += *(const LAS f32x4*)(wup + r * 256 + 4 * lane) * lane_bcast(tot, 4 * r);
        f32x4 gk;
#pragma unroll
        for (int q = 0; q < 4; ++q) { const float zz = z[q]; gk[q] = (fminf(zz, 0.f) - log1pf(__expf(-fabsf(zz)))) * (1.f / 16.f); }
        *(GAS f32x4*)(wsp<float>(F, WS_GK) + (size_t)m * 256 + 4 * lane) = gk;
    }
}

using pg8::Unit;
typedef pg8::f32x4 af4;
struct EpiInProj {
    static constexpr bool PERM = true;
    bf16 *QG, *KG, *VG, *RG, *QD, *KD, *VD; const float *gq, *gk;
    __device__ __forceinline__ void operator()(const af4 (&acc)[2][2][4][2], const Unit& u, int wr, int wc, int fr, int fq) const {
        const int pn = u.pn; const int row0 = u.pm * 256 + wr * 64 + fr;
        if (pn >= 6 && pn < 10) {
            const bool isq = pn < 8; bf16* base = isq ? QD : KD; const float* g = isq ? gq : gk; const float sc = isq ? C2 : 1.f;
            const int grp = 4 * ((pn - 6) & 1) + wc;
            af4 gv[2][2];
#pragma unroll
            for (int bj = 0; bj < 2; ++bj)
#pragma unroll
                for (int n = 0; n < 2; ++n) gv[bj][n] = *(const af4*)(g + 32 * bj + 8 * fq + 4 * n) * sc;
#pragma unroll
            for (int ai = 0; ai < 2; ++ai)
#pragma unroll
                for (int m = 0; m < 4; ++m) {
                    float ss = 0.f;
#pragma unroll
                    for (int bj = 0; bj < 2; ++bj)
#pragma unroll
                        for (int n = 0; n < 2; ++n) { const af4 v = acc[ai][bj][m][n]; ss += (v[0] * v[0] + v[1] * v[1]) + (v[2] * v[2] + v[3] * v[3]); }
                    ss += __shfl_xor(ss, 16); ss += __shfl_xor(ss, 32);
                    const float rs = rsqrtf(ss * (1.f / 64.f) + EPS);
                    bf16* rowp = base + (size_t)(row0 + ai * 128 + m * 16) * 512 + grp * 64 + 8 * fq;
#pragma unroll
                    for (int bj = 0; bj < 2; ++bj) { const af4 v0 = acc[ai][bj][m][0] * rs * gv[bj][0], v1 = acc[ai][bj][m][1] * rs * gv[bj][1];
                        pg8::u32x4 w; w.x = pg8::cvt_pk_bf16(v0[0], v0[1]); w.y = pg8::cvt_pk_bf16(v0[2], v0[3]); w.z = pg8::cvt_pk_bf16(v1[0], v1[1]); w.w = pg8::cvt_pk_bf16(v1[2], v1[3]);
                        *(pg8::u32x4*)(rowp + 32 * bj) = w; }
                }
        } else {
            bf16* base; int pitch, colt; int act = 0;
            if (pn == 0) { base = QG; pitch = 256; colt = 0; act = 1; }
            else if (pn == 1) { base = KG; pitch = 256; colt = 0; }
            else if (pn < 4) { base = VG; pitch = 512; colt = (pn - 2) * 256; }
            else if (pn < 6) { base = RG; pitch = 512; colt = (pn - 4) * 256; act = 2; }
            else { base = VD; pitch = 512; colt = (pn - 10) * 256; }
            const int col0 = colt + wc * 32 + 8 * fq;
#pragma unroll
            for (int ai = 0; ai < 2; ++ai)
#pragma unroll
                for (int m = 0; m < 4; ++m) { bf16* rowp = base + (size_t)(row0 + ai * 128 + m * 16) * pitch + col0;
#pragma unroll
                    for (int bj = 0; bj < 2; ++bj) { af4 v0 = acc[ai][bj][m][0], v1 = acc[ai][bj][m][1];
                        if (act == 1) { v0 = v0 * 0.125f; v1 = v1 * 0.125f; }
                        if (act == 2) {
#pragma unroll
                            for (int q = 0; q < 4; ++q) { v0[q] = v0[q] * sigmoidf_(v0[q]); v1[q] = v1[q] * sigmoidf_(v1[q]); } }
                        pg8::u32x4 w; w.x = pg8::cvt_pk_bf16(v0[0], v0[1]); w.y = pg8::cvt_pk_bf16(v0[2], v0[3]); w.z = pg8::cvt_pk_bf16(v1[0], v1[1]); w.w = pg8::cvt_pk_bf16(v1[2], v1[3]);
                        *(pg8::u32x4*)(rowp + bj * 128) = w; } }
        }
    }
};
struct EpiOutProj {
    static constexpr bool PERM = false;
    const float* x; float* out; const float* mod;
    __device__ __forceinline__ void operator()(const af4 (&acc)[2][2][4][2], const Unit& u, int wr, int wc, int fr, int fq) const {
        const int b = (u.pm * 256) / SEQ; const int col0 = u.pn * 256 + wc * 32 + 4 * fq;
        af4 gt[2][2];
#pragma unroll
        for (int bj = 0; bj < 2; ++bj)
#pragma unroll
            for (int n = 0; n < 2; ++n) gt[bj][n] = *(const af4*)(mod + (size_t)b * 6144 + 2048 + col0 + bj * 128 + n * 16);
#pragma unroll
        for (int ai = 0; ai < 2; ++ai)
#pragma unroll
            for (int m = 0; m < 4; ++m) { const size_t off = (size_t)(u.pm * 256 + ai * 128 + wr * 64 + m * 16 + fr) * D + col0;
#pragma unroll
                for (int bj = 0; bj < 2; ++bj)
#pragma unroll
                    for (int n = 0; n < 2; ++n) { const af4 xv = *(const af4*)(x + off + bj * 128 + n * 16); *(af4*)(out + off + bj * 128 + n * 16) = xv + gt[bj][n] * acc[ai][bj][m][n]; }
                if (m & 1) asm volatile("" ::: "memory"); }
    }
};
struct EpiSwiGLU {
    static constexpr bool PERM = false;
    unsigned char* Y; const float* bgu;
    __device__ __forceinline__ void operator()(const af4 (&acc)[2][2][4][2], const Unit& u, int wr, int wc, int fr, int fq) const {
        const int f0 = u.pn * 128 + wc * 32 + 4 * fq; const float* bb = bgu + (size_t)u.e * 2048 + f0;
        af4 bg[2], bu[2];
#pragma unroll
        for (int n = 0; n < 2; ++n) { bg[n] = *(const af4*)(bb + 16 * n); bu[n] = *(const af4*)(bb + 1024 + 16 * n); }
#pragma unroll
        for (int ai = 0; ai < 2; ++ai)
#pragma unroll
            for (int m = 0; m < 4; ++m) { unsigned char* rowp = Y + (size_t)(u.pm * 256 + ai * 128 + wr * 64 + m * 16 + fr) * FF + f0;
#pragma unroll
                for (int n = 0; n < 2; ++n) { const af4 g = acc[ai][0][m][n] * WSCALE_INV + bg[n], up = acc[ai][1][m][n] * WSCALE_INV + bu[n]; af4 y;
#pragma unroll
                    for (int q = 0; q < 4; ++q) { const float gg = fminf(g[q], 7.f), uu = fminf(fmaxf(up[q], -7.f), 7.f); y[q] = (uu + 1.f) * gg * sigmoidf_(1.702f * gg); }
                    *(unsigned*)(rowp + 16 * n) = pk4_fp8(y[0], y[1], y[2], y[3]); } }
    }
};
struct EpiDown {
    static constexpr bool PERM = false;
    bf16* Cn; const float* bd; const float* roww;
    __device__ __forceinline__ void operator()(const af4 (&acc)[2][2][4][2], const Unit& u, int wr, int wc, int fr, int fq) const {
        const int col0 = u.pn * 256 + wc * 32 + 4 * fq; const float* bb = bd + (size_t)u.e * 1024 + col0;
        af4 bv[2][2];
#pragma unroll
        for (int bj = 0; bj < 2; ++bj)
#pragma unroll
            for (int n = 0; n < 2; ++n) bv[bj][n] = *(const af4*)(bb + bj * 128 + 16 * n);
#pragma unroll
        for (int ai = 0; ai < 2; ++ai)
#pragma unroll
            for (int m = 0; m < 4; ++m) { const int row = u.pm * 256 + ai * 128 + wr * 64 + m * 16 + fr; const float rw = roww[row]; bf16* rowp = Cn + (size_t)row * 1024 + col0;
#pragma unroll
                for (int bj = 0; bj < 2; ++bj)
#pragma unroll
                    for (int n = 0; n < 2; ++n) { const af4 v = (acc[ai][bj][m][n] * WSCALE_INV + bv[bj][n]) * rw;
                        v2u w; w.x = pg8::cvt_pk_bf16(v[0], v[1]); w.y = pg8::cvt_pk_bf16(v[2], v[3]); *(v2u*)(rowp + bj * 128 + 16 * n) = w; } }
    }
};

typedef float cf4 __attribute__((ext_vector_type(4)));
#define MFMA16(a, b, c) __builtin_amdgcn_mfma_f32_16x16x32_bf16((a), (b), (c), 0, 0, 0)
constexpr int GP = 72;
__device__ __forceinline__ void gla_a_unit(Frame& F, int chunk) {
    const int tid = F.tid, lane = F.lane, w = F.wave;
    const int bh = chunk >> 7, n = chunk & 127, b = bh >> 2, h = bh & 3;
    const size_t R0 = (size_t)b * SEQ + (size_t)n * 64;
    LAS float* gc = (LAS float*)F.lds;
    LAS float* segt = (LAS float*)(F.lds + 16384);
    LAS bf16* QEs = (LAS bf16*)(F.lds + 18432);
    LAS bf16* KEs = (LAS bf16*)(F.lds + 18432 + 9216);
    LAS bf16* KST = (LAS bf16*)(F.lds + 18432 + 2 * 9216);
    LAS bf16* VT = (LAS bf16*)(F.lds + 18432 + 3 * 9216);
    LAS bf16* AM = (LAS bf16*)(F.lds + 18432 + 3 * 9216 + 18432);
    const float* GK = wsp<const float>(F, WS_GK);
    { const int r = tid >> 3, d0 = (tid & 7) * 8; const float* gp = GK + (R0 + r) * 256 + h * 64 + d0;
      *(LAS f32x4*)(gc + r * 64 + d0) = *(const f32x4*)gp; *(LAS f32x4*)(gc + r * 64 + d0 + 4) = *(const f32x4*)(gp + 4); }
    __syncthreads();
    { const int seg = tid >> 6, d = tid & 63; float run = 0.f;
#pragma unroll
      for (int i = 0; i < 8; ++i) { run += gc[(seg * 8 + i) * 64 + d]; gc[(seg * 8 + i) * 64 + d] = run; }
      segt[seg * 64 + d] = run; }
    __syncthreads();
    { const int seg = tid >> 6, d = tid & 63; float off = 0.f;
      for (int s2 = 0; s2 < seg; ++s2) off += segt[s2 * 64 + d];
#pragma unroll
      for (int i = 0; i < 8; ++i) gc[(seg * 8 + i) * 64 + d] += off; }
    __syncthreads();
    { const int r = tid >> 3, d0 = (tid & 7) * 8;
      const v4u qv = *(const v4u*)(wsp<const bf16>(F, WS_QG) + (R0 + r) * 256 + h * 64 + d0);
      const v4u kv = *(const v4u*)(wsp<const bf16>(F, WS_KG) + (R0 + r) * 256 + h * 64 + d0);
      float qf[8], kf[8];
#pragma unroll
      for (int i = 0; i < 4; ++i) { qf[2 * i] = bflo(qv[i]); qf[2 * i + 1] = bfhi(qv[i]); kf[2 * i] = bflo(kv[i]); kf[2 * i + 1] = bfhi(kv[i]); }
      float qe[8], ke[8];
#pragma unroll
      for (int i = 0; i < 8; ++i) { const float g = gc[r * 64 + d0 + i], gl = gc[63 * 64 + d0 + i];
          qe[i] = qf[i] * __expf(g); ke[i] = kf[i] * __expf(-g); KST[(d0 + i) * GP + r] = (bf16)f2bf(kf[i] * __expf(gl - g)); }
      v4u qo, ko;
#pragma unroll
      for (int i = 0; i < 4; ++i) { qo[i] = pk2(qe[2 * i], qe[2 * i + 1]); ko[i] = pk2(ke[2 * i], ke[2 * i + 1]); }
      *(LAS v4u*)(QEs + r * GP + d0) = qo; *(LAS v4u*)(KEs + r * GP + d0) = ko;
      *(v4u*)(wsp<bf16>(F, WS_QE) + (R0 + r) * 256 + h * 64 + d0) = qo;
      const int e0 = (tid & 7) * 16;
      const v4u va = *(const v4u*)(wsp<const bf16>(F, WS_VG) + (R0 + r) * 512 + h * 128 + e0);
      const v4u vb = *(const v4u*)(wsp<const bf16>(F, WS_VG) + (R0 + r) * 512 + h * 128 + e0 + 8);
#pragma unroll
      for (int i = 0; i < 4; ++i) { VT[(e0 + 2 * i) * GP + r] = (bf16)(va[i] & 0xffffu); VT[(e0 + 2 * i + 1) * GP + r] = (bf16)(va[i] >> 16);
                                    VT[(e0 + 8 + 2 * i) * GP + r] = (bf16)(vb[i] & 0xffffu); VT[(e0 + 8 + 2 * i + 1) * GP + r] = (bf16)(vb[i] >> 16); }
      if (tid < 64) wsp<float>(F, WS_DEC)[(size_t)chunk * 64 + tid] = __expf(gc[63 * 64 + tid]);
    }
    __syncthreads();
    const int l15 = lane & 15, l4 = lane >> 4;
#pragma unroll
    for (int q = 0; q < 2; ++q) { const int tile = 2 * w + q, ti = tile >> 2, tj = tile & 3;
        cf4 a = {0.f, 0.f, 0.f, 0.f};
        if (tj <= ti) {
#pragma unroll
            for (int kk = 0; kk < 2; ++kk) { const bf16x8 fa = *(const LAS bf16x8*)(QEs + (16 * ti + l15) * GP + kk * 32 + 8 * l4); const bf16x8 fb = *(const LAS bf16x8*)(KEs + (16 * tj + l15) * GP + kk * 32 + 8 * l4); a = MFMA16(fa, fb, a); } }
#pragma unroll
        for (int r = 0; r < 4; ++r) { const int cr = 16 * ti + 4 * l4 + r, cj = 16 * tj + l15; AM[cr * GP + cj] = (bf16)f2bf(cj <= cr ? a[r] : 0.f); } }
    { float* UT = wsp<float>(F, WS_UT) + (size_t)chunk * 8192;
#pragma unroll
      for (int td = 0; td < 4; ++td) { cf4 a = {0.f, 0.f, 0.f, 0.f};
#pragma unroll
          for (int kk = 0; kk < 2; ++kk) { const bf16x8 fa = *(const LAS bf16x8*)(VT + (16 * w + l15) * GP + kk * 32 + 8 * l4); const bf16x8 fb = *(const LAS bf16x8*)(KST + (16 * td + l15) * GP + kk * 32 + 8 * l4); a = MFMA16(fa, fb, a); }
#pragma unroll
          for (int r = 0; r < 4; ++r) UT[(16 * w + 4 * l4 + r) * 64 + 16 * td + l15] = a[r]; } }
    __syncthreads();
    { float* OI = wsp<float>(F, WS_OI);
#pragma unroll
      for (int tc = 0; tc < 4; ++tc) { cf4 a = {0.f, 0.f, 0.f, 0.f};
#pragma unroll
          for (int kk = 0; kk < 2; ++kk) { const bf16x8 fa = *(const LAS bf16x8*)(AM + (16 * tc + l15) * GP + kk * 32 + 8 * l4); const bf16x8 fb = *(const LAS bf16x8*)(VT + (16 * w + l15) * GP + kk * 32 + 8 * l4); a = MFMA16(fa, fb, a); }
#pragma unroll
          for (int r = 0; r < 4; ++r) OI[(R0 + 16 * tc + 4 * l4 + r) * 512 + h * 128 + 16 * w + l15] = a[r]; } }
    __syncthreads();
}
__device__ __forceinline__ void gla_b_phase(Frame& F) {
    const float* UT = wsp<const float>(F, WS_UT); const float* DEC = wsp<const float>(F, WS_DEC); bf16* SP = wsp<bf16>(F, WS_SP);
    for (int gt = F.vcu * 512 + F.tid; gt < 16 * 8192; gt += F.G * 512) {
        const int bh = gt >> 13, ed = gt & 8191, d = gt & 63; float S = 0.f;
#pragma unroll 8
        for (int n = 0; n < 128; ++n) { const size_t ch = (size_t)bh * 128 + n; const float u = UT[ch * 8192 + ed], dc = DEC[ch * 64 + d]; SP[ch * 8192 + ed] = (bf16)f2bf(S); S = S * dc + u; }
    }
}
__device__ __forceinline__ void gla_c_unit(Frame& F, int unit) {
    const int tid = F.tid, lane = F.lane, w = F.wave;
    const int bh = unit >> 6, n2 = unit & 63, b = bh >> 2, h = bh & 3;
    const size_t R0 = (size_t)b * SEQ + (size_t)n2 * 128;
    LAS bf16* QEs = (LAS bf16*)F.lds;
    LAS bf16* SPs = (LAS bf16*)(F.lds + 18432);
    { const int r = tid >> 2, d0 = (tid & 3) * 16; const bf16* src = wsp<const bf16>(F, WS_QE) + (R0 + r) * 256 + h * 64 + d0;
      *(LAS v4u*)(QEs + r * GP + d0) = *(const v4u*)src; *(LAS v4u*)(QEs + r * GP + d0 + 8) = *(const v4u*)(src + 8);
      const bf16* sp = wsp<const bf16>(F, WS_SP) + ((size_t)bh * 128 + 2 * n2) * 8192;
      const int row = tid >> 1, dd = (tid & 1) * 32;
#pragma unroll
      for (int i = 0; i < 4; ++i) *(LAS v4u*)(SPs + row * GP + dd + 8 * i) = *(const v4u*)(sp + (size_t)row * 64 + dd + 8 * i); }
    __syncthreads();
    const int l15 = lane & 15, l4 = lane >> 4, c2 = w >> 2, tc = w & 3;
    cf4 a[8];
#pragma unroll
    for (int te = 0; te < 8; ++te) { a[te] = (cf4){0.f, 0.f, 0.f, 0.f};
#pragma unroll
        for (int kk = 0; kk < 2; ++kk) { const bf16x8 fa = *(const LAS bf16x8*)(QEs + (64 * c2 + 16 * tc + l15) * GP + kk * 32 + 8 * l4); const bf16x8 fb = *(const LAS bf16x8*)(SPs + (128 * c2 + 16 * te + l15) * GP + kk * 32 + 8 * l4); a[te] = MFMA16(fa, fb, a[te]); } }
    const float* OI = wsp<const float>(F, WS_OI); const bf16* RG = wsp<const bf16>(F, WS_RG); bf16* A2 = wsp<bf16>(F, WS_A2);
    float gg[8];
#pragma unroll
    for (int te = 0; te < 8; ++te) gg[te] = F.g_gla_out[16 * te + l15];
#pragma unroll
    for (int r = 0; r < 4; ++r) { const size_t row = R0 + 64 * c2 + 16 * tc + 4 * l4 + r; float ss = 0.f; float o[8];
#pragma unroll
        for (int te = 0; te < 8; ++te) { o[te] = a[te][r] + OI[row * 512 + h * 128 + 16 * te + l15]; ss += o[te] * o[te]; }
        ss += __shfl_xor(ss, 1); ss += __shfl_xor(ss, 2); ss += __shfl_xor(ss, 4); ss += __shfl_xor(ss, 8);
        const float rs = rsqrtf(ss * (1.f / 128.f) + EPS);
#pragma unroll
        for (int te = 0; te < 8; ++te) { const int e = 16 * te + l15; A2[row * 1024 + h * 128 + e] = (bf16)f2bf(o[te] * rs * gg[te] * bf2f(RG[row * 512 + h * 128 + e])); } }
    __syncthreads();
}

namespace att {
constexpr int KSLOT = 8192, VSLOT = 16384, NSLOT = 3;
constexpr int LDS_K = 0, LDS_V = NSLOT * KSLOT, LDS_TBL = LDS_V + NSLOT * VSLOT, LDS_WS = LDS_TBL + 1024, LDS_Q = LDS_WS + 8 * 256, LDS_END = LDS_Q + 8 * 4096;
static_assert(LDS_END <= RING_BYTES, "attention LDS");
__device__ __forceinline__ int crow(int r, int hi) { return (r & 3) + 8 * (r >> 2) + 4 * hi; }
__device__ __forceinline__ void glds16(const void* gsrc, unsigned lds_dst) { unsigned keep;
    asm volatile("s_mov_b32 %0, m0\n\ts_mov_b32 m0, %2\n\ts_nop 0\n\tglobal_load_lds_dwordx4 %1, off\n\ts_mov_b32 m0, %0" : "=&s"(keep) : "v"(gsrc), "s"(lds_dst) : "memory"); }
typedef float f32x2_t __attribute__((ext_vector_type(2))); typedef __bf16 bf16x2_t __attribute__((ext_vector_type(2)));
__device__ __forceinline__ unsigned cvtpk_s(float lo, float hi) { f32x2_t v = {lo, hi}; bf16x2_t b = __builtin_convertvector(v, bf16x2_t); return __builtin_bit_cast(unsigned, b); }
typedef short v4i16_t __attribute__((ext_vector_type(4)));
typedef LAS const char* lds_cptr;
__device__ __forceinline__ s16x4 vtr(lds_cptr p) { return __builtin_bit_cast(s16x4, __builtin_amdgcn_ds_read_tr16_b64_v4i16((LAS v4i16_t*)p)); }
#define MFMA32(a, b, c) __builtin_amdgcn_mfma_f32_32x32x16_bf16((a), (b), (c), 0, 0, 0)
#define ATT_WAIT_BAR(N) asm volatile("s_waitcnt vmcnt(" #N ") lgkmcnt(0)\n\ts_barrier" ::: "memory")

__device__ __forceinline__ void attn_map(f32x16 (&o)[4], int b, int h, int m, int qb, const bf16* QD, const bf16* KD, const bf16* VD, LAS unsigned char* shm) {
    int lane = threadIdx.x & 63; asm volatile("" : "+v"(lane));
    const int tid = threadIdx.x, r32 = lane & 31, hi = lane >> 5; const int wid = __builtin_amdgcn_readfirstlane(tid >> 6);
    const size_t rowbase = (size_t)b * SEQ; const int q0 = qb * 256;
    const bf16* Qw = QD + (rowbase + q0 + wid * 32) * 512 + (h * 2 + m) * 64;
    const bf16* Kh = KD + rowbase * 512 + (h * 2 + m) * 64; const bf16* Vh = VD + rowbase * 512 + h * 128;
    const unsigned lds0 = (unsigned)(uintptr_t)shm;
    const LAS float* tbl = (const LAS float*)(shm + LDS_TBL) + m * 128;
    LAS float* wsf = (LAS float*)(shm + LDS_WS) + wid * 64;
    const bf16* ksrc = Kh + (size_t)lane * 512 + wid * 8;
    const bf16* vsrc = Vh + (size_t)(16 * (wid & 3) + (lane >> 2)) * 512 + (wid >> 2) * 32 + (lane & 3) * 8;
    const unsigned kdst = lds0 + LDS_K + wid * 1024, vdst = lds0 + LDS_V + wid * 1024;
#define DMA_K(t, slot) glds16(ksrc + (size_t)(t) * 64 * 512, (unsigned)__builtin_amdgcn_readfirstlane(kdst + (slot) * KSLOT))
#define DMA_V(t, slot) do { glds16(vsrc + (size_t)(t) * 64 * 512, (unsigned)__builtin_amdgcn_readfirstlane(vdst + (slot) * VSLOT)); \
        glds16(vsrc + (size_t)(t) * 64 * 512 + 64, (unsigned)__builtin_amdgcn_readfirstlane(vdst + (slot) * VSLOT + 8192)); } while (0)
    const int NT = 4 * qb + 4;
    VM_WAIT();
    DMA_K(0, 0); DMA_V(0, 0); DMA_K(1, 1); DMA_K(2, 2);
    const lds_cptr qlds = (lds_cptr)shm + LDS_Q + wid * 4096 + lane * 16;
    { bf16x8 qr[4];
#pragma unroll
      for (int d0 = 0; d0 < 4; ++d0) qr[d0] = *(const bf16x8*)(Qw + (size_t)r32 * 512 + d0 * 16 + hi * 8);
      asm volatile("s_waitcnt vmcnt(0)" : "+v"(qr[0]), "+v"(qr[1]), "+v"(qr[2]), "+v"(qr[3]) :: "memory");
#pragma unroll
      for (int d0 = 0; d0 < 4; ++d0) *(LAS bf16x8*)(shm + LDS_Q + wid * 4096 + lane * 16 + d0 * 1024) = qr[d0]; }
#pragma unroll
    for (int d0 = 0; d0 < 4; ++d0) o[d0] = (f32x16){};
    float lsum = 0.f;
    const int qw0 = q0 + wid * 32, qabs = qw0 + r32;
    const lds_cptr shm3 = (lds_cptr)shm;
    const lds_cptr kp0 = shm3 + LDS_K + hi * 1024 + r32 * 16;
    const lds_cptr vp0 = shm3 + LDS_V + ((lane >> 4) & 1) * 32 + (lane & 3) * 8 + (4 * hi + ((lane & 15) >> 2)) * 64;
#define QK_TILE(C0, C1, kp) do { C0 = (f32x16){}; C1 = (f32x16){}; \
        _Pragma("unroll") for (int d0 = 0; d0 < 4; ++d0) { if (d0 == 2) __builtin_amdgcn_sched_barrier(0); const bf16x8 b0 = *(const LAS bf16x8*)((kp) + d0 * 2048); const bf16x8 b1 = *(const LAS bf16x8*)((kp) + d0 * 2048 + 512); \
            const bf16x8 qf_ = *(const LAS bf16x8*)(qlds + d0 * 1024); C0 = MFMA32(b0, qf_, C0); C1 = MFMA32(b1, qf_, C1); } } while (0)
#define MASK_BIAS(C0, C1, t) do { const int kvb_ = (t) * 64; if (kvb_ + 191 > qw0) { int dbase = qabs - kvb_ - 4 * hi; asm volatile("" : "+v"(dbase)); \
        _Pragma("unroll") for (int r = 0; r < 16; ++r) { const int d0_ = dbase - ((r & 3) + 8 * (r >> 2)); const int d1_ = d0_ - 32; \
            C0[r] = d0_ < 0 ? -INFINITY : C0[r] + tbl[d0_ > 127 ? 127 : d0_]; C1[r] = d1_ < 0 ? -INFINITY : C1[r] + tbl[d1_ > 127 ? 127 : d1_]; } } } while (0)
#define VLOAD(vf, vp, d0) do { _Pragma("unroll") for (int ks = 0; ks < 4; ++ks) { const s16x4 lo_ = vtr((vp) + (d0) * 4096 + ks * 1024), hh_ = vtr((vp) + (d0) * 4096 + ks * 1024 + 512); \
            vf[ks] = (bf16x8){lo_[0], lo_[1], lo_[2], lo_[3], hh_[0], hh_[1], hh_[2], hh_[3]}; } } while (0)
#define PV4(d0, vf) do { _Pragma("unroll") for (int ks = 0; ks < 4; ++ks) o[d0] = MFMA32(__builtin_bit_cast(bf16x8, pw[ks]), vf[ks], o[d0]); } while (0)
#define PACK_SUM(P0, P1) do { float sacc = 0.f; _Pragma("unroll") for (int r = 0; r < 16; ++r) sacc += P0[r] + P1[r]; lsum += sacc; \
        _Pragma("unroll") for (int i = 0; i < 4; ++i) { pw[0][i] = cvtpk_s(P0[2 * i], P0[2 * i + 1]); pw[1][i] = cvtpk_s(P0[8 + 2 * i], P0[9 + 2 * i]); pw[2][i] = cvtpk_s(P1[2 * i], P1[2 * i + 1]); pw[3][i] = cvtpk_s(P1[8 + 2 * i], P1[9 + 2 * i]); } } while (0)
#define EXP_PACK(C, pwa, pwb) do { float sacc = 0.f; _Pragma("unroll") for (int r = 0; r < 16; ++r) { C[r] = __builtin_amdgcn_exp2f(C[r]); sacc += C[r]; } lsum += sacc; \
        _Pragma("unroll") for (int i = 0; i < 4; ++i) { pwa[i] = cvtpk_s(C[2 * i], C[2 * i + 1]); pwb[i] = cvtpk_s(C[8 + 2 * i], C[9 + 2 * i]); } } while (0)
#define KLOAD(kf, kp) do { _Pragma("unroll") for (int d0 = 0; d0 < 4; ++d0) { kf[2 * d0] = *(const LAS bf16x8*)((kp) + d0 * 2048); kf[2 * d0 + 1] = *(const LAS bf16x8*)((kp) + d0 * 2048 + 512); } } while (0)
#define QLOAD(qf) do { _Pragma("unroll") for (int d0 = 0; d0 < 4; ++d0) qf[d0] = *(const LAS bf16x8*)(qlds + d0 * 1024); } while (0)
#define QK8(C0, C1, kf, qf) do { C0 = (f32x16){}; C1 = (f32x16){}; _Pragma("unroll") for (int d0 = 0; d0 < 4; ++d0) { C0 = MFMA32(kf[2 * d0], qf[d0], C0); C1 = MFMA32(kf[2 * d0 + 1], qf[d0], C1); } } while (0)
#define SB() __builtin_amdgcn_sched_barrier(0)
    f32x16 C0, C1; v4u pw[4], pwn[4]; bf16x8 va[4], vb[4], kf[8], qf[4];
    ATT_WAIT_BAR(0);
    KLOAD(kf, kp0); QLOAD(qf);
    ATT_WAIT_BAR(0);
    if (3 < NT) DMA_K(3, 0);
    DMA_V(1, 1);
    QK8(C0, C1, kf, qf);
    MASK_BIAS(C0, C1, 0);
    EXP_PACK(C0, pw[0], pw[1]); EXP_PACK(C1, pw[2], pw[3]);
    KLOAD(kf, kp0 + KSLOT);
    int ks_cur = 1, vs_prev = 0;
    for (int t = 1; t < NT; ++t) {
        if (t + 2 < NT) { ATT_WAIT_BAR(3); } else { ATT_WAIT_BAR(2); }
        { const int vs_new = (vs_prev == 0) ? 2 : vs_prev - 1;
          if (t + 3 < NT) DMA_K(t + 3, ks_cur);
          if (t + 1 < NT) DMA_V(t + 1, vs_new); }
        const int ks_next = (ks_cur == 2) ? 0 : ks_cur + 1;
        const lds_cptr vp = vp0 + vs_prev * VSLOT;
        SB();
        VLOAD(va, vp, 0); VLOAD(vb, vp, 1); QLOAD(qf);
        SB();
        QK8(C0, C1, kf, qf);
        SB();
        MASK_BIAS(C0, C1, t);
        SB();
        PV4(0, va); PV4(1, vb);
        SB();
        VLOAD(va, vp, 2); VLOAD(vb, vp, 3);
        KLOAD(kf, kp0 + ks_next * KSLOT);
        SB();
        EXP_PACK(C0, pwn[0], pwn[1]);
        SB();
        PV4(2, va); PV4(3, vb);
        EXP_PACK(C1, pwn[2], pwn[3]);
        SB();
#pragma unroll
        for (int i = 0; i < 4; ++i) pw[i] = pwn[i];
        ks_cur = ks_next; vs_prev = (vs_prev == 2) ? 0 : vs_prev + 1;
    }
    ATT_WAIT_BAR(0);
    { const lds_cptr vp = vp0 + vs_prev * VSLOT;
      VLOAD(va, vp, 0); VLOAD(vb, vp, 1); PV4(0, va); PV4(1, vb);
      VLOAD(va, vp, 2); VLOAD(vb, vp, 3); PV4(2, va); PV4(3, vb); }
    { auto rr = __builtin_amdgcn_permlane32_swap(__float_as_uint(lsum), __float_as_uint(lsum), false, false); lsum = __uint_as_float(rr[0]) + __uint_as_float(rr[1]); }
    if (hi == 0) wsf[r32] = lsum;
    LDS_WAIT();
#pragma unroll
    for (int r = 0; r < 16; ++r) { const float rl = 1.0f / wsf[crow(r, hi)];
#pragma unroll
        for (int d0 = 0; d0 < 4; ++d0) o[d0][r] *= rl; }
    ATT_WAIT_BAR(0);
#undef DMA_K
#undef DMA_V
#undef QK_TILE
#undef MASK_BIAS
#undef VLOAD
#undef PV4
#undef PACK_SUM
#undef EXP_PACK
#undef KLOAD
#undef QLOAD
#undef QK8
#undef SB
}
__device__ __forceinline__ int t5_bucket(int n) {
    if (n < 16) return n;
    const float nf = (float)n; int large = 16 + (int)(logf(nf / 16.f) / logf(8.f) * 16.f);
    return large < 31 ? large : 31;
}
__device__ __forceinline__ void attn_unit(Frame& F, int b, int h, int qb, float lam) {
    LAS unsigned char* shm = F.lds;
    int tid = F.tid; asm volatile("" : "+v"(tid));
    const int lane = tid & 63, r32 = lane & 31, hi = lane >> 5, wid = F.wave;
    if (tid < 256) { const int m = tid >> 7, d = tid & 127; const int col = h * 2 + m;
        ((LAS float*)(shm + LDS_TBL))[tid] = (F.rel_bias[t5_bucket(d) * 8 + col] - F.rel_bias[31 * 8 + col]) * LOG2E; }
    __syncthreads();
    const bf16* QD = wsp<const bf16>(F, WS_QD); const bf16* KD = wsp<const bf16>(F, WS_KD); const bf16* VD = wsp<const bf16>(F, WS_VD);
    float* stash = wsp<float>(F, WS_STASH) + (size_t)F.vcu * 32768 + tid * 64;
    f32x16 o[4];
#pragma nounroll
    for (int m = 0; m < 2; ++m) {
        attn_map(o, b, h, m, qb, QD, KD, VD, shm);
        if (m == 0) {
#pragma unroll
            for (int d0 = 0; d0 < 4; ++d0)
#pragma unroll
                for (int r = 0; r < 16; r += 4) *(f32x4*)(stash + d0 * 16 + r) = (f32x4){o[d0][r], o[d0][r + 1], o[d0][r + 2], o[d0][r + 3]};
        } else {
            float ss[16];
#pragma unroll
            for (int r = 0; r < 16; ++r) ss[r] = 0.f;
#pragma unroll
            for (int d0 = 0; d0 < 4; ++d0)
#pragma unroll
                for (int r4 = 0; r4 < 16; r4 += 4) { const f32x4 sv = *(const f32x4*)(stash + d0 * 16 + r4);
#pragma unroll
                    for (int q = 0; q < 4; ++q) { const int r = r4 + q; const float v = sv[q] - lam * o[d0][r]; o[d0][r] = v; ss[r] += v * v; } }
            float gs[4];
#pragma unroll
            for (int d0 = 0; d0 < 4; ++d0) gs[d0] = F.g_subln[32 * d0 + r32] * 0.8f;
            bf16* A2 = wsp<bf16>(F, WS_A2);
            const size_t rowb = (size_t)b * SEQ + (size_t)qb * 256 + wid * 32;
            bf16* a2b = A2 + (rowb + 4 * hi) * 1024 + 512 + h * 128 + r32; asm volatile("" : "+v"(a2b));
#pragma unroll
            for (int r = 0; r < 16; ++r) { float s = ss[r];
                s += __shfl_xor(s, 1); s += __shfl_xor(s, 2); s += __shfl_xor(s, 4); s += __shfl_xor(s, 8); s += __shfl_xor(s, 16);
                const float rs = rsqrtf(s * (1.f / 128.f) + EPS);
                bf16* rowp = a2b + (size_t)((r & 3) + 8 * (r >> 2)) * 1024;
#pragma unroll
                for (int d0 = 0; d0 < 4; ++d0) rowp[32 * d0] = (bf16)f2bf(o[d0][r] * rs * gs[d0]); }
        }
    }
    __syncthreads();
}
}

__device__ __forceinline__ void p7_phase(Frame& F) {
    const int tid = F.tid, lane = F.lane;
    LAS float* wr = (LAS float*)F.lds;
    LAS unsigned* hist = (LAS unsigned*)(F.lds + HIST_OFF);
    for (int idx = tid; idx < 32768; idx += 512) { const int k = idx >> 5, e = idx & 31; wr[e * 1024 + k] = F.w_router[idx]; }
    if (tid < 32) hist[tid] = 0u;
    __syncthreads();
    const float* MOD = wsp<const float>(F, WS_MOD);
    const int gw = F.vcu * NWAVES + F.wave, NGW = F.G * NWAVES; const int rpw = (T + NGW - 1) / NGW;
    int curb = -1; f32x4 gsc[4], shv[4], nx[4];
    { const int m0 = (gw * rpw < T) ? gw * rpw : 0; const GAS f32x4* xr = (const GAS f32x4*)(F.out + (size_t)m0 * D) + lane;
#pragma unroll
      for (int j = 0; j < 4; ++j) nx[j] = xr[64 * j]; }
#pragma nounroll
    for (int i = 0; i < rpw; ++i) {
        const int m = gw * rpw + i; if (m >= T) break;
        const int b = m / SEQ;
        if (b != curb) { curb = b;
#pragma unroll
            for (int j = 0; j < 4; ++j) { const int col = 256 * j + 4 * lane; const f32x4 g = *(const f32x4*)(F.g_norm2 + col);
                shv[j] = *(const f32x4*)(MOD + (size_t)b * 6144 + 3072 + col); gsc[j] = g * (*(const f32x4*)(MOD + (size_t)b * 6144 + 4096 + col) + 1.0f); } }
        f32x4 v[4]; float s = 0.f;
#pragma unroll
        for (int j = 0; j < 4; ++j) { v[j] = nx[j]; s += (v[j].x * v[j].x + v[j].y * v[j].y) + (v[j].z * v[j].z + v[j].w * v[j].w); }
        { const int m2 = (m + 1 < T) ? m + 1 : m; const GAS f32x4* xr = (const GAS f32x4*)(F.out + (size_t)m2 * D) + lane;
#pragma unroll
          for (int j = 0; j < 4; ++j) nx[j] = xr[64 * j]; }
        const float rstd = rsqrtf(wave_sum(s) * (1.f / D) + EPS);
        GAS unsigned* o4 = (GAS unsigned*)(wsp<unsigned char>(F, WS_XN) + (size_t)m * D) + lane;
#pragma unroll
        for (int j = 0; j < 4; ++j) { v[j] = v[j] * rstd * gsc[j] + shv[j]; o4[64 * j] = pk4_fp8(v[j].x, v[j].y, v[j].z, v[j].w); }
        float lg[32];
#pragma unroll
        for (int e = 0; e < 32; ++e) { float a = 0.f;
#pragma unroll
            for (int j = 0; j < 4; ++j) { const f32x4 w = *(const LAS f32x4*)(wr + e * 1024 + 256 * j + 4 * lane); a += (v[j].x * w.x + v[j].y * w.y) + (v[j].z * w.z + v[j].w * w.w); }
            lg[e] = a; if ((e & 7) == 7) asm volatile("" ::: "memory"); }
        { const float tot = xreduce<32>(lg, lane);
#pragma unroll
          for (int e = 0; e < 32; ++e) lg[e] = lane_bcast(tot, 2 * e) + F.b_router[e]; }
        int te[4]; float tv[4];
#pragma unroll
        for (int k = 0; k < 4; ++k) { float bv = -INFINITY; int bi = 0;
#pragma unroll
            for (int e = 0; e < 32; ++e) { const bool c = lg[e] > bv; bv = c ? lg[e] : bv; bi = c ? e : bi; }
            te[k] = bi; tv[k] = bv;
#pragma unroll
            for (int e = 0; e < 32; ++e) lg[e] = (e == bi) ? -INFINITY : lg[e]; }
        float ex[4], es = 0.f;
#pragma unroll
        for (int k = 0; k < 4; ++k) { ex[k] = __expf(tv[k] - tv[0]); es += ex[k]; }
        if (lane < 4) { const int e = lane == 0 ? te[0] : lane == 1 ? te[1] : lane == 2 ? te[2] : te[3]; const float w = (lane == 0 ? ex[0] : lane == 1 ? ex[1] : lane == 2 ? ex[2] : ex[3]) / es;
            wsp<int>(F, WS_TOPE)[(size_t)m * 4 + lane] = e; wsp<float>(F, WS_TOPW)[(size_t)m * 4 + lane] = w; __hip_atomic_fetch_add(hist + e, 1u, __ATOMIC_RELAXED, __HIP_MEMORY_SCOPE_WORKGROUP); }
    }
    __syncthreads();
    if (tid < 32) __hip_atomic_fetch_add(F.ctl + CW_CNT + tid, hist[tid], RLX_AGENT);
}
__device__ __forceinline__ void moe_tables(Frame& F, int& nMt) {
    LAS unsigned char* te = F.lds + TILEE_OFF;
    if (F.tid == 0) { int t0 = 0;
        for (int e = 0; e < NE; ++e) { const int c = (int)__hip_atomic_load(F.ctl + CW_CNT + e, RLX_AGENT); const int nt = (c + 255) >> 8; for (int j = 0; j < nt; ++j) te[t0 + j] = (unsigned char)e; t0 += nt; }
        F.MISC[16] = (unsigned)t0; }
    __syncthreads();
    nMt = __builtin_amdgcn_readfirstlane((int)F.MISC[16]);
}
__device__ __forceinline__ void p8_phase(Frame& F) {
    const int tid = F.tid, lane = F.lane;
    LAS unsigned* hist = (LAS unsigned*)(F.lds + HIST_OFF);
    if (tid < 96) hist[tid] = 0u;
    __syncthreads();
    const int gw = F.vcu * NWAVES + F.wave, NGW = F.G * NWAVES; const int rpw = (T + NGW - 1) / NGW;
    const int* TOPE = wsp<const int>(F, WS_TOPE); const float* TOPW = wsp<const float>(F, WS_TOPW);
    for (int i = 0; i < rpw; ++i) { const int m = gw * rpw + i; if (m >= T) break; if (lane < 4) __hip_atomic_fetch_add(hist + TOPE[(size_t)m * 4 + lane], 1u, __ATOMIC_RELAXED, __HIP_MEMORY_SCOPE_WORKGROUP); }
    __syncthreads();
    if (tid < 32) { unsigned pstart = 0; for (int e = 0; e < tid; ++e) { const unsigned c = __hip_atomic_load(F.ctl + CW_CNT + e, RLX_AGENT); pstart += (c + 255u) & ~255u; }
        hist[32 + tid] = pstart + __hip_atomic_fetch_add(F.ctl + CW_FILL + tid, hist[tid], RLX_AGENT); }
    __syncthreads();
    const unsigned char* H2 = wsp<const unsigned char>(F, WS_XN); unsigned char* XS = wsp<unsigned char>(F, WS_XS);
    for (int i = 0; i < rpw; ++i) { const int m = gw * rpw + i; if (m >= T) break;
        int pos = 0;
        if (lane < 4) { const int e = TOPE[(size_t)m * 4 + lane]; pos = (int)(hist[32 + e] + __hip_atomic_fetch_add(hist + 64 + e, 1u, __ATOMIC_RELAXED, __HIP_MEMORY_SCOPE_WORKGROUP));
            wsp<int>(F, WS_POS)[(size_t)m * 4 + lane] = pos; wsp<float>(F, WS_ROWW)[pos] = TOPW[(size_t)m * 4 + lane]; }
        const v4u a = *(const v4u*)(H2 + (size_t)m * D + lane * 16);
#pragma unroll
        for (int k = 0; k < 4; ++k) { const int p = __shfl(pos, k); *(v4u*)(XS + (size_t)p * D + lane * 16) = a; }
    }
}
__device__ __forceinline__ void p11_phase(Frame& F) {
    const int lane = F.lane;
    const float* MOD = wsp<const float>(F, WS_MOD); const bf16* CN = wsp<const bf16>(F, WS_CN); const int* POS = wsp<const int>(F, WS_POS);
    const int gw = F.vcu * NWAVES + F.wave, NGW = F.G * NWAVES; const int rpw = (T + NGW - 1) / NGW;
    const int mbeg = gw * rpw, mend = (mbeg + rpw < T) ? mbeg + rpw : T;
    if (mbeg >= mend) return;
    v4u ca[4], cc[4]; f32x4 xv[4]; int pn[4];
#define P11_LOAD(mm) do { _Pragma("unroll") for (int k = 0; k < 4; ++k) { const v4u* src = (const v4u*)(CN + (size_t)pn[k] * D + lane * 16); ca[k] = src[0]; cc[k] = src[1]; } \
        _Pragma("unroll") for (int q = 0; q < 4; ++q) xv[q] = *(const f32x4*)(F.out + (size_t)(mm) * D + lane * 16 + 4 * q); } while (0)
    { const int4 p4 = *(const int4*)(POS + (size_t)mbeg * 4); pn[0] = p4.x; pn[1] = p4.y; pn[2] = p4.z; pn[3] = p4.w; }
    P11_LOAD(mbeg);
    { const int m2 = (mbeg + 1 < mend) ? mbeg + 1 : mbeg; const int4 p4 = *(const int4*)(POS + (size_t)m2 * 4); pn[0] = p4.x; pn[1] = p4.y; pn[2] = p4.z; pn[3] = p4.w; }
#pragma nounroll
    for (int m = mbeg; m < mend; ++m) {
        const int b = m / SEQ;
        float acc[16];
#pragma unroll
        for (int q = 0; q < 16; ++q) acc[q] = 0.f;
#pragma unroll
        for (int k = 0; k < 4; ++k) {
#pragma unroll
            for (int q = 0; q < 4; ++q) { acc[2 * q] += bflo(ca[k][q]); acc[2 * q + 1] += bfhi(ca[k][q]); acc[8 + 2 * q] += bflo(cc[k][q]); acc[8 + 2 * q + 1] += bfhi(cc[k][q]); } }
        f32x4 ov[4]; const float* gt = MOD + (size_t)b * 6144 + 5120 + lane * 16;
#pragma unroll
        for (int q = 0; q < 4; ++q) { const f32x4 g = *(const f32x4*)(gt + 4 * q); const f32x4 av = {acc[4 * q], acc[4 * q + 1], acc[4 * q + 2], acc[4 * q + 3]}; ov[q] = xv[q] + g * av; }
        const int m1 = (m + 1 < mend) ? m + 1 : m;
        P11_LOAD(m1);
        { const int m2 = (m + 2 < mend) ? m + 2 : m1; const int4 p4 = *(const int4*)(POS + (size_t)m2 * 4); pn[0] = p4.x; pn[1] = p4.y; pn[2] = p4.z; pn[3] = p4.w; }
        float* orow = F.out + (size_t)m * D + lane * 16;
#pragma unroll
        for (int q = 0; q < 4; ++q) *(f32x4*)(orow + 4 * q) = ov[q];
    }
#undef P11_LOAD
}

constexpr int NPHASE = 12;
struct Args { const float* in[25]; float* out; unsigned char* ws; int ph_lo, ph_hi; };
__global__ void __launch_bounds__(NWAVES * 64, 2) fwd_kernel(Args args) {
    extern __shared__ __attribute__((aligned(16))) unsigned char lds[];
    Frame F;
    F.lds = (LAS unsigned char*)lds;
    F.MISC = (volatile LAS unsigned*)(F.lds + MISC_OFF);
    F.tid = threadIdx.x; F.lane = F.tid & 63; F.wave = __builtin_amdgcn_readfirstlane(F.tid >> 6);
    F.G = gridDim.x; { const int bx = blockIdx.x; F.vcu = (F.G % 8 == 0) ? (bx % 8) * (F.G / 8) + bx / 8 : bx; }
    F.ws = args.ws; F.ctl = (gu32*)(args.ws + WS_CTL); F.out = args.out;
    F.x = args.in[0]; F.c = args.in[1]; F.rel_bias = args.in[2]; F.w_ada = args.in[3]; F.b_ada = args.in[4]; F.g_norm1 = args.in[5]; F.w_in = args.in[6];
    F.w_gk_up = args.in[7]; F.b_gk_up = args.in[8]; F.g_gla_out = args.in[9]; F.g_qnorm = args.in[10]; F.g_knorm = args.in[11];
    F.lq1 = args.in[12]; F.lk1 = args.in[13]; F.lq2 = args.in[14]; F.lk2 = args.in[15]; F.g_subln = args.in[16]; F.w_out = args.in[17];
    F.g_norm2 = args.in[18]; F.w_router = args.in[19]; F.b_router = args.in[20]; F.w_gate_up = args.in[21]; F.b_gate_up = args.in[22]; F.w_down = args.in[23]; F.b_down = args.in[24];
    for (int u = F.tid; u < (LDS_BYTES - LDSCTL_OFF) / 4; u += NWAVES * 64) ((LAS unsigned*)(F.lds + LDSCTL_OFF))[u] = 0u;
    __syncthreads();
    const int lo = args.ph_lo, hi = args.ph_hi;
    const bool multi = (hi - lo) > 1;
    XcdBarrier bar; bar.bar = (unsigned*)(F.ctl + CW_BAR); bar.x = 0; bar.st = nullptr;
    if (multi) bar = xcd_barrier_post((unsigned*)(F.ctl + CW_BAR), F.MISC + 8);
#ifndef PHMASK
#define PHMASK 0xFFF
#endif
#define IN(k) (((PHMASK >> (k)) & 1) && lo <= (k) && (k) < hi)
#define SEAM(k) do { if (IN((k) + 1)) xcd_barrier(bar); } while (0)
#ifndef REPEAT_PH
#define REPEAT_PH 0
#endif
#define REPS(k) (((REPEAT_PH >> (k)) & 1) ? 2 : 1)

    if (IN(0)) { for (int rep_ = 0; rep_ < REPS(0); ++rep_) { if (rep_) xcd_barrier(bar); p0_phase(F); } SEAM(0); }
    if (IN(1)) { for (int rep_ = 0; rep_ < REPS(1); ++rep_) { if (rep_) xcd_barrier(bar); p1_phase(F); } SEAM(1); }
    if (IN(2)) {
        pg8::Gemm g{wsp<const bf16>(F, WS_XN), wsp<const bf16>(F, WS_WIN), T, NIN, D, 0};
        pg8::StaticOrder S; S.init(T / 256, NIN / 256, F.G, (int)blockIdx.x, nullptr, REPS(2));
        EpiInProj E{wsp<bf16>(F, WS_QG), wsp<bf16>(F, WS_KG), wsp<bf16>(F, WS_VG), wsp<bf16>(F, WS_RG), wsp<bf16>(F, WS_QD), wsp<bf16>(F, WS_KD), wsp<bf16>(F, WS_VD), F.g_qnorm, F.g_knorm};
        pg8::gemm_phase<EpiInProj, pg8::StaticOrder>(F.lds, g, S, E);
        SEAM(2);
    }
    if (IN(3)) { for (int rep_ = 0; rep_ < REPS(3); ++rep_) { if (rep_) xcd_barrier(bar); for (int c = F.vcu; c < NCHUNK; c += F.G) gla_a_unit(F, c); } SEAM(3); }
    if (IN(4)) { for (int rep_ = 0; rep_ < REPS(4); ++rep_) { if (rep_) xcd_barrier(bar); gla_b_phase(F); } SEAM(4); }
    if (IN(5)) for (int rep_ = 0; rep_ < REPS(5); ++rep_) { if (rep_) xcd_barrier(bar);
#ifndef NO_GLAC
        for (int u = F.vcu; u < NCHUNK / 2; u += F.G) gla_c_unit(F, u);
#endif
        float lam;
        { float a1 = F.lq1[F.lane] * F.lk1[F.lane], a2 = F.lq2[F.lane] * F.lk2[F.lane]; a1 = wave_sum(a1); a2 = wave_sum(a2); lam = __expf(a1) - __expf(a2) + 0.2f; }
#ifndef NO_ATT
        for (int p = F.vcu; p < 256; p += F.G) { const int bh = p >> 4, s = p & 15;
#pragma nounroll
            for (int j = 0; j < 2; ++j) att::attn_unit(F, bh >> 2, bh & 3, j ? s : 31 - s, lam); }
#endif
        SEAM(5);
    }
    if (IN(6)) {
        pg8::Gemm g{wsp<const bf16>(F, WS_A2), wsp<const bf16>(F, WS_WOUT), T, D, D, 0};
        pg8::StaticOrder S; S.init(T / 256, D / 256, F.G, (int)blockIdx.x, nullptr, REPS(6));
        EpiOutProj E{F.x, F.out, wsp<const float>(F, WS_MOD)};
        pg8::gemm_phase<EpiOutProj, pg8::StaticOrder>(F.lds, g, S, E);
        SEAM(6);
    }
    if (IN(7)) { p7_phase(F); SEAM(7); }
    if (IN(8)) { p8_phase(F); SEAM(8); }
    if (IN(9)) {
        int nMt; moe_tables(F, nMt);
        pg8::Gemm g{wsp<const bf16>(F, WS_XS), wsp<const bf16>(F, WS_WGU), PMAX, 2048, D / 2, (size_t)2048 * 512};
        pg8::StaticOrder S; S.init(nMt, 8, F.G, (int)blockIdx.x, F.lds + TILEE_OFF, REPS(9));
        EpiSwiGLU E{wsp<unsigned char>(F, WS_Y), F.b_gate_up};
        pg8::gemm_phase<EpiSwiGLU, pg8::StaticOrder, true>(F.lds, g, S, E);
        SEAM(9);
    }
    if (IN(10)) {
        int nMt; moe_tables(F, nMt);
        pg8::Gemm g{wsp<const bf16>(F, WS_Y), wsp<const bf16>(F, WS_WD), PMAX, 1024, FF / 2, (size_t)1024 * 512};
        pg8::StaticOrder S; S.init(nMt, 4, F.G, (int)blockIdx.x, F.lds + TILEE_OFF, REPS(10));
        EpiDown E{wsp<bf16>(F, WS_CN), F.b_down, wsp<const float>(F, WS_ROWW)};
        pg8::gemm_phase<EpiDown, pg8::StaticOrder, true>(F.lds, g, S, E);
        SEAM(10);
    }
    if (IN(11)) { p11_phase(F); }
#undef IN
#undef SEAM
}

extern "C" void kernel_launch(void* const* d_in, const int* in_sizes, int n_in, void* d_out, int out_size, void* d_ws, size_t ws_size, hipStream_t stream) {
    static int grid = 0;
    if (grid == 0) {
        if (n_in != 25 || in_sizes[0] != T * D || out_size != T * D || ws_size < WS_END) { fprintf(stderr, "kernel_launch: unexpected shapes (n_in %d, in0 %d, out %d, ws %zu); nothing launched\n", n_in, n_in > 0 ? in_sizes[0] : -1, out_size, ws_size); grid = -1; return; }
        int dev = 0, cus = 0, per_cu = 0;
        if (hipGetDevice(&dev) != hipSuccess || hipDeviceGetAttribute(&cus, hipDeviceAttributeMultiprocessorCount, dev) != hipSuccess) { grid = -1; return; }
        if (hipFuncSetAttribute((const void*)fwd_kernel, hipFuncAttributeMaxDynamicSharedMemorySize, LDS_BYTES) != hipSuccess) { fprintf(stderr, "kernel_launch: hipFuncSetAttribute failed\n"); grid = -1; return; }
        if (hipOccupancyMaxActiveBlocksPerMultiprocessor(&per_cu, (const void*)fwd_kernel, NWAVES * 64, LDS_BYTES) != hipSuccess || per_cu < 1)
            fprintf(stderr, "kernel_launch: note: occupancy query reports %d workgroups per CU\n", per_cu);
        (void)hipGetLastError();
        grid = cus;
    }
    if (grid < 0) return;
    if (hipMemsetAsync((char*)d_ws + WS_CTL, 0, CTL_ZERO_BYTES, stream) != hipSuccess) { fprintf(stderr, "kernel_launch: memset failed\n"); return; }
    Args a{};
    for (int i = 0; i < 25; ++i) a.in[i] = (const float*)d_in[i];
    a.out = (float*)d_out; a.ws = (unsigned char*)d_ws;
#if MK_N_LAUNCHES == 1
    a.ph_lo = 0; a.ph_hi = NPHASE;
    hipLaunchKernelGGL(fwd_kernel, dim3(grid), dim3(NWAVES * 64), LDS_BYTES, stream, a);
#else
    for (int p = 0; p < NPHASE; ++p) { a.ph_lo = p; a.ph_hi = p + 1; hipLaunchKernelGGL(fwd_kernel, dim3(grid), dim3(NWAVES * 64), LDS_BYTES, stream, a); }
#endif
    const hipError_t le = hipPeekAtLastError();
    if (le != hipSuccess) fprintf(stderr, "kernel_launch: launch failed: %s\n", hipGetErrorName(le));
}
```

```cpp
#include <hip/hip_runtime.h>
#include <cstdio>
#include <cstdint>

#ifndef MK_N_LAUNCHES
#define MK_N_LAUNCHES 1
#endif

namespace pg8 {
#define PG8_LAS __attribute__((address_space(3)))
typedef unsigned short bf16_t;
typedef short bf16x8 __attribute__((ext_vector_type(8)));
typedef float f32x4 __attribute__((ext_vector_type(4)));
typedef unsigned u32x4 __attribute__((ext_vector_type(4)));
typedef int i32x4 __attribute__((ext_vector_type(4)));
typedef int i32x8 __attribute__((ext_vector_type(8)));
typedef float f32x16 __attribute__((ext_vector_type(16)));
constexpr int BM = 256, BK = 64, HALF = 128, HTB = HALF * BK * 2, STAGE_BYTES = 8 * HTB, NXCD = 8, WGM = 8;

__host__ __device__ __forceinline__ int lds_byte(int r, int c) { const int st = (r >> 4) * 2 + (c >> 5), rr = r & 15, cc = c & 31, ob = rr * 64 + cc * 2; return st * 1024 + (ob ^ (((ob >> 9) & 1) << 5)); }
__host__ __device__ __forceinline__ void stage_rc(int b, int& R, int& C) { const int st = b / 1024, sb = b % 1024, swz = sb ^ (((sb >> 9) & 1) << 5); R = (st >> 1) * 16 + swz / 64; C = (st & 1) * 32 + (swz % 64) / 2; }
__host__ __device__ __forceinline__ int perm32(int rho) { const int n = rho >> 4, i = rho & 15; return 8 * (i >> 2) + 4 * n + (i & 3); }

struct Unit { int pm, pn, e; };
struct Gemm { const bf16_t* A; const bf16_t* Bt; int M, N, K; size_t estride; };

struct StaticOrder {
    int nM, nN, nwg, G, c, rep; const PG8_LAS unsigned char* tile_e;
    __device__ void init(int nM_, int nN_, int G_, int c_, const PG8_LAS unsigned char* te, int rep_ = 1) { nM = nM_; nN = nN_; nwg = nM * nN; G = G_; c = c_; tile_e = te; rep = rep_; }
    __device__ bool next(int i, Unit& u) const {
        long L = (long)i * G + c; if (L >= (long)nwg * rep) return false; if (rep > 1) L %= nwg;
        int wgid = (int)L; { const int q = nwg / NXCD, r = nwg % NXCD, xcd = wgid % NXCD, off = wgid / NXCD; wgid = (xcd < r ? xcd * (q + 1) : r * (q + 1) + (xcd - r) * q) + off; }
        const int nig = WGM * nN, gid = wgid / nig, fm = gid * WGM, gsz = (nM - fm) < WGM ? (nM - fm) : WGM;
        u.pm = fm + ((wgid % nig) % gsz); u.pn = (wgid % nig) / gsz; u.e = tile_e ? __builtin_amdgcn_readfirstlane((int)tile_e[u.pm]) : 0; return true;
    }
};

__device__ __forceinline__ unsigned cvt_pk_bf16(float lo, float hi) { unsigned r; asm volatile("v_cvt_pk_bf16_f32 %0, %1, %2" : "=v"(r) : "v"(lo), "v"(hi)); return r; }

template <class Epi, class Sched, bool FP8 = false>
__device__ __forceinline__ void gemm_phase(PG8_LAS unsigned char* lds, const Gemm g, const Sched& S, const Epi& E) {
    const int tid = threadIdx.x, wid = __builtin_amdgcn_readfirstlane(tid >> 6), lane = tid & 63, wr = wid >> 2, wc = wid & 3, fr = lane & 15, fq = lane >> 4;
    const int K = g.K, nt = K / BK;
    unsigned voffA[2], voffB[2];
#pragma unroll
    for (int i = 0; i < 2; ++i) { int R, C; stage_rc(tid * 16 + i * 8192, R, C); const int Rb = Epi::PERM ? ((R & ~31) + perm32(R & 31)) : R;
        voffA[i] = (unsigned)(R * K + C) * 2u; voffB[i] = (unsigned)(Rb * K + C) * 2u; }
    const size_t kstep = (size_t)(BK * 2);
    const size_t hstep = (size_t)HALF * K * 2;
    const size_t tstep = 2 * hstep;
    const size_t estep = g.estride * 2;
    const unsigned ldsw = (unsigned)wid * 1024u;
    const int aoff = lds_byte(wr * 64 + fr, fq * 8), boff = lds_byte(wc * 32 + fr, fq * 8);
#define PG8_SA(b, h) (((b) * 2 + (h)) * HTB)
#define PG8_SB(b, h) ((4 + (b) * 2 + (h)) * HTB)
#define PG8_STAGE(bufoff, gbase, voff) do { _Pragma("unroll") for (int _i = 0; _i < 2; ++_i) \
        __builtin_amdgcn_global_load_lds((const unsigned*)((const char*)(gbase) + (voff)[_i]), (PG8_LAS unsigned*)(lds + (bufoff) + ldsw + _i * 8192), 16, 0, 0); } while (0)
#define PG8_LDA(dst, b, h) do { _Pragma("unroll") for (int m = 0; m < 4; ++m) dst[m] = PG8_CAT2(*(const PG8_LAS i32x4*)(lds + PG8_SA(b, h) + aoff + m * 2048), *(const PG8_LAS i32x4*)(lds + PG8_SA(b, h) + aoff + m * 2048 + 1024)); } while (0)
#define PG8_LDB(dst, b, h) do { _Pragma("unroll") for (int n = 0; n < 2; ++n) dst[n] = PG8_CAT2(*(const PG8_LAS i32x4*)(lds + PG8_SB(b, h) + boff + n * 2048), *(const PG8_LAS i32x4*)(lds + PG8_SB(b, h) + boff + n * 2048 + 1024)); } while (0)
#define PG8_CAT2(x, y) __builtin_shufflevector((x), (y), 0, 1, 2, 3, 4, 5, 6, 7)
#define PG8_LO(x) __builtin_bit_cast(bf16x8, __builtin_shufflevector((x), (x), 0, 1, 2, 3))
#define PG8_HI(x) __builtin_bit_cast(bf16x8, __builtin_shufflevector((x), (x), 4, 5, 6, 7))
#define PG8_X4(v, m) ((f32x4){(v)[4 * (m)], (v)[4 * (m) + 1], (v)[4 * (m) + 2], (v)[4 * (m) + 3]})
#define PG8_INS(v, r, m) do { (v)[4 * (m)] = (r)[0]; (v)[4 * (m) + 1] = (r)[1]; (v)[4 * (m) + 2] = (r)[2]; (v)[4 * (m) + 3] = (r)[3]; } while (0)
#define PG8_MMA(ai, bj, At, Bt) do { __builtin_amdgcn_s_setprio(1); _Pragma("unroll") for (int m = 0; m < 4; ++m) _Pragma("unroll") for (int n = 0; n < 2; ++n) { \
        if constexpr (FP8) { const f32x4 r_ = __builtin_amdgcn_mfma_scale_f32_16x16x128_f8f6f4(Bt[n], At[m], PG8_X4(acc16[ai][bj][n], m), 0, 0, 0, 0x7F7F7F7F, 0, 0x7F7F7F7F); PG8_INS(acc16[ai][bj][n], r_, m); } \
        else { acc[ai][bj][m][n] = __builtin_amdgcn_mfma_f32_16x16x32_bf16(PG8_LO(Bt[n]), PG8_LO(At[m]), acc[ai][bj][m][n], 0, 0, 0); \
               acc[ai][bj][m][n] = __builtin_amdgcn_mfma_f32_16x16x32_bf16(PG8_HI(Bt[n]), PG8_HI(At[m]), acc[ai][bj][m][n], 0, 0, 0); } } \
        __builtin_amdgcn_s_setprio(0); } while (0)
#define PG8_WAIT_V(n) asm volatile("s_waitcnt vmcnt(" #n ")" ::: "memory")
#define PG8_WAIT_L(n) asm volatile("s_waitcnt lgkmcnt(" #n ")" ::: "memory")
#define PG8_BAR __builtin_amdgcn_s_barrier()
#define PG8_SCHED __builtin_amdgcn_sched_barrier(0)
    Unit cur, nxt; int ui = 0;
    if (!S.next(0, cur)) return;
    f32x4 acc[2][2][4][2];
#pragma unroll
    for (int a = 0; a < 2; ++a)
#pragma unroll
        for (int b = 0; b < 2; ++b)
#pragma unroll
            for (int m = 0; m < 4; ++m)
#pragma unroll
                for (int n = 0; n < 2; ++n) acc[a][b][m][n] = (f32x4){0.f, 0.f, 0.f, 0.f};
    f32x16 acc16[2][2][2];
#pragma unroll
    for (int a = 0; a < 2; ++a)
#pragma unroll
        for (int b = 0; b < 2; ++b)
#pragma unroll
            for (int n = 0; n < 2; ++n) acc16[a][b][n] = (f32x16){};
    i32x8 At[4], B0[2], B1[2];
    const char* cA = (const char*)g.A + (size_t)cur.pm * tstep; const char* cB = (const char*)g.Bt + (size_t)cur.e * estep + (size_t)cur.pn * tstep;
    PG8_STAGE(PG8_SB(0, 0), cB, voffB); PG8_STAGE(PG8_SB(0, 1), cB + hstep, voffB); PG8_STAGE(PG8_SA(0, 0), cA, voffA); PG8_STAGE(PG8_SA(0, 1), cA + hstep, voffA);
    if (wr == 1) PG8_BAR;
    PG8_WAIT_V(2); PG8_BAR;
    PG8_STAGE(PG8_SB(1, 0), cB + kstep, voffB); PG8_STAGE(PG8_SA(1, 0), cA + kstep, voffA); PG8_STAGE(PG8_SB(1, 1), cB + hstep + kstep, voffB);
    PG8_WAIT_V(6); PG8_BAR;
    for (;;) {
        const bool has_next = S.next(ui + 1, nxt);
        const char* nA = has_next ? (const char*)g.A + (size_t)nxt.pm * tstep : cA; const char* nB = has_next ? (const char*)g.Bt + (size_t)nxt.e * estep + (size_t)nxt.pn * tstep : cB;
#pragma nounroll
        for (int t = 0; t < nt; t += 2) {
            const bool last = (t == nt - 2);
            const char* a1 = cA + (size_t)(t + 1) * kstep;
            const char* a2 = last ? nA : cA + (size_t)(t + 2) * kstep; const char* b2 = last ? nB : cB + (size_t)(t + 2) * kstep;
            const char* a3 = a2 + kstep; const char* b3 = b2 + kstep;
            PG8_LDB(B0, 0, 0); PG8_LDB(B1, 0, 1); PG8_SCHED; PG8_LDA(At, 0, 0); PG8_STAGE(PG8_SA(1, 1), a1 + hstep, voffA);
            PG8_WAIT_V(8); PG8_WAIT_L(0); PG8_BAR; PG8_MMA(0, 0, At, B0); PG8_MMA(0, 1, At, B1); PG8_BAR; PG8_SCHED;
            PG8_LDA(At, 0, 1); PG8_STAGE(PG8_SB(0, 0), b2, voffB); PG8_STAGE(PG8_SB(0, 1), b2 + hstep, voffB); PG8_STAGE(PG8_SA(0, 0), a2, voffA);
            PG8_WAIT_V(8); PG8_WAIT_L(0); PG8_BAR; PG8_MMA(1, 0, At, B0); PG8_MMA(1, 1, At, B1); PG8_BAR; PG8_SCHED;
            PG8_LDB(B0, 1, 0); PG8_LDB(B1, 1, 1); PG8_SCHED; PG8_LDA(At, 1, 0); PG8_STAGE(PG8_SA(0, 1), a2 + hstep, voffA);
            PG8_WAIT_V(8); PG8_WAIT_L(0); PG8_BAR; PG8_MMA(0, 0, At, B0); PG8_MMA(0, 1, At, B1); PG8_BAR; PG8_SCHED;
            PG8_LDA(At, 1, 1); PG8_STAGE(PG8_SB(1, 0), b3, voffB); PG8_STAGE(PG8_SB(1, 1), b3 + hstep, voffB); PG8_STAGE(PG8_SA(1, 0), a3, voffA);
            PG8_WAIT_V(8); PG8_WAIT_L(0); PG8_BAR; PG8_MMA(1, 0, At, B0); PG8_MMA(1, 1, At, B1); PG8_BAR; PG8_SCHED;
        }
        if (wr == 0) PG8_BAR;
        if constexpr (FP8) {
#pragma unroll
            for (int a = 0; a < 2; ++a)
#pragma unroll
                for (int b = 0; b < 2; ++b)
#pragma unroll
                    for (int m = 0; m < 4; ++m)
#pragma unroll
                        for (int n = 0; n < 2; ++n) acc[a][b][m][n] = PG8_X4(acc16[a][b][n], m);
        }
        { int t2 = threadIdx.x; asm volatile("" : "+v"(t2)); E(acc, cur, wr, wc, t2 & 15, (t2 >> 4) & 3); }
        if (!has_next) break;
#pragma unroll
        for (int a = 0; a < 2; ++a)
#pragma unroll
            for (int b = 0; b < 2; ++b)
#pragma unroll
                for (int m = 0; m < 4; ++m)
#pragma unroll
                    for (int n = 0; n < 2; ++n) acc[a][b][m][n] = (f32x4){0.f, 0.f, 0.f, 0.f};
        if constexpr (FP8) {
#pragma unroll
            for (int a = 0; a < 2; ++a)
#pragma unroll
                for (int b = 0; b < 2; ++b)
#pragma unroll
                    for (int n = 0; n < 2; ++n) acc16[a][b][n] = (f32x16){};
        }
        cur = nxt; cA = nA; cB = nB; ++ui;
        if (wr == 1) PG8_BAR;
    }
    PG8_WAIT_V(0);
    PG8_BAR;
#undef PG8_SA
#undef PG8_SB
#undef PG8_STAGE
#undef PG8_LDA
#undef PG8_LDB
#undef PG8_MMA
#undef PG8_X4
#undef PG8_INS
#undef PG8_CAT2
#undef PG8_LO
#undef PG8_HI
#undef PG8_WAIT_V
#undef PG8_WAIT_L
#undef PG8_BAR
#undef PG8_SCHED
}
}

constexpr int NWAVES = 8;
constexpr int BATCH = 4, SEQ = 8192, D = 1024, T = BATCH * SEQ;
constexpr int INW = 3088, NIN = 3072;
constexpr int NE = 32, TOPK = 4, FF = 1024;
constexpr int PMAX = (T * TOPK / 256 + NE) * 256;
constexpr int NCHUNK = BATCH * 4 * (SEQ / 64);
constexpr float EPS = 1e-6f;
constexpr float LOG2E = 1.4426950408889634f;
constexpr float C2 = 0.125f * LOG2E;
constexpr float WSCALE = 32.f, WSCALE_INV = 1.f / 32.f;

constexpr size_t MiB = 1u << 20;
constexpr size_t WS_CTL = 0, CTL_ZERO_BYTES = 1 * MiB;
constexpr size_t WS_MODP = 1 * MiB;
constexpr size_t WS_MOD = 2 * MiB;
constexpr size_t WS_TOPE = 3 * MiB;
constexpr size_t WS_TOPW = 3 * MiB + 512 * 1024;
constexpr size_t WS_POS = 4 * MiB;
constexpr size_t WS_ROWW = 4 * MiB + 512 * 1024;
constexpr size_t WS_DEC = 6 * MiB;
constexpr size_t WS_WGU = 8 * MiB;
constexpr size_t WS_WD = 136 * MiB;
constexpr size_t WS_XN = 200 * MiB;
constexpr size_t WS_WIN = 264 * MiB;
constexpr size_t WS_WOUT = 270 * MiB;
constexpr size_t WS_GK = 272 * MiB;
constexpr size_t WS_QG = 304 * MiB;
constexpr size_t WS_KG = 320 * MiB;
constexpr size_t WS_VG = 336 * MiB;
constexpr size_t WS_RG = 368 * MiB;
constexpr size_t WS_QD = 400 * MiB;
constexpr size_t WS_KD = 432 * MiB;
constexpr size_t WS_VD = 464 * MiB;
constexpr size_t WS_UT = 496 * MiB;
constexpr size_t WS_SP = 560 * MiB;
constexpr size_t WS_OI = 592 * MiB;
constexpr size_t WS_QE = 656 * MiB;
constexpr size_t WS_A2 = 672 * MiB;
constexpr size_t WS_STASH = 736 * MiB;
constexpr size_t WS_XS = 264 * MiB;
constexpr size_t WS_Y = 400 * MiB;
constexpr size_t WS_CN = 536 * MiB;
constexpr size_t WS_END = 808 * MiB;
static_assert(WS_XS + (size_t)PMAX * 1024 <= WS_Y && WS_Y + (size_t)PMAX * 1024 <= WS_CN && WS_CN + (size_t)PMAX * 1024 * 2 <= WS_END, "ws map");
constexpr int CW_BAR = 4096;
constexpr int CW_CNT = 16384;
constexpr int CW_FILL = 16384 + 64;

constexpr int RING_BYTES = 131072;
constexpr int LDSCTL_OFF = RING_BYTES, MISC_OFF = LDSCTL_OFF + 320;
constexpr int TILEE_OFF = MISC_OFF + 128;
constexpr int HIST_OFF = TILEE_OFF + 1024;
constexpr int LDS_BYTES = 147456;
static_assert(HIST_OFF + 512 <= LDS_BYTES, "LDS map");

#define GAS __attribute__((address_space(1)))
#define LAS __attribute__((address_space(3)))
typedef unsigned short bf16;
typedef unsigned v4u __attribute__((ext_vector_type(4)));
typedef unsigned v2u __attribute__((ext_vector_type(2)));
typedef float f32x4 __attribute__((ext_vector_type(4)));
typedef float f32x16 __attribute__((ext_vector_type(16)));
typedef short bf16x8 __attribute__((ext_vector_type(8)));
typedef short s16x4 __attribute__((ext_vector_type(4)));
typedef GAS unsigned gu32;
#define RLX_AGENT __ATOMIC_RELAXED, __HIP_MEMORY_SCOPE_AGENT
#define LDS_WAIT() asm volatile("s_waitcnt lgkmcnt(0)" ::: "memory")
#define VM_WAIT() asm volatile("s_waitcnt vmcnt(0)" ::: "memory")
__device__ __forceinline__ unsigned f2bf(float f) { unsigned u = __builtin_bit_cast(unsigned, f); return (u + 0x7fffu + ((u >> 16) & 1u)) >> 16; }
__device__ __forceinline__ unsigned pk2(float lo, float hi) { return f2bf(lo) | (f2bf(hi) << 16); }
__device__ __forceinline__ float bf2f(unsigned short h) { return __builtin_bit_cast(float, (unsigned)h << 16); }
__device__ __forceinline__ float bflo(unsigned u) { return __builtin_bit_cast(float, u << 16); }
__device__ __forceinline__ float bfhi(unsigned u) { return __builtin_bit_cast(float, u & 0xffff0000u); }
__device__ __forceinline__ float wave_sum(float v) {
#pragma unroll
    for (int o = 1; o < 64; o <<= 1) v += __shfl_xor(v, o);
    return v;
}
__device__ __forceinline__ float sigmoidf_(float x) { return 1.f / (1.f + __expf(-x)); }
template <int CNT, int S, int N> __device__ __forceinline__ void xreduce_step(float (&v)[N], int lane) {
    if constexpr (CNT > 1) { constexpr int half = CNT / 2; const bool up = (lane & S) != 0;
#pragma unroll
        for (int i = 0; i < half; ++i) { const float send = up ? v[i] : v[i + half], keep = up ? v[i + half] : v[i]; v[i] = keep + __shfl_xor(send, S); }
        xreduce_step<half, S / 2, N>(v, lane); }
}
template <int S> __device__ __forceinline__ float xreduce_tail(float r) { if constexpr (S >= 1) { r += __shfl_xor(r, S); return xreduce_tail<S / 2>(r); } else return r; }
template <int N> __device__ __forceinline__ float xreduce(float (&v)[N], int lane) {
    xreduce_step<N, 32, N>(v, lane);
    return xreduce_tail<(N == 32 ? 1 : N == 16 ? 2 : N == 8 ? 4 : 8)>(v[0]);
}
__device__ __forceinline__ float lane_bcast(float v, int l) { return __builtin_bit_cast(float, __builtin_amdgcn_readlane(__builtin_bit_cast(int, v), l)); }

#define XB_TMO      128
#define XB_XCNT(j)  (256  + 64 * (j))
#define XB_XSUB(j)  (1280 + 64 * (j))
#define XB_XGEN(j)  (2304 + 64 * (j))
#define XB_TOP      3328
#define XB_TOPGEN   3392
#define XCD_BAR_WORDS 3456
#define XB_SPIN_CAP (1u << 18)
__device__ __forceinline__ unsigned xb_ld(unsigned* p)              { return __hip_atomic_load(p, __ATOMIC_RELAXED, __HIP_MEMORY_SCOPE_AGENT); }
__device__ __forceinline__ unsigned xb_add(unsigned* p, unsigned v) { return __hip_atomic_fetch_add(p, v, __ATOMIC_RELAXED, __HIP_MEMORY_SCOPE_AGENT); }
__device__ __forceinline__ unsigned xb_xcc_id() { return (unsigned)__builtin_amdgcn_s_getreg((3 << 11) | 20) & 0xFu; }
#define XB_SPIN(cond, bar) do { unsigned _sp = 0; while (cond) { __builtin_amdgcn_s_sleep(1); \
    if ((++_sp & 255u) == 0u) { if (xb_ld(&(bar)[XB_TMO])) break; if (_sp > XB_SPIN_CAP) { atomicAdd(&(bar)[XB_TMO], 1u); break; } } } } while (0)
struct XcdBarrier { unsigned* bar; unsigned x; volatile LAS unsigned* st; };
__device__ __forceinline__ XcdBarrier xcd_barrier_post(unsigned* bar, volatile LAS unsigned* st) {
    XcdBarrier b; b.bar = bar; b.x = xb_xcc_id(); b.st = st;
    if (threadIdx.x == 0) (void)xb_add(&bar[XB_XCNT(b.x)], 1u);
    return b;
}
__device__ __forceinline__ void xcd_barrier_complete(unsigned* bar, unsigned x, unsigned& nloc, unsigned& nx) {
    const unsigned G = gridDim.x * gridDim.y * gridDim.z;
    unsigned sum, cnt, mine, sp = 0u;
    for (;;) {
        sum = 0u; cnt = 0u; mine = 0u;
#pragma unroll
        for (unsigned j = 0; j < 16; ++j) { const unsigned c = xb_ld(&bar[XB_XCNT(j)]); sum += c; cnt += (c > 0u) ? 1u : 0u; mine = (j == x) ? c : mine; }
        if (sum == G) break;
        __builtin_amdgcn_s_sleep(1);
        if ((++sp & 255u) == 0u) { if (xb_ld(&bar[XB_TMO])) break; if (sp > XB_SPIN_CAP) { atomicAdd(&bar[XB_TMO], 1u); break; } }
    }
    nloc = mine > 0u ? mine : 1u; nx = cnt > 0u ? cnt : 1u;
}
__device__ __forceinline__ void xcd_barrier(const XcdBarrier& b) {
    asm volatile("s_waitcnt vmcnt(0)" ::: "memory");
    __syncthreads();
    if (threadIdx.x == 0) {
        unsigned* bar = b.bar;
        __builtin_amdgcn_s_waitcnt(0);
        unsigned nloc = b.st[0], nx = b.st[1];
        if (nloc == 0u) { xcd_barrier_complete(bar, b.x, nloc, nx); b.st[0] = nloc; b.st[1] = nx; }
        const unsigned old = xb_add(&bar[XB_XSUB(b.x)], 1u);
        const unsigned gen = old / nloc;
        if (old + 1u == (gen + 1u) * nloc) {
            __builtin_amdgcn_fence(__ATOMIC_RELEASE, "agent");
            asm volatile("s_waitcnt vmcnt(0)" ::: "memory");
            const unsigned og = xb_add(&bar[XB_TOP], 1u);
            const unsigned tg = og / nx;
            if (og + 1u == (tg + 1u) * nx) xb_add(&bar[XB_TOPGEN], 1u);
            else XB_SPIN(xb_ld(&bar[XB_TOPGEN]) == tg, bar);
            __builtin_amdgcn_fence(__ATOMIC_ACQUIRE, "agent");
            xb_add(&bar[XB_XGEN(b.x)], 1u);
            asm volatile("s_waitcnt vmcnt(0)" ::: "memory");
        } else {
            XB_SPIN(xb_ld(&bar[XB_XGEN(b.x)]) == gen, bar);
            __builtin_amdgcn_fence(__ATOMIC_ACQUIRE, "agent");
            asm volatile("s_waitcnt vmcnt(0)" ::: "memory");
        }
    }
    __syncthreads();
}

struct Frame {
    LAS unsigned char* lds;
    volatile LAS unsigned* MISC;
    gu32* ctl;
    int tid, lane, wave;
    int vcu, G;
    unsigned char* ws;
    const float *x, *c, *rel_bias, *w_ada, *b_ada, *g_norm1, *w_in, *w_gk_up, *b_gk_up, *g_gla_out, *g_qnorm, *g_knorm, *lq1, *lk1, *lq2, *lk2, *g_subln, *w_out,
                *g_norm2, *w_router, *b_router, *w_gate_up, *b_gate_up, *w_down, *b_down;
    float* out;
};
template <class Tp> __device__ __forceinline__ Tp* wsp(const Frame& F, size_t off) { return (Tp*)(F.ws + off); }

__device__ __forceinline__ void tr_item(const float* W, int ldw, int k0, int src0, bf16* WT, int K, int drow0, LAS float* scr, int lane) {
#pragma unroll 8
    for (int i = 0; i < 32; ++i) { const int kk = 2 * i + (lane >> 5); scr[kk * 33 + (lane & 31)] = W[(size_t)(k0 + kk) * ldw + src0 + (lane & 31)]; }
    LDS_WAIT(); asm volatile("" ::: "memory");
    const int c = lane & 7;
#pragma unroll
    for (int j = 0; j < 4; ++j) { const int n = (lane >> 3) + 8 * j; const LAS float* s = scr + (8 * c) * 33 + n;
        v4u o; o.x = pk2(s[0 * 33], s[1 * 33]); o.y = pk2(s[2 * 33], s[3 * 33]); o.z = pk2(s[4 * 33], s[5 * 33]); o.w = pk2(s[6 * 33], s[7 * 33]);
        *(GAS v4u*)(WT + (size_t)(drow0 + n) * K + k0 + 8 * c) = o; }
    LDS_WAIT(); asm volatile("" ::: "memory");
}
__device__ __forceinline__ unsigned pk4_fp8(float a, float b, float c, float d) { int p = __builtin_amdgcn_cvt_pk_fp8_f32(a, b, 0, false); p = __builtin_amdgcn_cvt_pk_fp8_f32(c, d, p, true); return (unsigned)p; }
__device__ __forceinline__ void tr_item_fp8(const float* W, int ldw, int k0, int src0, unsigned char* WT, int K, int drow0, float sc, LAS float* scr, int lane) {
    { float tmp[32]; const float* wp = W + (size_t)(k0 + (lane >> 5)) * ldw + src0 + (lane & 31);
#pragma unroll
      for (int i = 0; i < 32; ++i) tmp[i] = __builtin_nontemporal_load(wp + (size_t)(2 * i) * ldw);
#pragma unroll
      for (int i = 0; i < 32; ++i) scr[(2 * i + (lane >> 5)) * 33 + (lane & 31)] = tmp[i] * sc; }
    LDS_WAIT(); asm volatile("" ::: "memory");
    const int c = lane & 3;
#pragma unroll
    for (int j = 0; j < 2; ++j) { const int n = (lane >> 2) + 16 * j; const LAS float* s = scr + (16 * c) * 33 + n;
        v4u o;
#pragma unroll
        for (int q = 0; q < 4; ++q) o[q] = pk4_fp8(s[(4 * q) * 33], s[(4 * q + 1) * 33], s[(4 * q + 2) * 33], s[(4 * q + 3) * 33]);
        *(GAS v4u*)(WT + (size_t)(drow0 + n) * K + k0 + 16 * c) = o; }
    LDS_WAIT(); asm volatile("" ::: "memory");
}
__device__ __forceinline__ int win_src0(int ng) {
    const int pn = ng >> 3, gi = ng & 7, bj = gi >> 2, wc = gi & 3;
    if (pn < 6) return pn * 256 + gi * 32;
    if (pn < 10) { const int base = (pn < 8) ? 1552 : 2064; const int gq = 4 * ((pn - 6) & 1) + wc; return base + 64 * gq + 32 * bj; }
    return 2576 + (pn - 10) * 256 + gi * 32;
}
__device__ __forceinline__ void p0_phase(Frame& F) {
    LAS float* scr = (LAS float*)(F.lds + F.wave * 16384);
    const int gw = F.vcu * NWAVES + F.wave, NGW = F.G * NWAVES, lane = F.lane;
    for (int it = gw; it < 768; it += NGW) {
        const int cg = it % 96, ks = it / 96, j = cg * 64 + lane;
#pragma unroll
        for (int q = 0; q < 8; ++q) { const int idx = q * 64 + lane, b = idx >> 7, kk = idx & 127; const float cv = F.c[b * 1024 + ks * 128 + kk]; scr[idx] = cv * sigmoidf_(cv); }
        LDS_WAIT(); asm volatile("" ::: "memory");
        float a0 = 0.f, a1 = 0.f, a2 = 0.f, a3 = 0.f;
        const float* wp = F.w_ada + (size_t)(ks * 128) * 6144 + j;
#pragma unroll 16
        for (int kk = 0; kk < 128; ++kk) { const float w = wp[(size_t)kk * 6144]; a0 += scr[kk] * w; a1 += scr[128 + kk] * w; a2 += scr[256 + kk] * w; a3 += scr[384 + kk] * w; }
        float* mp = wsp<float>(F, WS_MODP) + (size_t)(ks * 4) * 6144 + j;
        mp[0] = a0; mp[6144] = a1; mp[2 * 6144] = a2; mp[3 * 6144] = a3;
        LDS_WAIT(); asm volatile("" ::: "memory");
    }
    constexpr int I_IN = 96 * 16, I_OUT = 32 * 16, I_GU = 32 * 64 * 16, I_D = 32 * 32 * 16;
    constexpr int NITEMS = I_IN + I_OUT + I_GU + I_D;
    for (int it = gw; it < NITEMS; it += NGW) {
        int r = it;
        if (r < I_IN) { const int kb = r / 96, ng = r % 96; tr_item(F.w_in, INW, kb * 64, win_src0(ng), wsp<bf16>(F, WS_WIN), 1024, ng * 32, scr, lane); continue; } r -= I_IN;
        if (r < I_OUT) { const int kb = r / 32, ng = r % 32; tr_item(F.w_out, 1024, kb * 64, ng * 32, wsp<bf16>(F, WS_WOUT), 1024, ng * 32, scr, lane); continue; } r -= I_OUT;
        if (r < I_GU) { const int e = r / 1024, q = r % 1024, kb = q / 64, dg = q % 64, pn = dg >> 3, gi = dg & 7, bj = gi >> 2, j32 = gi & 3;
            tr_item_fp8(F.w_gate_up + (size_t)e * 1024 * 2048, 2048, kb * 64, bj * 1024 + pn * 128 + j32 * 32, wsp<unsigned char>(F, WS_WGU) + (size_t)e * 2048 * 1024, 1024, dg * 32, WSCALE, scr, lane); continue; } r -= I_GU;
        { const int e = r / 512, q = r % 512, kb = q / 32, ng = q % 32;
            tr_item_fp8(F.w_down + (size_t)e * 1024 * 1024, 1024, kb * 64, ng * 32, wsp<unsigned char>(F, WS_WD) + (size_t)e * 1024 * 1024, 1024, ng * 32, WSCALE, scr, lane); }
    }
}

__device__ __forceinline__ f32x4 mod_from_partials(const Frame& F, int b, int col) {
    const float* mp = wsp<const float>(F, WS_MODP) + (size_t)b * 6144 + col;
    f32x4 s = *(const f32x4*)(F.b_ada + col);
#pragma unroll
    for (int ks = 0; ks < 8; ++ks) s += *(const f32x4*)(mp + (size_t)ks * 4 * 6144);
    return s;
}
__device__ __forceinline__ void p1_phase(Frame& F) {
    const int tid = F.tid, lane = F.lane;
    LAS float* wlo = (LAS float*)(F.lds);
    LAS float* wup = (LAS float*)(F.lds + 65536);
    LAS float* bup = (LAS float*)(F.lds + 65536 + 16384);
    for (int idx = tid; idx < 16384; idx += 512) { const int k = idx >> 4, r = idx & 15; wlo[r * 1024 + k] = F.w_in[(size_t)k * INW + 1536 + r]; }
    for (int idx = tid; idx < 4096; idx += 512) wup[idx] = F.w_gk_up[idx];
    if (tid < 256) bup[tid] = F.b_gk_up[tid];
    { const int gt = F.vcu * 512 + tid; if (gt < 4 * 6144 / 4) { const int i = gt * 4, b = i / 6144, col = i % 6144; *(f32x4*)(wsp<float>(F, WS_MOD) + i) = mod_from_partials(F, b, col); } }
    __syncthreads();
    const int gw = F.vcu * NWAVES + F.wave, NGW = F.G * NWAVES;
    const int rpw = (T + NGW - 1) / NGW;
    int curb = -1; f32x4 gsc[4], shv[4], nx[4];
    { const int m0 = (gw * rpw < T) ? gw * rpw : 0; const GAS f32x4* xr = (const GAS f32x4*)(F.x + (size_t)m0 * D) + lane;
#pragma unroll
      for (int j = 0; j < 4; ++j) nx[j] = xr[64 * j]; }
#pragma nounroll
    for (int i = 0; i < rpw; ++i) {
        const int m = gw * rpw + i; if (m >= T) break;
        const int b = m / SEQ;
        if (b != curb) { curb = b;
#pragma unroll
            for (int j = 0; j < 4; ++j) { const int col = 256 * j + 4 * lane; const f32x4 g = *(const f32x4*)(F.g_norm1 + col);
                shv[j] = mod_from_partials(F, b, col); gsc[j] = g * (mod_from_partials(F, b, 1024 + col) + 1.0f); } }
        f32x4 v[4]; float s = 0.f;
#pragma unroll
        for (int j = 0; j < 4; ++j) { v[j] = nx[j]; s += (v[j].x * v[j].x + v[j].y * v[j].y) + (v[j].z * v[j].z + v[j].w * v[j].w); }
        { const int m2 = (m + 1 < T) ? m + 1 : m; const GAS f32x4* xr = (const GAS f32x4*)(F.x + (size_t)m2 * D) + lane;
#pragma unroll
          for (int j = 0; j < 4; ++j) nx[j] = xr[64 * j]; }
        const float rstd = rsqrtf(wave_sum(s) * (1.f / D) + EPS);
        GAS v2u* o8 = (GAS v2u*)(wsp<bf16>(F, WS_XN) + (size_t)m * D) + lane;
#pragma unroll
        for (int j = 0; j < 4; ++j) { v[j] = v[j] * rstd * gsc[j] + shv[j]; v2u o; o.x = pk2(v[j].x, v[j].y); o.y = pk2(v[j].z, v[j].w); o8[64 * j] = o; }
        float part[16];
#pragma unroll
        for (int r = 0; r < 16; ++r) { float a = 0.f;
#pragma unroll
            for (int j = 0; j < 4; ++j) { const f32x4 w = *(const LAS f32x4*)(wlo + r * 1024 + 256 * j + 4 * lane); a += (v[j].x * w.x + v[j].y * w.y) + (v[j].z * w.z + v[j].w * w.w); }
            part[r] = a; if ((r & 3) == 3) asm volatile("" ::: "memory"); }
        const float tot = xreduce<16>(part, lane);
        f32x4 z = *(const LAS f32x4*)(bup + 4 * lane);
#pragma unroll
        for (int r = 0; r < 16; ++r) z += *(const LAS f32x4*)(wup + r * 256 + 4 * lane) * lane_bcast(tot, 4 * r);
        f32x4 gk;
#pragma unroll
        for (int q = 0; q < 4; ++q) { const float zz = z[q]; gk[q] = (fminf(zz, 0.f) - log1pf(__expf(-fabsf(zz)))) * (1.f / 16.f); }
        *(GAS f32x4*)(wsp<float>(F, WS_GK) + (size_t)m * 256 + 4 * lane) = gk;
    }
}

using pg8::Unit;
typedef pg8::f32x4 af4;
struct EpiInProj {
    static constexpr bool PERM = true;
    bf16 *QG, *KG, *VG, *RG, *QD, *KD, *VD; const float *gq, *gk;
    __device__ __forceinline__ void operator()(const af4 (&acc)[2][2][4][2], const Unit& u, int wr, int wc, int fr, int fq) const {
        const int pn = u.pn; const int row0 = u.pm * 256 + wr * 64 + fr;
        if (pn >= 6 && pn < 10) {
            const bool isq = pn < 8; bf16* base = isq ? QD : KD; const float* g = isq ? gq : gk; const float sc = isq ? C2 : 1.f;
            const int grp = 4 * ((pn - 6) & 1) + wc;
            af4 gv[2][2];
#pragma unroll
            for (int bj = 0; bj < 2; ++bj)
#pragma unroll
                for (int n = 0; n < 2; ++n) gv[bj][n] = *(const af4*)(g + 32 * bj + 8 * fq + 4 * n) * sc;
#pragma unroll
            for (int ai = 0; ai < 2; ++ai)
#pragma unroll
                for (int m = 0; m < 4; ++m) {
                    float ss = 0.f;
#pragma unroll
                    for (int bj = 0; bj < 2; ++bj)
#pragma unroll
                        for (int n = 0; n < 2; ++n) { const af4 v = acc[ai][bj][m][n]; ss += (v[0] * v[0] + v[1] * v[1]) + (v[2] * v[2] + v[3] * v[3]); }
                    ss += __shfl_xor(ss, 16); ss += __shfl_xor(ss, 32);
                    const float rs = rsqrtf(ss * (1.f / 64.f) + EPS);
                    bf16* rowp = base + (size_t)(row0 + ai * 128 + m * 16) * 512 + grp * 64 + 8 * fq;
#pragma unroll
                    for (int bj = 0; bj < 2; ++bj) { const af4 v0 = acc[ai][bj][m][0] * rs * gv[bj][0], v1 = acc[ai][bj][m][1] * rs * gv[bj][1];
                        pg8::u32x4 w; w.x = pg8::cvt_pk_bf16(v0[0], v0[1]); w.y = pg8::cvt_pk_bf16(v0[2], v0[3]); w.z = pg8::cvt_pk_bf16(v1[0], v1[1]); w.w = pg8::cvt_pk_bf16(v1[2], v1[3]);
                        *(pg8::u32x4*)(rowp + 32 * bj) = w; }
                }
        } else {
            bf16* base; int pitch, colt; int act = 0;
            if (pn == 0) { base = QG; pitch = 256; colt = 0; act = 1; }
            else if (pn == 1) { base = KG; pitch = 256; colt = 0; }
            else if (pn < 4) { base = VG; pitch = 512; colt = (pn - 2) * 256; }
            else if (pn < 6) { base = RG; pitch = 512; colt = (pn - 4) * 256; act = 2; }
            else { base = VD; pitch = 512; colt = (pn - 10) * 256; }
            const int col0 = colt + wc * 32 + 8 * fq;
#pragma unroll
            for (int ai = 0; ai < 2; ++ai)
#pragma unroll
                for (int m = 0; m < 4; ++m) { bf16* rowp = base + (size_t)(row0 + ai * 128 + m * 16) * pitch + col0;
#pragma unroll
                    for (int bj = 0; bj < 2; ++bj) { af4 v0 = acc[ai][bj][m][0], v1 = acc[ai][bj][m][1];
                        if (act == 1) { v0 = v0 * 0.125f; v1 = v1 * 0.125f; }
                        if (act == 2) {
#pragma unroll
                            for (int q = 0; q < 4; ++q) { v0[q] = v0[q] * sigmoidf_(v0[q]); v1[q] = v1[q] * sigmoidf_(v1[q]); } }
                        pg8::u32x4 w; w.x = pg8::cvt_pk_bf16(v0[0], v0[1]); w.y = pg8::cvt_pk_bf16(v0[2], v0[3]); w.z = pg8::cvt_pk_bf16(v1[0], v1[1]); w.w = pg8::cvt_pk_bf16(v1[2], v1[3]);
                        *(pg8::u32x4*)(rowp + bj * 128) = w; } }
        }
    }
};
struct EpiOutProj {
    static constexpr bool PERM = false;
    const float* x; float* out; const float* mod;
    __device__ __forceinline__ void operator()(const af4 (&acc)[2][2][4][2], const Unit& u, int wr, int wc, int fr, int fq) const {
        const int b = (u.pm * 256) / SEQ; const int col0 = u.pn * 256 + wc * 32 + 4 * fq;
        af4 gt[2][2];
#pragma unroll
        for (int bj = 0; bj < 2; ++bj)
#pragma unroll
            for (int n = 0; n < 2; ++n) gt[bj][n] = *(const af4*)(mod + (size_t)b * 6144 + 2048 + col0 + bj * 128 + n * 16);
#pragma unroll
        for (int ai = 0; ai < 2; ++ai)
#pragma unroll
            for (int m = 0; m < 4; ++m) { const size_t off = (size_t)(u.pm * 256 + ai * 128 + wr * 64 + m * 16 + fr) * D + col0;
#pragma unroll
                for (int bj = 0; bj < 2; ++bj)
#pragma unroll
                    for (int n = 0; n < 2; ++n) { const af4 xv = *(const af4*)(x + off + bj * 128 + n * 16); *(af4*)(out + off + bj * 128 + n * 16) = xv + gt[bj][n] * acc[ai][bj][m][n]; }
                if (m & 1) asm volatile("" ::: "memory"); }
    }
};
struct EpiSwiGLU {
    static constexpr bool PERM = false;
    unsigned char* Y; const float* bgu;
    __device__ __forceinline__ void operator()(const af4 (&acc)[2][2][4][2], const Unit& u, int wr, int wc, int fr, int fq) const {
        const int f0 = u.pn * 128 + wc * 32 + 4 * fq; const float* bb = bgu + (size_t)u.e * 2048 + f0;
        af4 bg[2], bu[2];
#pragma unroll
        for (int n = 0; n < 2; ++n) { bg[n] = *(const af4*)(bb + 16 * n); bu[n] = *(const af4*)(bb + 1024 + 16 * n); }
#pragma unroll
        for (int ai = 0; ai < 2; ++ai)
#pragma unroll
            for (int m = 0; m < 4; ++m) { unsigned char* rowp = Y + (size_t)(u.pm * 256 + ai * 128 + wr * 64 + m * 16 + fr) * FF + f0;
#pragma unroll
                for (int n = 0; n < 2; ++n) { const af4 g = acc[ai][0][m][n] * WSCALE_INV + bg[n], up = acc[ai][1][m][n] * WSCALE_INV + bu[n]; af4 y;
#pragma unroll
                    for (int q = 0; q < 4; ++q) { const float gg = fminf(g[q], 7.f), uu = fminf(fmaxf(up[q], -7.f), 7.f); y[q] = (uu + 1.f) * gg * sigmoidf_(1.702f * gg); }
                    *(unsigned*)(rowp + 16 * n) = pk4_fp8(y[0], y[1], y[2], y[3]); } }
    }
};
struct EpiDown {
    static constexpr bool PERM = false;
    bf16* Cn; const float* bd; const float* roww;
    __device__ __forceinline__ void operator()(const af4 (&acc)[2][2][4][2], const Unit& u, int wr, int wc, int fr, int fq) const {
        const int col0 = u.pn * 256 + wc * 32 + 4 * fq; const float* bb = bd + (size_t)u.e * 1024 + col0;
        af4 bv[2][2];
#pragma unroll
        for (int bj = 0; bj < 2; ++bj)
#pragma unroll
            for (int n = 0; n < 2; ++n) bv[bj][n] = *(const af4*)(bb + bj * 128 + 16 * n);
#pragma unroll
        for (int ai = 0; ai < 2; ++ai)
#pragma unroll
            for (int m = 0; m < 4; ++m) { const int row = u.pm * 256 + ai * 128 + wr * 64 + m * 16 + fr; bf16* rowp = Cn + (size_t)row * 1024 + col0;
#pragma unroll
                for (int bj = 0; bj < 2; ++bj)
#pragma unroll
                    for (int n = 0; n < 2; ++n) { const af4 v = acc[ai][bj][m][n] * WSCALE_INV + bv[bj][n];
                        v2u w; w.x = pg8::cvt_pk_bf16(v[0], v[1]); w.y = pg8::cvt_pk_bf16(v[2], v[3]); *(v2u*)(rowp + bj * 128 + 16 * n) = w; } }
    }
};

typedef float cf4 __attribute__((ext_vector_type(4)));
#define MFMA16(a, b, c) __builtin_amdgcn_mfma_f32_16x16x32_bf16((a), (b), (c), 0, 0, 0)
constexpr int GP = 72;
__device__ __forceinline__ void gla_a_unit(Frame& F, int chunk) {
    const int tid = F.tid, lane = F.lane, w = F.wave;
    const int bh = chunk >> 7, n = chunk & 127, b = bh >> 2, h = bh & 3;
    const size_t R0 = (size_t)b * SEQ + (size_t)n * 64;
    LAS float* gc = (LAS float*)F.lds;
    LAS float* segt = (LAS float*)(F.lds + 16384);
    LAS bf16* QEs = (LAS bf16*)(F.lds + 18432);
    LAS bf16* KEs = (LAS bf16*)(F.lds + 18432 + 9216);
    LAS bf16* KST = (LAS bf16*)(F.lds + 18432 + 2 * 9216);
    LAS bf16* VT = (LAS bf16*)(F.lds + 18432 + 3 * 9216);
    LAS bf16* AM = (LAS bf16*)(F.lds + 18432 + 3 * 9216 + 18432);
    const float* GK = wsp<const float>(F, WS_GK);
    { const int r = tid >> 3, d0 = (tid & 7) * 8; const float* gp = GK + (R0 + r) * 256 + h * 64 + d0;
      *(LAS f32x4*)(gc + r * 64 + d0) = *(const f32x4*)gp; *(LAS f32x4*)(gc + r * 64 + d0 + 4) = *(const f32x4*)(gp + 4); }
    __syncthreads();
    { const int seg = tid >> 6, d = tid & 63; float run = 0.f;
#pragma unroll
      for (int i = 0; i < 8; ++i) { run += gc[(seg * 8 + i) * 64 + d]; gc[(seg * 8 + i) * 64 + d] = run; }
      segt[seg * 64 + d] = run; }
    __syncthreads();
    { const int seg = tid >> 6, d = tid & 63; float off = 0.f;
      for (int s2 = 0; s2 < seg; ++s2) off += segt[s2 * 64 + d];
#pragma unroll
      for (int i = 0; i < 8; ++i) gc[(seg * 8 + i) * 64 + d] += off; }
    __syncthreads();
    { const int r = tid >> 3, d0 = (tid & 7) * 8;
      const v4u qv = *(const v4u*)(wsp<const bf16>(F, WS_QG) + (R0 + r) * 256 + h * 64 + d0);
      const v4u kv = *(const v4u*)(wsp<const bf16>(F, WS_KG) + (R0 + r) * 256 + h * 64 + d0);
      float qf[8], kf[8];
#pragma unroll
      for (int i = 0; i < 4; ++i) { qf[2 * i] = bflo(qv[i]); qf[2 * i + 1] = bfhi(qv[i]); kf[2 * i] = bflo(kv[i]); kf[2 * i + 1] = bfhi(kv[i]); }
      float qe[8], ke[8];
#pragma unroll
      for (int i = 0; i < 8; ++i) { const float g = gc[r * 64 + d0 + i], gl = gc[63 * 64 + d0 + i];
          qe[i] = qf[i] * __expf(g); ke[i] = kf[i] * __expf(-g); KST[(d0 + i) * GP + r] = (bf16)f2bf(kf[i] * __expf(gl - g)); }
      v4u qo, ko;
#pragma unroll
      for (int i = 0; i < 4; ++i) { qo[i] = pk2(qe[2 * i], qe[2 * i + 1]); ko[i] = pk2(ke[2 * i], ke[2 * i + 1]); }
      *(LAS v4u*)(QEs + r * GP + d0) = qo; *(LAS v4u*)(KEs + r * GP + d0) = ko;
      *(v4u*)(wsp<bf16>(F, WS_QE) + (R0 + r) * 256 + h * 64 + d0) = qo;
      const int e0 = (tid & 7) * 16;
      const v4u va = *(const v4u*)(wsp<const bf16>(F, WS_VG) + (R0 + r) * 512 + h * 128 + e0);
      const v4u vb = *(const v4u*)(wsp<const bf16>(F, WS_VG) + (R0 + r) * 512 + h * 128 + e0 + 8);
#pragma unroll
      for (int i = 0; i < 4; ++i) { VT[(e0 + 2 * i) * GP + r] = (bf16)(va[i] & 0xffffu); VT[(e0 + 2 * i + 1) * GP + r] = (bf16)(va[i] >> 16);
                                    VT[(e0 + 8 + 2 * i) * GP + r] = (bf16)(vb[i] & 0xffffu); VT[(e0 + 8 + 2 * i + 1) * GP + r] = (bf16)(vb[i] >> 16); }
      if (tid < 64) wsp<float>(F, WS_DEC)[(size_t)chunk * 64 + tid] = __expf(gc[63 * 64 + tid]);
    }
    __syncthreads();
    const int l15 = lane & 15, l4 = lane >> 4;
#pragma unroll
    for (int q = 0; q < 2; ++q) { const int tile = 2 * w + q, ti = tile >> 2, tj = tile & 3;
        cf4 a = {0.f, 0.f, 0.f, 0.f};
        if (tj <= ti) {
#pragma unroll
            for (int kk = 0; kk < 2; ++kk) { const bf16x8 fa = *(const LAS bf16x8*)(QEs + (16 * ti + l15) * GP + kk * 32 + 8 * l4); const bf16x8 fb = *(const LAS bf16x8*)(KEs + (16 * tj + l15) * GP + kk * 32 + 8 * l4); a = MFMA16(fa, fb, a); } }
#pragma unroll
        for (int r = 0; r < 4; ++r) { const int cr = 16 * ti + 4 * l4 + r, cj = 16 * tj + l15; AM[cr * GP + cj] = (bf16)f2bf(cj <= cr ? a[r] : 0.f); } }
    { float* UT = wsp<float>(F, WS_UT) + (size_t)chunk * 8192;
#pragma unroll
      for (int td = 0; td < 4; ++td) { cf4 a = {0.f, 0.f, 0.f, 0.f};
#pragma unroll
          for (int kk = 0; kk < 2; ++kk) { const bf16x8 fa = *(const LAS bf16x8*)(VT + (16 * w + l15) * GP + kk * 32 + 8 * l4); const bf16x8 fb = *(const LAS bf16x8*)(KST + (16 * td + l15) * GP + kk * 32 + 8 * l4); a = MFMA16(fa, fb, a); }
#pragma unroll
          for (int r = 0; r < 4; ++r) UT[(16 * w + 4 * l4 + r) * 64 + 16 * td + l15] = a[r]; } }
    __syncthreads();
    { float* OI = wsp<float>(F, WS_OI);
#pragma unroll
      for (int tc = 0; tc < 4; ++tc) { cf4 a = {0.f, 0.f, 0.f, 0.f};
#pragma unroll
          for (int kk = 0; kk < 2; ++kk) { const bf16x8 fa = *(const LAS bf16x8*)(AM + (16 * tc + l15) * GP + kk * 32 + 8 * l4); const bf16x8 fb = *(const LAS bf16x8*)(VT + (16 * w + l15) * GP + kk * 32 + 8 * l4); a = MFMA16(fa, fb, a); }
#pragma unroll
          for (int r = 0; r < 4; ++r) OI[(R0 + 16 * tc + 4 * l4 + r) * 512 + h * 128 + 16 * w + l15] = a[r]; } }
    __syncthreads();
}
__device__ __forceinline__ void gla_b_phase(Frame& F) {
    const float* UT = wsp<const float>(F, WS_UT); const float* DEC = wsp<const float>(F, WS_DEC); bf16* SP = wsp<bf16>(F, WS_SP);
    for (int gt = F.vcu * 512 + F.tid; gt < 16 * 8192; gt += F.G * 512) {
        const int bh = gt >> 13, ed = gt & 8191, d = gt & 63; float S = 0.f;
#pragma unroll 8
        for (int n = 0; n < 128; ++n) { const size_t ch = (size_t)bh * 128 + n; const float u = UT[ch * 8192 + ed], dc = DEC[ch * 64 + d]; SP[ch * 8192 + ed] = (bf16)f2bf(S); S = S * dc + u; }
    }
}
__device__ __forceinline__ void gla_c_unit(Frame& F, int unit) {
    const int tid = F.tid, lane = F.lane, w = F.wave;
    const int bh = unit >> 6, n2 = unit & 63, b = bh >> 2, h = bh & 3;
    const size_t R0 = (size_t)b * SEQ + (size_t)n2 * 128;
    LAS bf16* QEs = (LAS bf16*)F.lds;
    LAS bf16* SPs = (LAS bf16*)(F.lds + 18432);
    { const int r = tid >> 2, d0 = (tid & 3) * 16; const bf16* src = wsp<const bf16>(F, WS_QE) + (R0 + r) * 256 + h * 64 + d0;
      *(LAS v4u*)(QEs + r * GP + d0) = *(const v4u*)src; *(LAS v4u*)(QEs + r * GP + d0 + 8) = *(const v4u*)(src + 8);
      const bf16* sp = wsp<const bf16>(F, WS_SP) + ((size_t)bh * 128 + 2 * n2) * 8192;
      const int row = tid >> 1, dd = (tid & 1) * 32;
#pragma unroll
      for (int i = 0; i < 4; ++i) *(LAS v4u*)(SPs + row * GP + dd + 8 * i) = *(const v4u*)(sp + (size_t)row * 64 + dd + 8 * i); }
    __syncthreads();
    const int l15 = lane & 15, l4 = lane >> 4, c2 = w >> 2, tc = w & 3;
    cf4 a[8];
#pragma unroll
    for (int te = 0; te < 8; ++te) { a[te] = (cf4){0.f, 0.f, 0.f, 0.f};
#pragma unroll
        for (int kk = 0; kk < 2; ++kk) { const bf16x8 fa = *(const LAS bf16x8*)(QEs + (64 * c2 + 16 * tc + l15) * GP + kk * 32 + 8 * l4); const bf16x8 fb = *(const LAS bf16x8*)(SPs + (128 * c2 + 16 * te + l15) * GP + kk * 32 + 8 * l4); a[te] = MFMA16(fa, fb, a[te]); } }
    const float* OI = wsp<const float>(F, WS_OI); const bf16* RG = wsp<const bf16>(F, WS_RG); bf16* A2 = wsp<bf16>(F, WS_A2);
    float gg[8];
#pragma unroll
    for (int te = 0; te < 8; ++te) gg[te] = F.g_gla_out[16 * te + l15];
#pragma unroll
    for (int r = 0; r < 4; ++r) { const size_t row = R0 + 64 * c2 + 16 * tc + 4 * l4 + r; float ss = 0.f; float o[8];
#pragma unroll
        for (int te = 0; te < 8; ++te) { o[te] = a[te][r] + OI[row * 512 + h * 128 + 16 * te + l15]; ss += o[te] * o[te]; }
        ss += __shfl_xor(ss, 1); ss += __shfl_xor(ss, 2); ss += __shfl_xor(ss, 4); ss += __shfl_xor(ss, 8);
        const float rs = rsqrtf(ss * (1.f / 128.f) + EPS);
#pragma unroll
        for (int te = 0; te < 8; ++te) { const int e = 16 * te + l15; A2[row * 1024 + h * 128 + e] = (bf16)f2bf(o[te] * rs * gg[te] * bf2f(RG[row * 512 + h * 128 + e])); } }
    __syncthreads();
}

namespace att {
constexpr int KSLOT = 8192, VSLOT = 16384, NSLOT = 3;
constexpr int LDS_K = 0, LDS_V = NSLOT * KSLOT, LDS_TBL = LDS_V + NSLOT * VSLOT, LDS_WS = LDS_TBL + 1024, LDS_Q = LDS_WS + 8 * 256, LDS_END = LDS_Q + 8 * 4096;
static_assert(LDS_END <= RING_BYTES, "attention LDS");
__device__ __forceinline__ int crow(int r, int hi) { return (r & 3) + 8 * (r >> 2) + 4 * hi; }
__device__ __forceinline__ void glds16(const void* gsrc, unsigned lds_dst) { unsigned keep;
    asm volatile("s_mov_b32 %0, m0\n\ts_mov_b32 m0, %2\n\ts_nop 0\n\tglobal_load_lds_dwordx4 %1, off\n\ts_mov_b32 m0, %0" : "=&s"(keep) : "v"(gsrc), "s"(lds_dst) : "memory"); }
typedef float f32x2_t __attribute__((ext_vector_type(2))); typedef __bf16 bf16x2_t __attribute__((ext_vector_type(2)));
__device__ __forceinline__ unsigned cvtpk_s(float lo, float hi) { f32x2_t v = {lo, hi}; bf16x2_t b = __builtin_convertvector(v, bf16x2_t); return __builtin_bit_cast(unsigned, b); }
typedef short v4i16_t __attribute__((ext_vector_type(4)));
typedef LAS const char* lds_cptr;
__device__ __forceinline__ s16x4 vtr(lds_cptr p) { return __builtin_bit_cast(s16x4, __builtin_amdgcn_ds_read_tr16_b64_v4i16((LAS v4i16_t*)p)); }
#define MFMA32(a, b, c) __builtin_amdgcn_mfma_f32_32x32x16_bf16((a), (b), (c), 0, 0, 0)
#define ATT_WAIT_BAR(N) asm volatile("s_waitcnt vmcnt(" #N ") lgkmcnt(0)\n\ts_barrier" ::: "memory")

__device__ __forceinline__ void attn_map(f32x16 (&o)[4], int b, int h, int m, int qb, const bf16* QD, const bf16* KD, const bf16* VD, LAS unsigned char* shm) {
    int lane = threadIdx.x & 63; asm volatile("" : "+v"(lane));
    const int tid = threadIdx.x, r32 = lane & 31, hi = lane >> 5; const int wid = __builtin_amdgcn_readfirstlane(tid >> 6);
    const size_t rowbase = (size_t)b * SEQ; const int q0 = qb * 256;
    const bf16* Qw = QD + (rowbase + q0 + wid * 32) * 512 + (h * 2 + m) * 64;
    const bf16* Kh = KD + rowbase * 512 + (h * 2 + m) * 64; const bf16* Vh = VD + rowbase * 512 + h * 128;
    const unsigned lds0 = (unsigned)(uintptr_t)shm;
    const LAS float* tbl = (const LAS float*)(shm + LDS_TBL) + m * 128;
    LAS float* wsf = (LAS float*)(shm + LDS_WS) + wid * 64;
    const bf16* ksrc = Kh + (size_t)lane * 512 + wid * 8;
    const bf16* vsrc = Vh + (size_t)(16 * (wid & 3) + (lane >> 2)) * 512 + (wid >> 2) * 32 + (lane & 3) * 8;
    const unsigned kdst = lds0 + LDS_K + wid * 1024, vdst = lds0 + LDS_V + wid * 1024;
#define DMA_K(t, slot) glds16(ksrc + (size_t)(t) * 64 * 512, (unsigned)__builtin_amdgcn_readfirstlane(kdst + (slot) * KSLOT))
#define DMA_V(t, slot) do { glds16(vsrc + (size_t)(t) * 64 * 512, (unsigned)__builtin_amdgcn_readfirstlane(vdst + (slot) * VSLOT)); \
        glds16(vsrc + (size_t)(t) * 64 * 512 + 64, (unsigned)__builtin_amdgcn_readfirstlane(vdst + (slot) * VSLOT + 8192)); } while (0)
    const int NT = 4 * qb + 4;
    VM_WAIT();
    DMA_K(0, 0); DMA_V(0, 0); DMA_K(1, 1); DMA_K(2, 2);
    const lds_cptr qlds = (lds_cptr)shm + LDS_Q + wid * 4096 + lane * 16;
    { bf16x8 qr[4];
#pragma unroll
      for (int d0 = 0; d0 < 4; ++d0) qr[d0] = *(const bf16x8*)(Qw + (size_t)r32 * 512 + d0 * 16 + hi * 8);
      asm volatile("s_waitcnt vmcnt(0)" : "+v"(qr[0]), "+v"(qr[1]), "+v"(qr[2]), "+v"(qr[3]) :: "memory");
#pragma unroll
      for (int d0 = 0; d0 < 4; ++d0) *(LAS bf16x8*)(shm + LDS_Q + wid * 4096 + lane * 16 + d0 * 1024) = qr[d0]; }
#pragma unroll
    for (int d0 = 0; d0 < 4; ++d0) o[d0] = (f32x16){};
    float lsum = 0.f;
    const int qw0 = q0 + wid * 32, qabs = qw0 + r32;
    const lds_cptr shm3 = (lds_cptr)shm;
    const lds_cptr kp0 = shm3 + LDS_K + hi * 1024 + r32 * 16;
    const lds_cptr vp0 = shm3 + LDS_V + ((lane >> 4) & 1) * 32 + (lane & 3) * 8 + (4 * hi + ((lane & 15) >> 2)) * 64;
#define QK_TILE(C0, C1, kp) do { C0 = (f32x16){}; C1 = (f32x16){}; \
        _Pragma("unroll") for (int d0 = 0; d0 < 4; ++d0) { if (d0 == 2) __builtin_amdgcn_sched_barrier(0); const bf16x8 b0 = *(const LAS bf16x8*)((kp) + d0 * 2048); const bf16x8 b1 = *(const LAS bf16x8*)((kp) + d0 * 2048 + 512); \
            const bf16x8 qf_ = *(const LAS bf16x8*)(qlds + d0 * 1024); C0 = MFMA32(b0, qf_, C0); C1 = MFMA32(b1, qf_, C1); } } while (0)
#define MASK_BIAS(C0, C1, t) do { const int kvb_ = (t) * 64; if (kvb_ + 191 > qw0) { int dbase = qabs - kvb_ - 4 * hi; asm volatile("" : "+v"(dbase)); \
        _Pragma("unroll") for (int r = 0; r < 16; ++r) { const int d0_ = dbase - ((r & 3) + 8 * (r >> 2)); const int d1_ = d0_ - 32; \
            C0[r] = d0_ < 0 ? -INFINITY : C0[r] + tbl[d0_ > 127 ? 127 : d0_]; C1[r] = d1_ < 0 ? -INFINITY : C1[r] + tbl[d1_ > 127 ? 127 : d1_]; } } } while (0)
#define VLOAD(vf, vp, d0) do { _Pragma("unroll") for (int ks = 0; ks < 4; ++ks) { const s16x4 lo_ = vtr((vp) + (d0) * 4096 + ks * 1024), hh_ = vtr((vp) + (d0) * 4096 + ks * 1024 + 512); \
            vf[ks] = (bf16x8){lo_[0], lo_[1], lo_[2], lo_[3], hh_[0], hh_[1], hh_[2], hh_[3]}; } } while (0)
#define PV4(d0, vf) do { _Pragma("unroll") for (int ks = 0; ks < 4; ++ks) o[d0] = MFMA32(__builtin_bit_cast(bf16x8, pw[ks]), vf[ks], o[d0]); } while (0)
#define PACK_SUM(P0, P1) do { float sacc = 0.f; _Pragma("unroll") for (int r = 0; r < 16; ++r) sacc += P0[r] + P1[r]; lsum += sacc; \
        _Pragma("unroll") for (int i = 0; i < 4; ++i) { pw[0][i] = cvtpk_s(P0[2 * i], P0[2 * i + 1]); pw[1][i] = cvtpk_s(P0[8 + 2 * i], P0[9 + 2 * i]); pw[2][i] = cvtpk_s(P1[2 * i], P1[2 * i + 1]); pw[3][i] = cvtpk_s(P1[8 + 2 * i], P1[9 + 2 * i]); } } while (0)
#define EXP_PACK(C, pwa, pwb) do { float sacc = 0.f; _Pragma("unroll") for (int r = 0; r < 16; ++r) { C[r] = __builtin_amdgcn_exp2f(C[r]); sacc += C[r]; } lsum += sacc; \
        _Pragma("unroll") for (int i = 0; i < 4; ++i) { pwa[i] = cvtpk_s(C[2 * i], C[2 * i + 1]); pwb[i] = cvtpk_s(C[8 + 2 * i], C[9 + 2 * i]); } } while (0)
#define KLOAD(kf, kp) do { _Pragma("unroll") for (int d0 = 0; d0 < 4; ++d0) { kf[2 * d0] = *(const LAS bf16x8*)((kp) + d0 * 2048); kf[2 * d0 + 1] = *(const LAS bf16x8*)((kp) + d0 * 2048 + 512); } } while (0)
#define QLOAD(qf) do { _Pragma("unroll") for (int d0 = 0; d0 < 4; ++d0) qf[d0] = *(const LAS bf16x8*)(qlds + d0 * 1024); } while (0)
#define QK8(C0, C1, kf, qf) do { C0 = (f32x16){}; C1 = (f32x16){}; _Pragma("unroll") for (int d0 = 0; d0 < 4; ++d0) { C0 = MFMA32(kf[2 * d0], qf[d0], C0); C1 = MFMA32(kf[2 * d0 + 1], qf[d0], C1); } } while (0)
#define SB() __builtin_amdgcn_sched_barrier(0)
    f32x16 C0, C1; v4u pw[4], pwn[4]; bf16x8 va[4], vb[4], kf[8], qf[4];
    ATT_WAIT_BAR(0);
    KLOAD(kf, kp0); QLOAD(qf);
    ATT_WAIT_BAR(0);
    if (3 < NT) DMA_K(3, 0);
    DMA_V(1, 1);
    QK8(C0, C1, kf, qf);
    MASK_BIAS(C0, C1, 0);
    EXP_PACK(C0, pw[0], pw[1]); EXP_PACK(C1, pw[2], pw[3]);
    KLOAD(kf, kp0 + KSLOT);
    int ks_cur = 1, vs_prev = 0;
    for (int t = 1; t < NT; ++t) {
        if (t + 2 < NT) { ATT_WAIT_BAR(3); } else { ATT_WAIT_BAR(2); }
        { const int vs_new = (vs_prev == 0) ? 2 : vs_prev - 1;
          if (t + 3 < NT) DMA_K(t + 3, ks_cur);
          if (t + 1 < NT) DMA_V(t + 1, vs_new); }
        const int ks_next = (ks_cur == 2) ? 0 : ks_cur + 1;
        const lds_cptr vp = vp0 + vs_prev * VSLOT;
        SB();
        VLOAD(va, vp, 0); VLOAD(vb, vp, 1); QLOAD(qf);
        SB();
        QK8(C0, C1, kf, qf);
        SB();
        MASK_BIAS(C0, C1, t);
        SB();
        PV4(0, va); PV4(1, vb);
        SB();
        VLOAD(va, vp, 2); VLOAD(vb, vp, 3);
        KLOAD(kf, kp0 + ks_next * KSLOT);
        SB();
        EXP_PACK(C0, pwn[0], pwn[1]);
        SB();
        PV4(2, va); PV4(3, vb);
        EXP_PACK(C1, pwn[2], pwn[3]);
        SB();
#pragma unroll
        for (int i = 0; i < 4; ++i) pw[i] = pwn[i];
        ks_cur = ks_next; vs_prev = (vs_prev == 2) ? 0 : vs_prev + 1;
    }
    ATT_WAIT_BAR(0);
    { const lds_cptr vp = vp0 + vs_prev * VSLOT;
      VLOAD(va, vp, 0); VLOAD(vb, vp, 1); PV4(0, va); PV4(1, vb);
      VLOAD(va, vp, 2); VLOAD(vb, vp, 3); PV4(2, va); PV4(3, vb); }
    { auto rr = __builtin_amdgcn_permlane32_swap(__float_as_uint(lsum), __float_as_uint(lsum), false, false); lsum = __uint_as_float(rr[0]) + __uint_as_float(rr[1]); }
    if (hi == 0) wsf[r32] = lsum;
    LDS_WAIT();
#pragma unroll
    for (int r = 0; r < 16; ++r) { const float rl = 1.0f / wsf[crow(r, hi)];
#pragma unroll
        for (int d0 = 0; d0 < 4; ++d0) o[d0][r] *= rl; }
    ATT_WAIT_BAR(0);
#undef DMA_K
#undef DMA_V
#undef QK_TILE
#undef MASK_BIAS
#undef VLOAD
#undef PV4
#undef PACK_SUM
#undef EXP_PACK
#undef KLOAD
#undef QLOAD
#undef QK8
#undef SB
}
__device__ __forceinline__ int t5_bucket(int n) {
    if (n < 16) return n;
    const float nf = (float)n; int large = 16 + (int)(logf(nf / 16.f) / logf(8.f) * 16.f);
    return large < 31 ? large : 31;
}
__device__ __forceinline__ void attn_unit(Frame& F, int b, int h, int qb, float lam) {
    LAS unsigned char* shm = F.lds;
    int tid = F.tid; asm volatile("" : "+v"(tid));
    const int lane = tid & 63, r32 = lane & 31, hi = lane >> 5, wid = F.wave;
    if (tid < 256) { const int m = tid >> 7, d = tid & 127; const int col = h * 2 + m;
        ((LAS float*)(shm + LDS_TBL))[tid] = (F.rel_bias[t5_bucket(d) * 8 + col] - F.rel_bias[31 * 8 + col]) * LOG2E; }
    __syncthreads();
    const bf16* QD = wsp<const bf16>(F, WS_QD); const bf16* KD = wsp<const bf16>(F, WS_KD); const bf16* VD = wsp<const bf16>(F, WS_VD);
    float* stash = wsp<float>(F, WS_STASH) + (size_t)F.vcu * 32768 + tid * 64;
    f32x16 o[4];
#pragma nounroll
    for (int m = 0; m < 2; ++m) {
        attn_map(o, b, h, m, qb, QD, KD, VD, shm);
        if (m == 0) {
#pragma unroll
            for (int d0 = 0; d0 < 4; ++d0)
#pragma unroll
                for (int r = 0; r < 16; r += 4) *(f32x4*)(stash + d0 * 16 + r) = (f32x4){o[d0][r], o[d0][r + 1], o[d0][r + 2], o[d0][r + 3]};
        } else {
            float ss[16];
#pragma unroll
            for (int r = 0; r < 16; ++r) ss[r] = 0.f;
#pragma unroll
            for (int d0 = 0; d0 < 4; ++d0)
#pragma unroll
                for (int r4 = 0; r4 < 16; r4 += 4) { const f32x4 sv = *(const f32x4*)(stash + d0 * 16 + r4);
#pragma unroll
                    for (int q = 0; q < 4; ++q) { const int r = r4 + q; const float v = sv[q] - lam * o[d0][r]; o[d0][r] = v; ss[r] += v * v; } }
            float gs[4];
#pragma unroll
            for (int d0 = 0; d0 < 4; ++d0) gs[d0] = F.g_subln[32 * d0 + r32] * 0.8f;
            bf16* A2 = wsp<bf16>(F, WS_A2);
            const size_t rowb = (size_t)b * SEQ + (size_t)qb * 256 + wid * 32;
            bf16* a2b = A2 + (rowb + 4 * hi) * 1024 + 512 + h * 128 + r32; asm volatile("" : "+v"(a2b));
#pragma unroll
            for (int r = 0; r < 16; ++r) { float s = ss[r];
                s += __shfl_xor(s, 1); s += __shfl_xor(s, 2); s += __shfl_xor(s, 4); s += __shfl_xor(s, 8); s += __shfl_xor(s, 16);
                const float rs = rsqrtf(s * (1.f / 128.f) + EPS);
                bf16* rowp = a2b + (size_t)((r & 3) + 8 * (r >> 2)) * 1024;
#pragma unroll
                for (int d0 = 0; d0 < 4; ++d0) rowp[32 * d0] = (bf16)f2bf(o[d0][r] * rs * gs[d0]); }
        }
    }
    __syncthreads();
}
}

__device__ __forceinline__ void p7_phase(Frame& F) {
    const int tid = F.tid, lane = F.lane;
    LAS float* wr = (LAS float*)F.lds;
    LAS unsigned* hist = (LAS unsigned*)(F.lds + HIST_OFF);
    for (int idx = tid; idx < 32768; idx += 512) { const int k = idx >> 5, e = idx & 31; wr[e * 1024 + k] = F.w_router[idx]; }
    if (tid < 32) hist[tid] = 0u;
    __syncthreads();
    const float* MOD = wsp<const float>(F, WS_MOD);
    const int gw = F.vcu * NWAVES + F.wave, NGW = F.G * NWAVES; const int rpw = (T + NGW - 1) / NGW;
    int curb = -1; f32x4 gsc[4], shv[4], nx[4];
    { const int m0 = (gw * rpw < T) ? gw * rpw : 0; const GAS f32x4* xr = (const GAS f32x4*)(F.out + (size_t)m0 * D) + lane;
#pragma unroll
      for (int j = 0; j < 4; ++j) nx[j] = xr[64 * j]; }
#pragma nounroll
    for (int i = 0; i < rpw; ++i) {
        const int m = gw * rpw + i; if (m >= T) break;
        const int b = m / SEQ;
        if (b != curb) { curb = b;
#pragma unroll
            for (int j = 0; j < 4; ++j) { const int col = 256 * j + 4 * lane; const f32x4 g = *(const f32x4*)(F.g_norm2 + col);
                shv[j] = *(const f32x4*)(MOD + (size_t)b * 6144 + 3072 + col); gsc[j] = g * (*(const f32x4*)(MOD + (size_t)b * 6144 + 4096 + col) + 1.0f); } }
        f32x4 v[4]; float s = 0.f;
#pragma unroll
        for (int j = 0; j < 4; ++j) { v[j] = nx[j]; s += (v[j].x * v[j].x + v[j].y * v[j].y) + (v[j].z * v[j].z + v[j].w * v[j].w); }
        { const int m2 = (m + 1 < T) ? m + 1 : m; const GAS f32x4* xr = (const GAS f32x4*)(F.out + (size_t)m2 * D) + lane;
#pragma unroll
          for (int j = 0; j < 4; ++j) nx[j] = xr[64 * j]; }
        const float rstd = rsqrtf(wave_sum(s) * (1.f / D) + EPS);
        GAS unsigned* o4 = (GAS unsigned*)(wsp<unsigned char>(F, WS_XN) + (size_t)m * D) + lane;
#pragma unroll
        for (int j = 0; j < 4; ++j) { v[j] = v[j] * rstd * gsc[j] + shv[j]; o4[64 * j] = pk4_fp8(v[j].x, v[j].y, v[j].z, v[j].w); }
        float lg[32];
#pragma unroll
        for (int e = 0; e < 32; ++e) { float a = 0.f;
#pragma unroll
            for (int j = 0; j < 4; ++j) { const f32x4 w = *(const LAS f32x4*)(wr + e * 1024 + 256 * j + 4 * lane); a += (v[j].x * w.x + v[j].y * w.y) + (v[j].z * w.z + v[j].w * w.w); }
            lg[e] = a; if ((e & 7) == 7) asm volatile("" ::: "memory"); }
        { const float tot = xreduce<32>(lg, lane);
#pragma unroll
          for (int e = 0; e < 32; ++e) lg[e] = lane_bcast(tot, 2 * e) + F.b_router[e]; }
        int te[4]; float tv[4];
#pragma unroll
        for (int k = 0; k < 4; ++k) { float bv = -INFINITY; int bi = 0;
#pragma unroll
            for (int e = 0; e < 32; ++e) { const bool c = lg[e] > bv; bv = c ? lg[e] : bv; bi = c ? e : bi; }
            te[k] = bi; tv[k] = bv;
#pragma unroll
            for (int e = 0; e < 32; ++e) lg[e] = (e == bi) ? -INFINITY : lg[e]; }
        float ex[4], es = 0.f;
#pragma unroll
        for (int k = 0; k < 4; ++k) { ex[k] = __expf(tv[k] - tv[0]); es += ex[k]; }
        if (lane < 4) { const int e = lane == 0 ? te[0] : lane == 1 ? te[1] : lane == 2 ? te[2] : te[3]; const float w = (lane == 0 ? ex[0] : lane == 1 ? ex[1] : lane == 2 ? ex[2] : ex[3]) / es;
            wsp<int>(F, WS_TOPE)[(size_t)m * 4 + lane] = e; wsp<float>(F, WS_TOPW)[(size_t)m * 4 + lane] = w; __hip_atomic_fetch_add(hist + e, 1u, __ATOMIC_RELAXED, __HIP_MEMORY_SCOPE_WORKGROUP); }
    }
    __syncthreads();
    if (tid < 32) __hip_atomic_fetch_add(F.ctl + CW_CNT + tid, hist[tid], RLX_AGENT);
}
__device__ __forceinline__ void moe_tables(Frame& F, int& nMt) {
    LAS unsigned char* te = F.lds + TILEE_OFF;
    if (F.tid == 0) { int t0 = 0;
        for (int e = 0; e < NE; ++e) { const int c = (int)__hip_atomic_load(F.ctl + CW_CNT + e, RLX_AGENT); const int nt = (c + 255) >> 8; for (int j = 0; j < nt; ++j) te[t0 + j] = (unsigned char)e; t0 += nt; }
        F.MISC[16] = (unsigned)t0; }
    __syncthreads();
    nMt = __builtin_amdgcn_readfirstlane((int)F.MISC[16]);
}
__device__ __forceinline__ void p8_phase(Frame& F) {
    const int tid = F.tid, lane = F.lane;
    LAS unsigned* hist = (LAS unsigned*)(F.lds + HIST_OFF);
    if (tid < 96) hist[tid] = 0u;
    __syncthreads();
    const int gw = F.vcu * NWAVES + F.wave, NGW = F.G * NWAVES; const int rpw = (T + NGW - 1) / NGW;
    const int* TOPE = wsp<const int>(F, WS_TOPE);
    for (int i = 0; i < rpw; ++i) { const int m = gw * rpw + i; if (m >= T) break; if (lane < 4) __hip_atomic_fetch_add(hist + TOPE[(size_t)m * 4 + lane], 1u, __ATOMIC_RELAXED, __HIP_MEMORY_SCOPE_WORKGROUP); }
    __syncthreads();
    if (tid < 32) { unsigned pstart = 0; for (int e = 0; e < tid; ++e) { const unsigned c = __hip_atomic_load(F.ctl + CW_CNT + e, RLX_AGENT); pstart += (c + 255u) & ~255u; }
        hist[32 + tid] = pstart + __hip_atomic_fetch_add(F.ctl + CW_FILL + tid, hist[tid], RLX_AGENT); }
    __syncthreads();
    const unsigned char* H2 = wsp<const unsigned char>(F, WS_XN); unsigned char* XS = wsp<unsigned char>(F, WS_XS);
    for (int i = 0; i < rpw; ++i) { const int m = gw * rpw + i; if (m >= T) break;
        int pos = 0;
        if (lane < 4) { const int e = TOPE[(size_t)m * 4 + lane]; pos = (int)(hist[32 + e] + __hip_atomic_fetch_add(hist + 64 + e, 1u, __ATOMIC_RELAXED, __HIP_MEMORY_SCOPE_WORKGROUP));
            wsp<int>(F, WS_POS)[(size_t)m * 4 + lane] = pos; }
        const v4u a = *(const v4u*)(H2 + (size_t)m * D + lane * 16);
#pragma unroll
        for (int k = 0; k < 4; ++k) { const int p = __shfl(pos, k); *(v4u*)(XS + (size_t)p * D + lane * 16) = a; }
    }
}
__device__ __forceinline__ void p11_phase(Frame& F) {
    const int lane = F.lane;
    const float* MOD = wsp<const float>(F, WS_MOD); const bf16* CN = wsp<const bf16>(F, WS_CN); const int* POS = wsp<const int>(F, WS_POS);
    const int gw = F.vcu * NWAVES + F.wave, NGW = F.G * NWAVES; const int rpw = (T + NGW - 1) / NGW;
    const int mbeg = gw * rpw, mend = (mbeg + rpw < T) ? mbeg + rpw : T;
    if (mbeg >= mend) return;
    v4u ca[4], cc[4]; f32x4 xv[4]; int pn[4]; f32x4 wcur, wnxt; const float* TOPW = wsp<const float>(F, WS_TOPW);
#define P11_LOAD(mm) do { _Pragma("unroll") for (int k = 0; k < 4; ++k) { const v4u* src = (const v4u*)(CN + (size_t)pn[k] * D + lane * 16); ca[k] = src[0]; cc[k] = src[1]; } \
        _Pragma("unroll") for (int q = 0; q < 4; ++q) xv[q] = *(const f32x4*)(F.out + (size_t)(mm) * D + lane * 16 + 4 * q); } while (0)
    { const int4 p4 = *(const int4*)(POS + (size_t)mbeg * 4); pn[0] = p4.x; pn[1] = p4.y; pn[2] = p4.z; pn[3] = p4.w; }
    P11_LOAD(mbeg); wcur = *(const f32x4*)(TOPW + (size_t)mbeg * 4);
    { const int m2 = (mbeg + 1 < mend) ? mbeg + 1 : mbeg; const int4 p4 = *(const int4*)(POS + (size_t)m2 * 4); pn[0] = p4.x; pn[1] = p4.y; pn[2] = p4.z; pn[3] = p4.w; wnxt = *(const f32x4*)(TOPW + (size_t)m2 * 4); }
#pragma nounroll
    for (int m = mbeg; m < mend; ++m) {
        const int b = m / SEQ;
        float acc[16];
#pragma unroll
        for (int q = 0; q < 16; ++q) acc[q] = 0.f;
#pragma unroll
        for (int k = 0; k < 4; ++k) { const float wk = wcur[k];
#pragma unroll
            for (int q = 0; q < 4; ++q) { acc[2 * q] += wk * bflo(ca[k][q]); acc[2 * q + 1] += wk * bfhi(ca[k][q]); acc[8 + 2 * q] += wk * bflo(cc[k][q]); acc[8 + 2 * q + 1] += wk * bfhi(cc[k][q]); } }
        f32x4 ov[4]; const float* gt = MOD + (size_t)b * 6144 + 5120 + lane * 16;
#pragma unroll
        for (int q = 0; q < 4; ++q) { const f32x4 g = *(const f32x4*)(gt + 4 * q); const f32x4 av = {acc[4 * q], acc[4 * q + 1], acc[4 * q + 2], acc[4 * q + 3]}; ov[q] = xv[q] + g * av; }
        const int m1 = (m + 1 < mend) ? m + 1 : m;
        P11_LOAD(m1);
        wcur = wnxt;
        { const int m2 = (m + 2 < mend) ? m + 2 : m1; const int4 p4 = *(const int4*)(POS + (size_t)m2 * 4); pn[0] = p4.x; pn[1] = p4.y; pn[2] = p4.z; pn[3] = p4.w; wnxt = *(const f32x4*)(TOPW + (size_t)m2 * 4); }
        float* orow = F.out + (size_t)m * D + lane * 16;
#pragma unroll
        for (int q = 0; q < 4; ++q) *(f32x4*)(orow + 4 * q) = ov[q];
    }
#undef P11_LOAD
}

constexpr int NPHASE = 12;
struct Args { const float* in[25]; float* out; unsigned char* ws; int ph_lo, ph_hi; };
__global__ void __launch_bounds__(NWAVES * 64, 2) fwd_kernel(Args args) {
    extern __shared__ __attribute__((aligned(16))) unsigned char lds[];
    Frame F;
    F.lds = (LAS unsigned char*)lds;
    F.MISC = (volatile LAS unsigned*)(F.lds + MISC_OFF);
    F.tid = threadIdx.x; F.lane = F.tid & 63; F.wave = __builtin_amdgcn_readfirstlane(F.tid >> 6);
    F.G = gridDim.x; { const int bx = blockIdx.x; F.vcu = (F.G % 8 == 0) ? (bx % 8) * (F.G / 8) + bx / 8 : bx; }
    F.ws = args.ws; F.ctl = (gu32*)(args.ws + WS_CTL); F.out = args.out;
    F.x = args.in[0]; F.c = args.in[1]; F.rel_bias = args.in[2]; F.w_ada = args.in[3]; F.b_ada = args.in[4]; F.g_norm1 = args.in[5]; F.w_in = args.in[6];
    F.w_gk_up = args.in[7]; F.b_gk_up = args.in[8]; F.g_gla_out = args.in[9]; F.g_qnorm = args.in[10]; F.g_knorm = args.in[11];
    F.lq1 = args.in[12]; F.lk1 = args.in[13]; F.lq2 = args.in[14]; F.lk2 = args.in[15]; F.g_subln = args.in[16]; F.w_out = args.in[17];
    F.g_norm2 = args.in[18]; F.w_router = args.in[19]; F.b_router = args.in[20]; F.w_gate_up = args.in[21]; F.b_gate_up = args.in[22]; F.w_down = args.in[23]; F.b_down = args.in[24];
    for (int u = F.tid; u < (LDS_BYTES - LDSCTL_OFF) / 4; u += NWAVES * 64) ((LAS unsigned*)(F.lds + LDSCTL_OFF))[u] = 0u;
    __syncthreads();
    const int lo = args.ph_lo, hi = args.ph_hi;
    const bool multi = (hi - lo) > 1;
    XcdBarrier bar; bar.bar = (unsigned*)(F.ctl + CW_BAR); bar.x = 0; bar.st = nullptr;
    if (multi) bar = xcd_barrier_post((unsigned*)(F.ctl + CW_BAR), F.MISC + 8);
#ifndef PHMASK
#define PHMASK 0xFFF
#endif
#define IN(k) (((PHMASK >> (k)) & 1) && lo <= (k) && (k) < hi)
#define SEAM(k) do { if (IN((k) + 1)) xcd_barrier(bar); } while (0)
#ifndef REPEAT_PH
#define REPEAT_PH 0
#endif
#define REPS(k) (((REPEAT_PH >> (k)) & 1) ? 2 : 1)

    if (IN(0)) { for (int rep_ = 0; rep_ < REPS(0); ++rep_) { if (rep_) xcd_barrier(bar); p0_phase(F); } SEAM(0); }
    if (IN(1)) { for (int rep_ = 0; rep_ < REPS(1); ++rep_) { if (rep_) xcd_barrier(bar); p1_phase(F); } SEAM(1); }
    if (IN(2)) {
        pg8::Gemm g{wsp<const bf16>(F, WS_XN), wsp<const bf16>(F, WS_WIN), T, NIN, D, 0};
        pg8::StaticOrder S; S.init(T / 256, NIN / 256, F.G, (int)blockIdx.x, nullptr, REPS(2));
        EpiInProj E{wsp<bf16>(F, WS_QG), wsp<bf16>(F, WS_KG), wsp<bf16>(F, WS_VG), wsp<bf16>(F, WS_RG), wsp<bf16>(F, WS_QD), wsp<bf16>(F, WS_KD), wsp<bf16>(F, WS_VD), F.g_qnorm, F.g_knorm};
        pg8::gemm_phase<EpiInProj, pg8::StaticOrder>(F.lds, g, S, E);
        SEAM(2);
    }
    if (IN(3)) { for (int rep_ = 0; rep_ < REPS(3); ++rep_) { if (rep_) xcd_barrier(bar); for (int c = F.vcu; c < NCHUNK; c += F.G) gla_a_unit(F, c); } SEAM(3); }
    if (IN(4)) { for (int rep_ = 0; rep_ < REPS(4); ++rep_) { if (rep_) xcd_barrier(bar); gla_b_phase(F); } SEAM(4); }
    if (IN(5)) for (int rep_ = 0; rep_ < REPS(5); ++rep_) { if (rep_) xcd_barrier(bar);
#ifndef NO_GLAC
        for (int u = F.vcu; u < NCHUNK / 2; u += F.G) gla_c_unit(F, u);
#endif
        float lam;
        { float a1 = F.lq1[F.lane] * F.lk1[F.lane], a2 = F.lq2[F.lane] * F.lk2[F.lane]; a1 = wave_sum(a1); a2 = wave_sum(a2); lam = __expf(a1) - __expf(a2) + 0.2f; }
#ifndef NO_ATT
        for (int p = F.vcu; p < 256; p += F.G) { const int bh = p >> 4, s = p & 15;
#pragma nounroll
            for (int j = 0; j < 2; ++j) att::attn_unit(F, bh >> 2, bh & 3, j ? s : 31 - s, lam); }
#endif
        SEAM(5);
    }
    if (IN(6)) {
        pg8::Gemm g{wsp<const bf16>(F, WS_A2), wsp<const bf16>(F, WS_WOUT), T, D, D, 0};
        pg8::StaticOrder S; S.init(T / 256, D / 256, F.G, (int)blockIdx.x, nullptr, REPS(6));
        EpiOutProj E{F.x, F.out, wsp<const float>(F, WS_MOD)};
        pg8::gemm_phase<EpiOutProj, pg8::StaticOrder>(F.lds, g, S, E);
        SEAM(6);
    }
    if (IN(7)) { p7_phase(F); SEAM(7); }
    if (IN(8)) { p8_phase(F); SEAM(8); }
    if (IN(9)) {
        int nMt; moe_tables(F, nMt);
        pg8::Gemm g{wsp<const bf16>(F, WS_XS), wsp<const bf16>(F, WS_WGU), PMAX, 2048, D / 2, (size_t)2048 * 512};
        pg8::StaticOrder S; S.init(nMt, 8, F.G, (int)blockIdx.x, F.lds + TILEE_OFF, REPS(9));
        EpiSwiGLU E{wsp<unsigned char>(F, WS_Y), F.b_gate_up};
        pg8::gemm_phase<EpiSwiGLU, pg8::StaticOrder, true>(F.lds, g, S, E);
        SEAM(9);
    }
    if (IN(10)) {
        int nMt; moe_tables(F, nMt);
        pg8::Gemm g{wsp<const bf16>(F, WS_Y), wsp<const bf16>(F, WS_WD), PMAX, 1024, FF / 2, (size_t)1024 * 512};
        pg8::StaticOrder S; S.init(nMt, 4, F.G, (int)blockIdx.x, F.lds + TILEE_OFF, REPS(10));
        EpiDown E{wsp<bf16>(F, WS_CN), F.b_down, wsp<const float>(F, WS_ROWW)};
        pg8::gemm_phase<EpiDown, pg8::StaticOrder, true>(F.lds, g, S, E);
        SEAM(10);
    }
    if (IN(11)) { p11_phase(F); }
#undef IN
#undef SEAM
}

extern "C" void kernel_launch(void* const* d_in, const int* in_sizes, int n_in, void* d_out, int out_size, void* d_ws, size_t ws_size, hipStream_t stream) {
    static int grid = 0;
    if (grid == 0) {
        if (n_in != 25 || in_sizes[0] != T * D || out_size != T * D || ws_size < WS_END) { fprintf(stderr, "kernel_launch: unexpected shapes (n_in %d, in0 %d, out %d, ws %zu); nothing launched\n", n_in, n_in > 0 ? in_sizes[0] : -1, out_size, ws_size); grid = -1; return; }
        int dev = 0, cus = 0, per_cu = 0;
        if (hipGetDevice(&dev) != hipSuccess || hipDeviceGetAttribute(&cus, hipDeviceAttributeMultiprocessorCount, dev) != hipSuccess) { grid = -1; return; }
        if (hipFuncSetAttribute((const void*)fwd_kernel, hipFuncAttributeMaxDynamicSharedMemorySize, LDS_BYTES) != hipSuccess) { fprintf(stderr, "kernel_launch: hipFuncSetAttribute failed\n"); grid = -1; return; }
        if (hipOccupancyMaxActiveBlocksPerMultiprocessor(&per_cu, (const void*)fwd_kernel, NWAVES * 64, LDS_BYTES) != hipSuccess || per_cu < 1)
            fprintf(stderr, "kernel_launch: note: occupancy query reports %d workgroups per CU\n", per_cu);
        (void)hipGetLastError();
        grid = cus;
    }
    if (grid < 0) return;
    if (hipMemsetAsync((char*)d_ws + WS_CTL, 0, CTL_ZERO_BYTES, stream) != hipSuccess) { fprintf(stderr, "kernel_launch: memset failed\n"); return; }
    Args a{};
    for (int i = 0; i < 25; ++i) a.in[i] = (const float*)d_in[i];
    a.out = (float*)d_out; a.ws = (unsigned char*)d_ws;
#if MK_N_LAUNCHES == 1
    a.ph_lo = 0; a.ph_hi = NPHASE;
    hipLaunchKernelGGL(fwd_kernel, dim3(grid), dim3(NWAVES * 64), LDS_BYTES, stream, a);
#else
    for (int p = 0; p < NPHASE; ++p) { a.ph_lo = p; a.ph_hi = p + 1; hipLaunchKernelGGL(fwd_kernel, dim3(grid), dim3(NWAVES * 64), LDS_BYTES, stream, a); }
#endif
    const hipError_t le = hipPeekAtLastError();
    if (le != hipSuccess) fprintf(stderr, "kernel_launch: launch failed: %s\n", hipGetErrorName(le));
}
```

```cpp
#include <hip/hip_runtime.h>
#include <cstdio>
#include <cstdint>

#ifndef MK_N_LAUNCHES
#define MK_N_LAUNCHES 1
#endif

namespace pg8 {
#define PG8_LAS __attribute__((address_space(3)))
typedef unsigned short bf16_t;
typedef short bf16x8 __attribute__((ext_vector_type(8)));
typedef float f32x4 __attribute__((ext_vector_type(4)));
typedef unsigned u32x4 __attribute__((ext_vector_type(4)));
typedef int i32x4 __attribute__((ext_vector_type(4)));
typedef int i32x8 __attribute__((ext_vector_type(8)));
typedef float f32x16 __attribute__((ext_vector_type(16)));
constexpr int BM = 256, BK = 64, HALF = 128, HTB = HALF * BK * 2, STAGE_BYTES = 8 * HTB, NXCD = 8, WGM = 8;

__host__ __device__ __forceinline__ int lds_byte(int r, int c) { const int st = (r >> 4) * 2 + (c >> 5), rr = r & 15, cc = c & 31, ob = rr * 64 + cc * 2; return st * 1024 + (ob ^ (((ob >> 9) & 1) << 5)); }
__host__ __device__ __forceinline__ void stage_rc(int b, int& R, int& C) { const int st = b / 1024, sb = b % 1024, swz = sb ^ (((sb >> 9) & 1) << 5); R = (st >> 1) * 16 + swz / 64; C = (st & 1) * 32 + (swz % 64) / 2; }
__host__ __device__ __forceinline__ int perm32(int rho) { const int n = rho >> 4, i = rho & 15; return 8 * (i >> 2) + 4 * n + (i & 3); }

struct Unit { int pm, pn, e; };
struct Gemm { const bf16_t* A; const bf16_t* Bt; int M, N, K; size_t estride; };

struct StaticOrder {
    int nM, nN, nwg, G, c, rep; const PG8_LAS unsigned char* tile_e;
    __device__ void init(int nM_, int nN_, int G_, int c_, const PG8_LAS unsigned char* te, int rep_ = 1) { nM = nM_; nN = nN_; nwg = nM * nN; G = G_; c = c_; tile_e = te; rep = rep_; }
    __device__ bool next(int i, Unit& u) const {
        long L = (long)i * G + c; if (L >= (long)nwg * rep) return false; if (rep > 1) L %= nwg;
        int wgid = (int)L; { const int q = nwg / NXCD, r = nwg % NXCD, xcd = wgid % NXCD, off = wgid / NXCD; wgid = (xcd < r ? xcd * (q + 1) : r * (q + 1) + (xcd - r) * q) + off; }
        const int nig = WGM * nN, gid = wgid / nig, fm = gid * WGM, gsz = (nM - fm) < WGM ? (nM - fm) : WGM;
        u.pm = fm + ((wgid % nig) % gsz); u.pn = (wgid % nig) / gsz; u.e = tile_e ? __builtin_amdgcn_readfirstlane((int)tile_e[u.pm]) : 0; return true;
    }
};

__device__ __forceinline__ unsigned cvt_pk_bf16(float lo, float hi) { unsigned r; asm volatile("v_cvt_pk_bf16_f32 %0, %1, %2" : "=v"(r) : "v"(lo), "v"(hi)); return r; }

template <class Epi, class Sched, bool FP8 = false>
__device__ __forceinline__ void gemm_phase(PG8_LAS unsigned char* lds, const Gemm g, const Sched& S, const Epi& E) {
    const int tid = threadIdx.x, wid = __builtin_amdgcn_readfirstlane(tid >> 6), lane = tid & 63, wr = wid >> 2, wc = wid & 3, fr = lane & 15, fq = lane >> 4;
    const int K = g.K, nt = K / BK;
    unsigned voffA[2], voffB[2];
#pragma unroll
    for (int i = 0; i < 2; ++i) { int R, C; stage_rc(tid * 16 + i * 8192, R, C); const int Rb = Epi::PERM ? ((R & ~31) + perm32(R & 31)) : R;
        voffA[i] = (unsigned)(R * K + C) * 2u; voffB[i] = (unsigned)(Rb * K + C) * 2u; }
    const size_t kstep = (size_t)(BK * 2);
    const size_t hstep = (size_t)HALF * K * 2;
    const size_t tstep = 2 * hstep;
    const size_t estep = g.estride * 2;
    const unsigned ldsw = (unsigned)wid * 1024u;
    const int aoff = lds_byte(wr * 64 + fr, fq * 8), boff = lds_byte(wc * 32 + fr, fq * 8);
#define PG8_SA(b, h) (((b) * 2 + (h)) * HTB)
#define PG8_SB(b, h) ((4 + (b) * 2 + (h)) * HTB)
#define PG8_STAGE(bufoff, gbase, voff) do { _Pragma("unroll") for (int _i = 0; _i < 2; ++_i) \
        __builtin_amdgcn_global_load_lds((const unsigned*)((const char*)(gbase) + (voff)[_i]), (PG8_LAS unsigned*)(lds + (bufoff) + ldsw + _i * 8192), 16, 0, 0); } while (0)
#define PG8_LDA(dst, b, h) do { _Pragma("unroll") for (int m = 0; m < 4; ++m) dst[m] = PG8_CAT2(*(const PG8_LAS i32x4*)(lds + PG8_SA(b, h) + aoff + m * 2048), *(const PG8_LAS i32x4*)(lds + PG8_SA(b, h) + aoff + m * 2048 + 1024)); } while (0)
#define PG8_LDB(dst, b, h) do { _Pragma("unroll") for (int n = 0; n < 2; ++n) dst[n] = PG8_CAT2(*(const PG8_LAS i32x4*)(lds + PG8_SB(b, h) + boff + n * 2048), *(const PG8_LAS i32x4*)(lds + PG8_SB(b, h) + boff + n * 2048 + 1024)); } while (0)
#define PG8_CAT2(x, y) __builtin_shufflevector((x), (y), 0, 1, 2, 3, 4, 5, 6, 7)
#define PG8_LO(x) __builtin_bit_cast(bf16x8, __builtin_shufflevector((x), (x), 0, 1, 2, 3))
#define PG8_HI(x) __builtin_bit_cast(bf16x8, __builtin_shufflevector((x), (x), 4, 5, 6, 7))
#define PG8_X4(v, m) ((f32x4){(v)[4 * (m)], (v)[4 * (m) + 1], (v)[4 * (m) + 2], (v)[4 * (m) + 3]})
#define PG8_INS(v, r, m) do { (v)[4 * (m)] = (r)[0]; (v)[4 * (m) + 1] = (r)[1]; (v)[4 * (m) + 2] = (r)[2]; (v)[4 * (m) + 3] = (r)[3]; } while (0)
#define PG8_MMA(ai, bj, At, Bt) do { __builtin_amdgcn_s_setprio(1); _Pragma("unroll") for (int m = 0; m < 4; ++m) _Pragma("unroll") for (int n = 0; n < 2; ++n) { \
        if constexpr (FP8) { const f32x4 r_ = __builtin_amdgcn_mfma_scale_f32_16x16x128_f8f6f4(Bt[n], At[m], PG8_X4(acc16[ai][bj][n], m), 0, 0, 0, 0x7F7F7F7F, 0, 0x7F7F7F7F); PG8_INS(acc16[ai][bj][n], r_, m); } \
        else { acc[ai][bj][m][n] = __builtin_amdgcn_mfma_f32_16x16x32_bf16(PG8_LO(Bt[n]), PG8_LO(At[m]), acc[ai][bj][m][n], 0, 0, 0); \
               acc[ai][bj][m][n] = __builtin_amdgcn_mfma_f32_16x16x32_bf16(PG8_HI(Bt[n]), PG8_HI(At[m]), acc[ai][bj][m][n], 0, 0, 0); } } \
        __builtin_amdgcn_s_setprio(0); } while (0)
#define PG8_WAIT_V(n) asm volatile("s_waitcnt vmcnt(" #n ")" ::: "memory")
#define PG8_WAIT_L(n) asm volatile("s_waitcnt lgkmcnt(" #n ")" ::: "memory")
#define PG8_BAR __builtin_amdgcn_s_barrier()
#define PG8_SCHED __builtin_amdgcn_sched_barrier(0)
    Unit cur, nxt; int ui = 0;
    if (!S.next(0, cur)) return;
    f32x4 acc[2][2][4][2];
#pragma unroll
    for (int a = 0; a < 2; ++a)
#pragma unroll
        for (int b = 0; b < 2; ++b)
#pragma unroll
            for (int m = 0; m < 4; ++m)
#pragma unroll
                for (int n = 0; n < 2; ++n) acc[a][b][m][n] = (f32x4){0.f, 0.f, 0.f, 0.f};
    f32x16 acc16[2][2][2];
#pragma unroll
    for (int a = 0; a < 2; ++a)
#pragma unroll
        for (int b = 0; b < 2; ++b)
#pragma unroll
            for (int n = 0; n < 2; ++n) acc16[a][b][n] = (f32x16){};
    i32x8 At[4], B0[2], B1[2];
    const char* cA = (const char*)g.A + (size_t)cur.pm * tstep; const char* cB = (const char*)g.Bt + (size_t)cur.e * estep + (size_t)cur.pn * tstep;
    PG8_STAGE(PG8_SB(0, 0), cB, voffB); PG8_STAGE(PG8_SB(0, 1), cB + hstep, voffB); PG8_STAGE(PG8_SA(0, 0), cA, voffA); PG8_STAGE(PG8_SA(0, 1), cA + hstep, voffA);
    if (wr == 1) PG8_BAR;
    PG8_WAIT_V(2); PG8_BAR;
    PG8_STAGE(PG8_SB(1, 0), cB + kstep, voffB); PG8_STAGE(PG8_SA(1, 0), cA + kstep, voffA); PG8_STAGE(PG8_SB(1, 1), cB + hstep + kstep, voffB);
    PG8_WAIT_V(6); PG8_BAR;
    for (;;) {
        const bool has_next = S.next(ui + 1, nxt);
        const char* nA = has_next ? (const char*)g.A + (size_t)nxt.pm * tstep : cA; const char* nB = has_next ? (const char*)g.Bt + (size_t)nxt.e * estep + (size_t)nxt.pn * tstep : cB;
#pragma nounroll
        for (int t = 0; t < nt; t += 2) {
            const bool last = (t == nt - 2);
            const char* a1 = cA + (size_t)(t + 1) * kstep;
            const char* a2 = last ? nA : cA + (size_t)(t + 2) * kstep; const char* b2 = last ? nB : cB + (size_t)(t + 2) * kstep;
            const char* a3 = a2 + kstep; const char* b3 = b2 + kstep;
            PG8_LDB(B0, 0, 0); PG8_LDB(B1, 0, 1); PG8_SCHED; PG8_LDA(At, 0, 0); PG8_STAGE(PG8_SA(1, 1), a1 + hstep, voffA);
            PG8_WAIT_V(8); PG8_WAIT_L(0); PG8_BAR; PG8_MMA(0, 0, At, B0); PG8_MMA(0, 1, At, B1); PG8_BAR; PG8_SCHED;
            PG8_LDA(At, 0, 1); PG8_STAGE(PG8_SB(0, 0), b2, voffB); PG8_STAGE(PG8_SB(0, 1), b2 + hstep, voffB); PG8_STAGE(PG8_SA(0, 0), a2, voffA);
            PG8_WAIT_V(8); PG8_WAIT_L(0); PG8_BAR; PG8_MMA(1, 0, At, B0); PG8_MMA(1, 1, At, B1); PG8_BAR; PG8_SCHED;
            PG8_LDB(B0, 1, 0); PG8_LDB(B1, 1, 1); PG8_SCHED; PG8_LDA(At, 1, 0); PG8_STAGE(PG8_SA(0, 1), a2 + hstep, voffA);
            PG8_WAIT_V(8); PG8_WAIT_L(0); PG8_BAR; PG8_MMA(0, 0, At, B0); PG8_MMA(0, 1, At, B1); PG8_BAR; PG8_SCHED;
            PG8_LDA(At, 1, 1); PG8_STAGE(PG8_SB(1, 0), b3, voffB); PG8_STAGE(PG8_SB(1, 1), b3 + hstep, voffB); PG8_STAGE(PG8_SA(1, 0), a3, voffA);
            PG8_WAIT_V(8); PG8_WAIT_L(0); PG8_BAR; PG8_MMA(1, 0, At, B0); PG8_MMA(1, 1, At, B1); PG8_BAR; PG8_SCHED;
        }
        if (wr == 0) PG8_BAR;
        if constexpr (FP8) {
#pragma unroll
            for (int a = 0; a < 2; ++a)
#pragma unroll
                for (int b = 0; b < 2; ++b)
#pragma unroll
                    for (int m = 0; m < 4; ++m)
#pragma unroll
                        for (int n = 0; n < 2; ++n) acc[a][b][m][n] = PG8_X4(acc16[a][b][n], m);
        }
        { int t2 = threadIdx.x; asm volatile("" : "+v"(t2)); E(acc, cur, wr, wc, t2 & 15, (t2 >> 4) & 3); }
        if (!has_next) break;
#pragma unroll
        for (int a = 0; a < 2; ++a)
#pragma unroll
            for (int b = 0; b < 2; ++b)
#pragma unroll
                for (int m = 0; m < 4; ++m)
#pragma unroll
                    for (int n = 0; n < 2; ++n) acc[a][b][m][n] = (f32x4){0.f, 0.f, 0.f, 0.f};
        if constexpr (FP8) {
#pragma unroll
            for (int a = 0; a < 2; ++a)
#pragma unroll
                for (int b = 0; b < 2; ++b)
#pragma unroll
                    for (int n = 0; n < 2; ++n) acc16[a][b][n] = (f32x16){};
        }
        cur = nxt; cA = nA; cB = nB; ++ui;
        if (wr == 1) PG8_BAR;
    }
    PG8_WAIT_V(0);
    PG8_BAR;
#undef PG8_SA
#undef PG8_SB
#undef PG8_STAGE
#undef PG8_LDA
#undef PG8_LDB
#undef PG8_MMA
#undef PG8_X4
#undef PG8_INS
#undef PG8_CAT2
#undef PG8_LO
#undef PG8_HI
#undef PG8_WAIT_V
#undef PG8_WAIT_L
#undef PG8_BAR
#undef PG8_SCHED
}
}

constexpr int NWAVES = 8;
constexpr int BATCH = 4, SEQ = 8192, D = 1024, T = BATCH * SEQ;
constexpr int INW = 3088, NIN = 3072;
constexpr int NE = 32, TOPK = 4, FF = 1024;
constexpr int PMAX = (T * TOPK / 256 + NE) * 256;
constexpr int NCHUNK = BATCH * 4 * (SEQ / 64);
constexpr float EPS = 1e-6f;
constexpr float LOG2E = 1.4426950408889634f;
constexpr float C2 = 0.125f * LOG2E;
constexpr float WSCALE = 32.f, WSCALE_INV = 1.f / 32.f;

constexpr size_t MiB = 1u << 20;
constexpr size_t WS_CTL = 0, CTL_ZERO_BYTES = 1 * MiB;
constexpr size_t WS_MODP = 1 * MiB;
constexpr size_t WS_MOD = 2 * MiB;
constexpr size_t WS_TOPE = 3 * MiB;
constexpr size_t WS_TOPW = 3 * MiB + 512 * 1024;
constexpr size_t WS_POS = 4 * MiB;
constexpr size_t WS_ROWW = 4 * MiB + 512 * 1024;
constexpr size_t WS_DEC = 6 * MiB;
constexpr size_t WS_WGU = 8 * MiB;
constexpr size_t WS_WD = 136 * MiB;
constexpr size_t WS_XN = 200 * MiB;
constexpr size_t WS_WIN = 264 * MiB;
constexpr size_t WS_WOUT = 270 * MiB;
constexpr size_t WS_GK = 272 * MiB;
constexpr size_t WS_QG = 304 * MiB;
constexpr size_t WS_KG = 320 * MiB;
constexpr size_t WS_VG = 336 * MiB;
constexpr size_t WS_RG = 368 * MiB;
constexpr size_t WS_QD = 400 * MiB;
constexpr size_t WS_KD = 432 * MiB;
constexpr size_t WS_VD = 464 * MiB;
constexpr size_t WS_UT = 496 * MiB;
constexpr size_t WS_SP = 560 * MiB;
constexpr size_t WS_OI = 592 * MiB;
constexpr size_t WS_QE = 656 * MiB;
constexpr size_t WS_A2 = 672 * MiB;
constexpr size_t WS_STASH = 736 * MiB;
constexpr size_t WS_XS = 264 * MiB;
constexpr size_t WS_Y = 400 * MiB;
constexpr size_t WS_CN = 536 * MiB;
constexpr size_t WS_MIX = 808 * MiB;
constexpr size_t WS_END = 872 * MiB;
static_assert(WS_XS + (size_t)PMAX * 1024 <= WS_Y && WS_Y + (size_t)PMAX * 1024 <= WS_CN && WS_CN + (size_t)PMAX * 1024 * 2 <= WS_MIX, "ws map");
constexpr int CW_BAR = 4096;
constexpr int CW_CNT = 16384;
constexpr int CW_FILL = 16384 + 64;

constexpr int RING_BYTES = 131072;
constexpr int LDSCTL_OFF = RING_BYTES, MISC_OFF = LDSCTL_OFF + 320;
constexpr int TILEE_OFF = MISC_OFF + 128;
constexpr int HIST_OFF = TILEE_OFF + 1024;
constexpr int LDS_BYTES = 147456;
static_assert(HIST_OFF + 512 <= LDS_BYTES, "LDS map");

#define GAS __attribute__((address_space(1)))
#define LAS __attribute__((address_space(3)))
typedef unsigned short bf16;
typedef unsigned v4u __attribute__((ext_vector_type(4)));
typedef unsigned v2u __attribute__((ext_vector_type(2)));
typedef float f32x4 __attribute__((ext_vector_type(4)));
typedef float f32x16 __attribute__((ext_vector_type(16)));
typedef short bf16x8 __attribute__((ext_vector_type(8)));
typedef short s16x4 __attribute__((ext_vector_type(4)));
typedef GAS unsigned gu32;
#define RLX_AGENT __ATOMIC_RELAXED, __HIP_MEMORY_SCOPE_AGENT
#define LDS_WAIT() asm volatile("s_waitcnt lgkmcnt(0)" ::: "memory")
#define VM_WAIT() asm volatile("s_waitcnt vmcnt(0)" ::: "memory")
__device__ __forceinline__ unsigned f2bf(float f) { unsigned u = __builtin_bit_cast(unsigned, f); return (u + 0x7fffu + ((u >> 16) & 1u)) >> 16; }
__device__ __forceinline__ unsigned pk2(float lo, float hi) { return f2bf(lo) | (f2bf(hi) << 16); }
__device__ __forceinline__ float bf2f(unsigned short h) { return __builtin_bit_cast(float, (unsigned)h << 16); }
__device__ __forceinline__ float bflo(unsigned u) { return __builtin_bit_cast(float, u << 16); }
__device__ __forceinline__ float bfhi(unsigned u) { return __builtin_bit_cast(float, u & 0xffff0000u); }
__device__ __forceinline__ float wave_sum(float v) {
#pragma unroll
    for (int o = 1; o < 64; o <<= 1) v += __shfl_xor(v, o);
    return v;
}
__device__ __forceinline__ float sigmoidf_(float x) { return 1.f / (1.f + __expf(-x)); }
template <int CNT, int S, int N> __device__ __forceinline__ void xreduce_step(float (&v)[N], int lane) {
    if constexpr (CNT > 1) { constexpr int half = CNT / 2; const bool up = (lane & S) != 0;
#pragma unroll
        for (int i = 0; i < half; ++i) { const float send = up ? v[i] : v[i + half], keep = up ? v[i + half] : v[i]; v[i] = keep + __shfl_xor(send, S); }
        xreduce_step<half, S / 2, N>(v, lane); }
}
template <int S> __device__ __forceinline__ float xreduce_tail(float r) { if constexpr (S >= 1) { r += __shfl_xor(r, S); return xreduce_tail<S / 2>(r); } else return r; }
template <int N> __device__ __forceinline__ float xreduce(float (&v)[N], int lane) {
    xreduce_step<N, 32, N>(v, lane);
    return xreduce_tail<(N == 32 ? 1 : N == 16 ? 2 : N == 8 ? 4 : 8)>(v[0]);
}
__device__ __forceinline__ float lane_bcast(float v, int l) { return __builtin_bit_cast(float, __builtin_amdgcn_readlane(__builtin_bit_cast(int, v), l)); }

#define XB_TMO      128
#define XB_XCNT(j)  (256  + 64 * (j))
#define XB_XSUB(j)  (1280 + 64 * (j))
#define XB_XGEN(j)  (2304 + 64 * (j))
#define XB_TOP      3328
#define XB_TOPGEN   3392
#define XCD_BAR_WORDS 3456
#define XB_SPIN_CAP (1u << 18)
__device__ __forceinline__ unsigned xb_ld(unsigned* p)              { return __hip_atomic_load(p, __ATOMIC_RELAXED, __HIP_MEMORY_SCOPE_AGENT); }
__device__ __forceinline__ unsigned xb_add(unsigned* p, unsigned v) { return __hip_atomic_fetch_add(p, v, __ATOMIC_RELAXED, __HIP_MEMORY_SCOPE_AGENT); }
__device__ __forceinline__ unsigned xb_xcc_id() { return (unsigned)__builtin_amdgcn_s_getreg((3 << 11) | 20) & 0xFu; }
#define XB_SPIN(cond, bar) do { unsigned _sp = 0; while (cond) { __builtin_amdgcn_s_sleep(1); \
    if ((++_sp & 255u) == 0u) { if (xb_ld(&(bar)[XB_TMO])) break; if (_sp > XB_SPIN_CAP) { atomicAdd(&(bar)[XB_TMO], 1u); break; } } } } while (0)
struct XcdBarrier { unsigned* bar; unsigned x; volatile LAS unsigned* st; };
__device__ __forceinline__ XcdBarrier xcd_barrier_post(unsigned* bar, volatile LAS unsigned* st) {
    XcdBarrier b; b.bar = bar; b.x = xb_xcc_id(); b.st = st;
    if (threadIdx.x == 0) (void)xb_add(&bar[XB_XCNT(b.x)], 1u);
    return b;
}
__device__ __forceinline__ void xcd_barrier_complete(unsigned* bar, unsigned x, unsigned& nloc, unsigned& nx) {
    const unsigned G = gridDim.x * gridDim.y * gridDim.z;
    unsigned sum, cnt, mine, sp = 0u;
    for (;;) {
        sum = 0u; cnt = 0u; mine = 0u;
#pragma unroll
        for (unsigned j = 0; j < 16; ++j) { const unsigned c = xb_ld(&bar[XB_XCNT(j)]); sum += c; cnt += (c > 0u) ? 1u : 0u; mine = (j == x) ? c : mine; }
        if (sum == G) break;
        __builtin_amdgcn_s_sleep(1);
        if ((++sp & 255u) == 0u) { if (xb_ld(&bar[XB_TMO])) break; if (sp > XB_SPIN_CAP) { atomicAdd(&bar[XB_TMO], 1u); break; } }
    }
    nloc = mine > 0u ? mine : 1u; nx = cnt > 0u ? cnt : 1u;
}
__device__ __forceinline__ void xcd_barrier(const XcdBarrier& b) {
    asm volatile("s_waitcnt vmcnt(0)" ::: "memory");
    __syncthreads();
    if (threadIdx.x == 0) {
        unsigned* bar = b.bar;
        __builtin_amdgcn_s_waitcnt(0);
        unsigned nloc = b.st[0], nx = b.st[1];
        if (nloc == 0u) { xcd_barrier_complete(bar, b.x, nloc, nx); b.st[0] = nloc; b.st[1] = nx; }
        const unsigned old = xb_add(&bar[XB_XSUB(b.x)], 1u);
        const unsigned gen = old / nloc;
        if (old + 1u == (gen + 1u) * nloc) {
            __builtin_amdgcn_fence(__ATOMIC_RELEASE, "agent");
            asm volatile("s_waitcnt vmcnt(0)" ::: "memory");
            const unsigned og = xb_add(&bar[XB_TOP], 1u);
            const unsigned tg = og / nx;
            if (og + 1u == (tg + 1u) * nx) xb_add(&bar[XB_TOPGEN], 1u);
            else XB_SPIN(xb_ld(&bar[XB_TOPGEN]) == tg, bar);
            __builtin_amdgcn_fence(__ATOMIC_ACQUIRE, "agent");
            xb_add(&bar[XB_XGEN(b.x)], 1u);
            asm volatile("s_waitcnt vmcnt(0)" ::: "memory");
        } else {
            XB_SPIN(xb_ld(&bar[XB_XGEN(b.x)]) == gen, bar);
            __builtin_amdgcn_fence(__ATOMIC_ACQUIRE, "agent");
            asm volatile("s_waitcnt vmcnt(0)" ::: "memory");
        }
    }
    __syncthreads();
}

struct Frame {
    LAS unsigned char* lds;
    volatile LAS unsigned* MISC;
    gu32* ctl;
    int tid, lane, wave;
    int vcu, G;
    unsigned char* ws;
    const float *x, *c, *rel_bias, *w_ada, *b_ada, *g_norm1, *w_in, *w_gk_up, *b_gk_up, *g_gla_out, *g_qnorm, *g_knorm, *lq1, *lk1, *lq2, *lk2, *g_subln, *w_out,
                *g_norm2, *w_router, *b_router, *w_gate_up, *b_gate_up, *w_down, *b_down;
    float* out;
};
template <class Tp> __device__ __forceinline__ Tp* wsp(const Frame& F, size_t off) { return (Tp*)(F.ws + off); }

__device__ __forceinline__ void tr_item(const float* W, int ldw, int k0, int src0, bf16* WT, int K, int drow0, LAS float* scr, int lane) {
#pragma unroll 8
    for (int i = 0; i < 32; ++i) { const int kk = 2 * i + (lane >> 5); scr[kk * 33 + (lane & 31)] = W[(size_t)(k0 + kk) * ldw + src0 + (lane & 31)]; }
    LDS_WAIT(); asm volatile("" ::: "memory");
    const int c = lane & 7;
#pragma unroll
    for (int j = 0; j < 4; ++j) { const int n = (lane >> 3) + 8 * j; const LAS float* s = scr + (8 * c) * 33 + n;
        v4u o; o.x = pk2(s[0 * 33], s[1 * 33]); o.y = pk2(s[2 * 33], s[3 * 33]); o.z = pk2(s[4 * 33], s[5 * 33]); o.w = pk2(s[6 * 33], s[7 * 33]);
        *(GAS v4u*)(WT + (size_t)(drow0 + n) * K + k0 + 8 * c) = o; }
    LDS_WAIT(); asm volatile("" ::: "memory");
}
__device__ __forceinline__ unsigned pk4_fp8(float a, float b, float c, float d) { int p = __builtin_amdgcn_cvt_pk_fp8_f32(a, b, 0, false); p = __builtin_amdgcn_cvt_pk_fp8_f32(c, d, p, true); return (unsigned)p; }
__device__ __forceinline__ void tr_item_fp8(const float* W, int ldw, int k0, int src0, unsigned char* WT, int K, int drow0, float sc, LAS float* scr, int lane) {
    { float tmp[32]; const float* wp = W + (size_t)(k0 + (lane >> 5)) * ldw + src0 + (lane & 31);
#pragma unroll
      for (int i = 0; i < 32; ++i) tmp[i] = __builtin_nontemporal_load(wp + (size_t)(2 * i) * ldw);
#pragma unroll
      for (int i = 0; i < 32; ++i) scr[(2 * i + (lane >> 5)) * 33 + (lane & 31)] = tmp[i] * sc; }
    LDS_WAIT(); asm volatile("" ::: "memory");
    const int c = lane & 3;
#pragma unroll
    for (int j = 0; j < 2; ++j) { const int n = (lane >> 2) + 16 * j; const LAS float* s = scr + (16 * c) * 33 + n;
        v4u o;
#pragma unroll
        for (int q = 0; q < 4; ++q) o[q] = pk4_fp8(s[(4 * q) * 33], s[(4 * q + 1) * 33], s[(4 * q + 2) * 33], s[(4 * q + 3) * 33]);
        *(GAS v4u*)(WT + (size_t)(drow0 + n) * K + k0 + 16 * c) = o; }
    LDS_WAIT(); asm volatile("" ::: "memory");
}
__device__ __forceinline__ int win_src0(int ng) {
    const int pn = ng >> 3, gi = ng & 7, bj = gi >> 2, wc = gi & 3;
    if (pn < 6) return pn * 256 + gi * 32;
    if (pn < 10) { const int base = (pn < 8) ? 1552 : 2064; const int gq = 4 * ((pn - 6) & 1) + wc; return base + 64 * gq + 32 * bj; }
    return 2576 + (pn - 10) * 256 + gi * 32;
}
__device__ __forceinline__ void p0_phase(Frame& F) {
    LAS float* scr = (LAS float*)(F.lds + F.wave * 16384);
    const int gw = F.vcu * NWAVES + F.wave, NGW = F.G * NWAVES, lane = F.lane;
    for (int it = gw; it < 768; it += NGW) {
        const int cg = it % 96, ks = it / 96, j = cg * 64 + lane;
#pragma unroll
        for (int q = 0; q < 8; ++q) { const int idx = q * 64 + lane, b = idx >> 7, kk = idx & 127; const float cv = F.c[b * 1024 + ks * 128 + kk]; scr[idx] = cv * sigmoidf_(cv); }
        LDS_WAIT(); asm volatile("" ::: "memory");
        float a0 = 0.f, a1 = 0.f, a2 = 0.f, a3 = 0.f;
        const float* wp = F.w_ada + (size_t)(ks * 128) * 6144 + j;
#pragma unroll 16
        for (int kk = 0; kk < 128; ++kk) { const float w = wp[(size_t)kk * 6144]; a0 += scr[kk] * w; a1 += scr[128 + kk] * w; a2 += scr[256 + kk] * w; a3 += scr[384 + kk] * w; }
        float* mp = wsp<float>(F, WS_MODP) + (size_t)(ks * 4) * 6144 + j;
        mp[0] = a0; mp[6144] = a1; mp[2 * 6144] = a2; mp[3 * 6144] = a3;
        LDS_WAIT(); asm volatile("" ::: "memory");
    }
    constexpr int I_IN = 96 * 16, I_OUT = 32 * 16, I_GU = 32 * 64 * 16, I_D = 32 * 32 * 16;
    constexpr int NITEMS = I_IN + I_OUT + I_GU + I_D;
    for (int it = gw; it < NITEMS; it += NGW) {
        int r = it;
        if (r < I_IN) { const int kb = r / 96, ng = r % 96; tr_item(F.w_in, INW, kb * 64, win_src0(ng), wsp<bf16>(F, WS_WIN), 1024, ng * 32, scr, lane); continue; } r -= I_IN;
        if (r < I_OUT) { const int kb = r / 32, ng = r % 32; tr_item(F.w_out, 1024, kb * 64, ng * 32, wsp<bf16>(F, WS_WOUT), 1024, ng * 32, scr, lane); continue; } r -= I_OUT;
        if (r < I_GU) { const int e = r / 1024, q = r % 1024, kb = q / 64, dg = q % 64, pn = dg >> 3, gi = dg & 7, bj = gi >> 2, j32 = gi & 3;
            tr_item_fp8(F.w_gate_up + (size_t)e * 1024 * 2048, 2048, kb * 64, bj * 1024 + pn * 128 + j32 * 32, wsp<unsigned char>(F, WS_WGU) + (size_t)e * 2048 * 1024, 1024, dg * 32, WSCALE, scr, lane); continue; } r -= I_GU;
        { const int e = r / 512, q = r % 512, kb = q / 32, ng = q % 32;
            tr_item_fp8(F.w_down + (size_t)e * 1024 * 1024, 1024, kb * 64, ng * 32, wsp<unsigned char>(F, WS_WD) + (size_t)e * 1024 * 1024, 1024, ng * 32, WSCALE, scr, lane); }
    }
}

__device__ __forceinline__ f32x4 mod_from_partials(const Frame& F, int b, int col) {
    const float* mp = wsp<const float>(F, WS_MODP) + (size_t)b * 6144 + col;
    f32x4 s = *(const f32x4*)(F.b_ada + col);
#pragma unroll
    for (int ks = 0; ks < 8; ++ks) s += *(const f32x4*)(mp + (size_t)ks * 4 * 6144);
    return s;
}
__device__ __forceinline__ void p1_phase(Frame& F) {
    const int tid = F.tid, lane = F.lane;
    LAS float* wlo = (LAS float*)(F.lds);
    LAS float* wup = (LAS float*)(F.lds + 65536);
    LAS float* bup = (LAS float*)(F.lds + 65536 + 16384);
    for (int idx = tid; idx < 16384; idx += 512) { const int k = idx >> 4, r = idx & 15; wlo[r * 1024 + k] = F.w_in[(size_t)k * INW + 1536 + r]; }
    for (int idx = tid; idx < 4096; idx += 512) wup[idx] = F.w_gk_up[idx];
    if (tid < 256) bup[tid] = F.b_gk_up[tid];
    { const int gt = F.vcu * 512 + tid; if (gt < 4 * 6144 / 4) { const int i = gt * 4, b = i / 6144, col = i % 6144; *(f32x4*)(wsp<float>(F, WS_MOD) + i) = mod_from_partials(F, b, col); } }
    __syncthreads();
    const int gw = F.vcu * NWAVES + F.wave, NGW = F.G * NWAVES;
    const int rpw = (T + NGW - 1) / NGW;
    int curb = -1; f32x4 gsc[4], shv[4], nx[4];
    { const int m0 = (gw * rpw < T) ? gw * rpw : 0; const GAS f32x4* xr = (const GAS f32x4*)(F.x + (size_t)m0 * D) + lane;
#pragma unroll
      for (int j = 0; j < 4; ++j) nx[j] = xr[64 * j]; }
#pragma nounroll
    for (int i = 0; i < rpw; ++i) {
        const int m = gw * rpw + i; if (m >= T) break;
        const int b = m / SEQ;
        if (b != curb) { curb = b;
#pragma unroll
            for (int j = 0; j < 4; ++j) { const int col = 256 * j + 4 * lane; const f32x4 g = *(const f32x4*)(F.g_norm1 + col);
                shv[j] = mod_from_partials(F, b, col); gsc[j] = g * (mod_from_partials(F, b, 1024 + col) + 1.0f); } }
        f32x4 v[4]; float s = 0.f;
#pragma unroll
        for (int j = 0; j < 4; ++j) { v[j] = nx[j]; s += (v[j].x * v[j].x + v[j].y * v[j].y) + (v[j].z * v[j].z + v[j].w * v[j].w); }
        { const int m2 = (m + 1 < T) ? m + 1 : m; const GAS f32x4* xr = (const GAS f32x4*)(F.x + (size_t)m2 * D) + lane;
#pragma unroll
          for (int j = 0; j < 4; ++j) nx[j] = xr[64 * j]; }
        const float rstd = rsqrtf(wave_sum(s) * (1.f / D) + EPS);
        GAS v2u* o8 = (GAS v2u*)(wsp<bf16>(F, WS_XN) + (size_t)m * D) + lane;
#pragma unroll
        for (int j = 0; j < 4; ++j) { v[j] = v[j] * rstd * gsc[j] + shv[j]; v2u o; o.x = pk2(v[j].x, v[j].y); o.y = pk2(v[j].z, v[j].w); o8[64 * j] = o; }
        float part[16];
#pragma unroll
        for (int r = 0; r < 16; ++r) { float a = 0.f;
#pragma unroll
            for (int j = 0; j < 4; ++j) { const f32x4 w = *(const LAS f32x4*)(wlo + r * 1024 + 256 * j + 4 * lane); a += (v[j].x * w.x + v[j].y * w.y) + (v[j].z * w.z + v[j].w * w.w); }
            part[r] = a; if ((r & 3) == 3) asm volatile("" ::: "memory"); }
        const float tot = xreduce<16>(part, lane);
        f32x4 z = *(const LAS f32x4*)(bup + 4 * lane);
#pragma unroll
        for (int r = 0; r < 16; ++r) z += *(const LAS f32x4*)(wup + r * 256 + 4 * lane) * lane_bcast(tot, 4 * r);
        f32x4 gk;
#pragma unroll
        for (int q = 0; q < 4; ++q) { const float zz = z[q]; gk[q] = (fminf(zz, 0.f) - log1pf(__expf(-fabsf(zz)))) * (1.f / 16.f); }
        *(GAS f32x4*)(wsp<float>(F, WS_GK) + (size_t)m * 256 + 4 * lane) = gk;
    }
}

using pg8::Unit;
typedef pg8::f32x4 af4;
struct EpiInProj {
    static constexpr bool PERM = true;
    bf16 *QG, *KG, *VG, *RG, *QD, *KD, *VD; const float *gq, *gk;
    __device__ __forceinline__ void operator()(const af4 (&acc)[2][2][4][2], const Unit& u, int wr, int wc, int fr, int fq) const {
        const int pn = u.pn; const int row0 = u.pm * 256 + wr * 64 + fr;
        if (pn >= 6 && pn < 10) {
            const bool isq = pn < 8; bf16* base = isq ? QD : KD; const float* g = isq ? gq : gk; const float sc = isq ? C2 : 1.f;
            const int grp = 4 * ((pn - 6) & 1) + wc;
            af4 gv[2][2];
#pragma unroll
            for (int bj = 0; bj < 2; ++bj)
#pragma unroll
                for (int n = 0; n < 2; ++n) gv[bj][n] = *(const af4*)(g + 32 * bj + 8 * fq + 4 * n) * sc;
#pragma unroll
            for (int ai = 0; ai < 2; ++ai)
#pragma unroll
                for (int m = 0; m < 4; ++m) {
                    float ss = 0.f;
#pragma unroll
                    for (int bj = 0; bj < 2; ++bj)
#pragma unroll
                        for (int n = 0; n < 2; ++n) { const af4 v = acc[ai][bj][m][n]; ss += (v[0] * v[0] + v[1] * v[1]) + (v[2] * v[2] + v[3] * v[3]); }
                    ss += __shfl_xor(ss, 16); ss += __shfl_xor(ss, 32);
                    const float rs = rsqrtf(ss * (1.f / 64.f) + EPS);
                    bf16* rowp = base + (size_t)(row0 + ai * 128 + m * 16) * 512 + grp * 64 + 8 * fq;
#pragma unroll
                    for (int bj = 0; bj < 2; ++bj) { const af4 v0 = acc[ai][bj][m][0] * rs * gv[bj][0], v1 = acc[ai][bj][m][1] * rs * gv[bj][1];
                        pg8::u32x4 w; w.x = pg8::cvt_pk_bf16(v0[0], v0[1]); w.y = pg8::cvt_pk_bf16(v0[2], v0[3]); w.z = pg8::cvt_pk_bf16(v1[0], v1[1]); w.w = pg8::cvt_pk_bf16(v1[2], v1[3]);
                        *(pg8::u32x4*)(rowp + 32 * bj) = w; }
                }
        } else {
            bf16* base; int pitch, colt; int act = 0;
            if (pn == 0) { base = QG; pitch = 256; colt = 0; act = 1; }
            else if (pn == 1) { base = KG; pitch = 256; colt = 0; }
            else if (pn < 4) { base = VG; pitch = 512; colt = (pn - 2) * 256; }
            else if (pn < 6) { base = RG; pitch = 512; colt = (pn - 4) * 256; act = 2; }
            else { base = VD; pitch = 512; colt = (pn - 10) * 256; }
            const int col0 = colt + wc * 32 + 8 * fq;
#pragma unroll
            for (int ai = 0; ai < 2; ++ai)
#pragma unroll
                for (int m = 0; m < 4; ++m) { bf16* rowp = base + (size_t)(row0 + ai * 128 + m * 16) * pitch + col0;
#pragma unroll
                    for (int bj = 0; bj < 2; ++bj) { af4 v0 = acc[ai][bj][m][0], v1 = acc[ai][bj][m][1];
                        if (act == 1) { v0 = v0 * 0.125f; v1 = v1 * 0.125f; }
                        if (act == 2) {
#pragma unroll
                            for (int q = 0; q < 4; ++q) { v0[q] = v0[q] * sigmoidf_(v0[q]); v1[q] = v1[q] * sigmoidf_(v1[q]); } }
                        pg8::u32x4 w; w.x = pg8::cvt_pk_bf16(v0[0], v0[1]); w.y = pg8::cvt_pk_bf16(v0[2], v0[3]); w.z = pg8::cvt_pk_bf16(v1[0], v1[1]); w.w = pg8::cvt_pk_bf16(v1[2], v1[3]);
                        *(pg8::u32x4*)(rowp + bj * 128) = w; } }
        }
    }
};
struct EpiOutProj {
    static constexpr bool PERM = true;
    bf16* mix; const float* mod;
    __device__ __forceinline__ void operator()(const af4 (&acc)[2][2][4][2], const Unit& u, int wr, int wc, int fr, int fq) const {
        const int b = (u.pm * 256) / SEQ; const int col0 = u.pn * 256 + wc * 32 + 8 * fq;
        af4 gt[2][2];
#pragma unroll
        for (int bj = 0; bj < 2; ++bj)
#pragma unroll
            for (int n = 0; n < 2; ++n) gt[bj][n] = *(const af4*)(mod + (size_t)b * 6144 + 2048 + col0 + bj * 128 + 4 * n);
#pragma unroll
        for (int ai = 0; ai < 2; ++ai)
#pragma unroll
            for (int m = 0; m < 4; ++m) { bf16* rowp = mix + (size_t)(u.pm * 256 + ai * 128 + wr * 64 + m * 16 + fr) * D + col0;
#pragma unroll
                for (int bj = 0; bj < 2; ++bj) { const af4 v0 = acc[ai][bj][m][0] * gt[bj][0], v1 = acc[ai][bj][m][1] * gt[bj][1];
                    pg8::u32x4 w; w.x = pg8::cvt_pk_bf16(v0[0], v0[1]); w.y = pg8::cvt_pk_bf16(v0[2], v0[3]); w.z = pg8::cvt_pk_bf16(v1[0], v1[1]); w.w = pg8::cvt_pk_bf16(v1[2], v1[3]);
                    *(pg8::u32x4*)(rowp + bj * 128) = w; } }
    }
};
struct EpiSwiGLU {
    static constexpr bool PERM = false;
    unsigned char* Y; const float* bgu;
    __device__ __forceinline__ void operator()(const af4 (&acc)[2][2][4][2], const Unit& u, int wr, int wc, int fr, int fq) const {
        const int f0 = u.pn * 128 + wc * 32 + 4 * fq; const float* bb = bgu + (size_t)u.e * 2048 + f0;
        af4 bg[2], bu[2];
#pragma unroll
        for (int n = 0; n < 2; ++n) { bg[n] = *(const af4*)(bb + 16 * n); bu[n] = *(const af4*)(bb + 1024 + 16 * n); }
#pragma unroll
        for (int ai = 0; ai < 2; ++ai)
#pragma unroll
            for (int m = 0; m < 4; ++m) { unsigned char* rowp = Y + (size_t)(u.pm * 256 + ai * 128 + wr * 64 + m * 16 + fr) * FF + f0;
#pragma unroll
                for (int n = 0; n < 2; ++n) { const af4 g = acc[ai][0][m][n] * WSCALE_INV + bg[n], up = acc[ai][1][m][n] * WSCALE_INV + bu[n]; af4 y;
#pragma unroll
                    for (int q = 0; q < 4; ++q) { const float gg = fminf(g[q], 7.f), uu = fminf(fmaxf(up[q], -7.f), 7.f); y[q] = (uu + 1.f) * gg * sigmoidf_(1.702f * gg); }
                    *(unsigned*)(rowp + 16 * n) = pk4_fp8(y[0], y[1], y[2], y[3]); } }
    }
};
struct EpiDown {
    static constexpr bool PERM = true;
    unsigned char* Cn; const float* bd;
    __device__ __forceinline__ void operator()(const af4 (&acc)[2][2][4][2], const Unit& u, int wr, int wc, int fr, int fq) const {
        const int col0 = u.pn * 256 + wc * 32 + 8 * fq; const float* bb = bd + (size_t)u.e * 1024 + col0;
        af4 bv[2][2];
#pragma unroll
        for (int bj = 0; bj < 2; ++bj)
#pragma unroll
            for (int n = 0; n < 2; ++n) bv[bj][n] = *(const af4*)(bb + bj * 128 + 4 * n);
#pragma unroll
        for (int ai = 0; ai < 2; ++ai)
#pragma unroll
            for (int m = 0; m < 4; ++m) { const int row = u.pm * 256 + ai * 128 + wr * 64 + m * 16 + fr; unsigned char* rowp = Cn + (size_t)row * 1024 + col0;
#pragma unroll
                for (int bj = 0; bj < 2; ++bj) { const af4 v0 = acc[ai][bj][m][0] * WSCALE_INV + bv[bj][0], v1 = acc[ai][bj][m][1] * WSCALE_INV + bv[bj][1];
                    v2u w; w.x = pk4_fp8(v0[0], v0[1], v0[2], v0[3]); w.y = pk4_fp8(v1[0], v1[1], v1[2], v1[3]); *(v2u*)(rowp + bj * 128) = w; } }
    }
};

typedef float cf4 __attribute__((ext_vector_type(4)));
#define MFMA16(a, b, c) __builtin_amdgcn_mfma_f32_16x16x32_bf16((a), (b), (c), 0, 0, 0)
constexpr int GP = 72;
__device__ __forceinline__ void gla_a_unit(Frame& F, int chunk) {
    const int tid = F.tid, lane = F.lane, w = F.wave;
    const int bh = chunk >> 7, n = chunk & 127, b = bh >> 2, h = bh & 3;
    const size_t R0 = (size_t)b * SEQ + (size_t)n * 64;
    LAS float* gc = (LAS float*)F.lds;
    LAS float* segt = (LAS float*)(F.lds + 16384);
    LAS bf16* QEs = (LAS bf16*)(F.lds + 18432);
    LAS bf16* KEs = (LAS bf16*)(F.lds + 18432 + 9216);
    LAS bf16* KST = (LAS bf16*)(F.lds + 18432 + 2 * 9216);
    LAS bf16* VT = (LAS bf16*)(F.lds + 18432 + 3 * 9216);
    LAS bf16* AM = (LAS bf16*)(F.lds + 18432 + 3 * 9216 + 18432);
    const float* GK = wsp<const float>(F, WS_GK);
    { const int r = tid >> 3, d0 = (tid & 7) * 8; const float* gp = GK + (R0 + r) * 256 + h * 64 + d0;
      *(LAS f32x4*)(gc + r * 64 + d0) = *(const f32x4*)gp; *(LAS f32x4*)(gc + r * 64 + d0 + 4) = *(const f32x4*)(gp + 4); }
    __syncthreads();
    { const int seg = tid >> 6, d = tid & 63; float run = 0.f;
#pragma unroll
      for (int i = 0; i < 8; ++i) { run += gc[(seg * 8 + i) * 64 + d]; gc[(seg * 8 + i) * 64 + d] = run; }
      segt[seg * 64 + d] = run; }
    __syncthreads();
    { const int seg = tid >> 6, d = tid & 63; float off = 0.f;
      for (int s2 = 0; s2 < seg; ++s2) off += segt[s2 * 64 + d];
#pragma unroll
      for (int i = 0; i < 8; ++i) gc[(seg * 8 + i) * 64 + d] += off; }
    __syncthreads();
    { const int r = tid >> 3, d0 = (tid & 7) * 8;
      const v4u qv = *(const v4u*)(wsp<const bf16>(F, WS_QG) + (R0 + r) * 256 + h * 64 + d0);
      const v4u kv = *(const v4u*)(wsp<const bf16>(F, WS_KG) + (R0 + r) * 256 + h * 64 + d0);
      float qf[8], kf[8];
#pragma unroll
      for (int i = 0; i < 4; ++i) { qf[2 * i] = bflo(qv[i]); qf[2 * i + 1] = bfhi(qv[i]); kf[2 * i] = bflo(kv[i]); kf[2 * i + 1] = bfhi(kv[i]); }
      float qe[8], ke[8];
#pragma unroll
      for (int i = 0; i < 8; ++i) { const float g = gc[r * 64 + d0 + i], gl = gc[63 * 64 + d0 + i];
          qe[i] = qf[i] * __expf(g); ke[i] = kf[i] * __expf(-g); KST[(d0 + i) * GP + r] = (bf16)f2bf(kf[i] * __expf(gl - g)); }
      v4u qo, ko;
#pragma unroll
      for (int i = 0; i < 4; ++i) { qo[i] = pk2(qe[2 * i], qe[2 * i + 1]); ko[i] = pk2(ke[2 * i], ke[2 * i + 1]); }
      *(LAS v4u*)(QEs + r * GP + d0) = qo; *(LAS v4u*)(KEs + r * GP + d0) = ko;
      *(v4u*)(wsp<bf16>(F, WS_QE) + (R0 + r) * 256 + h * 64 + d0) = qo;
      const int e0 = (tid & 7) * 16;
      const v4u va = *(const v4u*)(wsp<const bf16>(F, WS_VG) + (R0 + r) * 512 + h * 128 + e0);
      const v4u vb = *(const v4u*)(wsp<const bf16>(F, WS_VG) + (R0 + r) * 512 + h * 128 + e0 + 8);
#pragma unroll
      for (int i = 0; i < 4; ++i) { VT[(e0 + 2 * i) * GP + r] = (bf16)(va[i] & 0xffffu); VT[(e0 + 2 * i + 1) * GP + r] = (bf16)(va[i] >> 16);
                                    VT[(e0 + 8 + 2 * i) * GP + r] = (bf16)(vb[i] & 0xffffu); VT[(e0 + 8 + 2 * i + 1) * GP + r] = (bf16)(vb[i] >> 16); }
      if (tid < 64) wsp<float>(F, WS_DEC)[(size_t)chunk * 64 + tid] = __expf(gc[63 * 64 + tid]);
    }
    __syncthreads();
    const int l15 = lane & 15, l4 = lane >> 4;
#pragma unroll
    for (int q = 0; q < 2; ++q) { const int tile = 2 * w + q, ti = tile >> 2, tj = tile & 3;
        cf4 a = {0.f, 0.f, 0.f, 0.f};
        if (tj <= ti) {
#pragma unroll
            for (int kk = 0; kk < 2; ++kk) { const bf16x8 fa = *(const LAS bf16x8*)(QEs + (16 * ti + l15) * GP + kk * 32 + 8 * l4); const bf16x8 fb = *(const LAS bf16x8*)(KEs + (16 * tj + l15) * GP + kk * 32 + 8 * l4); a = MFMA16(fa, fb, a); } }
#pragma unroll
        for (int r = 0; r < 4; ++r) { const int cr = 16 * ti + 4 * l4 + r, cj = 16 * tj + l15; AM[cr * GP + cj] = (bf16)f2bf(cj <= cr ? a[r] : 0.f); } }
    { float* UT = wsp<float>(F, WS_UT) + (size_t)chunk * 8192;
#pragma unroll
      for (int td = 0; td < 4; ++td) { cf4 a = {0.f, 0.f, 0.f, 0.f};
#pragma unroll
          for (int kk = 0; kk < 2; ++kk) { const bf16x8 fa = *(const LAS bf16x8*)(VT + (16 * w + l15) * GP + kk * 32 + 8 * l4); const bf16x8 fb = *(const LAS bf16x8*)(KST + (16 * td + l15) * GP + kk * 32 + 8 * l4); a = MFMA16(fa, fb, a); }
#pragma unroll
          for (int r = 0; r < 4; ++r) UT[(16 * w + 4 * l4 + r) * 64 + 16 * td + l15] = a[r]; } }
    __syncthreads();
    { float* OI = wsp<float>(F, WS_OI);
#pragma unroll
      for (int tc = 0; tc < 4; ++tc) { cf4 a = {0.f, 0.f, 0.f, 0.f};
#pragma unroll
          for (int kk = 0; kk < 2; ++kk) { const bf16x8 fa = *(const LAS bf16x8*)(AM + (16 * tc + l15) * GP + kk * 32 + 8 * l4); const bf16x8 fb = *(const LAS bf16x8*)(VT + (16 * w + l15) * GP + kk * 32 + 8 * l4); a = MFMA16(fa, fb, a); }
#pragma unroll
          for (int r = 0; r < 4; ++r) OI[(R0 + 16 * tc + 4 * l4 + r) * 512 + h * 128 + 16 * w + l15] = a[r]; } }
    __syncthreads();
}
__device__ __forceinline__ void gla_b_phase(Frame& F) {
    const float* UT = wsp<const float>(F, WS_UT); const float* DEC = wsp<const float>(F, WS_DEC); bf16* SP = wsp<bf16>(F, WS_SP);
    for (int gt = F.vcu * 512 + F.tid; gt < 16 * 8192; gt += F.G * 512) {
        const int bh = gt >> 13, ed = gt & 8191, d = gt & 63; float S = 0.f;
#pragma unroll 8
        for (int n = 0; n < 128; ++n) { const size_t ch = (size_t)bh * 128 + n; const float u = UT[ch * 8192 + ed], dc = DEC[ch * 64 + d]; SP[ch * 8192 + ed] = (bf16)f2bf(S); S = S * dc + u; }
    }
}
__device__ __forceinline__ void gla_c_unit(Frame& F, int unit) {
    const int tid = F.tid, lane = F.lane, w = F.wave;
    const int bh = unit >> 6, n2 = unit & 63, b = bh >> 2, h = bh & 3;
    const size_t R0 = (size_t)b * SEQ + (size_t)n2 * 128;
    LAS bf16* QEs = (LAS bf16*)F.lds;
    LAS bf16* SPs = (LAS bf16*)(F.lds + 18432);
    { const int r = tid >> 2, d0 = (tid & 3) * 16; const bf16* src = wsp<const bf16>(F, WS_QE) + (R0 + r) * 256 + h * 64 + d0;
      *(LAS v4u*)(QEs + r * GP + d0) = *(const v4u*)src; *(LAS v4u*)(QEs + r * GP + d0 + 8) = *(const v4u*)(src + 8);
      const bf16* sp = wsp<const bf16>(F, WS_SP) + ((size_t)bh * 128 + 2 * n2) * 8192;
      const int row = tid >> 1, dd = (tid & 1) * 32;
#pragma unroll
      for (int i = 0; i < 4; ++i) *(LAS v4u*)(SPs + row * GP + dd + 8 * i) = *(const v4u*)(sp + (size_t)row * 64 + dd + 8 * i); }
    __syncthreads();
    const int l15 = lane & 15, l4 = lane >> 4, c2 = w >> 2, tc = w & 3;
    cf4 a[8];
#pragma unroll
    for (int te = 0; te < 8; ++te) { a[te] = (cf4){0.f, 0.f, 0.f, 0.f};
#pragma unroll
        for (int kk = 0; kk < 2; ++kk) { const bf16x8 fa = *(const LAS bf16x8*)(QEs + (64 * c2 + 16 * tc + l15) * GP + kk * 32 + 8 * l4); const bf16x8 fb = *(const LAS bf16x8*)(SPs + (128 * c2 + 16 * te + l15) * GP + kk * 32 + 8 * l4); a[te] = MFMA16(fa, fb, a[te]); } }
    const float* OI = wsp<const float>(F, WS_OI); const bf16* RG = wsp<const bf16>(F, WS_RG); bf16* A2 = wsp<bf16>(F, WS_A2);
    float gg[8];
#pragma unroll
    for (int te = 0; te < 8; ++te) gg[te] = F.g_gla_out[16 * te + l15];
#pragma unroll
    for (int r = 0; r < 4; ++r) { const size_t row = R0 + 64 * c2 + 16 * tc + 4 * l4 + r; float ss = 0.f; float o[8];
#pragma unroll
        for (int te = 0; te < 8; ++te) { o[te] = a[te][r] + OI[row * 512 + h * 128 + 16 * te + l15]; ss += o[te] * o[te]; }
        ss += __shfl_xor(ss, 1); ss += __shfl_xor(ss, 2); ss += __shfl_xor(ss, 4); ss += __shfl_xor(ss, 8);
        const float rs = rsqrtf(ss * (1.f / 128.f) + EPS);
#pragma unroll
        for (int te = 0; te < 8; ++te) { const int e = 16 * te + l15; A2[row * 1024 + h * 128 + e] = (bf16)f2bf(o[te] * rs * gg[te] * bf2f(RG[row * 512 + h * 128 + e])); } }
    __syncthreads();
}

namespace att {
constexpr int KSLOT = 8192, VSLOT = 16384, NSLOT = 3;
constexpr int LDS_K = 0, LDS_V = NSLOT * KSLOT, LDS_TBL = LDS_V + NSLOT * VSLOT, LDS_WS = LDS_TBL + 1024, LDS_Q = LDS_WS + 8 * 256, LDS_END = LDS_Q + 8 * 4096;
static_assert(LDS_END <= RING_BYTES, "attention LDS");
__device__ __forceinline__ int crow(int r, int hi) { return (r & 3) + 8 * (r >> 2) + 4 * hi; }
__device__ __forceinline__ void glds16(const void* gsrc, unsigned lds_dst) { unsigned keep;
    asm volatile("s_mov_b32 %0, m0\n\ts_mov_b32 m0, %2\n\ts_nop 0\n\tglobal_load_lds_dwordx4 %1, off\n\ts_mov_b32 m0, %0" : "=&s"(keep) : "v"(gsrc), "s"(lds_dst) : "memory"); }
typedef float f32x2_t __attribute__((ext_vector_type(2))); typedef __bf16 bf16x2_t __attribute__((ext_vector_type(2)));
__device__ __forceinline__ unsigned cvtpk_s(float lo, float hi) { f32x2_t v = {lo, hi}; bf16x2_t b = __builtin_convertvector(v, bf16x2_t); return __builtin_bit_cast(unsigned, b); }
typedef short v4i16_t __attribute__((ext_vector_type(4)));
typedef LAS const char* lds_cptr;
__device__ __forceinline__ s16x4 vtr(lds_cptr p) { return __builtin_bit_cast(s16x4, __builtin_amdgcn_ds_read_tr16_b64_v4i16((LAS v4i16_t*)p)); }
#define MFMA32(a, b, c) __builtin_amdgcn_mfma_f32_32x32x16_bf16((a), (b), (c), 0, 0, 0)
#define ATT_WAIT_BAR(N) asm volatile("s_waitcnt vmcnt(" #N ") lgkmcnt(0)\n\ts_barrier" ::: "memory")

__device__ __forceinline__ void attn_map(f32x16 (&o)[4], int b, int h, int m, int qb, const bf16* QD, const bf16* KD, const bf16* VD, LAS unsigned char* shm) {
    int lane = threadIdx.x & 63; asm volatile("" : "+v"(lane));
    const int tid = threadIdx.x, r32 = lane & 31, hi = lane >> 5; const int wid = __builtin_amdgcn_readfirstlane(tid >> 6);
    const size_t rowbase = (size_t)b * SEQ; const int q0 = qb * 256;
    const bf16* Qw = QD + (rowbase + q0 + wid * 32) * 512 + (h * 2 + m) * 64;
    const bf16* Kh = KD + rowbase * 512 + (h * 2 + m) * 64; const bf16* Vh = VD + rowbase * 512 + h * 128;
    const unsigned lds0 = (unsigned)(uintptr_t)shm;
    const LAS float* tbl = (const LAS float*)(shm + LDS_TBL) + m * 128;
    LAS float* wsf = (LAS float*)(shm + LDS_WS) + wid * 64;
    const bf16* ksrc = Kh + (size_t)lane * 512 + wid * 8;
    const bf16* vsrc = Vh + (size_t)(16 * (wid & 3) + (lane >> 2)) * 512 + (wid >> 2) * 32 + (lane & 3) * 8;
    const unsigned kdst = lds0 + LDS_K + wid * 1024, vdst = lds0 + LDS_V + wid * 1024;
#define DMA_K(t, slot) glds16(ksrc + (size_t)(t) * 64 * 512, (unsigned)__builtin_amdgcn_readfirstlane(kdst + (slot) * KSLOT))
#define DMA_V(t, slot) do { glds16(vsrc + (size_t)(t) * 64 * 512, (unsigned)__builtin_amdgcn_readfirstlane(vdst + (slot) * VSLOT)); \
        glds16(vsrc + (size_t)(t) * 64 * 512 + 64, (unsigned)__builtin_amdgcn_readfirstlane(vdst + (slot) * VSLOT + 8192)); } while (0)
    const int NT = 4 * qb + 4;
    VM_WAIT();
    DMA_K(0, 0); DMA_V(0, 0); DMA_K(1, 1); DMA_K(2, 2);
    const lds_cptr qlds = (lds_cptr)shm + LDS_Q + wid * 4096 + lane * 16;
    { bf16x8 qr[4];
#pragma unroll
      for (int d0 = 0; d0 < 4; ++d0) qr[d0] = *(const bf16x8*)(Qw + (size_t)r32 * 512 + d0 * 16 + hi * 8);
      asm volatile("s_waitcnt vmcnt(0)" : "+v"(qr[0]), "+v"(qr[1]), "+v"(qr[2]), "+v"(qr[3]) :: "memory");
#pragma unroll
      for (int d0 = 0; d0 < 4; ++d0) *(LAS bf16x8*)(shm + LDS_Q + wid * 4096 + lane * 16 + d0 * 1024) = qr[d0]; }
#pragma unroll
    for (int d0 = 0; d0 < 4; ++d0) o[d0] = (f32x16){};
    float lsum = 0.f;
    const int qw0 = q0 + wid * 32, qabs = qw0 + r32;
    const lds_cptr shm3 = (lds_cptr)shm;
    const lds_cptr kp0 = shm3 + LDS_K + hi * 1024 + r32 * 16;
    const lds_cptr vp0 = shm3 + LDS_V + ((lane >> 4) & 1) * 32 + (lane & 3) * 8 + (4 * hi + ((lane & 15) >> 2)) * 64;
#define QK_TILE(C0, C1, kp) do { C0 = (f32x16){}; C1 = (f32x16){}; \
        _Pragma("unroll") for (int d0 = 0; d0 < 4; ++d0) { if (d0 == 2) __builtin_amdgcn_sched_barrier(0); const bf16x8 b0 = *(const LAS bf16x8*)((kp) + d0 * 2048); const bf16x8 b1 = *(const LAS bf16x8*)((kp) + d0 * 2048 + 512); \
            const bf16x8 qf_ = *(const LAS bf16x8*)(qlds + d0 * 1024); C0 = MFMA32(b0, qf_, C0); C1 = MFMA32(b1, qf_, C1); } } while (0)
#define MASK_BIAS(C0, C1, t) do { const int kvb_ = (t) * 64; if (kvb_ + 191 > qw0) { int dbase = qabs - kvb_ - 4 * hi; asm volatile("" : "+v"(dbase)); \
        _Pragma("unroll") for (int r = 0; r < 16; ++r) { const int d0_ = dbase - ((r & 3) + 8 * (r >> 2)); const int d1_ = d0_ - 32; \
            C0[r] = d0_ < 0 ? -INFINITY : C0[r] + tbl[d0_ > 127 ? 127 : d0_]; C1[r] = d1_ < 0 ? -INFINITY : C1[r] + tbl[d1_ > 127 ? 127 : d1_]; } } } while (0)
#define VLOAD(vf, vp, d0) do { _Pragma("unroll") for (int ks = 0; ks < 4; ++ks) { const s16x4 lo_ = vtr((vp) + (d0) * 4096 + ks * 1024), hh_ = vtr((vp) + (d0) * 4096 + ks * 1024 + 512); \
            vf[ks] = (bf16x8){lo_[0], lo_[1], lo_[2], lo_[3], hh_[0], hh_[1], hh_[2], hh_[3]}; } } while (0)
#define PV4(d0, vf) do { _Pragma("unroll") for (int ks = 0; ks < 4; ++ks) o[d0] = MFMA32(__builtin_bit_cast(bf16x8, pw[ks]), vf[ks], o[d0]); } while (0)
#define PACK_SUM(P0, P1) do { float sacc = 0.f; _Pragma("unroll") for (int r = 0; r < 16; ++r) sacc += P0[r] + P1[r]; lsum += sacc; \
        _Pragma("unroll") for (int i = 0; i < 4; ++i) { pw[0][i] = cvtpk_s(P0[2 * i], P0[2 * i + 1]); pw[1][i] = cvtpk_s(P0[8 + 2 * i], P0[9 + 2 * i]); pw[2][i] = cvtpk_s(P1[2 * i], P1[2 * i + 1]); pw[3][i] = cvtpk_s(P1[8 + 2 * i], P1[9 + 2 * i]); } } while (0)
#define EXP_PACK(C, pwa, pwb) do { float sacc = 0.f; _Pragma("unroll") for (int r = 0; r < 16; ++r) { C[r] = __builtin_amdgcn_exp2f(C[r]); sacc += C[r]; } lsum += sacc; \
        _Pragma("unroll") for (int i = 0; i < 4; ++i) { pwa[i] = cvtpk_s(C[2 * i], C[2 * i + 1]); pwb[i] = cvtpk_s(C[8 + 2 * i], C[9 + 2 * i]); } } while (0)
#define KLOAD(kf, kp) do { _Pragma("unroll") for (int d0 = 0; d0 < 4; ++d0) { kf[2 * d0] = *(const LAS bf16x8*)((kp) + d0 * 2048); kf[2 * d0 + 1] = *(const LAS bf16x8*)((kp) + d0 * 2048 + 512); } } while (0)
#define QLOAD(qf) do { _Pragma("unroll") for (int d0 = 0; d0 < 4; ++d0) qf[d0] = *(const LAS bf16x8*)(qlds + d0 * 1024); } while (0)
#define QK8(C0, C1, kf, qf) do { C0 = (f32x16){}; C1 = (f32x16){}; _Pragma("unroll") for (int d0 = 0; d0 < 4; ++d0) { C0 = MFMA32(kf[2 * d0], qf[d0], C0); C1 = MFMA32(kf[2 * d0 + 1], qf[d0], C1); } } while (0)
#define SB() __builtin_amdgcn_sched_barrier(0)
    f32x16 C0, C1; v4u pw[4], pwn[4]; bf16x8 va[4], vb[4], kf[8], qf[4];
    ATT_WAIT_BAR(0);
    KLOAD(kf, kp0); QLOAD(qf);
    ATT_WAIT_BAR(0);
    if (3 < NT) DMA_K(3, 0);
    DMA_V(1, 1);
    QK8(C0, C1, kf, qf);
    MASK_BIAS(C0, C1, 0);
    EXP_PACK(C0, pw[0], pw[1]); EXP_PACK(C1, pw[2], pw[3]);
    KLOAD(kf, kp0 + KSLOT);
    int ks_cur = 1, vs_prev = 0;
    for (int t = 1; t < NT; ++t) {
        if (t + 2 < NT) { ATT_WAIT_BAR(3); } else { ATT_WAIT_BAR(2); }
        { const int vs_new = (vs_prev == 0) ? 2 : vs_prev - 1;
          if (t + 3 < NT) DMA_K(t + 3, ks_cur);
          if (t + 1 < NT) DMA_V(t + 1, vs_new); }
        const int ks_next = (ks_cur == 2) ? 0 : ks_cur + 1;
        const lds_cptr vp = vp0 + vs_prev * VSLOT;
        SB();
        VLOAD(va, vp, 0); VLOAD(vb, vp, 1); QLOAD(qf);
        SB();
        QK8(C0, C1, kf, qf);
        SB();
        MASK_BIAS(C0, C1, t);
        SB();
        PV4(0, va); PV4(1, vb);
        EXP_PACK(C0, pwn[0], pwn[1]);
        SB();
        VLOAD(va, vp, 2); VLOAD(vb, vp, 3);
        KLOAD(kf, kp0 + ks_next * KSLOT);
        SB();
        PV4(2, va); PV4(3, vb);
        EXP_PACK(C1, pwn[2], pwn[3]);
        SB();
#pragma unroll
        for (int i = 0; i < 4; ++i) pw[i] = pwn[i];
        ks_cur = ks_next; vs_prev = (vs_prev == 2) ? 0 : vs_prev + 1;
    }
    ATT_WAIT_BAR(0);
    { const lds_cptr vp = vp0 + vs_prev * VSLOT;
      VLOAD(va, vp, 0); VLOAD(vb, vp, 1); PV4(0, va); PV4(1, vb);
      VLOAD(va, vp, 2); VLOAD(vb, vp, 3); PV4(2, va); PV4(3, vb); }
    { auto rr = __builtin_amdgcn_permlane32_swap(__float_as_uint(lsum), __float_as_uint(lsum), false, false); lsum = __uint_as_float(rr[0]) + __uint_as_float(rr[1]); }
    if (hi == 0) wsf[r32] = lsum;
    LDS_WAIT();
#pragma unroll
    for (int r = 0; r < 16; ++r) { const float rl = 1.0f / wsf[crow(r, hi)];
#pragma unroll
        for (int d0 = 0; d0 < 4; ++d0) o[d0][r] *= rl; }
    ATT_WAIT_BAR(0);
#undef DMA_K
#undef DMA_V
#undef QK_TILE
#undef MASK_BIAS
#undef VLOAD
#undef PV4
#undef PACK_SUM
#undef EXP_PACK
#undef KLOAD
#undef QLOAD
#undef QK8
#undef SB
}
__device__ __forceinline__ int t5_bucket(int n) {
    if (n < 16) return n;
    const float nf = (float)n; int large = 16 + (int)(logf(nf / 16.f) / logf(8.f) * 16.f);
    return large < 31 ? large : 31;
}
__device__ __forceinline__ void attn_unit(Frame& F, int b, int h, int qb, float lam) {
    LAS unsigned char* shm = F.lds;
    int tid = F.tid; asm volatile("" : "+v"(tid));
    const int lane = tid & 63, r32 = lane & 31, hi = lane >> 5, wid = F.wave;
    if (tid < 256) { const int m = tid >> 7, d = tid & 127; const int col = h * 2 + m;
        ((LAS float*)(shm + LDS_TBL))[tid] = (F.rel_bias[t5_bucket(d) * 8 + col] - F.rel_bias[31 * 8 + col]) * LOG2E; }
    __syncthreads();
    const bf16* QD = wsp<const bf16>(F, WS_QD); const bf16* KD = wsp<const bf16>(F, WS_KD); const bf16* VD = wsp<const bf16>(F, WS_VD);
    float* stash = wsp<float>(F, WS_STASH) + (size_t)F.vcu * 32768 + tid * 64;
    f32x16 o[4];
#pragma nounroll
    for (int m = 0; m < 2; ++m) {
        attn_map(o, b, h, m, qb, QD, KD, VD, shm);
        if (m == 0) {
#pragma unroll
            for (int d0 = 0; d0 < 4; ++d0)
#pragma unroll
                for (int r = 0; r < 16; r += 4) *(f32x4*)(stash + d0 * 16 + r) = (f32x4){o[d0][r], o[d0][r + 1], o[d0][r + 2], o[d0][r + 3]};
        } else {
            float ss[16];
#pragma unroll
            for (int r = 0; r < 16; ++r) ss[r] = 0.f;
#pragma unroll
            for (int d0 = 0; d0 < 4; ++d0)
#pragma unroll
                for (int r4 = 0; r4 < 16; r4 += 4) { const f32x4 sv = *(const f32x4*)(stash + d0 * 16 + r4);
#pragma unroll
                    for (int q = 0; q < 4; ++q) { const int r = r4 + q; const float v = sv[q] - lam * o[d0][r]; o[d0][r] = v; ss[r] += v * v; } }
            float gs[4];
#pragma unroll
            for (int d0 = 0; d0 < 4; ++d0) gs[d0] = F.g_subln[32 * d0 + r32] * 0.8f;
            bf16* A2 = wsp<bf16>(F, WS_A2);
            const size_t rowb = (size_t)b * SEQ + (size_t)qb * 256 + wid * 32;
            bf16* a2b = A2 + (rowb + 4 * hi) * 1024 + 512 + h * 128 + r32; asm volatile("" : "+v"(a2b));
#pragma unroll
            for (int r = 0; r < 16; ++r) { float s = ss[r];
                s += __shfl_xor(s, 1); s += __shfl_xor(s, 2); s += __shfl_xor(s, 4); s += __shfl_xor(s, 8); s += __shfl_xor(s, 16);
                const float rs = rsqrtf(s * (1.f / 128.f) + EPS);
                bf16* rowp = a2b + (size_t)((r & 3) + 8 * (r >> 2)) * 1024;
#pragma unroll
                for (int d0 = 0; d0 < 4; ++d0) rowp[32 * d0] = (bf16)f2bf(o[d0][r] * rs * gs[d0]); }
        }
    }
    __syncthreads();
}
}

__device__ __forceinline__ void p7_phase(Frame& F) {
    const int tid = F.tid, lane = F.lane;
    LAS float* wr = (LAS float*)F.lds;
    LAS unsigned* hist = (LAS unsigned*)(F.lds + HIST_OFF);
    for (int idx = tid; idx < 32768; idx += 512) { const int k = idx >> 5, e = idx & 31; wr[e * 1024 + k] = F.w_router[idx]; }
    if (tid < 32) hist[tid] = 0u;
    __syncthreads();
    const float* MOD = wsp<const float>(F, WS_MOD);
    const int gw = F.vcu * NWAVES + F.wave, NGW = F.G * NWAVES; const int rpw = (T + NGW - 1) / NGW;
    int curb = -1; f32x4 gsc[4], shv[4], nx[4];
    v2u nm[4]; const bf16* MIX = wsp<const bf16>(F, WS_MIX);
    { const int m0 = (gw * rpw < T) ? gw * rpw : 0; const GAS f32x4* xr = (const GAS f32x4*)(F.x + (size_t)m0 * D) + lane; const GAS v2u* mr = (const GAS v2u*)(MIX + (size_t)m0 * D) + lane;
#pragma unroll
      for (int j = 0; j < 4; ++j) { nx[j] = xr[64 * j]; nm[j] = mr[64 * j]; } }
#pragma nounroll
    for (int i = 0; i < rpw; ++i) {
        const int m = gw * rpw + i; if (m >= T) break;
        const int b = m / SEQ;
        if (b != curb) { curb = b;
#pragma unroll
            for (int j = 0; j < 4; ++j) { const int col = 256 * j + 4 * lane; const f32x4 g = *(const f32x4*)(F.g_norm2 + col);
                shv[j] = *(const f32x4*)(MOD + (size_t)b * 6144 + 3072 + col); gsc[j] = g * (*(const f32x4*)(MOD + (size_t)b * 6144 + 4096 + col) + 1.0f); } }
        f32x4 v[4]; float s = 0.f;
#pragma unroll
        for (int j = 0; j < 4; ++j) { v[j] = nx[j] + (f32x4){bflo(nm[j].x), bfhi(nm[j].x), bflo(nm[j].y), bfhi(nm[j].y)}; s += (v[j].x * v[j].x + v[j].y * v[j].y) + (v[j].z * v[j].z + v[j].w * v[j].w); }
        { const int m2 = (m + 1 < T) ? m + 1 : m; const GAS f32x4* xr = (const GAS f32x4*)(F.x + (size_t)m2 * D) + lane; const GAS v2u* mr = (const GAS v2u*)(MIX + (size_t)m2 * D) + lane;
#pragma unroll
          for (int j = 0; j < 4; ++j) { nx[j] = xr[64 * j]; nm[j] = mr[64 * j]; } }
        const float rstd = rsqrtf(wave_sum(s) * (1.f / D) + EPS);
        GAS unsigned* o4 = (GAS unsigned*)(wsp<unsigned char>(F, WS_XN) + (size_t)m * D) + lane;
#pragma unroll
        for (int j = 0; j < 4; ++j) { v[j] = v[j] * rstd * gsc[j] + shv[j]; o4[64 * j] = pk4_fp8(v[j].x, v[j].y, v[j].z, v[j].w); }
        float lg[32];
#pragma unroll
        for (int e = 0; e < 32; ++e) { float a = 0.f;
#pragma unroll
            for (int j = 0; j < 4; ++j) { const f32x4 w = *(const LAS f32x4*)(wr + e * 1024 + 256 * j + 4 * lane); a += (v[j].x * w.x + v[j].y * w.y) + (v[j].z * w.z + v[j].w * w.w); }
            lg[e] = a; if ((e & 7) == 7) asm volatile("" ::: "memory"); }
        { const float tot = xreduce<32>(lg, lane);
#pragma unroll
          for (int e = 0; e < 32; ++e) lg[e] = lane_bcast(tot, 2 * e) + F.b_router[e]; }
        int te[4]; float tv[4];
#pragma unroll
        for (int k = 0; k < 4; ++k) { float bv = -INFINITY; int bi = 0;
#pragma unroll
            for (int e = 0; e < 32; ++e) { const bool c = lg[e] > bv; bv = c ? lg[e] : bv; bi = c ? e : bi; }
            te[k] = bi; tv[k] = bv;
#pragma unroll
            for (int e = 0; e < 32; ++e) lg[e] = (e == bi) ? -INFINITY : lg[e]; }
        float ex[4], es = 0.f;
#pragma unroll
        for (int k = 0; k < 4; ++k) { ex[k] = __expf(tv[k] - tv[0]); es += ex[k]; }
        if (lane < 4) { const int e = lane == 0 ? te[0] : lane == 1 ? te[1] : lane == 2 ? te[2] : te[3]; const float w = (lane == 0 ? ex[0] : lane == 1 ? ex[1] : lane == 2 ? ex[2] : ex[3]) / es;
            wsp<int>(F, WS_TOPE)[(size_t)m * 4 + lane] = e; wsp<float>(F, WS_TOPW)[(size_t)m * 4 + lane] = w; __hip_atomic_fetch_add(hist + e, 1u, __ATOMIC_RELAXED, __HIP_MEMORY_SCOPE_WORKGROUP); }
    }
    __syncthreads();
    if (tid < 32) __hip_atomic_fetch_add(F.ctl + CW_CNT + tid, hist[tid], RLX_AGENT);
}
__device__ __forceinline__ void moe_tables(Frame& F, int& nMt) {
    LAS unsigned char* te = F.lds + TILEE_OFF;
    if (F.tid == 0) { int t0 = 0;
        for (int e = 0; e < NE; ++e) { const int c = (int)__hip_atomic_load(F.ctl + CW_CNT + e, RLX_AGENT); const int nt = (c + 255) >> 8; for (int j = 0; j < nt; ++j) te[t0 + j] = (unsigned char)e; t0 += nt; }
        F.MISC[16] = (unsigned)t0; }
    __syncthreads();
    nMt = __builtin_amdgcn_readfirstlane((int)F.MISC[16]);
}
__device__ __forceinline__ void p8_phase(Frame& F) {
    const int tid = F.tid, lane = F.lane;
    LAS unsigned* hist = (LAS unsigned*)(F.lds + HIST_OFF);
    if (tid < 96) hist[tid] = 0u;
    __syncthreads();
    const int gw = F.vcu * NWAVES + F.wave, NGW = F.G * NWAVES; const int rpw = (T + NGW - 1) / NGW;
    const int* TOPE = wsp<const int>(F, WS_TOPE);
    for (int i = 0; i < rpw; ++i) { const int m = gw * rpw + i; if (m >= T) break; if (lane < 4) __hip_atomic_fetch_add(hist + TOPE[(size_t)m * 4 + lane], 1u, __ATOMIC_RELAXED, __HIP_MEMORY_SCOPE_WORKGROUP); }
    __syncthreads();
    if (tid < 32) { unsigned pstart = 0; for (int e = 0; e < tid; ++e) { const unsigned c = __hip_atomic_load(F.ctl + CW_CNT + e, RLX_AGENT); pstart += (c + 255u) & ~255u; }
        hist[32 + tid] = pstart + __hip_atomic_fetch_add(F.ctl + CW_FILL + tid, hist[tid], RLX_AGENT); }
    __syncthreads();
    const unsigned char* H2 = wsp<const unsigned char>(F, WS_XN); unsigned char* XS = wsp<unsigned char>(F, WS_XS);
    for (int i = 0; i < rpw; ++i) { const int m = gw * rpw + i; if (m >= T) break;
        int pos = 0;
        if (lane < 4) { const int e = TOPE[(size_t)m * 4 + lane]; pos = (int)(hist[32 + e] + __hip_atomic_fetch_add(hist + 64 + e, 1u, __ATOMIC_RELAXED, __HIP_MEMORY_SCOPE_WORKGROUP));
            wsp<int>(F, WS_POS)[(size_t)m * 4 + lane] = pos; }
        const v4u a = *(const v4u*)(H2 + (size_t)m * D + lane * 16);
#pragma unroll
        for (int k = 0; k < 4; ++k) { const int p = __shfl(pos, k); *(v4u*)(XS + (size_t)p * D + lane * 16) = a; }
    }
}
__device__ __forceinline__ void p11_phase(Frame& F) {
    const int lane = F.lane;
    const float* MOD = wsp<const float>(F, WS_MOD); const unsigned char* CN = wsp<const unsigned char>(F, WS_CN); const int* POS = wsp<const int>(F, WS_POS);
    const int gw = F.vcu * NWAVES + F.wave, NGW = F.G * NWAVES; const int rpw = (T + NGW - 1) / NGW;
    const int mbeg = gw * rpw, mend = (mbeg + rpw < T) ? mbeg + rpw : T;
    if (mbeg >= mend) return;
    v4u ca[4], mx0, mx1; f32x4 xv[4]; int pn[4]; f32x4 wcur, wnxt; const float* TOPW = wsp<const float>(F, WS_TOPW); const bf16* MIXp = wsp<const bf16>(F, WS_MIX);
#define P11_LOAD(mm) do { _Pragma("unroll") for (int k = 0; k < 4; ++k) ca[k] = *(const v4u*)(CN + (size_t)pn[k] * D + lane * 16); \
        _Pragma("unroll") for (int q = 0; q < 4; ++q) xv[q] = *(const f32x4*)(F.x + (size_t)(mm) * D + lane * 16 + 4 * q); \
        { const v4u* ms_ = (const v4u*)(MIXp + (size_t)(mm) * D + lane * 16); mx0 = ms_[0]; mx1 = ms_[1]; } } while (0)
    { const int4 p4 = *(const int4*)(POS + (size_t)mbeg * 4); pn[0] = p4.x; pn[1] = p4.y; pn[2] = p4.z; pn[3] = p4.w; }
    P11_LOAD(mbeg); wcur = *(const f32x4*)(TOPW + (size_t)mbeg * 4);
    { const int m2 = (mbeg + 1 < mend) ? mbeg + 1 : mbeg; const int4 p4 = *(const int4*)(POS + (size_t)m2 * 4); pn[0] = p4.x; pn[1] = p4.y; pn[2] = p4.z; pn[3] = p4.w; wnxt = *(const f32x4*)(TOPW + (size_t)m2 * 4); }
#pragma nounroll
    for (int m = mbeg; m < mend; ++m) {
        const int b = m / SEQ;
        float acc[16];
#pragma unroll
        for (int q = 0; q < 16; ++q) acc[q] = 0.f;
#pragma unroll
        for (int k = 0; k < 4; ++k) { const float wk = wcur[k];
#pragma unroll
            for (int q = 0; q < 4; ++q) { const int wq = (int)ca[k][q];
                acc[4 * q] += wk * __builtin_amdgcn_cvt_f32_fp8(wq, 0); acc[4 * q + 1] += wk * __builtin_amdgcn_cvt_f32_fp8(wq, 1);
                acc[4 * q + 2] += wk * __builtin_amdgcn_cvt_f32_fp8(wq, 2); acc[4 * q + 3] += wk * __builtin_amdgcn_cvt_f32_fp8(wq, 3); } }
        f32x4 ov[4]; const float* gt = MOD + (size_t)b * 6144 + 5120 + lane * 16;
#pragma unroll
        for (int q = 0; q < 4; ++q) { const f32x4 g = *(const f32x4*)(gt + 4 * q); const f32x4 av = {acc[4 * q], acc[4 * q + 1], acc[4 * q + 2], acc[4 * q + 3]};
            const unsigned ma = q < 2 ? mx0[2 * q] : mx1[2 * q - 4], mb = q < 2 ? mx0[2 * q + 1] : mx1[2 * q - 3];
            ov[q] = xv[q] + (f32x4){bflo(ma), bfhi(ma), bflo(mb), bfhi(mb)} + g * av; }
        const int m1 = (m + 1 < mend) ? m + 1 : m;
        P11_LOAD(m1);
        wcur = wnxt;
        { const int m2 = (m + 2 < mend) ? m + 2 : m1; const int4 p4 = *(const int4*)(POS + (size_t)m2 * 4); pn[0] = p4.x; pn[1] = p4.y; pn[2] = p4.z; pn[3] = p4.w; wnxt = *(const f32x4*)(TOPW + (size_t)m2 * 4); }
        float* orow = F.out + (size_t)m * D + lane * 16;
#pragma unroll
        for (int q = 0; q < 4; ++q) *(f32x4*)(orow + 4 * q) = ov[q];
    }
#undef P11_LOAD
}

constexpr int NPHASE = 12;
struct Args { const float* in[25]; float* out; unsigned char* ws; int ph_lo, ph_hi; };
__global__ void __launch_bounds__(NWAVES * 64, 2) fwd_kernel(Args args) {
    extern __shared__ __attribute__((aligned(16))) unsigned char lds[];
    Frame F;
    F.lds = (LAS unsigned char*)lds;
    F.MISC = (volatile LAS unsigned*)(F.lds + MISC_OFF);
    F.tid = threadIdx.x; F.lane = F.tid & 63; F.wave = __builtin_amdgcn_readfirstlane(F.tid >> 6);
    F.G = gridDim.x; { const int bx = blockIdx.x; F.vcu = (F.G % 8 == 0) ? (bx % 8) * (F.G / 8) + bx / 8 : bx; }
    F.ws = args.ws; F.ctl = (gu32*)(args.ws + WS_CTL); F.out = args.out;
    F.x = args.in[0]; F.c = args.in[1]; F.rel_bias = args.in[2]; F.w_ada = args.in[3]; F.b_ada = args.in[4]; F.g_norm1 = args.in[5]; F.w_in = args.in[6];
    F.w_gk_up = args.in[7]; F.b_gk_up = args.in[8]; F.g_gla_out = args.in[9]; F.g_qnorm = args.in[10]; F.g_knorm = args.in[11];
    F.lq1 = args.in[12]; F.lk1 = args.in[13]; F.lq2 = args.in[14]; F.lk2 = args.in[15]; F.g_subln = args.in[16]; F.w_out = args.in[17];
    F.g_norm2 = args.in[18]; F.w_router = args.in[19]; F.b_router = args.in[20]; F.w_gate_up = args.in[21]; F.b_gate_up = args.in[22]; F.w_down = args.in[23]; F.b_down = args.in[24];
    for (int u = F.tid; u < (LDS_BYTES - LDSCTL_OFF) / 4; u += NWAVES * 64) ((LAS unsigned*)(F.lds + LDSCTL_OFF))[u] = 0u;
    __syncthreads();
    const int lo = args.ph_lo, hi = args.ph_hi;
    const bool multi = (hi - lo) > 1;
    XcdBarrier bar; bar.bar = (unsigned*)(F.ctl + CW_BAR); bar.x = 0; bar.st = nullptr;
    if (multi) bar = xcd_barrier_post((unsigned*)(F.ctl + CW_BAR), F.MISC + 8);
#ifndef PHMASK
#define PHMASK 0xFFF
#endif
#define IN(k) (((PHMASK >> (k)) & 1) && lo <= (k) && (k) < hi)
#define SEAM(k) do { if (IN((k) + 1)) xcd_barrier(bar); } while (0)
#ifndef REPEAT_PH
#define REPEAT_PH 0
#endif
#define REPS(k) (((REPEAT_PH >> (k)) & 1) ? 2 : 1)

    if (IN(0)) { for (int rep_ = 0; rep_ < REPS(0); ++rep_) { if (rep_) xcd_barrier(bar); p0_phase(F); } SEAM(0); }
    if (IN(1)) { for (int rep_ = 0; rep_ < REPS(1); ++rep_) { if (rep_) xcd_barrier(bar); p1_phase(F); } SEAM(1); }
    if (IN(2)) {
        pg8::Gemm g{wsp<const bf16>(F, WS_XN), wsp<const bf16>(F, WS_WIN), T, NIN, D, 0};
        pg8::StaticOrder S; S.init(T / 256, NIN / 256, F.G, (int)blockIdx.x, nullptr, REPS(2));
        EpiInProj E{wsp<bf16>(F, WS_QG), wsp<bf16>(F, WS_KG), wsp<bf16>(F, WS_VG), wsp<bf16>(F, WS_RG), wsp<bf16>(F, WS_QD), wsp<bf16>(F, WS_KD), wsp<bf16>(F, WS_VD), F.g_qnorm, F.g_knorm};
        pg8::gemm_phase<EpiInProj, pg8::StaticOrder>(F.lds, g, S, E);
        SEAM(2);
    }
    if (IN(3)) { for (int rep_ = 0; rep_ < REPS(3); ++rep_) { if (rep_) xcd_barrier(bar); for (int c = F.vcu; c < NCHUNK; c += F.G) gla_a_unit(F, c); } SEAM(3); }
    if (IN(4)) { for (int rep_ = 0; rep_ < REPS(4); ++rep_) { if (rep_) xcd_barrier(bar); gla_b_phase(F); } SEAM(4); }
    if (IN(5)) for (int rep_ = 0; rep_ < REPS(5); ++rep_) { if (rep_) xcd_barrier(bar);
#ifndef NO_GLAC
        for (int u = F.vcu; u < NCHUNK / 2; u += F.G) gla_c_unit(F, u);
#endif
        float lam;
        { float a1 = F.lq1[F.lane] * F.lk1[F.lane], a2 = F.lq2[F.lane] * F.lk2[F.lane]; a1 = wave_sum(a1); a2 = wave_sum(a2); lam = __expf(a1) - __expf(a2) + 0.2f; }
#ifndef NO_ATT
        for (int p = F.vcu; p < 256; p += F.G) { const int bh = p >> 4, s = p & 15;
#pragma nounroll
            for (int j = 0; j < 2; ++j) att::attn_unit(F, bh >> 2, bh & 3, j ? s : 31 - s, lam); }
#endif
        SEAM(5);
    }
    if (IN(6)) {
        pg8::Gemm g{wsp<const bf16>(F, WS_A2), wsp<const bf16>(F, WS_WOUT), T, D, D, 0};
        pg8::StaticOrder S; S.init(T / 256, D / 256, F.G, (int)blockIdx.x, nullptr, REPS(6));
        EpiOutProj E{wsp<bf16>(F, WS_MIX), wsp<const float>(F, WS_MOD)};
        pg8::gemm_phase<EpiOutProj, pg8::StaticOrder>(F.lds, g, S, E);
        SEAM(6);
    }
    if (IN(7)) { p7_phase(F); SEAM(7); }
    if (IN(8)) { p8_phase(F); SEAM(8); }
    if (IN(9)) {
        int nMt; moe_tables(F, nMt);
        pg8::Gemm g{wsp<const bf16>(F, WS_XS), wsp<const bf16>(F, WS_WGU), PMAX, 2048, D / 2, (size_t)2048 * 512};
        pg8::StaticOrder S; S.init(nMt, 8, F.G, (int)blockIdx.x, F.lds + TILEE_OFF, REPS(9));
        EpiSwiGLU E{wsp<unsigned char>(F, WS_Y), F.b_gate_up};
        pg8::gemm_phase<EpiSwiGLU, pg8::StaticOrder, true>(F.lds, g, S, E);
        SEAM(9);
    }
    if (IN(10)) {
        int nMt; moe_tables(F, nMt);
        pg8::Gemm g{wsp<const bf16>(F, WS_Y), wsp<const bf16>(F, WS_WD), PMAX, 1024, FF / 2, (size_t)1024 * 512};
        pg8::StaticOrder S; S.init(nMt, 4, F.G, (int)blockIdx.x, F.lds + TILEE_OFF, REPS(10));
        EpiDown E{wsp<unsigned char>(F, WS_CN), F.b_down};
        pg8::gemm_phase<EpiDown, pg8::StaticOrder, true>(F.lds, g, S, E);
        SEAM(10);
    }
    if (IN(11)) { p11_phase(F); }
#undef IN
#undef SEAM
}

extern "C" void kernel_launch(void* const* d_in, const int* in_sizes, int n_in, void* d_out, int out_size, void* d_ws, size_t ws_size, hipStream_t stream) {
    static int grid = 0;
    if (grid == 0) {
        if (n_in != 25 || in_sizes[0] != T * D || out_size != T * D || ws_size < WS_END) { fprintf(stderr, "kernel_launch: unexpected shapes (n_in %d, in0 %d, out %d, ws %zu); nothing launched\n", n_in, n_in > 0 ? in_sizes[0] : -1, out_size, ws_size); grid = -1; return; }
        int dev = 0, cus = 0, per_cu = 0;
        if (hipGetDevice(&dev) != hipSuccess || hipDeviceGetAttribute(&cus, hipDeviceAttributeMultiprocessorCount, dev) != hipSuccess) { grid = -1; return; }
        if (hipFuncSetAttribute((const void*)fwd_kernel, hipFuncAttributeMaxDynamicSharedMemorySize, LDS_BYTES) != hipSuccess) { fprintf(stderr, "kernel_launch: hipFuncSetAttribute failed\n"); grid = -1; return; }
        if (hipOccupancyMaxActiveBlocksPerMultiprocessor(&per_cu, (const void*)fwd_kernel, NWAVES * 64, LDS_BYTES) != hipSuccess || per_cu < 1)
            fprintf(stderr, "kernel_launch: note: occupancy query reports %d workgroups per CU\n", per_cu);
        (void)hipGetLastError();
        grid = cus;
    }
    if (grid < 0) return;
    if (hipMemsetAsync((char*)d_ws + WS_CTL, 0, CTL_ZERO_BYTES, stream) != hipSuccess) { fprintf(stderr, "kernel_launch: memset failed\n"); return; }
    Args a{};
    for (int i = 0; i < 25; ++i) a.in[i] = (const float*)d_in[i];
    a.out = (float*)d_out; a.ws = (unsigned char*)d_ws;
#if MK_N_LAUNCHES == 1
    a.ph_lo = 0; a.ph_hi = NPHASE;
    hipLaunchKernelGGL(fwd_kernel, dim3(grid), dim3(NWAVES * 64), LDS_BYTES, stream, a);
#else
    for (int p = 0; p < NPHASE; ++p) { a.ph_lo = p; a.ph_hi = p + 1; hipLaunchKernelGGL(fwd_kernel, dim3(grid), dim3(NWAVES * 64), LDS_BYTES, stream, a); }
#endif
    const hipError_t le = hipPeekAtLastError();
    if (le != hipSuccess) fprintf(stderr, "kernel_launch: launch failed: %s\n", hipGetErrorName(le));
}
```

```cpp
#include <hip/hip_runtime.h>
#include <cstdio>
#include <cstdint>

#ifndef MK_N_LAUNCHES
#define MK_N_LAUNCHES 1
#endif

namespace pg8 {
#define PG8_LAS __attribute__((address_space(3)))
typedef unsigned short bf16_t;
typedef short bf16x8 __attribute__((ext_vector_type(8)));
typedef float f32x4 __attribute__((ext_vector_type(4)));
typedef unsigned u32x4 __attribute__((ext_vector_type(4)));
typedef int i32x4 __attribute__((ext_vector_type(4)));
typedef int i32x8 __attribute__((ext_vector_type(8)));
typedef float f32x16 __attribute__((ext_vector_type(16)));
constexpr int BM = 256, BK = 64, HALF = 128, HTB = HALF * BK * 2, STAGE_BYTES = 8 * HTB, NXCD = 8, WGM = 8;

__host__ __device__ __forceinline__ int lds_byte(int r, int c) { const int st = (r >> 4) * 2 + (c >> 5), rr = r & 15, cc = c & 31, ob = rr * 64 + cc * 2; return st * 1024 + (ob ^ (((ob >> 9) & 1) << 5)); }
__host__ __device__ __forceinline__ void stage_rc(int b, int& R, int& C) { const int st = b / 1024, sb = b % 1024, swz = sb ^ (((sb >> 9) & 1) << 5); R = (st >> 1) * 16 + swz / 64; C = (st & 1) * 32 + (swz % 64) / 2; }
__host__ __device__ __forceinline__ int perm32(int rho) { const int n = rho >> 4, i = rho & 15; return 8 * (i >> 2) + 4 * n + (i & 3); }

struct Unit { int pm, pn, e; };
struct Gemm { const bf16_t* A; const bf16_t* Bt; int M, N, K; size_t estride; };

struct StaticOrder {
    int nM, nN, nwg, G, c, rep; const PG8_LAS unsigned char* tile_e;
    __device__ void init(int nM_, int nN_, int G_, int c_, const PG8_LAS unsigned char* te, int rep_ = 1) { nM = nM_; nN = nN_; nwg = nM * nN; G = G_; c = c_; tile_e = te; rep = rep_; }
    __device__ bool next(int i, Unit& u) const {
        long L = (long)i * G + c; if (L >= (long)nwg * rep) return false; if (rep > 1) L %= nwg;
        int wgid = (int)L; { const int q = nwg / NXCD, r = nwg % NXCD, xcd = wgid % NXCD, off = wgid / NXCD; wgid = (xcd < r ? xcd * (q + 1) : r * (q + 1) + (xcd - r) * q) + off; }
        const int nig = WGM * nN, gid = wgid / nig, fm = gid * WGM, gsz = (nM - fm) < WGM ? (nM - fm) : WGM;
        u.pm = fm + ((wgid % nig) % gsz); u.pn = (wgid % nig) / gsz; u.e = tile_e ? __builtin_amdgcn_readfirstlane((int)tile_e[u.pm]) : 0; return true;
    }
};

__device__ __forceinline__ unsigned cvt_pk_bf16(float lo, float hi) { unsigned r; asm volatile("v_cvt_pk_bf16_f32 %0, %1, %2" : "=v"(r) : "v"(lo), "v"(hi)); return r; }

template <class Epi, class Sched, bool FP8 = false>
__device__ __forceinline__ void gemm_phase(PG8_LAS unsigned char* lds, const Gemm g, const Sched& S, const Epi& E) {
    const int tid = threadIdx.x, wid = __builtin_amdgcn_readfirstlane(tid >> 6), lane = tid & 63, wr = wid >> 2, wc = wid & 3, fr = lane & 15, fq = lane >> 4;
    const int K = g.K, nt = K / BK;
    unsigned voffA[2], voffB[2];
#pragma unroll
    for (int i = 0; i < 2; ++i) { int R, C; stage_rc(tid * 16 + i * 8192, R, C); const int Rb = Epi::PERM ? ((R & ~31) + perm32(R & 31)) : R;
        voffA[i] = (unsigned)(R * K + C) * 2u; voffB[i] = (unsigned)(Rb * K + C) * 2u; }
    const size_t kstep = (size_t)(BK * 2);
    const size_t hstep = (size_t)HALF * K * 2;
    const size_t tstep = 2 * hstep;
    const size_t estep = g.estride * 2;
    const unsigned ldsw = (unsigned)wid * 1024u;
    const int aoff = lds_byte(wr * 64 + fr, fq * 8), boff = lds_byte(wc * 32 + fr, fq * 8);
#define PG8_SA(b, h) (((b) * 2 + (h)) * HTB)
#define PG8_SB(b, h) ((4 + (b) * 2 + (h)) * HTB)
#define PG8_STAGE(bufoff, gbase, voff) do { _Pragma("unroll") for (int _i = 0; _i < 2; ++_i) \
        __builtin_amdgcn_global_load_lds((const unsigned*)((const char*)(gbase) + (voff)[_i]), (PG8_LAS unsigned*)(lds + (bufoff) + ldsw + _i * 8192), 16, 0, 0); } while (0)
#define PG8_LDA(dst, b, h) do { _Pragma("unroll") for (int m = 0; m < 4; ++m) dst[m] = PG8_CAT2(*(const PG8_LAS i32x4*)(lds + PG8_SA(b, h) + aoff + m * 2048), *(const PG8_LAS i32x4*)(lds + PG8_SA(b, h) + aoff + m * 2048 + 1024)); } while (0)
#define PG8_LDB(dst, b, h) do { _Pragma("unroll") for (int n = 0; n < 2; ++n) dst[n] = PG8_CAT2(*(const PG8_LAS i32x4*)(lds + PG8_SB(b, h) + boff + n * 2048), *(const PG8_LAS i32x4*)(lds + PG8_SB(b, h) + boff + n * 2048 + 1024)); } while (0)
#define PG8_CAT2(x, y) __builtin_shufflevector((x), (y), 0, 1, 2, 3, 4, 5, 6, 7)
#define PG8_LO(x) __builtin_bit_cast(bf16x8, __builtin_shufflevector((x), (x), 0, 1, 2, 3))
#define PG8_HI(x) __builtin_bit_cast(bf16x8, __builtin_shufflevector((x), (x), 4, 5, 6, 7))
#define PG8_X4(v, m) ((f32x4){(v)[4 * (m)], (v)[4 * (m) + 1], (v)[4 * (m) + 2], (v)[4 * (m) + 3]})
#define PG8_INS(v, r, m) do { (v)[4 * (m)] = (r)[0]; (v)[4 * (m) + 1] = (r)[1]; (v)[4 * (m) + 2] = (r)[2]; (v)[4 * (m) + 3] = (r)[3]; } while (0)
#define PG8_MMA(ai, bj, At, Bt) do { __builtin_amdgcn_s_setprio(1); _Pragma("unroll") for (int m = 0; m < 4; ++m) _Pragma("unroll") for (int n = 0; n < 2; ++n) { \
        if constexpr (FP8) { const f32x4 r_ = __builtin_amdgcn_mfma_scale_f32_16x16x128_f8f6f4(Bt[n], At[m], PG8_X4(acc16[ai][bj][n], m), 0, 0, 0, 0x7F7F7F7F, 0, 0x7F7F7F7F); PG8_INS(acc16[ai][bj][n], r_, m); } \
        else { acc[ai][bj][m][n] = __builtin_amdgcn_mfma_f32_16x16x32_bf16(PG8_LO(Bt[n]), PG8_LO(At[m]), acc[ai][bj][m][n], 0, 0, 0); \
               acc[ai][bj][m][n] = __builtin_amdgcn_mfma_f32_16x16x32_bf16(PG8_HI(Bt[n]), PG8_HI(At[m]), acc[ai][bj][m][n], 0, 0, 0); } } \
        __builtin_amdgcn_s_setprio(0); } while (0)
#define PG8_WAIT_V(n) asm volatile("s_waitcnt vmcnt(" #n ")" ::: "memory")
#define PG8_WAIT_L(n) asm volatile("s_waitcnt lgkmcnt(" #n ")" ::: "memory")
#define PG8_BAR __builtin_amdgcn_s_barrier()
#define PG8_SCHED __builtin_amdgcn_sched_barrier(0)
    Unit cur, nxt; int ui = 0;
    if (!S.next(0, cur)) return;
    f32x4 acc[2][2][4][2];
#pragma unroll
    for (int a = 0; a < 2; ++a)
#pragma unroll
        for (int b = 0; b < 2; ++b)
#pragma unroll
            for (int m = 0; m < 4; ++m)
#pragma unroll
                for (int n = 0; n < 2; ++n) acc[a][b][m][n] = (f32x4){0.f, 0.f, 0.f, 0.f};
    f32x16 acc16[2][2][2];
#pragma unroll
    for (int a = 0; a < 2; ++a)
#pragma unroll
        for (int b = 0; b < 2; ++b)
#pragma unroll
            for (int n = 0; n < 2; ++n) acc16[a][b][n] = (f32x16){};
    i32x8 At[4], B0[2], B1[2];
    const char* cA = (const char*)g.A + (size_t)cur.pm * tstep; const char* cB = (const char*)g.Bt + (size_t)cur.e * estep + (size_t)cur.pn * tstep;
    PG8_STAGE(PG8_SB(0, 0), cB, voffB); PG8_STAGE(PG8_SB(0, 1), cB + hstep, voffB); PG8_STAGE(PG8_SA(0, 0), cA, voffA); PG8_STAGE(PG8_SA(0, 1), cA + hstep, voffA);
    if (wr == 1) PG8_BAR;
    PG8_WAIT_V(2); PG8_BAR;
    PG8_STAGE(PG8_SB(1, 0), cB + kstep, voffB); PG8_STAGE(PG8_SA(1, 0), cA + kstep, voffA); PG8_STAGE(PG8_SB(1, 1), cB + hstep + kstep, voffB);
    PG8_WAIT_V(6); PG8_BAR;
    for (;;) {
        const bool has_next = S.next(ui + 1, nxt);
        const char* nA = has_next ? (const char*)g.A + (size_t)nxt.pm * tstep : cA; const char* nB = has_next ? (const char*)g.Bt + (size_t)nxt.e * estep + (size_t)nxt.pn * tstep : cB;
#pragma nounroll
        for (int t = 0; t < nt; t += 2) {
            const bool last = (t == nt - 2);
            const char* a1 = cA + (size_t)(t + 1) * kstep;
            const char* a2 = last ? nA : cA + (size_t)(t + 2) * kstep; const char* b2 = last ? nB : cB + (size_t)(t + 2) * kstep;
            const char* a3 = a2 + kstep; const char* b3 = b2 + kstep;
            PG8_LDB(B0, 0, 0); PG8_LDB(B1, 0, 1); PG8_SCHED; PG8_LDA(At, 0, 0); PG8_STAGE(PG8_SA(1, 1), a1 + hstep, voffA);
            PG8_WAIT_V(8); PG8_WAIT_L(0); PG8_BAR; PG8_MMA(0, 0, At, B0); PG8_MMA(0, 1, At, B1); PG8_BAR; PG8_SCHED;
            PG8_LDA(At, 0, 1); PG8_STAGE(PG8_SB(0, 0), b2, voffB); PG8_STAGE(PG8_SB(0, 1), b2 + hstep, voffB); PG8_STAGE(PG8_SA(0, 0), a2, voffA);
            PG8_WAIT_V(8); PG8_WAIT_L(0); PG8_BAR; PG8_MMA(1, 0, At, B0); PG8_MMA(1, 1, At, B1); PG8_BAR; PG8_SCHED;
            PG8_LDB(B0, 1, 0); PG8_LDB(B1, 1, 1); PG8_SCHED; PG8_LDA(At, 1, 0); PG8_STAGE(PG8_SA(0, 1), a2 + hstep, voffA);
            PG8_WAIT_V(8); PG8_WAIT_L(0); PG8_BAR; PG8_MMA(0, 0, At, B0); PG8_MMA(0, 1, At, B1); PG8_BAR; PG8_SCHED;
            PG8_LDA(At, 1, 1); PG8_STAGE(PG8_SB(1, 0), b3, voffB); PG8_STAGE(PG8_SB(1, 1), b3 + hstep, voffB); PG8_STAGE(PG8_SA(1, 0), a3, voffA);
            PG8_WAIT_V(8); PG8_WAIT_L(0); PG8_BAR; PG8_MMA(1, 0, At, B0); PG8_MMA(1, 1, At, B1); PG8_BAR; PG8_SCHED;
        }
        if (wr == 0) PG8_BAR;
        if constexpr (FP8) {
#pragma unroll
            for (int a = 0; a < 2; ++a)
#pragma unroll
                for (int b = 0; b < 2; ++b)
#pragma unroll
                    for (int m = 0; m < 4; ++m)
#pragma unroll
                        for (int n = 0; n < 2; ++n) acc[a][b][m][n] = PG8_X4(acc16[a][b][n], m);
        }
        { int t2 = threadIdx.x; asm volatile("" : "+v"(t2)); E(acc, cur, wr, wc, t2 & 15, (t2 >> 4) & 3); }
        if (!has_next) break;
#pragma unroll
        for (int a = 0; a < 2; ++a)
#pragma unroll
            for (int b = 0; b < 2; ++b)
#pragma unroll
                for (int m = 0; m < 4; ++m)
#pragma unroll
                    for (int n = 0; n < 2; ++n) acc[a][b][m][n] = (f32x4){0.f, 0.f, 0.f, 0.f};
        if constexpr (FP8) {
#pragma unroll
            for (int a = 0; a < 2; ++a)
#pragma unroll
                for (int b = 0; b < 2; ++b)
#pragma unroll
                    for (int n = 0; n < 2; ++n) acc16[a][b][n] = (f32x16){};
        }
        cur = nxt; cA = nA; cB = nB; ++ui;
        if (wr == 1) PG8_BAR;
    }
    PG8_WAIT_V(0);
    PG8_BAR;
#undef PG8_SA
#undef PG8_SB
#undef PG8_STAGE
#undef PG8_LDA
#undef PG8_LDB
#undef PG8_MMA
#undef PG8_X4
#undef PG8_INS
#undef PG8_CAT2
#undef PG8_LO
#undef PG8_HI
#undef PG8_WAIT_V
#undef PG8_WAIT_L
#undef PG8_BAR
#undef PG8_SCHED
}
}

constexpr int NWAVES = 8;
constexpr int BATCH = 4, SEQ = 8192, D = 1024, T = BATCH * SEQ;
constexpr int INW = 3088, NIN = 3072;
constexpr int NE = 32, TOPK = 4, FF = 1024;
constexpr int PMAX = (T * TOPK / 256 + NE) * 256;
constexpr int NCHUNK = BATCH * 4 * (SEQ / 64);
constexpr float EPS = 1e-6f;
constexpr float LOG2E = 1.4426950408889634f;
constexpr float C2 = 0.125f * LOG2E;
constexpr float WSCALE = 32.f, WSCALE_INV = 1.f / 32.f;

constexpr size_t MiB = 1u << 20;
constexpr size_t WS_CTL = 0, CTL_ZERO_BYTES = 1 * MiB;
constexpr size_t WS_MODP = 1 * MiB;
constexpr size_t WS_MOD = 2 * MiB;
constexpr size_t WS_TOPE = 3 * MiB;
constexpr size_t WS_TOPW = 3 * MiB + 512 * 1024;
constexpr size_t WS_POS = 4 * MiB;
constexpr size_t WS_ROWW = 4 * MiB + 512 * 1024;
constexpr size_t WS_DEC = 6 * MiB;
constexpr size_t WS_WGU = 8 * MiB;
constexpr size_t WS_WD = 136 * MiB;
constexpr size_t WS_XN = 200 * MiB;
constexpr size_t WS_WIN = 264 * MiB;
constexpr size_t WS_WOUT = 270 * MiB;
constexpr size_t WS_GK = 272 * MiB;
constexpr size_t WS_QG = 304 * MiB;
constexpr size_t WS_KG = 320 * MiB;
constexpr size_t WS_VG = 336 * MiB;
constexpr size_t WS_RG = 368 * MiB;
constexpr size_t WS_QD = 400 * MiB;
constexpr size_t WS_KD = 432 * MiB;
constexpr size_t WS_VD = 464 * MiB;
constexpr size_t WS_UT = 496 * MiB;
constexpr size_t WS_SP = 560 * MiB;
constexpr size_t WS_OI = 592 * MiB;
constexpr size_t WS_QE = 656 * MiB;
constexpr size_t WS_A2 = 672 * MiB;
constexpr size_t WS_STASH = 736 * MiB;
constexpr size_t WS_XS = 264 * MiB;
constexpr size_t WS_Y = 400 * MiB;
constexpr size_t WS_CN = 536 * MiB;
constexpr size_t WS_MIX = 808 * MiB;
constexpr size_t WS_END = 872 * MiB;
static_assert(WS_XS + (size_t)PMAX * 1024 <= WS_Y && WS_Y + (size_t)PMAX * 1024 <= WS_CN && WS_CN + (size_t)PMAX * 1024 * 2 <= WS_MIX, "ws map");
constexpr int CW_BAR = 4096;
constexpr int CW_CNT = 16384;
constexpr int CW_FILL = 16384 + 64;

constexpr int RING_BYTES = 131072;
constexpr int LDSCTL_OFF = RING_BYTES, MISC_OFF = LDSCTL_OFF + 320;
constexpr int TILEE_OFF = MISC_OFF + 128;
constexpr int HIST_OFF = TILEE_OFF + 1024;
constexpr int LDS_BYTES = 147456;
static_assert(HIST_OFF + 512 <= LDS_BYTES, "LDS map");

#define GAS __attribute__((address_space(1)))
#define LAS __attribute__((address_space(3)))
typedef unsigned short bf16;
typedef unsigned v4u __attribute__((ext_vector_type(4)));
typedef unsigned v2u __attribute__((ext_vector_type(2)));
typedef float f32x4 __attribute__((ext_vector_type(4)));
typedef float f32x16 __attribute__((ext_vector_type(16)));
typedef short bf16x8 __attribute__((ext_vector_type(8)));
typedef short s16x4 __attribute__((ext_vector_type(4)));
typedef GAS unsigned gu32;
#define RLX_AGENT __ATOMIC_RELAXED, __HIP_MEMORY_SCOPE_AGENT
#define LDS_WAIT() asm volatile("s_waitcnt lgkmcnt(0)" ::: "memory")
#define VM_WAIT() asm volatile("s_waitcnt vmcnt(0)" ::: "memory")
__device__ __forceinline__ unsigned f2bf(float f) { unsigned u = __builtin_bit_cast(unsigned, f); return (u + 0x7fffu + ((u >> 16) & 1u)) >> 16; }
__device__ __forceinline__ unsigned pk2(float lo, float hi) { return f2bf(lo) | (f2bf(hi) << 16); }
__device__ __forceinline__ float bf2f(unsigned short h) { return __builtin_bit_cast(float, (unsigned)h << 16); }
__device__ __forceinline__ float bflo(unsigned u) { return __builtin_bit_cast(float, u << 16); }
__device__ __forceinline__ float bfhi(unsigned u) { return __builtin_bit_cast(float, u & 0xffff0000u); }
__device__ __forceinline__ float wave_sum(float v) {
#pragma unroll
    for (int o = 1; o < 64; o <<= 1) v += __shfl_xor(v, o);
    return v;
}
__device__ __forceinline__ float sigmoidf_(float x) { return 1.f / (1.f + __expf(-x)); }
typedef float f32x2 __attribute__((ext_vector_type(2)));
__device__ __forceinline__ unsigned wave_umax(unsigned v) {
    v = max(v, (unsigned)__builtin_amdgcn_update_dpp(0, (int)v, 0x111, 0xf, 0xf, true));
    v = max(v, (unsigned)__builtin_amdgcn_update_dpp(0, (int)v, 0x112, 0xf, 0xf, true));
    v = max(v, (unsigned)__builtin_amdgcn_update_dpp(0, (int)v, 0x114, 0xf, 0xf, true));
    v = max(v, (unsigned)__builtin_amdgcn_update_dpp(0, (int)v, 0x118, 0xf, 0xf, true));
    v = max(v, (unsigned)__builtin_amdgcn_update_dpp(0, (int)v, 0x142, 0xa, 0xf, false));
    v = max(v, (unsigned)__builtin_amdgcn_update_dpp(0, (int)v, 0x143, 0xc, 0xf, false));
    return (unsigned)__builtin_amdgcn_readlane((int)v, 63);
}
template <int CNT, int S, int N> __device__ __forceinline__ void xreduce_step(float (&v)[N], int lane) {
    if constexpr (CNT > 1) { constexpr int half = CNT / 2; const bool up = (lane & S) != 0;
#pragma unroll
        for (int i = 0; i < half; ++i) { const float send = up ? v[i] : v[i + half], keep = up ? v[i + half] : v[i]; v[i] = keep + __shfl_xor(send, S); }
        xreduce_step<half, S / 2, N>(v, lane); }
}
template <int S> __device__ __forceinline__ float xreduce_tail(float r) { if constexpr (S >= 1) { r += __shfl_xor(r, S); return xreduce_tail<S / 2>(r); } else return r; }
template <int N> __device__ __forceinline__ float xreduce(float (&v)[N], int lane) {
    xreduce_step<N, 32, N>(v, lane);
    return xreduce_tail<(N == 32 ? 1 : N == 16 ? 2 : N == 8 ? 4 : 8)>(v[0]);
}
__device__ __forceinline__ float lane_bcast(float v, int l) { return __builtin_bit_cast(float, __builtin_amdgcn_readlane(__builtin_bit_cast(int, v), l)); }

#define XB_TMO      128
#define XB_XCNT(j)  (256  + 64 * (j))
#define XB_XSUB(j)  (1280 + 64 * (j))
#define XB_XGEN(j)  (2304 + 64 * (j))
#define XB_TOP      3328
#define XB_TOPGEN   3392
#define XCD_BAR_WORDS 3456
#define XB_SPIN_CAP (1u << 18)
__device__ __forceinline__ unsigned xb_ld(unsigned* p)              { return __hip_atomic_load(p, __ATOMIC_RELAXED, __HIP_MEMORY_SCOPE_AGENT); }
__device__ __forceinline__ unsigned xb_add(unsigned* p, unsigned v) { return __hip_atomic_fetch_add(p, v, __ATOMIC_RELAXED, __HIP_MEMORY_SCOPE_AGENT); }
__device__ __forceinline__ unsigned xb_xcc_id() { return (unsigned)__builtin_amdgcn_s_getreg((3 << 11) | 20) & 0xFu; }
#define XB_SPIN(cond, bar) do { unsigned _sp = 0; while (cond) { __builtin_amdgcn_s_sleep(1); \
    if ((++_sp & 255u) == 0u) { if (xb_ld(&(bar)[XB_TMO])) break; if (_sp > XB_SPIN_CAP) { atomicAdd(&(bar)[XB_TMO], 1u); break; } } } } while (0)
struct XcdBarrier { unsigned* bar; unsigned x; volatile LAS unsigned* st; };
__device__ __forceinline__ XcdBarrier xcd_barrier_post(unsigned* bar, volatile LAS unsigned* st) {
    XcdBarrier b; b.bar = bar; b.x = xb_xcc_id(); b.st = st;
    if (threadIdx.x == 0) (void)xb_add(&bar[XB_XCNT(b.x)], 1u);
    return b;
}
__device__ __forceinline__ void xcd_barrier_complete(unsigned* bar, unsigned x, unsigned& nloc, unsigned& nx) {
    const unsigned G = gridDim.x * gridDim.y * gridDim.z;
    unsigned sum, cnt, mine, sp = 0u;
    for (;;) {
        sum = 0u; cnt = 0u; mine = 0u;
#pragma unroll
        for (unsigned j = 0; j < 16; ++j) { const unsigned c = xb_ld(&bar[XB_XCNT(j)]); sum += c; cnt += (c > 0u) ? 1u : 0u; mine = (j == x) ? c : mine; }
        if (sum == G) break;
        __builtin_amdgcn_s_sleep(1);
        if ((++sp & 255u) == 0u) { if (xb_ld(&bar[XB_TMO])) break; if (sp > XB_SPIN_CAP) { atomicAdd(&bar[XB_TMO], 1u); break; } }
    }
    nloc = mine > 0u ? mine : 1u; nx = cnt > 0u ? cnt : 1u;
}
__device__ __forceinline__ void xcd_barrier(const XcdBarrier& b) {
    asm volatile("s_waitcnt vmcnt(0)" ::: "memory");
    __syncthreads();
    if (threadIdx.x == 0) {
        unsigned* bar = b.bar;
        __builtin_amdgcn_s_waitcnt(0);
        unsigned nloc = b.st[0], nx = b.st[1];
        if (nloc == 0u) { xcd_barrier_complete(bar, b.x, nloc, nx); b.st[0] = nloc; b.st[1] = nx; }
        const unsigned old = xb_add(&bar[XB_XSUB(b.x)], 1u);
        const unsigned gen = old / nloc;
        if (old + 1u == (gen + 1u) * nloc) {
            __builtin_amdgcn_fence(__ATOMIC_RELEASE, "agent");
            asm volatile("s_waitcnt vmcnt(0)" ::: "memory");
            const unsigned og = xb_add(&bar[XB_TOP], 1u);
            const unsigned tg = og / nx;
            if (og + 1u == (tg + 1u) * nx) xb_add(&bar[XB_TOPGEN], 1u);
            else XB_SPIN(xb_ld(&bar[XB_TOPGEN]) == tg, bar);
            __builtin_amdgcn_fence(__ATOMIC_ACQUIRE, "agent");
            xb_add(&bar[XB_XGEN(b.x)], 1u);
            asm volatile("s_waitcnt vmcnt(0)" ::: "memory");
        } else {
            XB_SPIN(xb_ld(&bar[XB_XGEN(b.x)]) == gen, bar);
            __builtin_amdgcn_fence(__ATOMIC_ACQUIRE, "agent");
            asm volatile("s_waitcnt vmcnt(0)" ::: "memory");
        }
    }
    __syncthreads();
}

struct Frame {
    LAS unsigned char* lds;
    volatile LAS unsigned* MISC;
    gu32* ctl;
    int tid, lane, wave;
    int vcu, G;
    unsigned char* ws;
    const float *x, *c, *rel_bias, *w_ada, *b_ada, *g_norm1, *w_in, *w_gk_up, *b_gk_up, *g_gla_out, *g_qnorm, *g_knorm, *lq1, *lk1, *lq2, *lk2, *g_subln, *w_out,
                *g_norm2, *w_router, *b_router, *w_gate_up, *b_gate_up, *w_down, *b_down;
    float* out;
};
template <class Tp> __device__ __forceinline__ Tp* wsp(const Frame& F, size_t off) { return (Tp*)(F.ws + off); }

__device__ __forceinline__ void tr_item(const float* W, int ldw, int k0, int src0, bf16* WT, int K, int drow0, LAS float* scr, int lane) {
#pragma unroll 8
    for (int i = 0; i < 32; ++i) { const int kk = 2 * i + (lane >> 5); scr[kk * 33 + (lane & 31)] = W[(size_t)(k0 + kk) * ldw + src0 + (lane & 31)]; }
    LDS_WAIT(); asm volatile("" ::: "memory");
    const int c = lane & 7;
#pragma unroll
    for (int j = 0; j < 4; ++j) { const int n = (lane >> 3) + 8 * j; const LAS float* s = scr + (8 * c) * 33 + n;
        v4u o; o.x = pk2(s[0 * 33], s[1 * 33]); o.y = pk2(s[2 * 33], s[3 * 33]); o.z = pk2(s[4 * 33], s[5 * 33]); o.w = pk2(s[6 * 33], s[7 * 33]);
        *(GAS v4u*)(WT + (size_t)(drow0 + n) * K + k0 + 8 * c) = o; }
    LDS_WAIT(); asm volatile("" ::: "memory");
}
__device__ __forceinline__ unsigned pk4_fp8(float a, float b, float c, float d) { int p = __builtin_amdgcn_cvt_pk_fp8_f32(a, b, 0, false); p = __builtin_amdgcn_cvt_pk_fp8_f32(c, d, p, true); return (unsigned)p; }
__device__ __forceinline__ void tr_item_fp8(const float* W, int ldw, int k0, int src0, unsigned char* WT, int K, int drow0, float sc, LAS float* scr, int lane) {
    { float tmp[32]; const float* wp = W + (size_t)(k0 + (lane >> 5)) * ldw + src0 + (lane & 31);
#pragma unroll
      for (int i = 0; i < 32; ++i) tmp[i] = __builtin_nontemporal_load(wp + (size_t)(2 * i) * ldw);
#pragma unroll
      for (int i = 0; i < 32; ++i) scr[(2 * i + (lane >> 5)) * 33 + (lane & 31)] = tmp[i] * sc; }
    LDS_WAIT(); asm volatile("" ::: "memory");
    const int c = lane & 3;
#pragma unroll
    for (int j = 0; j < 2; ++j) { const int n = (lane >> 2) + 16 * j; const LAS float* s = scr + (16 * c) * 33 + n;
        v4u o;
#pragma unroll
        for (int q = 0; q < 4; ++q) o[q] = pk4_fp8(s[(4 * q) * 33], s[(4 * q + 1) * 33], s[(4 * q + 2) * 33], s[(4 * q + 3) * 33]);
        *(GAS v4u*)(WT + (size_t)(drow0 + n) * K + k0 + 16 * c) = o; }
    LDS_WAIT(); asm volatile("" ::: "memory");
}
__device__ __forceinline__ int win_src0(int ng) {
    const int pn = ng >> 3, gi = ng & 7, bj = gi >> 2, wc = gi & 3;
    if (pn < 6) return pn * 256 + gi * 32;
    if (pn < 10) { const int base = (pn < 8) ? 1552 : 2064; const int gq = 4 * ((pn - 6) & 1) + wc; return base + 64 * gq + 32 * bj; }
    return 2576 + (pn - 10) * 256 + gi * 32;
}
__device__ __forceinline__ void p0_phase(Frame& F) {
    LAS float* scr = (LAS float*)(F.lds + F.wave * 16384);
    const int gw = F.vcu * NWAVES + F.wave, NGW = F.G * NWAVES, lane = F.lane;
    for (int it = gw; it < 768; it += NGW) {
        const int cg = it % 96, ks = it / 96, j = cg * 64 + lane;
#pragma unroll
        for (int q = 0; q < 8; ++q) { const int idx = q * 64 + lane, b = idx >> 7, kk = idx & 127; const float cv = F.c[b * 1024 + ks * 128 + kk]; scr[idx] = cv * sigmoidf_(cv); }
        LDS_WAIT(); asm volatile("" ::: "memory");
        float a0 = 0.f, a1 = 0.f, a2 = 0.f, a3 = 0.f;
        const float* wp = F.w_ada + (size_t)(ks * 128) * 6144 + j;
#pragma unroll 16
        for (int kk = 0; kk < 128; ++kk) { const float w = wp[(size_t)kk * 6144]; a0 += scr[kk] * w; a1 += scr[128 + kk] * w; a2 += scr[256 + kk] * w; a3 += scr[384 + kk] * w; }
        float* mp = wsp<float>(F, WS_MODP) + (size_t)(ks * 4) * 6144 + j;
        mp[0] = a0; mp[6144] = a1; mp[2 * 6144] = a2; mp[3 * 6144] = a3;
        LDS_WAIT(); asm volatile("" ::: "memory");
    }
    constexpr int I_IN = 96 * 16, I_OUT = 32 * 16, I_GU = 32 * 64 * 16, I_D = 32 * 32 * 16;
    constexpr int NITEMS = I_IN + I_OUT + I_GU + I_D;
    for (int it = gw; it < NITEMS; it += NGW) {
        int r = it;
        if (r < I_IN) { const int kb = r / 96, ng = r % 96; tr_item(F.w_in, INW, kb * 64, win_src0(ng), wsp<bf16>(F, WS_WIN), 1024, ng * 32, scr, lane); continue; } r -= I_IN;
        if (r < I_OUT) { const int kb = r / 32, ng = r % 32; tr_item(F.w_out, 1024, kb * 64, ng * 32, wsp<bf16>(F, WS_WOUT), 1024, ng * 32, scr, lane); continue; } r -= I_OUT;
        if (r < I_GU) { const int e = r / 1024, q = r % 1024, kb = q / 64, dg = q % 64, pn = dg >> 3, gi = dg & 7, bj = gi >> 2, j32 = gi & 3;
            tr_item_fp8(F.w_gate_up + (size_t)e * 1024 * 2048, 2048, kb * 64, bj * 1024 + pn * 128 + j32 * 32, wsp<unsigned char>(F, WS_WGU) + (size_t)e * 2048 * 1024, 1024, dg * 32, WSCALE, scr, lane); continue; } r -= I_GU;
        { const int e = r / 512, q = r % 512, kb = q / 32, ng = q % 32;
            tr_item_fp8(F.w_down + (size_t)e * 1024 * 1024, 1024, kb * 64, ng * 32, wsp<unsigned char>(F, WS_WD) + (size_t)e * 1024 * 1024, 1024, ng * 32, WSCALE, scr, lane); }
    }
}

__device__ __forceinline__ f32x4 mod_from_partials(const Frame& F, int b, int col) {
    const float* mp = wsp<const float>(F, WS_MODP) + (size_t)b * 6144 + col;
    f32x4 s = *(const f32x4*)(F.b_ada + col);
#pragma unroll
    for (int ks = 0; ks < 8; ++ks) s += *(const f32x4*)(mp + (size_t)ks * 4 * 6144);
    return s;
}
__device__ __forceinline__ void p1_phase(Frame& F) {
    const int tid = F.tid, lane = F.lane;
    LAS float* wlo = (LAS float*)(F.lds);
    LAS float* wup = (LAS float*)(F.lds + 65536);
    LAS float* bup = (LAS float*)(F.lds + 65536 + 16384);
    for (int idx = tid; idx < 16384; idx += 512) { const int k = idx >> 4, r = idx & 15; wlo[r * 1024 + k] = F.w_in[(size_t)k * INW + 1536 + r]; }
    for (int idx = tid; idx < 4096; idx += 512) wup[idx] = F.w_gk_up[idx];
    if (tid < 256) bup[tid] = F.b_gk_up[tid];
    { const int gt = F.vcu * 512 + tid; if (gt < 4 * 6144 / 4) { const int i = gt * 4, b = i / 6144, col = i % 6144; *(f32x4*)(wsp<float>(F, WS_MOD) + i) = mod_from_partials(F, b, col); } }
    __syncthreads();
    const int gw = F.vcu * NWAVES + F.wave, NGW = F.G * NWAVES;
    const int rpw = (T + NGW - 1) / NGW;
    int curb = -1; f32x4 gsc[4], shv[4], nx[4];
    { const int m0 = (gw * rpw < T) ? gw * rpw : 0; const GAS f32x4* xr = (const GAS f32x4*)(F.x + (size_t)m0 * D) + lane;
#pragma unroll
      for (int j = 0; j < 4; ++j) nx[j] = xr[64 * j]; }
#pragma nounroll
    for (int i = 0; i < rpw; ++i) {
        const int m = gw * rpw + i; if (m >= T) break;
        const int b = m / SEQ;
        if (b != curb) { curb = b;
#pragma unroll
            for (int j = 0; j < 4; ++j) { const int col = 256 * j + 4 * lane; const f32x4 g = *(const f32x4*)(F.g_norm1 + col);
                shv[j] = mod_from_partials(F, b, col); gsc[j] = g * (mod_from_partials(F, b, 1024 + col) + 1.0f); } }
        f32x4 v[4]; float s = 0.f;
#pragma unroll
        for (int j = 0; j < 4; ++j) { v[j] = nx[j]; s += (v[j].x * v[j].x + v[j].y * v[j].y) + (v[j].z * v[j].z + v[j].w * v[j].w); }
        { const int m2 = (m + 1 < T) ? m + 1 : m; const GAS f32x4* xr = (const GAS f32x4*)(F.x + (size_t)m2 * D) + lane;
#pragma unroll
          for (int j = 0; j < 4; ++j) nx[j] = xr[64 * j]; }
        const float rstd = rsqrtf(wave_sum(s) * (1.f / D) + EPS);
        GAS v2u* o8 = (GAS v2u*)(wsp<bf16>(F, WS_XN) + (size_t)m * D) + lane;
#pragma unroll
        for (int j = 0; j < 4; ++j) { v[j] = v[j] * rstd * gsc[j] + shv[j]; v2u o; o.x = pk2(v[j].x, v[j].y); o.y = pk2(v[j].z, v[j].w); o8[64 * j] = o; }
        float part[16];
        { f32x4 wa[16], wb[16];
#define P1_LD(dst, rb) do { _Pragma("unroll") for (int q = 0; q < 16; ++q) dst[q] = *(const LAS f32x4*)(wlo + ((rb) * 4 + (q >> 2)) * 1024 + 256 * (q & 3) + 4 * lane); } while (0)
#define P1_DOT(src, rb) do { _Pragma("unroll") for (int rr = 0; rr < 4; ++rr) { f32x2 a2 = {0.f, 0.f}; _Pragma("unroll") for (int j = 0; j < 4; ++j) { const f32x4 w = src[rr * 4 + j]; a2 += v[j].lo * w.lo; a2 += v[j].hi * w.hi; } part[(rb) * 4 + rr] = a2.x + a2.y; } } while (0)
          P1_LD(wa, 0); __builtin_amdgcn_sched_barrier(0);
          P1_LD(wb, 1); __builtin_amdgcn_sched_barrier(0);
          P1_DOT(wa, 0); __builtin_amdgcn_sched_barrier(0);
          P1_LD(wa, 2); __builtin_amdgcn_sched_barrier(0);
          P1_DOT(wb, 1); __builtin_amdgcn_sched_barrier(0);
          P1_LD(wb, 3); __builtin_amdgcn_sched_barrier(0);
          P1_DOT(wa, 2); __builtin_amdgcn_sched_barrier(0);
          P1_DOT(wb, 3); __builtin_amdgcn_sched_barrier(0);
#undef P1_LD
#undef P1_DOT
        }
        const float tot = xreduce<16>(part, lane);
        f32x4 z = *(const LAS f32x4*)(bup + 4 * lane);
#pragma unroll
        for (int r = 0; r < 16; ++r) z += *(const LAS f32x4*)(wup + r * 256 + 4 * lane) * lane_bcast(tot, 4 * r);
        f32x4 gk;
#pragma unroll
        for (int q = 0; q < 4; ++q) { const float zz = z[q]; gk[q] = (fminf(zz, 0.f) - __logf(1.f + __expf(-fabsf(zz)))) * (1.f / 16.f); }
        *(GAS f32x4*)(wsp<float>(F, WS_GK) + (size_t)m * 256 + 4 * lane) = gk;
    }
}

using pg8::Unit;
typedef pg8::f32x4 af4;
struct EpiInProj {
    static constexpr bool PERM = true;
    bf16 *QG, *KG, *VG, *RG, *QD, *KD, *VD; const float *gq, *gk;
    __device__ __forceinline__ void operator()(const af4 (&acc)[2][2][4][2], const Unit& u, int wr, int wc, int fr, int fq) const {
        const int pn = u.pn; const int row0 = u.pm * 256 + wr * 64 + fr;
        if (pn >= 6 && pn < 10) {
            const bool isq = pn < 8; bf16* base = isq ? QD : KD; const float* g = isq ? gq : gk; const float sc = isq ? C2 : 1.f;
            const int grp = 4 * ((pn - 6) & 1) + wc;
            af4 gv[2][2];
#pragma unroll
            for (int bj = 0; bj < 2; ++bj)
#pragma unroll
                for (int n = 0; n < 2; ++n) gv[bj][n] = *(const af4*)(g + 32 * bj + 8 * fq + 4 * n) * sc;
#pragma unroll
            for (int ai = 0; ai < 2; ++ai)
#pragma unroll
                for (int m = 0; m < 4; ++m) {
                    float ss = 0.f;
#pragma unroll
                    for (int bj = 0; bj < 2; ++bj)
#pragma unroll
                        for (int n = 0; n < 2; ++n) { const af4 v = acc[ai][bj][m][n]; ss += (v[0] * v[0] + v[1] * v[1]) + (v[2] * v[2] + v[3] * v[3]); }
                    ss += __shfl_xor(ss, 16); ss += __shfl_xor(ss, 32);
                    const float rs = rsqrtf(ss * (1.f / 64.f) + EPS);
                    bf16* rowp = base + (size_t)(row0 + ai * 128 + m * 16) * 512 + grp * 64 + 8 * fq;
#pragma unroll
                    for (int bj = 0; bj < 2; ++bj) { const af4 v0 = acc[ai][bj][m][0] * rs * gv[bj][0], v1 = acc[ai][bj][m][1] * rs * gv[bj][1];
                        pg8::u32x4 w; w.x = pg8::cvt_pk_bf16(v0[0], v0[1]); w.y = pg8::cvt_pk_bf16(v0[2], v0[3]); w.z = pg8::cvt_pk_bf16(v1[0], v1[1]); w.w = pg8::cvt_pk_bf16(v1[2], v1[3]);
                        *(pg8::u32x4*)(rowp + 32 * bj) = w; }
                }
        } else {
            bf16* base; int pitch, colt; int act = 0;
            if (pn == 0) { base = QG; pitch = 256; colt = 0; act = 1; }
            else if (pn == 1) { base = KG; pitch = 256; colt = 0; }
            else if (pn < 4) { base = VG; pitch = 512; colt = (pn - 2) * 256; }
            else if (pn < 6) { base = RG; pitch = 512; colt = (pn - 4) * 256; act = 2; }
            else { base = VD; pitch = 512; colt = (pn - 10) * 256; }
            const int col0 = colt + wc * 32 + 8 * fq;
#pragma unroll
            for (int ai = 0; ai < 2; ++ai)
#pragma unroll
                for (int m = 0; m < 4; ++m) { bf16* rowp = base + (size_t)(row0 + ai * 128 + m * 16) * pitch + col0;
#pragma unroll
                    for (int bj = 0; bj < 2; ++bj) { af4 v0 = acc[ai][bj][m][0], v1 = acc[ai][bj][m][1];
                        if (act == 1) { v0 = v0 * 0.125f; v1 = v1 * 0.125f; }
                        if (act == 2) {
#pragma unroll
                            for (int q = 0; q < 4; ++q) { v0[q] = v0[q] * sigmoidf_(v0[q]); v1[q] = v1[q] * sigmoidf_(v1[q]); } }
                        pg8::u32x4 w; w.x = pg8::cvt_pk_bf16(v0[0], v0[1]); w.y = pg8::cvt_pk_bf16(v0[2], v0[3]); w.z = pg8::cvt_pk_bf16(v1[0], v1[1]); w.w = pg8::cvt_pk_bf16(v1[2], v1[3]);
                        *(pg8::u32x4*)(rowp + bj * 128) = w; } }
        }
    }
};
struct EpiOutProj {
    static constexpr bool PERM = true;
    bf16* mix; const float* mod;
    __device__ __forceinline__ void operator()(const af4 (&acc)[2][2][4][2], const Unit& u, int wr, int wc, int fr, int fq) const {
        const int b = (u.pm * 256) / SEQ; const int col0 = u.pn * 256 + wc * 32 + 8 * fq;
        af4 gt[2][2];
#pragma unroll
        for (int bj = 0; bj < 2; ++bj)
#pragma unroll
            for (int n = 0; n < 2; ++n) gt[bj][n] = *(const af4*)(mod + (size_t)b * 6144 + 2048 + col0 + bj * 128 + 4 * n);
#pragma unroll
        for (int ai = 0; ai < 2; ++ai)
#pragma unroll
            for (int m = 0; m < 4; ++m) { bf16* rowp = mix + (size_t)(u.pm * 256 + ai * 128 + wr * 64 + m * 16 + fr) * D + col0;
#pragma unroll
                for (int bj = 0; bj < 2; ++bj) { const af4 v0 = acc[ai][bj][m][0] * gt[bj][0], v1 = acc[ai][bj][m][1] * gt[bj][1];
                    pg8::u32x4 w; w.x = pg8::cvt_pk_bf16(v0[0], v0[1]); w.y = pg8::cvt_pk_bf16(v0[2], v0[3]); w.z = pg8::cvt_pk_bf16(v1[0], v1[1]); w.w = pg8::cvt_pk_bf16(v1[2], v1[3]);
                    *(pg8::u32x4*)(rowp + bj * 128) = w; } }
    }
};
struct EpiSwiGLU {
    static constexpr bool PERM = false;
    unsigned char* Y; const float* bgu;
    __device__ __forceinline__ void operator()(const af4 (&acc)[2][2][4][2], const Unit& u, int wr, int wc, int fr, int fq) const {
        const int f0 = u.pn * 128 + wc * 32 + 4 * fq; const float* bb = bgu + (size_t)u.e * 2048 + f0;
        af4 bg[2], bu[2];
#pragma unroll
        for (int n = 0; n < 2; ++n) { bg[n] = *(const af4*)(bb + 16 * n); bu[n] = *(const af4*)(bb + 1024 + 16 * n); }
#pragma unroll
        for (int ai = 0; ai < 2; ++ai)
#pragma unroll
            for (int m = 0; m < 4; ++m) { unsigned char* rowp = Y + (size_t)(u.pm * 256 + ai * 128 + wr * 64 + m * 16 + fr) * FF + f0;
#pragma unroll
                for (int n = 0; n < 2; ++n) { const af4 g = acc[ai][0][m][n] * WSCALE_INV + bg[n], up = acc[ai][1][m][n] * WSCALE_INV + bu[n]; af4 y;
#pragma unroll
                    for (int q = 0; q < 4; ++q) { const float gg = fminf(g[q], 7.f), uu = fminf(fmaxf(up[q], -7.f), 7.f); y[q] = (uu + 1.f) * gg * sigmoidf_(1.702f * gg); }
                    *(unsigned*)(rowp + 16 * n) = pk4_fp8(y[0], y[1], y[2], y[3]); } }
    }
};
struct EpiDown {
    static constexpr bool PERM = true;
    unsigned char* Cn; const float* bd;
    __device__ __forceinline__ void operator()(const af4 (&acc)[2][2][4][2], const Unit& u, int wr, int wc, int fr, int fq) const {
        const int col0 = u.pn * 256 + wc * 32 + 8 * fq; const float* bb = bd + (size_t)u.e * 1024 + col0;
        af4 bv[2][2];
#pragma unroll
        for (int bj = 0; bj < 2; ++bj)
#pragma unroll
            for (int n = 0; n < 2; ++n) bv[bj][n] = *(const af4*)(bb + bj * 128 + 4 * n);
#pragma unroll
        for (int ai = 0; ai < 2; ++ai)
#pragma unroll
            for (int m = 0; m < 4; ++m) { const int row = u.pm * 256 + ai * 128 + wr * 64 + m * 16 + fr; unsigned char* rowp = Cn + (size_t)row * 1024 + col0;
#pragma unroll
                for (int bj = 0; bj < 2; ++bj) { const af4 v0 = acc[ai][bj][m][0] * WSCALE_INV + bv[bj][0], v1 = acc[ai][bj][m][1] * WSCALE_INV + bv[bj][1];
                    v2u w; w.x = pk4_fp8(v0[0], v0[1], v0[2], v0[3]); w.y = pk4_fp8(v1[0], v1[1], v1[2], v1[3]); *(v2u*)(rowp + bj * 128) = w; } }
    }
};

typedef float cf4 __attribute__((ext_vector_type(4)));
#define MFMA16(a, b, c) __builtin_amdgcn_mfma_f32_16x16x32_bf16((a), (b), (c), 0, 0, 0)
constexpr int GP = 72;
__device__ __forceinline__ void gla_a_unit(Frame& F, int chunk) {
    const int tid = F.tid, lane = F.lane, w = F.wave;
    const int bh = chunk >> 7, n = chunk & 127, b = bh >> 2, h = bh & 3;
    const size_t R0 = (size_t)b * SEQ + (size_t)n * 64;
    LAS float* gc = (LAS float*)F.lds;
    LAS float* segt = (LAS float*)(F.lds + 16384);
    LAS bf16* QEs = (LAS bf16*)(F.lds + 18432);
    LAS bf16* KEs = (LAS bf16*)(F.lds + 18432 + 9216);
    LAS bf16* KST = (LAS bf16*)(F.lds + 18432 + 2 * 9216);
    LAS bf16* VT = (LAS bf16*)(F.lds + 18432 + 3 * 9216);
    LAS bf16* AM = (LAS bf16*)(F.lds + 18432 + 3 * 9216 + 18432);
    const float* GK = wsp<const float>(F, WS_GK);
    { const int r = tid >> 3, d0 = (tid & 7) * 8; const float* gp = GK + (R0 + r) * 256 + h * 64 + d0;
      *(LAS f32x4*)(gc + r * 64 + d0) = *(const f32x4*)gp; *(LAS f32x4*)(gc + r * 64 + d0 + 4) = *(const f32x4*)(gp + 4); }
    __syncthreads();
    { const int seg = tid >> 6, d = tid & 63; float run = 0.f;
#pragma unroll
      for (int i = 0; i < 8; ++i) { run += gc[(seg * 8 + i) * 64 + d]; gc[(seg * 8 + i) * 64 + d] = run; }
      segt[seg * 64 + d] = run; }
    __syncthreads();
    { const int seg = tid >> 6, d = tid & 63; float off = 0.f;
      for (int s2 = 0; s2 < seg; ++s2) off += segt[s2 * 64 + d];
#pragma unroll
      for (int i = 0; i < 8; ++i) gc[(seg * 8 + i) * 64 + d] += off; }
    __syncthreads();
    { const int r = tid >> 3, d0 = (tid & 7) * 8;
      const v4u qv = *(const v4u*)(wsp<const bf16>(F, WS_QG) + (R0 + r) * 256 + h * 64 + d0);
      const v4u kv = *(const v4u*)(wsp<const bf16>(F, WS_KG) + (R0 + r) * 256 + h * 64 + d0);
      float qf[8], kf[8];
#pragma unroll
      for (int i = 0; i < 4; ++i) { qf[2 * i] = bflo(qv[i]); qf[2 * i + 1] = bfhi(qv[i]); kf[2 * i] = bflo(kv[i]); kf[2 * i + 1] = bfhi(kv[i]); }
      float qe[8], ke[8];
#pragma unroll
      for (int i = 0; i < 8; ++i) { const float g = gc[r * 64 + d0 + i], gl = gc[63 * 64 + d0 + i];
          qe[i] = qf[i] * __expf(g); ke[i] = kf[i] * __expf(-g); KST[(d0 + i) * GP + r] = (bf16)f2bf(kf[i] * __expf(gl - g)); }
      v4u qo, ko;
#pragma unroll
      for (int i = 0; i < 4; ++i) { qo[i] = pk2(qe[2 * i], qe[2 * i + 1]); ko[i] = pk2(ke[2 * i], ke[2 * i + 1]); }
      *(LAS v4u*)(QEs + r * GP + d0) = qo; *(LAS v4u*)(KEs + r * GP + d0) = ko;
      *(v4u*)(wsp<bf16>(F, WS_QE) + (R0 + r) * 256 + h * 64 + d0) = qo;
      const int e0 = (tid & 7) * 16;
      const v4u va = *(const v4u*)(wsp<const bf16>(F, WS_VG) + (R0 + r) * 512 + h * 128 + e0);
      const v4u vb = *(const v4u*)(wsp<const bf16>(F, WS_VG) + (R0 + r) * 512 + h * 128 + e0 + 8);
#pragma unroll
      for (int i = 0; i < 4; ++i) { VT[(e0 + 2 * i) * GP + r] = (bf16)(va[i] & 0xffffu); VT[(e0 + 2 * i + 1) * GP + r] = (bf16)(va[i] >> 16);
                                    VT[(e0 + 8 + 2 * i) * GP + r] = (bf16)(vb[i] & 0xffffu); VT[(e0 + 8 + 2 * i + 1) * GP + r] = (bf16)(vb[i] >> 16); }
      if (tid < 64) wsp<float>(F, WS_DEC)[(size_t)chunk * 64 + tid] = __expf(gc[63 * 64 + tid]);
    }
    __syncthreads();
    const int l15 = lane & 15, l4 = lane >> 4;
#pragma unroll
    for (int q = 0; q < 2; ++q) { const int tile = 2 * w + q, ti = tile >> 2, tj = tile & 3;
        cf4 a = {0.f, 0.f, 0.f, 0.f};
        if (tj <= ti) {
#pragma unroll
            for (int kk = 0; kk < 2; ++kk) { const bf16x8 fa = *(const LAS bf16x8*)(QEs + (16 * ti + l15) * GP + kk * 32 + 8 * l4); const bf16x8 fb = *(const LAS bf16x8*)(KEs + (16 * tj + l15) * GP + kk * 32 + 8 * l4); a = MFMA16(fa, fb, a); } }
#pragma unroll
        for (int r = 0; r < 4; ++r) { const int cr = 16 * ti + 4 * l4 + r, cj = 16 * tj + l15; AM[cr * GP + cj] = (bf16)f2bf(cj <= cr ? a[r] : 0.f); } }
    { float* UT = wsp<float>(F, WS_UT) + (size_t)chunk * 8192;
#pragma unroll
      for (int td = 0; td < 4; ++td) { cf4 a = {0.f, 0.f, 0.f, 0.f};
#pragma unroll
          for (int kk = 0; kk < 2; ++kk) { const bf16x8 fa = *(const LAS bf16x8*)(VT + (16 * w + l15) * GP + kk * 32 + 8 * l4); const bf16x8 fb = *(const LAS bf16x8*)(KST + (16 * td + l15) * GP + kk * 32 + 8 * l4); a = MFMA16(fa, fb, a); }
#pragma unroll
          for (int r = 0; r < 4; ++r) UT[(16 * w + 4 * l4 + r) * 64 + 16 * td + l15] = a[r]; } }
    __syncthreads();
    { float* OI = wsp<float>(F, WS_OI);
#pragma unroll
      for (int tc = 0; tc < 4; ++tc) { cf4 a = {0.f, 0.f, 0.f, 0.f};
#pragma unroll
          for (int kk = 0; kk < 2; ++kk) { const bf16x8 fa = *(const LAS bf16x8*)(AM + (16 * tc + l15) * GP + kk * 32 + 8 * l4); const bf16x8 fb = *(const LAS bf16x8*)(VT + (16 * w + l15) * GP + kk * 32 + 8 * l4); a = MFMA16(fa, fb, a); }
#pragma unroll
          for (int r = 0; r < 4; ++r) OI[(R0 + 16 * tc + 4 * l4 + r) * 512 + h * 128 + 16 * w + l15] = a[r]; } }
    __syncthreads();
}
__device__ __forceinline__ void gla_b_phase(Frame& F) {
    const float* UT = wsp<const float>(F, WS_UT); const float* DEC = wsp<const float>(F, WS_DEC); bf16* SP = wsp<bf16>(F, WS_SP);
    for (int gt = F.vcu * 512 + F.tid; gt < 16 * 8192; gt += F.G * 512) {
        const int bh = gt >> 13, ed = gt & 8191, d = gt & 63; float S = 0.f;
#pragma unroll 8
        for (int n = 0; n < 128; ++n) { const size_t ch = (size_t)bh * 128 + n; const float u = UT[ch * 8192 + ed], dc = DEC[ch * 64 + d]; SP[ch * 8192 + ed] = (bf16)f2bf(S); S = S * dc + u; }
    }
}
__device__ __forceinline__ void gla_c_unit(Frame& F, int unit) {
    const int tid = F.tid, lane = F.lane, w = F.wave;
    const int bh = unit >> 6, n2 = unit & 63, b = bh >> 2, h = bh & 3;
    const size_t R0 = (size_t)b * SEQ + (size_t)n2 * 128;
    LAS bf16* QEs = (LAS bf16*)F.lds;
    LAS bf16* SPs = (LAS bf16*)(F.lds + 18432);
    { const int r = tid >> 2, d0 = (tid & 3) * 16; const bf16* src = wsp<const bf16>(F, WS_QE) + (R0 + r) * 256 + h * 64 + d0;
      *(LAS v4u*)(QEs + r * GP + d0) = *(const v4u*)src; *(LAS v4u*)(QEs + r * GP + d0 + 8) = *(const v4u*)(src + 8);
      const bf16* sp = wsp<const bf16>(F, WS_SP) + ((size_t)bh * 128 + 2 * n2) * 8192;
      const int row = tid >> 1, dd = (tid & 1) * 32;
#pragma unroll
      for (int i = 0; i < 4; ++i) *(LAS v4u*)(SPs + row * GP + dd + 8 * i) = *(const v4u*)(sp + (size_t)row * 64 + dd + 8 * i); }
    __syncthreads();
    const int l15 = lane & 15, l4 = lane >> 4, c2 = w >> 2, tc = w & 3;
    cf4 a[8];
#pragma unroll
    for (int te = 0; te < 8; ++te) { a[te] = (cf4){0.f, 0.f, 0.f, 0.f};
#pragma unroll
        for (int kk = 0; kk < 2; ++kk) { const bf16x8 fa = *(const LAS bf16x8*)(QEs + (64 * c2 + 16 * tc + l15) * GP + kk * 32 + 8 * l4); const bf16x8 fb = *(const LAS bf16x8*)(SPs + (128 * c2 + 16 * te + l15) * GP + kk * 32 + 8 * l4); a[te] = MFMA16(fa, fb, a[te]); } }
    const float* OI = wsp<const float>(F, WS_OI); const bf16* RG = wsp<const bf16>(F, WS_RG); bf16* A2 = wsp<bf16>(F, WS_A2);
    float gg[8];
#pragma unroll
    for (int te = 0; te < 8; ++te) gg[te] = F.g_gla_out[16 * te + l15];
#pragma unroll
    for (int r = 0; r < 4; ++r) { const size_t row = R0 + 64 * c2 + 16 * tc + 4 * l4 + r; float ss = 0.f; float o[8];
#pragma unroll
        for (int te = 0; te < 8; ++te) { o[te] = a[te][r] + OI[row * 512 + h * 128 + 16 * te + l15]; ss += o[te] * o[te]; }
        ss += __shfl_xor(ss, 1); ss += __shfl_xor(ss, 2); ss += __shfl_xor(ss, 4); ss += __shfl_xor(ss, 8);
        const float rs = rsqrtf(ss * (1.f / 128.f) + EPS);
#pragma unroll
        for (int te = 0; te < 8; ++te) { const int e = 16 * te + l15; A2[row * 1024 + h * 128 + e] = (bf16)f2bf(o[te] * rs * gg[te] * bf2f(RG[row * 512 + h * 128 + e])); } }
    __syncthreads();
}

namespace att {
constexpr int KSLOT = 8192, VSLOT = 16384, NSLOT = 3;
constexpr int LDS_K = 0, LDS_V = NSLOT * KSLOT, LDS_TBL = LDS_V + NSLOT * VSLOT, LDS_WS = LDS_TBL + 1024, LDS_Q = LDS_WS + 8 * 256, LDS_END = LDS_Q + 8 * 4096;
static_assert(LDS_END <= RING_BYTES, "attention LDS");
__device__ __forceinline__ int crow(int r, int hi) { return (r & 3) + 8 * (r >> 2) + 4 * hi; }
__device__ __forceinline__ void glds16(const void* gsrc, unsigned lds_dst) { unsigned keep;
    asm volatile("s_mov_b32 %0, m0\n\ts_mov_b32 m0, %2\n\ts_nop 0\n\tglobal_load_lds_dwordx4 %1, off\n\ts_mov_b32 m0, %0" : "=&s"(keep) : "v"(gsrc), "s"(lds_dst) : "memory"); }
typedef float f32x2_t __attribute__((ext_vector_type(2))); typedef __bf16 bf16x2_t __attribute__((ext_vector_type(2)));
__device__ __forceinline__ unsigned cvtpk_s(float lo, float hi) { f32x2_t v = {lo, hi}; bf16x2_t b = __builtin_convertvector(v, bf16x2_t); return __builtin_bit_cast(unsigned, b); }
typedef short v4i16_t __attribute__((ext_vector_type(4)));
typedef LAS const char* lds_cptr;
__device__ __forceinline__ s16x4 vtr(lds_cptr p) { return __builtin_bit_cast(s16x4, __builtin_amdgcn_ds_read_tr16_b64_v4i16((LAS v4i16_t*)p)); }
#define MFMA32(a, b, c) __builtin_amdgcn_mfma_f32_32x32x16_bf16((a), (b), (c), 0, 0, 0)
#define ATT_WAIT_BAR(N) asm volatile("s_waitcnt vmcnt(" #N ") lgkmcnt(0)\n\ts_barrier" ::: "memory")

__device__ __forceinline__ void attn_map(f32x16 (&o)[4], int b, int h, int m, int qb, const bf16* QD, const bf16* KD, const bf16* VD, LAS unsigned char* shm) {
    int lane = threadIdx.x & 63; asm volatile("" : "+v"(lane));
    const int tid = threadIdx.x, r32 = lane & 31, hi = lane >> 5; const int wid = __builtin_amdgcn_readfirstlane(tid >> 6);
    const size_t rowbase = (size_t)b * SEQ; const int q0 = qb * 256;
    const bf16* Qw = QD + (rowbase + q0 + wid * 32) * 512 + (h * 2 + m) * 64;
    const bf16* Kh = KD + rowbase * 512 + (h * 2 + m) * 64; const bf16* Vh = VD + rowbase * 512 + h * 128;
    const unsigned lds0 = (unsigned)(uintptr_t)shm;
    const LAS float* tbl = (const LAS float*)(shm + LDS_TBL) + m * 128;
    LAS float* wsf = (LAS float*)(shm + LDS_WS) + wid * 64;
    const bf16* ksrc = Kh + (size_t)lane * 512 + wid * 8;
    const bf16* vsrc = Vh + (size_t)(16 * (wid & 3) + (lane >> 2)) * 512 + (wid >> 2) * 32 + (lane & 3) * 8;
    const unsigned kdst = lds0 + LDS_K + wid * 1024, vdst = lds0 + LDS_V + wid * 1024;
#define DMA_K(t, slot) glds16(ksrc + (size_t)(t) * 64 * 512, (unsigned)__builtin_amdgcn_readfirstlane(kdst + (slot) * KSLOT))
#define DMA_V(t, slot) do { glds16(vsrc + (size_t)(t) * 64 * 512, (unsigned)__builtin_amdgcn_readfirstlane(vdst + (slot) * VSLOT)); \
        glds16(vsrc + (size_t)(t) * 64 * 512 + 64, (unsigned)__builtin_amdgcn_readfirstlane(vdst + (slot) * VSLOT + 8192)); } while (0)
    const int NT = 4 * qb + 4;
    VM_WAIT();
    DMA_K(0, 0); DMA_V(0, 0); DMA_K(1, 1); DMA_K(2, 2);
    const lds_cptr qlds = (lds_cptr)shm + LDS_Q + wid * 4096 + lane * 16;
    { bf16x8 qr[4];
#pragma unroll
      for (int d0 = 0; d0 < 4; ++d0) qr[d0] = *(const bf16x8*)(Qw + (size_t)r32 * 512 + d0 * 16 + hi * 8);
      asm volatile("s_waitcnt vmcnt(0)" : "+v"(qr[0]), "+v"(qr[1]), "+v"(qr[2]), "+v"(qr[3]) :: "memory");
#pragma unroll
      for (int d0 = 0; d0 < 4; ++d0) *(LAS bf16x8*)(shm + LDS_Q + wid * 4096 + lane * 16 + d0 * 1024) = qr[d0]; }
#pragma unroll
    for (int d0 = 0; d0 < 4; ++d0) o[d0] = (f32x16){};
    float lsum = 0.f;
    const int qw0 = q0 + wid * 32, qabs = qw0 + r32;
    const lds_cptr shm3 = (lds_cptr)shm;
    const lds_cptr kp0 = shm3 + LDS_K + hi * 1024 + r32 * 16;
    const lds_cptr vp0 = shm3 + LDS_V + ((lane >> 4) & 1) * 32 + (lane & 3) * 8 + (4 * hi + ((lane & 15) >> 2)) * 64;
#define QK_TILE(C0, C1, kp) do { C0 = (f32x16){}; C1 = (f32x16){}; \
        _Pragma("unroll") for (int d0 = 0; d0 < 4; ++d0) { if (d0 == 2) __builtin_amdgcn_sched_barrier(0); const bf16x8 b0 = *(const LAS bf16x8*)((kp) + d0 * 2048); const bf16x8 b1 = *(const LAS bf16x8*)((kp) + d0 * 2048 + 512); \
            const bf16x8 qf_ = *(const LAS bf16x8*)(qlds + d0 * 1024); C0 = MFMA32(b0, qf_, C0); C1 = MFMA32(b1, qf_, C1); } } while (0)
#define MASK_BIAS(C0, C1, t) do { const int kvb_ = (t) * 64; if (kvb_ + 191 > qw0) { int dbase = qabs - kvb_ - 4 * hi; asm volatile("" : "+v"(dbase)); \
        _Pragma("unroll") for (int r = 0; r < 16; ++r) { const int d0_ = dbase - ((r & 3) + 8 * (r >> 2)); const int d1_ = d0_ - 32; \
            C0[r] = d0_ < 0 ? -INFINITY : C0[r] + tbl[d0_ > 127 ? 127 : d0_]; C1[r] = d1_ < 0 ? -INFINITY : C1[r] + tbl[d1_ > 127 ? 127 : d1_]; } } } while (0)
#define VLOAD(vf, vp, d0) do { _Pragma("unroll") for (int ks = 0; ks < 4; ++ks) { const s16x4 lo_ = vtr((vp) + (d0) * 4096 + ks * 1024), hh_ = vtr((vp) + (d0) * 4096 + ks * 1024 + 512); \
            vf[ks] = (bf16x8){lo_[0], lo_[1], lo_[2], lo_[3], hh_[0], hh_[1], hh_[2], hh_[3]}; } } while (0)
#define PV4(d0, vf) do { _Pragma("unroll") for (int ks = 0; ks < 4; ++ks) o[d0] = MFMA32(__builtin_bit_cast(bf16x8, pw[ks]), vf[ks], o[d0]); } while (0)
#define PACK_SUM(P0, P1) do { float sacc = 0.f; _Pragma("unroll") for (int r = 0; r < 16; ++r) sacc += P0[r] + P1[r]; lsum += sacc; \
        _Pragma("unroll") for (int i = 0; i < 4; ++i) { pw[0][i] = cvtpk_s(P0[2 * i], P0[2 * i + 1]); pw[1][i] = cvtpk_s(P0[8 + 2 * i], P0[9 + 2 * i]); pw[2][i] = cvtpk_s(P1[2 * i], P1[2 * i + 1]); pw[3][i] = cvtpk_s(P1[8 + 2 * i], P1[9 + 2 * i]); } } while (0)
#define EXP_PACK(C, pwa, pwb) do { float sacc = 0.f; _Pragma("unroll") for (int r = 0; r < 16; ++r) { C[r] = __builtin_amdgcn_exp2f(C[r]); sacc += C[r]; } lsum += sacc; \
        _Pragma("unroll") for (int i = 0; i < 4; ++i) { pwa[i] = cvtpk_s(C[2 * i], C[2 * i + 1]); pwb[i] = cvtpk_s(C[8 + 2 * i], C[9 + 2 * i]); } } while (0)
#define KLOAD(kf, kp) do { _Pragma("unroll") for (int d0 = 0; d0 < 4; ++d0) { kf[2 * d0] = *(const LAS bf16x8*)((kp) + d0 * 2048); kf[2 * d0 + 1] = *(const LAS bf16x8*)((kp) + d0 * 2048 + 512); } } while (0)
#define QLOAD(qf) do { _Pragma("unroll") for (int d0 = 0; d0 < 4; ++d0) qf[d0] = *(const LAS bf16x8*)(qlds + d0 * 1024); } while (0)
#define QK8(C0, C1, kf, qf) do { C0 = (f32x16){}; C1 = (f32x16){}; _Pragma("unroll") for (int d0 = 0; d0 < 4; ++d0) { C0 = MFMA32(kf[2 * d0], qf[d0], C0); C1 = MFMA32(kf[2 * d0 + 1], qf[d0], C1); } } while (0)
#define SB() __builtin_amdgcn_sched_barrier(0)
    f32x16 C0, C1; v4u pw[4], pwn[4]; bf16x8 va[4], vb[4], kf[8], qf[4];
    ATT_WAIT_BAR(0);
    KLOAD(kf, kp0); QLOAD(qf);
    ATT_WAIT_BAR(0);
    if (3 < NT) DMA_K(3, 0);
    DMA_V(1, 1);
    QK8(C0, C1, kf, qf);
    MASK_BIAS(C0, C1, 0);
    EXP_PACK(C0, pw[0], pw[1]); EXP_PACK(C1, pw[2], pw[3]);
    KLOAD(kf, kp0 + KSLOT);
    int ks_cur = 1, vs_prev = 0;
    for (int t = 1; t < NT; ++t) {
        if (t + 2 < NT) { ATT_WAIT_BAR(3); } else { ATT_WAIT_BAR(2); }
        { const int vs_new = (vs_prev == 0) ? 2 : vs_prev - 1;
          if (t + 3 < NT) DMA_K(t + 3, ks_cur);
          if (t + 1 < NT) DMA_V(t + 1, vs_new); }
        const int ks_next = (ks_cur == 2) ? 0 : ks_cur + 1;
        const lds_cptr vp = vp0 + vs_prev * VSLOT;
        SB();
        VLOAD(va, vp, 0); VLOAD(vb, vp, 1); QLOAD(qf);
        SB();
        QK8(C0, C1, kf, qf);
        SB();
        MASK_BIAS(C0, C1, t);
        SB();
        PV4(0, va); PV4(1, vb);
        EXP_PACK(C0, pwn[0], pwn[1]);
        SB();
        VLOAD(va, vp, 2); VLOAD(vb, vp, 3);
        KLOAD(kf, kp0 + ks_next * KSLOT);
        SB();
        PV4(2, va); PV4(3, vb);
        EXP_PACK(C1, pwn[2], pwn[3]);
        SB();
#pragma unroll
        for (int i = 0; i < 4; ++i) pw[i] = pwn[i];
        ks_cur = ks_next; vs_prev = (vs_prev == 2) ? 0 : vs_prev + 1;
    }
    ATT_WAIT_BAR(0);
    { const lds_cptr vp = vp0 + vs_prev * VSLOT;
      VLOAD(va, vp, 0); VLOAD(vb, vp, 1); PV4(0, va); PV4(1, vb);
      VLOAD(va, vp, 2); VLOAD(vb, vp, 3); PV4(2, va); PV4(3, vb); }
    { auto rr = __builtin_amdgcn_permlane32_swap(__float_as_uint(lsum), __float_as_uint(lsum), false, false); lsum = __uint_as_float(rr[0]) + __uint_as_float(rr[1]); }
    if (hi == 0) wsf[r32] = lsum;
    LDS_WAIT();
#pragma unroll
    for (int r = 0; r < 16; ++r) { const float rl = 1.0f / wsf[crow(r, hi)];
#pragma unroll
        for (int d0 = 0; d0 < 4; ++d0) o[d0][r] *= rl; }
    ATT_WAIT_BAR(0);
#undef DMA_K
#undef DMA_V
#undef QK_TILE
#undef MASK_BIAS
#undef VLOAD
#undef PV4
#undef PACK_SUM
#undef EXP_PACK
#undef KLOAD
#undef QLOAD
#undef QK8
#undef SB
}
__device__ __forceinline__ int t5_bucket(int n) {
    if (n < 16) return n;
    const float nf = (float)n; int large = 16 + (int)(logf(nf / 16.f) / logf(8.f) * 16.f);
    return large < 31 ? large : 31;
}
__device__ __forceinline__ void attn_unit(Frame& F, int b, int h, int qb, float lam) {
    LAS unsigned char* shm = F.lds;
    int tid = F.tid; asm volatile("" : "+v"(tid));
    const int lane = tid & 63, r32 = lane & 31, hi = lane >> 5, wid = F.wave;
    if (tid < 256) { const int m = tid >> 7, d = tid & 127; const int col = h * 2 + m;
        ((LAS float*)(shm + LDS_TBL))[tid] = (F.rel_bias[t5_bucket(d) * 8 + col] - F.rel_bias[31 * 8 + col]) * LOG2E; }
    __syncthreads();
    const bf16* QD = wsp<const bf16>(F, WS_QD); const bf16* KD = wsp<const bf16>(F, WS_KD); const bf16* VD = wsp<const bf16>(F, WS_VD);
    float* stash = wsp<float>(F, WS_STASH) + (size_t)F.vcu * 32768 + tid * 64;
    f32x16 o[4];
#pragma nounroll
    for (int m = 0; m < 2; ++m) {
        attn_map(o, b, h, m, qb, QD, KD, VD, shm);
        if (m == 0) {
#pragma unroll
            for (int d0 = 0; d0 < 4; ++d0)
#pragma unroll
                for (int r = 0; r < 16; r += 4) *(f32x4*)(stash + d0 * 16 + r) = (f32x4){o[d0][r], o[d0][r + 1], o[d0][r + 2], o[d0][r + 3]};
        } else {
            float ss[16];
#pragma unroll
            for (int r = 0; r < 16; ++r) ss[r] = 0.f;
#pragma unroll
            for (int d0 = 0; d0 < 4; ++d0)
#pragma unroll
                for (int r4 = 0; r4 < 16; r4 += 4) { const f32x4 sv = *(const f32x4*)(stash + d0 * 16 + r4);
#pragma unroll
                    for (int q = 0; q < 4; ++q) { const int r = r4 + q; const float v = sv[q] - lam * o[d0][r]; o[d0][r] = v; ss[r] += v * v; } }
            float gs[4];
#pragma unroll
            for (int d0 = 0; d0 < 4; ++d0) gs[d0] = F.g_subln[32 * d0 + r32] * 0.8f;
            bf16* A2 = wsp<bf16>(F, WS_A2);
            const size_t rowb = (size_t)b * SEQ + (size_t)qb * 256 + wid * 32;
            bf16* a2b = A2 + (rowb + 4 * hi) * 1024 + 512 + h * 128 + r32; asm volatile("" : "+v"(a2b));
#pragma unroll
            for (int r = 0; r < 16; ++r) { float s = ss[r];
                s += __shfl_xor(s, 1); s += __shfl_xor(s, 2); s += __shfl_xor(s, 4); s += __shfl_xor(s, 8); s += __shfl_xor(s, 16);
                const float rs = rsqrtf(s * (1.f / 128.f) + EPS);
                bf16* rowp = a2b + (size_t)((r & 3) + 8 * (r >> 2)) * 1024;
#pragma unroll
                for (int d0 = 0; d0 < 4; ++d0) rowp[32 * d0] = (bf16)f2bf(o[d0][r] * rs * gs[d0]); }
        }
    }
    __syncthreads();
}
}

__device__ __forceinline__ void p7_phase(Frame& F, bool count = true) {
    const int tid = F.tid, lane = F.lane;
    LAS float* wr = (LAS float*)F.lds;
    LAS unsigned* hist = (LAS unsigned*)(F.lds + HIST_OFF);
    for (int idx = tid; idx < 32768; idx += 512) { const int k = idx >> 5, e = idx & 31; wr[e * 1024 + k] = F.w_router[idx]; }
    if (tid < 32) hist[tid] = 0u;
    __syncthreads();
    const float* MOD = wsp<const float>(F, WS_MOD);
    const int gw = F.vcu * NWAVES + F.wave, NGW = F.G * NWAVES; const int rpw = (T + NGW - 1) / NGW;
    int curb = -1; f32x4 gsc[4], shv[4], nx[4];
    v2u nm[4]; const bf16* MIX = wsp<const bf16>(F, WS_MIX);
    { const int m0 = (gw * rpw < T) ? gw * rpw : 0; const GAS f32x4* xr = (const GAS f32x4*)(F.x + (size_t)m0 * D) + lane; const GAS v2u* mr = (const GAS v2u*)(MIX + (size_t)m0 * D) + lane;
#pragma unroll
      for (int j = 0; j < 4; ++j) { nx[j] = xr[64 * j]; nm[j] = mr[64 * j]; } }
#pragma nounroll
    for (int i = 0; i < rpw; ++i) {
        const int m = gw * rpw + i; if (m >= T) break;
        const int b = m / SEQ;
        if (b != curb) { curb = b;
#pragma unroll
            for (int j = 0; j < 4; ++j) { const int col = 256 * j + 4 * lane; const f32x4 g = *(const f32x4*)(F.g_norm2 + col);
                shv[j] = *(const f32x4*)(MOD + (size_t)b * 6144 + 3072 + col); gsc[j] = g * (*(const f32x4*)(MOD + (size_t)b * 6144 + 4096 + col) + 1.0f); } }
        f32x4 v[4]; float s = 0.f;
#pragma unroll
        for (int j = 0; j < 4; ++j) { v[j] = nx[j] + (f32x4){bflo(nm[j].x), bfhi(nm[j].x), bflo(nm[j].y), bfhi(nm[j].y)}; s += (v[j].x * v[j].x + v[j].y * v[j].y) + (v[j].z * v[j].z + v[j].w * v[j].w); }
        { const int m2 = (m + 1 < T) ? m + 1 : m; const GAS f32x4* xr = (const GAS f32x4*)(F.x + (size_t)m2 * D) + lane; const GAS v2u* mr = (const GAS v2u*)(MIX + (size_t)m2 * D) + lane;
#pragma unroll
          for (int j = 0; j < 4; ++j) { nx[j] = xr[64 * j]; nm[j] = mr[64 * j]; } }
        const float rstd = rsqrtf(wave_sum(s) * (1.f / D) + EPS);
        GAS unsigned* o4 = (GAS unsigned*)(wsp<unsigned char>(F, WS_XN) + (size_t)m * D) + lane;
#pragma unroll
        for (int j = 0; j < 4; ++j) { v[j] = v[j] * rstd * gsc[j] + shv[j]; o4[64 * j] = pk4_fp8(v[j].x, v[j].y, v[j].z, v[j].w); }
        float lg[32];
        { f32x4 wa[8], wb[8];
#define P7_LD(dst, eb) do { _Pragma("unroll") for (int q = 0; q < 8; ++q) dst[q] = *(const LAS f32x4*)(wr + ((eb) * 2 + (q >> 2)) * 1024 + 256 * (q & 3) + 4 * lane); } while (0)
#define P7_DOT(src, eb) do { _Pragma("unroll") for (int rr = 0; rr < 2; ++rr) { f32x2 a2 = {0.f, 0.f}; _Pragma("unroll") for (int j = 0; j < 4; ++j) { const f32x4 w = src[rr * 4 + j]; a2 += v[j].lo * w.lo; a2 += v[j].hi * w.hi; } lg[(eb) * 2 + rr] = a2.x + a2.y; } } while (0)
          P7_LD(wa, 0); __builtin_amdgcn_sched_barrier(0);
#pragma unroll
          for (int eb = 0; eb < 16; eb += 2) {
              P7_LD(wb, eb + 1); __builtin_amdgcn_sched_barrier(0);
              P7_DOT(wa, eb); __builtin_amdgcn_sched_barrier(0);
              if (eb + 2 < 16) { P7_LD(wa, eb + 2); __builtin_amdgcn_sched_barrier(0); }
              P7_DOT(wb, eb + 1); __builtin_amdgcn_sched_barrier(0);
          }
#undef P7_LD
#undef P7_DOT
        }
        const float myl = xreduce<32>(lg, lane) + F.b_router[lane >> 1];
        unsigned key; { const unsigned u = __builtin_bit_cast(unsigned, myl); const unsigned o = (u & 0x80000000u) ? ~u : (u | 0x80000000u); key = (o & ~31u) | (unsigned)(31 - (lane >> 1)); }
        int te[4]; float tv[4];
#pragma unroll
        for (int k = 0; k < 4; ++k) { const unsigned mx = wave_umax(key); te[k] = 31 - (int)(mx & 31u); tv[k] = lane_bcast(myl, 2 * te[k]); key = (key == mx) ? 0u : key; }
        float ex[4], es = 0.f;
#pragma unroll
        for (int k = 0; k < 4; ++k) { ex[k] = __expf(tv[k] - tv[0]); es += ex[k]; }
        if (lane < 4) { const int e = lane == 0 ? te[0] : lane == 1 ? te[1] : lane == 2 ? te[2] : te[3]; const float w = (lane == 0 ? ex[0] : lane == 1 ? ex[1] : lane == 2 ? ex[2] : ex[3]) / es;
            wsp<int>(F, WS_TOPE)[(size_t)m * 4 + lane] = e; wsp<float>(F, WS_TOPW)[(size_t)m * 4 + lane] = w; __hip_atomic_fetch_add(hist + e, 1u, __ATOMIC_RELAXED, __HIP_MEMORY_SCOPE_WORKGROUP); }
    }
    __syncthreads();
    if (tid < 32 && count) __hip_atomic_fetch_add(F.ctl + CW_CNT + tid, hist[tid], RLX_AGENT);
}
__device__ __forceinline__ void moe_tables(Frame& F, int& nMt) {
    LAS unsigned char* te = F.lds + TILEE_OFF;
    if (F.tid == 0) { int t0 = 0;
        for (int e = 0; e < NE; ++e) { const int c = (int)__hip_atomic_load(F.ctl + CW_CNT + e, RLX_AGENT); const int nt = (c + 255) >> 8; for (int j = 0; j < nt; ++j) te[t0 + j] = (unsigned char)e; t0 += nt; }
        F.MISC[16] = (unsigned)t0; }
    __syncthreads();
    nMt = __builtin_amdgcn_readfirstlane((int)F.MISC[16]);
}
__device__ __forceinline__ void p8_phase(Frame& F) {
    const int tid = F.tid, lane = F.lane;
    LAS unsigned* hist = (LAS unsigned*)(F.lds + HIST_OFF);
    if (tid < 96) hist[tid] = 0u;
    __syncthreads();
    const int gw = F.vcu * NWAVES + F.wave, NGW = F.G * NWAVES; const int rpw = (T + NGW - 1) / NGW;
    const int* TOPE = wsp<const int>(F, WS_TOPE);
    for (int i = 0; i < rpw; ++i) { const int m = gw * rpw + i; if (m >= T) break; if (lane < 4) __hip_atomic_fetch_add(hist + TOPE[(size_t)m * 4 + lane], 1u, __ATOMIC_RELAXED, __HIP_MEMORY_SCOPE_WORKGROUP); }
    __syncthreads();
    if (tid < 32) { unsigned pstart = 0; for (int e = 0; e < tid; ++e) { const unsigned c = __hip_atomic_load(F.ctl + CW_CNT + e, RLX_AGENT); pstart += (c + 255u) & ~255u; }
        hist[32 + tid] = pstart + __hip_atomic_fetch_add(F.ctl + CW_FILL + tid, hist[tid], RLX_AGENT); }
    __syncthreads();
    const unsigned char* H2 = wsp<const unsigned char>(F, WS_XN); unsigned char* XS = wsp<unsigned char>(F, WS_XS);
    for (int i = 0; i < rpw; ++i) { const int m = gw * rpw + i; if (m >= T) break;
        int pos = 0;
        if (lane < 4) { const int e = TOPE[(size_t)m * 4 + lane]; pos = (int)(hist[32 + e] + __hip_atomic_fetch_add(hist + 64 + e, 1u, __ATOMIC_RELAXED, __HIP_MEMORY_SCOPE_WORKGROUP));
            wsp<int>(F, WS_POS)[(size_t)m * 4 + lane] = pos; }
        const v4u a = *(const v4u*)(H2 + (size_t)m * D + lane * 16);
#pragma unroll
        for (int k = 0; k < 4; ++k) { const int p = __shfl(pos, k); *(v4u*)(XS + (size_t)p * D + lane * 16) = a; }
    }
}
__device__ __forceinline__ void p11_phase(Frame& F) {
    const int lane = F.lane;
    const float* MOD = wsp<const float>(F, WS_MOD); const unsigned char* CN = wsp<const unsigned char>(F, WS_CN); const int* POS = wsp<const int>(F, WS_POS);
    const int gw = F.vcu * NWAVES + F.wave, NGW = F.G * NWAVES; const int rpw = (T + NGW - 1) / NGW;
    const int mbeg = gw * rpw, mend = (mbeg + rpw < T) ? mbeg + rpw : T;
    if (mbeg >= mend) return;
    v4u ca[4], mx0, mx1; f32x4 xv[4]; int pn[4]; f32x4 wcur, wnxt; const float* TOPW = wsp<const float>(F, WS_TOPW); const bf16* MIXp = wsp<const bf16>(F, WS_MIX);
#define P11_LOAD(mm) do { _Pragma("unroll") for (int k = 0; k < 4; ++k) ca[k] = *(const v4u*)(CN + (size_t)pn[k] * D + lane * 16); \
        _Pragma("unroll") for (int q = 0; q < 4; ++q) xv[q] = *(const f32x4*)(F.x + (size_t)(mm) * D + lane * 16 + 4 * q); \
        { const v4u* ms_ = (const v4u*)(MIXp + (size_t)(mm) * D + lane * 16); mx0 = ms_[0]; mx1 = ms_[1]; } } while (0)
    { const int4 p4 = *(const int4*)(POS + (size_t)mbeg * 4); pn[0] = p4.x; pn[1] = p4.y; pn[2] = p4.z; pn[3] = p4.w; }
    P11_LOAD(mbeg); wcur = *(const f32x4*)(TOPW + (size_t)mbeg * 4);
    { const int m2 = (mbeg + 1 < mend) ? mbeg + 1 : mbeg; const int4 p4 = *(const int4*)(POS + (size_t)m2 * 4); pn[0] = p4.x; pn[1] = p4.y; pn[2] = p4.z; pn[3] = p4.w; wnxt = *(const f32x4*)(TOPW + (size_t)m2 * 4); }
#pragma nounroll
    for (int m = mbeg; m < mend; ++m) {
        const int b = m / SEQ;
        float acc[16];
#pragma unroll
        for (int q = 0; q < 16; ++q) acc[q] = 0.f;
#pragma unroll
        for (int k = 0; k < 4; ++k) { const float wk = wcur[k];
#pragma unroll
            for (int q = 0; q < 4; ++q) { const int wq = (int)ca[k][q];
                acc[4 * q] += wk * __builtin_amdgcn_cvt_f32_fp8(wq, 0); acc[4 * q + 1] += wk * __builtin_amdgcn_cvt_f32_fp8(wq, 1);
                acc[4 * q + 2] += wk * __builtin_amdgcn_cvt_f32_fp8(wq, 2); acc[4 * q + 3] += wk * __builtin_amdgcn_cvt_f32_fp8(wq, 3); } }
        f32x4 ov[4]; const float* gt = MOD + (size_t)b * 6144 + 5120 + lane * 16;
#pragma unroll
        for (int q = 0; q < 4; ++q) { const f32x4 g = *(const f32x4*)(gt + 4 * q); const f32x4 av = {acc[4 * q], acc[4 * q + 1], acc[4 * q + 2], acc[4 * q + 3]};
            const unsigned ma = q < 2 ? mx0[2 * q] : mx1[2 * q - 4], mb = q < 2 ? mx0[2 * q + 1] : mx1[2 * q - 3];
            ov[q] = xv[q] + (f32x4){bflo(ma), bfhi(ma), bflo(mb), bfhi(mb)} + g * av; }
        const int m1 = (m + 1 < mend) ? m + 1 : m;
        P11_LOAD(m1);
        wcur = wnxt;
        { const int m2 = (m + 2 < mend) ? m + 2 : m1; const int4 p4 = *(const int4*)(POS + (size_t)m2 * 4); pn[0] = p4.x; pn[1] = p4.y; pn[2] = p4.z; pn[3] = p4.w; wnxt = *(const f32x4*)(TOPW + (size_t)m2 * 4); }
        float* orow = F.out + (size_t)m * D + lane * 16;
#pragma unroll
        for (int q = 0; q < 4; ++q) *(f32x4*)(orow + 4 * q) = ov[q];
    }
#undef P11_LOAD
}

constexpr int NPHASE = 12;
struct Args { const float* in[25]; float* out; unsigned char* ws; int ph_lo, ph_hi; };
__global__ void __launch_bounds__(NWAVES * 64, 2) fwd_kernel(Args args) {
    extern __shared__ __attribute__((aligned(16))) unsigned char lds[];
    Frame F;
    F.lds = (LAS unsigned char*)lds;
    F.MISC = (volatile LAS unsigned*)(F.lds + MISC_OFF);
    F.tid = threadIdx.x; F.lane = F.tid & 63; F.wave = __builtin_amdgcn_readfirstlane(F.tid >> 6);
    F.G = gridDim.x; { const int bx = blockIdx.x; F.vcu = (F.G % 8 == 0) ? (bx % 8) * (F.G / 8) + bx / 8 : bx; }
    F.ws = args.ws; F.ctl = (gu32*)(args.ws + WS_CTL); F.out = args.out;
    F.x = args.in[0]; F.c = args.in[1]; F.rel_bias = args.in[2]; F.w_ada = args.in[3]; F.b_ada = args.in[4]; F.g_norm1 = args.in[5]; F.w_in = args.in[6];
    F.w_gk_up = args.in[7]; F.b_gk_up = args.in[8]; F.g_gla_out = args.in[9]; F.g_qnorm = args.in[10]; F.g_knorm = args.in[11];
    F.lq1 = args.in[12]; F.lk1 = args.in[13]; F.lq2 = args.in[14]; F.lk2 = args.in[15]; F.g_subln = args.in[16]; F.w_out = args.in[17];
    F.g_norm2 = args.in[18]; F.w_router = args.in[19]; F.b_router = args.in[20]; F.w_gate_up = args.in[21]; F.b_gate_up = args.in[22]; F.w_down = args.in[23]; F.b_down = args.in[24];
    for (int u = F.tid; u < (LDS_BYTES - LDSCTL_OFF) / 4; u += NWAVES * 64) ((LAS unsigned*)(F.lds + LDSCTL_OFF))[u] = 0u;
    __syncthreads();
    const int lo = args.ph_lo, hi = args.ph_hi;
    const bool multi = (hi - lo) > 1;
    XcdBarrier bar; bar.bar = (unsigned*)(F.ctl + CW_BAR); bar.x = 0; bar.st = nullptr;
    if (multi) bar = xcd_barrier_post((unsigned*)(F.ctl + CW_BAR), F.MISC + 8);
#ifndef PHMASK
#define PHMASK 0xFFF
#endif
#define IN(k) (((PHMASK >> (k)) & 1) && lo <= (k) && (k) < hi)
#define SEAM(k) do { if (IN((k) + 1)) xcd_barrier(bar); } while (0)
#ifndef REPEAT_PH
#define REPEAT_PH 0
#endif
#define REPS(k) (((REPEAT_PH >> (k)) & 1) ? 2 : 1)

    if (IN(0)) { for (int rep_ = 0; rep_ < REPS(0); ++rep_) { if (rep_) xcd_barrier(bar); p0_phase(F); } SEAM(0); }
    if (IN(1)) { for (int rep_ = 0; rep_ < REPS(1); ++rep_) { if (rep_) xcd_barrier(bar); p1_phase(F); } SEAM(1); }
    if (IN(2)) {
        pg8::Gemm g{wsp<const bf16>(F, WS_XN), wsp<const bf16>(F, WS_WIN), T, NIN, D, 0};
        pg8::StaticOrder S; S.init(T / 256, NIN / 256, F.G, (int)blockIdx.x, nullptr, REPS(2));
        EpiInProj E{wsp<bf16>(F, WS_QG), wsp<bf16>(F, WS_KG), wsp<bf16>(F, WS_VG), wsp<bf16>(F, WS_RG), wsp<bf16>(F, WS_QD), wsp<bf16>(F, WS_KD), wsp<bf16>(F, WS_VD), F.g_qnorm, F.g_knorm};
        pg8::gemm_phase<EpiInProj, pg8::StaticOrder>(F.lds, g, S, E);
        SEAM(2);
    }
    if (IN(3)) { for (int rep_ = 0; rep_ < REPS(3); ++rep_) { if (rep_) xcd_barrier(bar); for (int c = F.vcu; c < NCHUNK; c += F.G) gla_a_unit(F, c); } SEAM(3); }
    if (IN(4)) { for (int rep_ = 0; rep_ < REPS(4); ++rep_) { if (rep_) xcd_barrier(bar); gla_b_phase(F); } SEAM(4); }
    if (IN(5)) for (int rep_ = 0; rep_ < REPS(5); ++rep_) { if (rep_) xcd_barrier(bar);
#ifndef NO_GLAC
        for (int u = F.vcu; u < NCHUNK / 2; u += F.G) gla_c_unit(F, u);
#endif
        float lam;
        { float a1 = F.lq1[F.lane] * F.lk1[F.lane], a2 = F.lq2[F.lane] * F.lk2[F.lane]; a1 = wave_sum(a1); a2 = wave_sum(a2); lam = __expf(a1) - __expf(a2) + 0.2f; }
#ifndef NO_ATT
        for (int p = F.vcu; p < 256; p += F.G) { const int bh = p >> 4, s = p & 15;
#pragma nounroll
            for (int j = 0; j < 2; ++j) att::attn_unit(F, bh >> 2, bh & 3, j ? s : 31 - s, lam); }
#endif
        SEAM(5);
    }
    if (IN(6)) {
        pg8::Gemm g{wsp<const bf16>(F, WS_A2), wsp<const bf16>(F, WS_WOUT), T, D, D, 0};
        pg8::StaticOrder S; S.init(T / 256, D / 256, F.G, (int)blockIdx.x, nullptr, REPS(6));
        EpiOutProj E{wsp<bf16>(F, WS_MIX), wsp<const float>(F, WS_MOD)};
        pg8::gemm_phase<EpiOutProj, pg8::StaticOrder>(F.lds, g, S, E);
        SEAM(6);
    }
    if (IN(7)) { for (int rep_ = 0; rep_ < REPS(7); ++rep_) { if (rep_) xcd_barrier(bar); p7_phase(F, rep_ == 0); } SEAM(7); }
    if (IN(8)) { p8_phase(F); SEAM(8); }
    if (IN(9)) {
        int nMt; moe_tables(F, nMt);
        pg8::Gemm g{wsp<const bf16>(F, WS_XS), wsp<const bf16>(F, WS_WGU), PMAX, 2048, D / 2, (size_t)2048 * 512};
        pg8::StaticOrder S; S.init(nMt, 8, F.G, (int)blockIdx.x, F.lds + TILEE_OFF, REPS(9));
        EpiSwiGLU E{wsp<unsigned char>(F, WS_Y), F.b_gate_up};
        pg8::gemm_phase<EpiSwiGLU, pg8::StaticOrder, true>(F.lds, g, S, E);
        SEAM(9);
    }
    if (IN(10)) {
        int nMt; moe_tables(F, nMt);
        pg8::Gemm g{wsp<const bf16>(F, WS_Y), wsp<const bf16>(F, WS_WD), PMAX, 1024, FF / 2, (size_t)1024 * 512};
        pg8::StaticOrder S; S.init(nMt, 4, F.G, (int)blockIdx.x, F.lds + TILEE_OFF, REPS(10));
        EpiDown E{wsp<unsigned char>(F, WS_CN), F.b_down};
        pg8::gemm_phase<EpiDown, pg8::StaticOrder, true>(F.lds, g, S, E);
        SEAM(10);
    }
    if (IN(11)) { p11_phase(F); }
#undef IN
#undef SEAM
}

extern "C" void kernel_launch(void* const* d_in, const int* in_sizes, int n_in, void* d_out, int out_size, void* d_ws, size_t ws_size, hipStream_t stream) {
    static int grid = 0;
    if (grid == 0) {
        if (n_in != 25 || in_sizes[0] != T * D || out_size != T * D || ws_size < WS_END) { fprintf(stderr, "kernel_launch: unexpected shapes (n_in %d, in0 %d, out %d, ws %zu); nothing launched\n", n_in, n_in > 0 ? in_sizes[0] : -1, out_size, ws_size); grid = -1; return; }
        int dev = 0, cus = 0, per_cu = 0;
        if (hipGetDevice(&dev) != hipSuccess || hipDeviceGetAttribute(&cus, hipDeviceAttributeMultiprocessorCount, dev) != hipSuccess) { grid = -1; return; }
        if (hipFuncSetAttribute((const void*)fwd_kernel, hipFuncAttributeMaxDynamicSharedMemorySize, LDS_BYTES) != hipSuccess) { fprintf(stderr, "kernel_launch: hipFuncSetAttribute failed\n"); grid = -1; return; }
        if (hipOccupancyMaxActiveBlocksPerMultiprocessor(&per_cu, (const void*)fwd_kernel, NWAVES * 64, LDS_BYTES) != hipSuccess || per_cu < 1)
            fprintf(stderr, "kernel_launch: note: occupancy query reports %d workgroups per CU\n", per_cu);
        (void)hipGetLastError();
        grid = cus;
    }
    if (grid < 0) return;
    if (hipMemsetAsync((char*)d_ws + WS_CTL, 0, CTL_ZERO_BYTES, stream) != hipSuccess) { fprintf(stderr, "kernel_launch: memset failed\n"); return; }
    Args a{};
    for (int i = 0; i < 25; ++i) a.in[i] = (const float*)d_in[i];
    a.out = (float*)d_out; a.ws = (unsigned char*)d_ws;
#if MK_N_LAUNCHES == 1
    a.ph_lo = 0; a.ph_hi = NPHASE;
    hipLaunchKernelGGL(fwd_kernel, dim3(grid), dim3(NWAVES * 64), LDS_BYTES, stream, a);
#else
    for (int p = 0; p < NPHASE; ++p) { a.ph_lo = p; a.ph_hi = p + 1; hipLaunchKernelGGL(fwd_kernel, dim3(grid), dim3(NWAVES * 64), LDS_BYTES, stream, a); }
#endif
    const hipError_t le = hipPeekAtLastError();
    if (le != hipSuccess) fprintf(stderr, "kernel_launch: launch failed: %s\n", hipGetErrorName(le));
}
```

```cpp
#include <hip/hip_runtime.h>
#include <cstdio>
#include <cstdint>

#ifndef MK_N_LAUNCHES
#define MK_N_LAUNCHES 1
#endif

namespace pg8 {
#define PG8_LAS __attribute__((address_space(3)))
typedef unsigned short bf16_t;
typedef short bf16x8 __attribute__((ext_vector_type(8)));
typedef float f32x4 __attribute__((ext_vector_type(4)));
typedef unsigned u32x4 __attribute__((ext_vector_type(4)));
typedef int i32x4 __attribute__((ext_vector_type(4)));
typedef int i32x8 __attribute__((ext_vector_type(8)));
typedef float f32x16 __attribute__((ext_vector_type(16)));
constexpr int BM = 256, BK = 64, HALF = 128, HTB = HALF * BK * 2, STAGE_BYTES = 8 * HTB, NXCD = 8, WGM = 8;

__host__ __device__ __forceinline__ int lds_byte(int r, int c) { const int st = (r >> 4) * 2 + (c >> 5), rr = r & 15, cc = c & 31, ob = rr * 64 + cc * 2; return st * 1024 + (ob ^ (((ob >> 9) & 1) << 5)); }
__host__ __device__ __forceinline__ void stage_rc(int b, int& R, int& C) { const int st = b / 1024, sb = b % 1024, swz = sb ^ (((sb >> 9) & 1) << 5); R = (st >> 1) * 16 + swz / 64; C = (st & 1) * 32 + (swz % 64) / 2; }
__host__ __device__ __forceinline__ int perm32(int rho) { const int n = rho >> 4, i = rho & 15; return 8 * (i >> 2) + 4 * n + (i & 3); }

struct Unit { int pm, pn, e; };
struct Gemm { const bf16_t* A; const bf16_t* Bt; int M, N, K; size_t estride; };

struct StaticOrder {
    int nM, nN, nwg, G, c, rep; const PG8_LAS unsigned char* tile_e;
    __device__ void init(int nM_, int nN_, int G_, int c_, const PG8_LAS unsigned char* te, int rep_ = 1) { nM = nM_; nN = nN_; nwg = nM * nN; G = G_; c = c_; tile_e = te; rep = rep_; }
    __device__ bool next(int i, Unit& u) const {
        long L = (long)i * G + c; if (L >= (long)nwg * rep) return false; if (rep > 1) L %= nwg;
        int wgid = (int)L; { const int q = nwg / NXCD, r = nwg % NXCD, xcd = wgid % NXCD, off = wgid / NXCD; wgid = (xcd < r ? xcd * (q + 1) : r * (q + 1) + (xcd - r) * q) + off; }
        const int nig = WGM * nN, gid = wgid / nig, fm = gid * WGM, gsz = (nM - fm) < WGM ? (nM - fm) : WGM;
        u.pm = fm + ((wgid % nig) % gsz); u.pn = (wgid % nig) / gsz; u.e = tile_e ? __builtin_amdgcn_readfirstlane((int)tile_e[u.pm]) : 0; return true;
    }
};

__device__ __forceinline__ unsigned cvt_pk_bf16(float lo, float hi) { unsigned r; asm volatile("v_cvt_pk_bf16_f32 %0, %1, %2" : "=v"(r) : "v"(lo), "v"(hi)); return r; }

template <class Epi, class Sched, bool FP8 = false>
__device__ __forceinline__ void gemm_phase(PG8_LAS unsigned char* lds, const Gemm g, const Sched& S, const Epi& E) {
    const int tid = threadIdx.x, wid = __builtin_amdgcn_readfirstlane(tid >> 6), lane = tid & 63, wr = wid >> 2, wc = wid & 3, fr = lane & 15, fq = lane >> 4;
    const int K = g.K, nt = K / BK;
    unsigned voffA[2], voffB[2];
#pragma unroll
    for (int i = 0; i < 2; ++i) { int R, C; stage_rc(tid * 16 + i * 8192, R, C); const int Rb = Epi::PERM ? ((R & ~31) + perm32(R & 31)) : R;
        voffA[i] = (unsigned)(R * K + C) * 2u; voffB[i] = (unsigned)(Rb * K + C) * 2u; }
    const size_t kstep = (size_t)(BK * 2);
    const size_t hstep = (size_t)HALF * K * 2;
    const size_t tstep = 2 * hstep;
    const size_t estep = g.estride * 2;
    const unsigned ldsw = (unsigned)wid * 1024u;
    const int aoff = lds_byte(wr * 64 + fr, fq * 8), boff = lds_byte(wc * 32 + fr, fq * 8);
#define PG8_SA(b, h) (((b) * 2 + (h)) * HTB)
#define PG8_SB(b, h) ((4 + (b) * 2 + (h)) * HTB)
#define PG8_STAGE(bufoff, gbase, voff) do { _Pragma("unroll") for (int _i = 0; _i < 2; ++_i) \
        __builtin_amdgcn_global_load_lds((const unsigned*)((const char*)(gbase) + (voff)[_i]), (PG8_LAS unsigned*)(lds + (bufoff) + ldsw + _i * 8192), 16, 0, 0); } while (0)
#define PG8_LDA(dst, b, h) do { _Pragma("unroll") for (int m = 0; m < 4; ++m) dst[m] = PG8_CAT2(*(const PG8_LAS i32x4*)(lds + PG8_SA(b, h) + aoff + m * 2048), *(const PG8_LAS i32x4*)(lds + PG8_SA(b, h) + aoff + m * 2048 + 1024)); } while (0)
#define PG8_LDB(dst, b, h) do { _Pragma("unroll") for (int n = 0; n < 2; ++n) dst[n] = PG8_CAT2(*(const PG8_LAS i32x4*)(lds + PG8_SB(b, h) + boff + n * 2048), *(const PG8_LAS i32x4*)(lds + PG8_SB(b, h) + boff + n * 2048 + 1024)); } while (0)
#define PG8_CAT2(x, y) __builtin_shufflevector((x), (y), 0, 1, 2, 3, 4, 5, 6, 7)
#define PG8_LO(x) __builtin_bit_cast(bf16x8, __builtin_shufflevector((x), (x), 0, 1, 2, 3))
#define PG8_HI(x) __builtin_bit_cast(bf16x8, __builtin_shufflevector((x), (x), 4, 5, 6, 7))
#define PG8_X4(v, m) ((f32x4){(v)[4 * (m)], (v)[4 * (m) + 1], (v)[4 * (m) + 2], (v)[4 * (m) + 3]})
#define PG8_INS(v, r, m) do { (v)[4 * (m)] = (r)[0]; (v)[4 * (m) + 1] = (r)[1]; (v)[4 * (m) + 2] = (r)[2]; (v)[4 * (m) + 3] = (r)[3]; } while (0)
#define PG8_MMA(ai, bj, At, Bt) do { __builtin_amdgcn_s_setprio(1); _Pragma("unroll") for (int m = 0; m < 4; ++m) _Pragma("unroll") for (int n = 0; n < 2; ++n) { \
        if constexpr (FP8) { const f32x4 r_ = __builtin_amdgcn_mfma_scale_f32_16x16x128_f8f6f4(Bt[n], At[m], PG8_X4(acc16[ai][bj][n], m), 0, 0, 0, 0x7F7F7F7F, 0, 0x7F7F7F7F); PG8_INS(acc16[ai][bj][n], r_, m); } \
        else { acc[ai][bj][m][n] = __builtin_amdgcn_mfma_f32_16x16x32_bf16(PG8_LO(Bt[n]), PG8_LO(At[m]), acc[ai][bj][m][n], 0, 0, 0); \
               acc[ai][bj][m][n] = __builtin_amdgcn_mfma_f32_16x16x32_bf16(PG8_HI(Bt[n]), PG8_HI(At[m]), acc[ai][bj][m][n], 0, 0, 0); } } \
        __builtin_amdgcn_s_setprio(0); } while (0)
#define PG8_WAIT_V(n) asm volatile("s_waitcnt vmcnt(" #n ")" ::: "memory")
#define PG8_WAIT_L(n) asm volatile("s_waitcnt lgkmcnt(" #n ")" ::: "memory")
#define PG8_BAR __builtin_amdgcn_s_barrier()
#define PG8_SCHED __builtin_amdgcn_sched_barrier(0)
    Unit cur, nxt; int ui = 0;
    if (!S.next(0, cur)) return;
    f32x4 acc[2][2][4][2];
#pragma unroll
    for (int a = 0; a < 2; ++a)
#pragma unroll
        for (int b = 0; b < 2; ++b)
#pragma unroll
            for (int m = 0; m < 4; ++m)
#pragma unroll
                for (int n = 0; n < 2; ++n) acc[a][b][m][n] = (f32x4){0.f, 0.f, 0.f, 0.f};
    f32x16 acc16[2][2][2];
#pragma unroll
    for (int a = 0; a < 2; ++a)
#pragma unroll
        for (int b = 0; b < 2; ++b)
#pragma unroll
            for (int n = 0; n < 2; ++n) acc16[a][b][n] = (f32x16){};
    i32x8 At[4], B0[2], B1[2];
    const char* cA = (const char*)g.A + (size_t)cur.pm * tstep; const char* cB = (const char*)g.Bt + (size_t)cur.e * estep + (size_t)cur.pn * tstep;
    PG8_STAGE(PG8_SB(0, 0), cB, voffB); PG8_STAGE(PG8_SB(0, 1), cB + hstep, voffB); PG8_STAGE(PG8_SA(0, 0), cA, voffA); PG8_STAGE(PG8_SA(0, 1), cA + hstep, voffA);
    if (wr == 1) PG8_BAR;
    PG8_WAIT_V(2); PG8_BAR;
    PG8_STAGE(PG8_SB(1, 0), cB + kstep, voffB); PG8_STAGE(PG8_SA(1, 0), cA + kstep, voffA); PG8_STAGE(PG8_SB(1, 1), cB + hstep + kstep, voffB);
    PG8_WAIT_V(6); PG8_BAR;
    for (;;) {
        const bool has_next = S.next(ui + 1, nxt);
        const char* nA = has_next ? (const char*)g.A + (size_t)nxt.pm * tstep : cA; const char* nB = has_next ? (const char*)g.Bt + (size_t)nxt.e * estep + (size_t)nxt.pn * tstep : cB;
#pragma nounroll
        for (int t = 0; t < nt; t += 2) {
            const bool last = (t == nt - 2);
            const char* a1 = cA + (size_t)(t + 1) * kstep;
            const char* a2 = last ? nA : cA + (size_t)(t + 2) * kstep; const char* b2 = last ? nB : cB + (size_t)(t + 2) * kstep;
            const char* a3 = a2 + kstep; const char* b3 = b2 + kstep;
            PG8_LDB(B0, 0, 0); PG8_LDB(B1, 0, 1); PG8_SCHED; PG8_LDA(At, 0, 0); PG8_STAGE(PG8_SA(1, 1), a1 + hstep, voffA);
            PG8_WAIT_V(8); PG8_WAIT_L(0); PG8_BAR; PG8_MMA(0, 0, At, B0); PG8_MMA(0, 1, At, B1); PG8_BAR; PG8_SCHED;
            PG8_LDA(At, 0, 1); PG8_STAGE(PG8_SB(0, 0), b2, voffB); PG8_STAGE(PG8_SB(0, 1), b2 + hstep, voffB); PG8_STAGE(PG8_SA(0, 0), a2, voffA);
            PG8_WAIT_V(8); PG8_WAIT_L(0); PG8_BAR; PG8_MMA(1, 0, At, B0); PG8_MMA(1, 1, At, B1); PG8_BAR; PG8_SCHED;
            PG8_LDB(B0, 1, 0); PG8_LDB(B1, 1, 1); PG8_SCHED; PG8_LDA(At, 1, 0); PG8_STAGE(PG8_SA(0, 1), a2 + hstep, voffA);
            PG8_WAIT_V(8); PG8_WAIT_L(0); PG8_BAR; PG8_MMA(0, 0, At, B0); PG8_MMA(0, 1, At, B1); PG8_BAR; PG8_SCHED;
            PG8_LDA(At, 1, 1); PG8_STAGE(PG8_SB(1, 0), b3, voffB); PG8_STAGE(PG8_SB(1, 1), b3 + hstep, voffB); PG8_STAGE(PG8_SA(1, 0), a3, voffA);
            PG8_WAIT_V(8); PG8_WAIT_L(0); PG8_BAR; PG8_MMA(1, 0, At, B0); PG8_MMA(1, 1, At, B1); PG8_BAR; PG8_SCHED;
        }
        if (wr == 0) PG8_BAR;
        if constexpr (FP8) {
#pragma unroll
            for (int a = 0; a < 2; ++a)
#pragma unroll
                for (int b = 0; b < 2; ++b)
#pragma unroll
                    for (int m = 0; m < 4; ++m)
#pragma unroll
                        for (int n = 0; n < 2; ++n) acc[a][b][m][n] = PG8_X4(acc16[a][b][n], m);
        }
        { int t2 = threadIdx.x; asm volatile("" : "+v"(t2)); E(acc, cur, wr, wc, t2 & 15, (t2 >> 4) & 3); }
        if (!has_next) break;
#pragma unroll
        for (int a = 0; a < 2; ++a)
#pragma unroll
            for (int b = 0; b < 2; ++b)
#pragma unroll
                for (int m = 0; m < 4; ++m)
#pragma unroll
                    for (int n = 0; n < 2; ++n) acc[a][b][m][n] = (f32x4){0.f, 0.f, 0.f, 0.f};
        if constexpr (FP8) {
#pragma unroll
            for (int a = 0; a < 2; ++a)
#pragma unroll
                for (int b = 0; b < 2; ++b)
#pragma unroll
                    for (int n = 0; n < 2; ++n) acc16[a][b][n] = (f32x16){};
        }
        cur = nxt; cA = nA; cB = nB; ++ui;
        if (wr == 1) PG8_BAR;
    }
    PG8_WAIT_V(0);
    PG8_BAR;
#undef PG8_SA
#undef PG8_SB
#undef PG8_STAGE
#undef PG8_LDA
#undef PG8_LDB
#undef PG8_MMA
#undef PG8_X4
#undef PG8_INS
#undef PG8_CAT2
#undef PG8_LO
#undef PG8_HI
#undef PG8_WAIT_V
#undef PG8_WAIT_L
#undef PG8_BAR
#undef PG8_SCHED
}
}

constexpr int NWAVES = 8;
constexpr int BATCH = 4, SEQ = 8192, D = 1024, T = BATCH * SEQ;
constexpr int INW = 3088, NIN = 3072;
constexpr int NE = 32, TOPK = 4, FF = 1024;
constexpr int PMAX = (T * TOPK / 256 + NE) * 256;
constexpr int NCHUNK = BATCH * 4 * (SEQ / 64);
constexpr float EPS = 1e-6f;
constexpr float LOG2E = 1.4426950408889634f;
constexpr float C2 = 0.125f * LOG2E;
constexpr float WSCALE = 32.f, WSCALE_INV = 1.f / 32.f;

constexpr size_t MiB = 1u << 20;
constexpr size_t WS_CTL = 0, CTL_ZERO_BYTES = 1 * MiB;
constexpr size_t WS_MODP = 1 * MiB;
constexpr size_t WS_MOD = 2 * MiB;
constexpr size_t WS_TOPE = 3 * MiB;
constexpr size_t WS_TOPW = 3 * MiB + 512 * 1024;
constexpr size_t WS_POS = 4 * MiB;
constexpr size_t WS_ROWW = 4 * MiB + 512 * 1024;
constexpr size_t WS_DEC = 6 * MiB;
constexpr size_t WS_WGU = 8 * MiB;
constexpr size_t WS_WD = 136 * MiB;
constexpr size_t WS_XN = 200 * MiB;
constexpr size_t WS_WIN = 264 * MiB;
constexpr size_t WS_WOUT = 270 * MiB;
constexpr size_t WS_GK = 272 * MiB;
constexpr size_t WS_QG = 304 * MiB;
constexpr size_t WS_KG = 320 * MiB;
constexpr size_t WS_VG = 336 * MiB;
constexpr size_t WS_RG = 368 * MiB;
constexpr size_t WS_QD = 400 * MiB;
constexpr size_t WS_KD = 432 * MiB;
constexpr size_t WS_VD = 464 * MiB;
constexpr size_t WS_UT = 496 * MiB;
constexpr size_t WS_SP = 560 * MiB;
constexpr size_t WS_OI = 592 * MiB;
constexpr size_t WS_QE = 656 * MiB;
constexpr size_t WS_A2 = 672 * MiB;
constexpr size_t WS_STASH = 736 * MiB;
constexpr size_t WS_XS = 264 * MiB;
constexpr size_t WS_Y = 400 * MiB;
constexpr size_t WS_CN = 536 * MiB;
constexpr size_t WS_MIX = 808 * MiB;
constexpr size_t WS_END = 872 * MiB;
static_assert(WS_XS + (size_t)PMAX * 1024 <= WS_Y && WS_Y + (size_t)PMAX * 1024 <= WS_CN && WS_CN + (size_t)PMAX * 1024 * 2 <= WS_MIX, "ws map");
constexpr int CW_BAR = 4096;
constexpr int CW_CNT = 16384;
constexpr int CW_FILL = 16384 + 64;

constexpr int RING_BYTES = 131072;
constexpr int LDSCTL_OFF = RING_BYTES, MISC_OFF = LDSCTL_OFF + 320;
constexpr int TILEE_OFF = MISC_OFF + 128;
constexpr int HIST_OFF = TILEE_OFF + 1024;
constexpr int LDS_BYTES = 147456;
static_assert(HIST_OFF + 512 <= LDS_BYTES, "LDS map");

#define GAS __attribute__((address_space(1)))
#define LAS __attribute__((address_space(3)))
typedef unsigned short bf16;
typedef unsigned v4u __attribute__((ext_vector_type(4)));
typedef unsigned v2u __attribute__((ext_vector_type(2)));
typedef float f32x4 __attribute__((ext_vector_type(4)));
typedef float f32x16 __attribute__((ext_vector_type(16)));
typedef short bf16x8 __attribute__((ext_vector_type(8)));
typedef short s16x4 __attribute__((ext_vector_type(4)));
typedef GAS unsigned gu32;
#define RLX_AGENT __ATOMIC_RELAXED, __HIP_MEMORY_SCOPE_AGENT
#define LDS_WAIT() asm volatile("s_waitcnt lgkmcnt(0)" ::: "memory")
#define VM_WAIT() asm volatile("s_waitcnt vmcnt(0)" ::: "memory")
__device__ __forceinline__ unsigned f2bf(float f) { unsigned u = __builtin_bit_cast(unsigned, f); return (u + 0x7fffu + ((u >> 16) & 1u)) >> 16; }
__device__ __forceinline__ unsigned pk2(float lo, float hi) { return f2bf(lo) | (f2bf(hi) << 16); }
__device__ __forceinline__ float bf2f(unsigned short h) { return __builtin_bit_cast(float, (unsigned)h << 16); }
__device__ __forceinline__ float bflo(unsigned u) { return __builtin_bit_cast(float, u << 16); }
__device__ __forceinline__ float bfhi(unsigned u) { return __builtin_bit_cast(float, u & 0xffff0000u); }
__device__ __forceinline__ float wave_sum(float v) {
#pragma unroll
    for (int o = 1; o < 64; o <<= 1) v += __shfl_xor(v, o);
    return v;
}
__device__ __forceinline__ float sigmoidf_(float x) { return 1.f / (1.f + __expf(-x)); }
typedef float f32x2 __attribute__((ext_vector_type(2)));
__device__ __forceinline__ unsigned wave_umax(unsigned v) {
    v = max(v, (unsigned)__builtin_amdgcn_update_dpp(0, (int)v, 0x111, 0xf, 0xf, true));
    v = max(v, (unsigned)__builtin_amdgcn_update_dpp(0, (int)v, 0x112, 0xf, 0xf, true));
    v = max(v, (unsigned)__builtin_amdgcn_update_dpp(0, (int)v, 0x114, 0xf, 0xf, true));
    v = max(v, (unsigned)__builtin_amdgcn_update_dpp(0, (int)v, 0x118, 0xf, 0xf, true));
    v = max(v, (unsigned)__builtin_amdgcn_update_dpp(0, (int)v, 0x142, 0xa, 0xf, false));
    v = max(v, (unsigned)__builtin_amdgcn_update_dpp(0, (int)v, 0x143, 0xc, 0xf, false));
    return (unsigned)__builtin_amdgcn_readlane((int)v, 63);
}
template <int CNT, int S, int N> __device__ __forceinline__ void xreduce_step(float (&v)[N], int lane) {
    if constexpr (CNT > 1) { constexpr int half = CNT / 2; const bool up = (lane & S) != 0;
#pragma unroll
        for (int i = 0; i < half; ++i) { const float send = up ? v[i] : v[i + half], keep = up ? v[i + half] : v[i]; v[i] = keep + __shfl_xor(send, S); }
        xreduce_step<half, S / 2, N>(v, lane); }
}
template <int S> __device__ __forceinline__ float xreduce_tail(float r) { if constexpr (S >= 1) { r += __shfl_xor(r, S); return xreduce_tail<S / 2>(r); } else return r; }
template <int N> __device__ __forceinline__ float xreduce(float (&v)[N], int lane) {
    xreduce_step<N, 32, N>(v, lane);
    return xreduce_tail<(N == 32 ? 1 : N == 16 ? 2 : N == 8 ? 4 : 8)>(v[0]);
}
__device__ __forceinline__ float lane_bcast(float v, int l) { return __builtin_bit_cast(float, __builtin_amdgcn_readlane(__builtin_bit_cast(int, v), l)); }

#define XB_TMO      128
#define XB_XCNT(j)  (256  + 64 * (j))
#define XB_XSUB(j)  (1280 + 64 * (j))
#define XB_XGEN(j)  (2304 + 64 * (j))
#define XB_TOP      3328
#define XB_TOPGEN   3392
#define XCD_BAR_WORDS 3456
#define XB_SPIN_CAP (1u << 18)
__device__ __forceinline__ unsigned xb_ld(unsigned* p)              { return __hip_atomic_load(p, __ATOMIC_RELAXED, __HIP_MEMORY_SCOPE_AGENT); }
__device__ __forceinline__ unsigned xb_add(unsigned* p, unsigned v) { return __hip_atomic_fetch_add(p, v, __ATOMIC_RELAXED, __HIP_MEMORY_SCOPE_AGENT); }
__device__ __forceinline__ unsigned xb_xcc_id() { return (unsigned)__builtin_amdgcn_s_getreg((3 << 11) | 20) & 0xFu; }
#define XB_SPIN(cond, bar) do { unsigned _sp = 0; while (cond) { __builtin_amdgcn_s_sleep(1); \
    if ((++_sp & 255u) == 0u) { if (xb_ld(&(bar)[XB_TMO])) break; if (_sp > XB_SPIN_CAP) { atomicAdd(&(bar)[XB_TMO], 1u); break; } } } } while (0)
struct XcdBarrier { unsigned* bar; unsigned x; volatile LAS unsigned* st; };
__device__ __forceinline__ XcdBarrier xcd_barrier_post(unsigned* bar, volatile LAS unsigned* st) {
    XcdBarrier b; b.bar = bar; b.x = xb_xcc_id(); b.st = st;
    if (threadIdx.x == 0) (void)xb_add(&bar[XB_XCNT(b.x)], 1u);
    return b;
}
__device__ __forceinline__ void xcd_barrier_complete(unsigned* bar, unsigned x, unsigned& nloc, unsigned& nx) {
    const unsigned G = gridDim.x * gridDim.y * gridDim.z;
    unsigned sum, cnt, mine, sp = 0u;
    for (;;) {
        sum = 0u; cnt = 0u; mine = 0u;
#pragma unroll
        for (unsigned j = 0; j < 16; ++j) { const unsigned c = xb_ld(&bar[XB_XCNT(j)]); sum += c; cnt += (c > 0u) ? 1u : 0u; mine = (j == x) ? c : mine; }
        if (sum == G) break;
        __builtin_amdgcn_s_sleep(1);
        if ((++sp & 255u) == 0u) { if (xb_ld(&bar[XB_TMO])) break; if (sp > XB_SPIN_CAP) { atomicAdd(&bar[XB_TMO], 1u); break; } }
    }
    nloc = mine > 0u ? mine : 1u; nx = cnt > 0u ? cnt : 1u;
}
__device__ __forceinline__ void xcd_barrier(const XcdBarrier& b) {
    asm volatile("s_waitcnt vmcnt(0)" ::: "memory");
    __syncthreads();
    if (threadIdx.x == 0) {
        unsigned* bar = b.bar;
        __builtin_amdgcn_s_waitcnt(0);
        unsigned nloc = b.st[0], nx = b.st[1];
        if (nloc == 0u) { xcd_barrier_complete(bar, b.x, nloc, nx); b.st[0] = nloc; b.st[1] = nx; }
        const unsigned old = xb_add(&bar[XB_XSUB(b.x)], 1u);
        const unsigned gen = old / nloc;
        if (old + 1u == (gen + 1u) * nloc) {
            __builtin_amdgcn_fence(__ATOMIC_RELEASE, "agent");
            asm volatile("s_waitcnt vmcnt(0)" ::: "memory");
            const unsigned og = xb_add(&bar[XB_TOP], 1u);
            const unsigned tg = og / nx;
            if (og + 1u == (tg + 1u) * nx) xb_add(&bar[XB_TOPGEN], 1u);
            else XB_SPIN(xb_ld(&bar[XB_TOPGEN]) == tg, bar);
            __builtin_amdgcn_fence(__ATOMIC_ACQUIRE, "agent");
            xb_add(&bar[XB_XGEN(b.x)], 1u);
            asm volatile("s_waitcnt vmcnt(0)" ::: "memory");
        } else {
            XB_SPIN(xb_ld(&bar[XB_XGEN(b.x)]) == gen, bar);
            __builtin_amdgcn_fence(__ATOMIC_ACQUIRE, "agent");
            asm volatile("s_waitcnt vmcnt(0)" ::: "memory");
        }
    }
    __syncthreads();
}

struct Frame {
    LAS unsigned char* lds;
    volatile LAS unsigned* MISC;
    gu32* ctl;
    int tid, lane, wave;
    int vcu, G;
    unsigned char* ws;
    const float *x, *c, *rel_bias, *w_ada, *b_ada, *g_norm1, *w_in, *w_gk_up, *b_gk_up, *g_gla_out, *g_qnorm, *g_knorm, *lq1, *lk1, *lq2, *lk2, *g_subln, *w_out,
                *g_norm2, *w_router, *b_router, *w_gate_up, *b_gate_up, *w_down, *b_down;
    float* out;
};
template <class Tp> __device__ __forceinline__ Tp* wsp(const Frame& F, size_t off) { return (Tp*)(F.ws + off); }

__device__ __forceinline__ void tr_item(const float* W, int ldw, int k0, int src0, bf16* WT, int K, int drow0, LAS float* scr, int lane) {
#pragma unroll 8
    for (int i = 0; i < 32; ++i) { const int kk = 2 * i + (lane >> 5); scr[kk * 33 + (lane & 31)] = W[(size_t)(k0 + kk) * ldw + src0 + (lane & 31)]; }
    LDS_WAIT(); asm volatile("" ::: "memory");
    const int c = lane & 7;
#pragma unroll
    for (int j = 0; j < 4; ++j) { const int n = (lane >> 3) + 8 * j; const LAS float* s = scr + (8 * c) * 33 + n;
        v4u o; o.x = pk2(s[0 * 33], s[1 * 33]); o.y = pk2(s[2 * 33], s[3 * 33]); o.z = pk2(s[4 * 33], s[5 * 33]); o.w = pk2(s[6 * 33], s[7 * 33]);
        *(GAS v4u*)(WT + (size_t)(drow0 + n) * K + k0 + 8 * c) = o; }
    LDS_WAIT(); asm volatile("" ::: "memory");
}
__device__ __forceinline__ unsigned pk4_fp8(float a, float b, float c, float d) { int p = __builtin_amdgcn_cvt_pk_fp8_f32(a, b, 0, false); p = __builtin_amdgcn_cvt_pk_fp8_f32(c, d, p, true); return (unsigned)p; }
__device__ __forceinline__ void tr_item_fp8(const float* W, int ldw, int k0, int src0, unsigned char* WT, int K, int drow0, float sc, LAS float* scr, int lane) {
    { float tmp[32]; const float* wp = W + (size_t)(k0 + (lane >> 5)) * ldw + src0 + (lane & 31);
#pragma unroll
      for (int i = 0; i < 32; ++i) tmp[i] = __builtin_nontemporal_load(wp + (size_t)(2 * i) * ldw);
#pragma unroll
      for (int i = 0; i < 32; ++i) scr[(2 * i + (lane >> 5)) * 33 + (lane & 31)] = tmp[i] * sc; }
    LDS_WAIT(); asm volatile("" ::: "memory");
    const int c = lane & 3;
#pragma unroll
    for (int j = 0; j < 2; ++j) { const int n = (lane >> 2) + 16 * j; const LAS float* s = scr + (16 * c) * 33 + n;
        v4u o;
#pragma unroll
        for (int q = 0; q < 4; ++q) o[q] = pk4_fp8(s[(4 * q) * 33], s[(4 * q + 1) * 33], s[(4 * q + 2) * 33], s[(4 * q + 3) * 33]);
        *(GAS v4u*)(WT + (size_t)(drow0 + n) * K + k0 + 16 * c) = o; }
    LDS_WAIT(); asm volatile("" ::: "memory");
}
__device__ __forceinline__ int win_src0(int ng) {
    const int pn = ng >> 3, gi = ng & 7, bj = gi >> 2, wc = gi & 3;
    if (pn < 6) return pn * 256 + gi * 32;
    if (pn < 10) { const int base = (pn < 8) ? 1552 : 2064; const int gq = 4 * ((pn - 6) & 1) + wc; return base + 64 * gq + 32 * bj; }
    return 2576 + (pn - 10) * 256 + gi * 32;
}
__device__ __forceinline__ void p0_phase(Frame& F) {
    LAS float* scr = (LAS float*)(F.lds + F.wave * 16384);
    const int gw = F.vcu * NWAVES + F.wave, NGW = F.G * NWAVES, lane = F.lane;
    for (int it = gw; it < 768; it += NGW) {
        const int cg = it % 96, ks = it / 96, j = cg * 64 + lane;
#pragma unroll
        for (int q = 0; q < 8; ++q) { const int idx = q * 64 + lane, b = idx >> 7, kk = idx & 127; const float cv = F.c[b * 1024 + ks * 128 + kk]; scr[idx] = cv * sigmoidf_(cv); }
        LDS_WAIT(); asm volatile("" ::: "memory");
        float a0 = 0.f, a1 = 0.f, a2 = 0.f, a3 = 0.f;
        const float* wp = F.w_ada + (size_t)(ks * 128) * 6144 + j;
#pragma unroll 16
        for (int kk = 0; kk < 128; ++kk) { const float w = wp[(size_t)kk * 6144]; a0 += scr[kk] * w; a1 += scr[128 + kk] * w; a2 += scr[256 + kk] * w; a3 += scr[384 + kk] * w; }
        float* mp = wsp<float>(F, WS_MODP) + (size_t)(ks * 4) * 6144 + j;
        mp[0] = a0; mp[6144] = a1; mp[2 * 6144] = a2; mp[3 * 6144] = a3;
        LDS_WAIT(); asm volatile("" ::: "memory");
    }
    constexpr int I_IN = 96 * 16, I_OUT = 32 * 16, I_GU = 32 * 64 * 16, I_D = 32 * 32 * 16;
    constexpr int NITEMS = I_IN + I_OUT + I_GU + I_D;
    for (int it = gw; it < NITEMS; it += NGW) {
        int r = it;
        if (r < I_IN) { const int kb = r / 96, ng = r % 96; tr_item(F.w_in, INW, kb * 64, win_src0(ng), wsp<bf16>(F, WS_WIN), 1024, ng * 32, scr, lane); continue; } r -= I_IN;
        if (r < I_OUT) { const int kb = r / 32, ng = r % 32; tr_item(F.w_out, 1024, kb * 64, ng * 32, wsp<bf16>(F, WS_WOUT), 1024, ng * 32, scr, lane); continue; } r -= I_OUT;
        if (r < I_GU) { const int e = r / 1024, q = r % 1024, kb = q / 64, dg = q % 64, pn = dg >> 3, gi = dg & 7, bj = gi >> 2, j32 = gi & 3;
            tr_item_fp8(F.w_gate_up + (size_t)e * 1024 * 2048, 2048, kb * 64, bj * 1024 + pn * 128 + j32 * 32, wsp<unsigned char>(F, WS_WGU) + (size_t)e * 2048 * 1024, 1024, dg * 32, WSCALE, scr, lane); continue; } r -= I_GU;
        { const int e = r / 512, q = r % 512, kb = q / 32, ng = q % 32;
            tr_item_fp8(F.w_down + (size_t)e * 1024 * 1024, 1024, kb * 64, ng * 32, wsp<unsigned char>(F, WS_WD) + (size_t)e * 1024 * 1024, 1024, ng * 32, WSCALE, scr, lane); }
    }
}

#ifndef SPREAD_ROWS
#define SPREAD_ROWS 0
#endif
__device__ __forceinline__ int srow(int gw, int i, int NGW) { return (SPREAD_ROWS && NGW * 16 == T) ? ((gw >> 9) * SEQ + i * 512 + (gw & 511)) : (gw * ((T + NGW - 1) / NGW) + i); }
__device__ __forceinline__ f32x4 mod_from_partials(const Frame& F, int b, int col) {
    const float* mp = wsp<const float>(F, WS_MODP) + (size_t)b * 6144 + col;
    f32x4 s = *(const f32x4*)(F.b_ada + col);
#pragma unroll
    for (int ks = 0; ks < 8; ++ks) s += *(const f32x4*)(mp + (size_t)ks * 4 * 6144);
    return s;
}
typedef float cf4p __attribute__((ext_vector_type(4)));
__device__ __forceinline__ void p1_phase(Frame& F) {
    const int tid = F.tid, lane = F.lane;
    constexpr int WLP = 1032;
    LAS bf16* wloT = (LAS bf16*)(F.lds);
    LAS bf16* wupT = (LAS bf16*)(F.lds + 36864);
    LAS float* bup = (LAS float*)(F.lds + 36864 + 16384);
    LAS float* tsc = (LAS float*)(F.lds + 36864 + 16384 + 1024) + F.wave * 288;
    { f32x4 t[8]; const int k0 = tid >> 2, r4 = (tid & 3) * 4;
#pragma unroll
      for (int it = 0; it < 8; ++it) t[it] = *(const f32x4*)(F.w_in + (size_t)(k0 + 128 * it) * INW + 1536 + r4);
#pragma unroll
      for (int it = 0; it < 8; ++it)
#pragma unroll
          for (int q = 0; q < 4; ++q) wloT[(r4 + q) * WLP + k0 + 128 * it] = (bf16)f2bf(t[it][q]); }
    { float t[8]; const int c = tid & 255, rh = tid >> 8;
#pragma unroll
      for (int j = 0; j < 8; ++j) t[j] = F.w_gk_up[(8 * rh + j) * 256 + c];
      v4u o; o.x = pk2(t[0], t[1]); o.y = pk2(t[2], t[3]); o.z = pk2(t[4], t[5]); o.w = pk2(t[6], t[7]);
      *(LAS v4u*)(wupT + c * 32 + 8 * rh) = o; *(LAS v4u*)(wupT + c * 32 + 16 + 8 * rh) = (v4u){0u, 0u, 0u, 0u}; }
    if (tid < 256) bup[tid] = F.b_gk_up[tid];
    { const int gt = F.vcu * 512 + tid; if (gt < 4 * 6144 / 4) { const int i = gt * 4, b = i / 6144, col = i % 6144; *(f32x4*)(wsp<float>(F, WS_MOD) + i) = mod_from_partials(F, b, col); } }
    __syncthreads();
    const int gw = F.vcu * NWAVES + F.wave, NGW = F.G * NWAVES;
    int curb = -1; f32x4 gsc[4], shv[4];
    for (int grp = gw; grp < T / 16; grp += NGW) {
#define ROWI(i) srow(grp, (i), T / 16)
        const int m0 = ROWI(0);
        f32x4 nx[4];
        { const GAS f32x4* xr = (const GAS f32x4*)(F.x + (size_t)m0 * D) + lane;
#pragma unroll
          for (int j = 0; j < 4; ++j) nx[j] = xr[64 * j]; }
        { const int b = m0 / SEQ;
          if (b != curb) { curb = b;
#pragma unroll
              for (int j = 0; j < 4; ++j) { const int col = 256 * j + 4 * lane; const f32x4 g = *(const f32x4*)(F.g_norm1 + col);
                  shv[j] = mod_from_partials(F, b, col); gsc[j] = g * (mod_from_partials(F, b, 1024 + col) + 1.0f); } } }
#pragma nounroll
        for (int i = 0; i < 16; ++i) {
            const int m = ROWI(i);
            f32x4 v[4]; float s = 0.f;
#pragma unroll
            for (int j = 0; j < 4; ++j) { v[j] = nx[j]; s += (v[j].x * v[j].x + v[j].y * v[j].y) + (v[j].z * v[j].z + v[j].w * v[j].w); }
            { const GAS f32x4* xr = (const GAS f32x4*)(F.x + (size_t)ROWI(i + 1 < 16 ? i + 1 : i) * D) + lane;
#pragma unroll
              for (int j = 0; j < 4; ++j) nx[j] = xr[64 * j]; }
            const float rstd = rsqrtf(wave_sum(s) * (1.f / D) + EPS);
            GAS v2u* o8 = (GAS v2u*)(wsp<bf16>(F, WS_XN) + (size_t)m * D) + lane;
#pragma unroll
            for (int j = 0; j < 4; ++j) { v[j] = v[j] * rstd * gsc[j] + shv[j]; v2u o; o.x = pk2(v[j].x, v[j].y); o.y = pk2(v[j].z, v[j].w); o8[64 * j] = o; }
        }
        __builtin_amdgcn_fence(__ATOMIC_RELEASE, "workgroup"); asm volatile("s_waitcnt vmcnt(0)" ::: "memory"); __builtin_amdgcn_fence(__ATOMIC_ACQUIRE, "workgroup");
        int lb = lane; asm volatile("" : "+v"(lb));
        const int l15 = lb & 15, q4 = lb >> 4;
        cf4p acc = {0.f, 0.f, 0.f, 0.f};
        { const bf16* arow = wsp<const bf16>(F, WS_XN) + (size_t)ROWI(l15) * D + 8 * q4; const LAS bf16* brow = wloT + l15 * WLP + 8 * q4;
#pragma unroll 4
          for (int sI = 0; sI < 32; ++sI) { const bf16x8 fa = *(const bf16x8*)(arow + 32 * sI); const bf16x8 fb = *(const LAS bf16x8*)(brow + 32 * sI);
              acc = __builtin_amdgcn_mfma_f32_16x16x32_bf16(fa, fb, acc, 0, 0, 0); } }
#pragma unroll
        for (int r = 0; r < 4; ++r) tsc[(4 * q4 + r) * 17 + l15] = acc[r];
        LDS_WAIT(); asm volatile("" ::: "memory");
        bf16x8 fa2;
        { float t8[8];
#pragma unroll
          for (int j = 0; j < 8; ++j) t8[j] = (q4 < 2) ? tsc[l15 * 17 + 8 * (q4 & 1) + j] : 0.f;
          v4u pk; pk.x = pk2(t8[0], t8[1]); pk.y = pk2(t8[2], t8[3]); pk.z = pk2(t8[4], t8[5]); pk.w = pk2(t8[6], t8[7]); fa2 = __builtin_bit_cast(bf16x8, pk); }
        float* GK = wsp<float>(F, WS_GK);
#pragma unroll 4
        for (int t = 0; t < 16; ++t) { const bf16x8 fb2 = *(const LAS bf16x8*)(wupT + (16 * t + l15) * 32 + 8 * q4);
            cf4p z = {0.f, 0.f, 0.f, 0.f}; z = __builtin_amdgcn_mfma_f32_16x16x32_bf16(fa2, fb2, z, 0, 0, 0);
            const float bb = bup[16 * t + l15];
#pragma unroll
            for (int r = 0; r < 4; ++r) { const float zz = z[r] + bb; GK[(size_t)ROWI(4 * q4 + r) * 256 + 16 * t + l15] = (fminf(zz, 0.f) - __logf(1.f + __expf(-fabsf(zz)))) * (1.f / 16.f); } }
        LDS_WAIT(); asm volatile("" ::: "memory");
#undef ROWI
    }
}

using pg8::Unit;
typedef pg8::f32x4 af4;
struct EpiInProj {
    static constexpr bool PERM = true;
    bf16 *QG, *KG, *VG, *RG, *QD, *KD, *VD; const float *gq, *gk;
    __device__ __forceinline__ void operator()(const af4 (&acc)[2][2][4][2], const Unit& u, int wr, int wc, int fr, int fq) const {
        const int pn = u.pn; const int row0 = u.pm * 256 + wr * 64 + fr;
        if (pn >= 6 && pn < 10) {
            const bool isq = pn < 8; bf16* base = isq ? QD : KD; const float* g = isq ? gq : gk; const float sc = isq ? C2 : 1.f;
            const int grp = 4 * ((pn - 6) & 1) + wc;
            af4 gv[2][2];
#pragma unroll
            for (int bj = 0; bj < 2; ++bj)
#pragma unroll
                for (int n = 0; n < 2; ++n) gv[bj][n] = *(const af4*)(g + 32 * bj + 8 * fq + 4 * n) * sc;
#pragma unroll
            for (int ai = 0; ai < 2; ++ai)
#pragma unroll
                for (int m = 0; m < 4; ++m) {
                    float ss = 0.f;
#pragma unroll
                    for (int bj = 0; bj < 2; ++bj)
#pragma unroll
                        for (int n = 0; n < 2; ++n) { const af4 v = acc[ai][bj][m][n]; ss += (v[0] * v[0] + v[1] * v[1]) + (v[2] * v[2] + v[3] * v[3]); }
                    ss += __shfl_xor(ss, 16); ss += __shfl_xor(ss, 32);
                    const float rs = rsqrtf(ss * (1.f / 64.f) + EPS);
                    bf16* rowp = base + (size_t)(row0 + ai * 128 + m * 16) * 512 + grp * 64 + 8 * fq;
#pragma unroll
                    for (int bj = 0; bj < 2; ++bj) { const af4 v0 = acc[ai][bj][m][0] * rs * gv[bj][0], v1 = acc[ai][bj][m][1] * rs * gv[bj][1];
                        pg8::u32x4 w; w.x = pg8::cvt_pk_bf16(v0[0], v0[1]); w.y = pg8::cvt_pk_bf16(v0[2], v0[3]); w.z = pg8::cvt_pk_bf16(v1[0], v1[1]); w.w = pg8::cvt_pk_bf16(v1[2], v1[3]);
                        *(pg8::u32x4*)(rowp + 32 * bj) = w; }
                }
        } else {
            bf16* base; int pitch, colt; int act = 0;
            if (pn == 0) { base = QG; pitch = 256; colt = 0; act = 1; }
            else if (pn == 1) { base = KG; pitch = 256; colt = 0; }
            else if (pn < 4) { base = VG; pitch = 512; colt = (pn - 2) * 256; }
            else if (pn < 6) { base = RG; pitch = 512; colt = (pn - 4) * 256; act = 2; }
            else { base = VD; pitch = 512; colt = (pn - 10) * 256; }
            const int col0 = colt + wc * 32 + 8 * fq;
#pragma unroll
            for (int ai = 0; ai < 2; ++ai)
#pragma unroll
                for (int m = 0; m < 4; ++m) { bf16* rowp = base + (size_t)(row0 + ai * 128 + m * 16) * pitch + col0;
#pragma unroll
                    for (int bj = 0; bj < 2; ++bj) { af4 v0 = acc[ai][bj][m][0], v1 = acc[ai][bj][m][1];
                        if (act == 1) { v0 = v0 * 0.125f; v1 = v1 * 0.125f; }
                        if (act == 2) {
#pragma unroll
                            for (int q = 0; q < 4; ++q) { v0[q] = v0[q] * sigmoidf_(v0[q]); v1[q] = v1[q] * sigmoidf_(v1[q]); } }
                        pg8::u32x4 w; w.x = pg8::cvt_pk_bf16(v0[0], v0[1]); w.y = pg8::cvt_pk_bf16(v0[2], v0[3]); w.z = pg8::cvt_pk_bf16(v1[0], v1[1]); w.w = pg8::cvt_pk_bf16(v1[2], v1[3]);
                        *(pg8::u32x4*)(rowp + bj * 128) = w; } }
        }
    }
};
struct EpiOutProj {
    static constexpr bool PERM = true;
    bf16* mix; const float* mod;
    __device__ __forceinline__ void operator()(const af4 (&acc)[2][2][4][2], const Unit& u, int wr, int wc, int fr, int fq) const {
        const int b = (u.pm * 256) / SEQ; const int col0 = u.pn * 256 + wc * 32 + 8 * fq;
        af4 gt[2][2];
#pragma unroll
        for (int bj = 0; bj < 2; ++bj)
#pragma unroll
            for (int n = 0; n < 2; ++n) gt[bj][n] = *(const af4*)(mod + (size_t)b * 6144 + 2048 + col0 + bj * 128 + 4 * n);
#pragma unroll
        for (int ai = 0; ai < 2; ++ai)
#pragma unroll
            for (int m = 0; m < 4; ++m) { bf16* rowp = mix + (size_t)(u.pm * 256 + ai * 128 + wr * 64 + m * 16 + fr) * D + col0;
#pragma unroll
                for (int bj = 0; bj < 2; ++bj) { const af4 v0 = acc[ai][bj][m][0] * gt[bj][0], v1 = acc[ai][bj][m][1] * gt[bj][1];
                    pg8::u32x4 w; w.x = pg8::cvt_pk_bf16(v0[0], v0[1]); w.y = pg8::cvt_pk_bf16(v0[2], v0[3]); w.z = pg8::cvt_pk_bf16(v1[0], v1[1]); w.w = pg8::cvt_pk_bf16(v1[2], v1[3]);
                    *(pg8::u32x4*)(rowp + bj * 128) = w; } }
    }
};
struct EpiSwiGLU {
    static constexpr bool PERM = false;
    unsigned char* Y; const float* bgu;
    __device__ __forceinline__ void operator()(const af4 (&acc)[2][2][4][2], const Unit& u, int wr, int wc, int fr, int fq) const {
        const int f0 = u.pn * 128 + wc * 32 + 4 * fq; const float* bb = bgu + (size_t)u.e * 2048 + f0;
        af4 bg[2], bu[2];
#pragma unroll
        for (int n = 0; n < 2; ++n) { bg[n] = *(const af4*)(bb + 16 * n); bu[n] = *(const af4*)(bb + 1024 + 16 * n); }
#pragma unroll
        for (int ai = 0; ai < 2; ++ai)
#pragma unroll
            for (int m = 0; m < 4; ++m) { unsigned char* rowp = Y + (size_t)(u.pm * 256 + ai * 128 + wr * 64 + m * 16 + fr) * FF + f0;
#pragma unroll
                for (int n = 0; n < 2; ++n) { const af4 g = acc[ai][0][m][n] * WSCALE_INV + bg[n], up = acc[ai][1][m][n] * WSCALE_INV + bu[n]; af4 y;
#pragma unroll
                    for (int q = 0; q < 4; ++q) { const float gg = fminf(g[q], 7.f), uu = fminf(fmaxf(up[q], -7.f), 7.f); y[q] = (uu + 1.f) * gg * sigmoidf_(1.702f * gg); }
                    *(unsigned*)(rowp + 16 * n) = pk4_fp8(y[0], y[1], y[2], y[3]); } }
    }
};
struct EpiDown {
    static constexpr bool PERM = true;
    unsigned char* Cn; const float* bd;
    __device__ __forceinline__ void operator()(const af4 (&acc)[2][2][4][2], const Unit& u, int wr, int wc, int fr, int fq) const {
        const int col0 = u.pn * 256 + wc * 32 + 8 * fq; const float* bb = bd + (size_t)u.e * 1024 + col0;
        af4 bv[2][2];
#pragma unroll
        for (int bj = 0; bj < 2; ++bj)
#pragma unroll
            for (int n = 0; n < 2; ++n) bv[bj][n] = *(const af4*)(bb + bj * 128 + 4 * n);
#pragma unroll
        for (int ai = 0; ai < 2; ++ai)
#pragma unroll
            for (int m = 0; m < 4; ++m) { const int row = u.pm * 256 + ai * 128 + wr * 64 + m * 16 + fr; unsigned char* rowp = Cn + (size_t)row * 1024 + col0;
#pragma unroll
                for (int bj = 0; bj < 2; ++bj) { const af4 v0 = acc[ai][bj][m][0] * WSCALE_INV + bv[bj][0], v1 = acc[ai][bj][m][1] * WSCALE_INV + bv[bj][1];
                    v2u w; w.x = pk4_fp8(v0[0], v0[1], v0[2], v0[3]); w.y = pk4_fp8(v1[0], v1[1], v1[2], v1[3]); *(v2u*)(rowp + bj * 128) = w; } }
    }
};

typedef float cf4 __attribute__((ext_vector_type(4)));
#define MFMA16(a, b, c) __builtin_amdgcn_mfma_f32_16x16x32_bf16((a), (b), (c), 0, 0, 0)
constexpr int GP = 72;
__device__ __forceinline__ void gla_a_unit(Frame& F, int chunk) {
    const int tid = F.tid, lane = F.lane, w = F.wave;
    const int bh = chunk >> 7, n = chunk & 127, b = bh >> 2, h = bh & 3;
    const size_t R0 = (size_t)b * SEQ + (size_t)n * 64;
    LAS float* gc = (LAS float*)F.lds;
    LAS float* segt = (LAS float*)(F.lds + 16384);
    LAS bf16* QEs = (LAS bf16*)(F.lds + 18432);
    LAS bf16* KEs = (LAS bf16*)(F.lds + 18432 + 9216);
    LAS bf16* KST = (LAS bf16*)(F.lds + 18432 + 2 * 9216);
    LAS bf16* VT = (LAS bf16*)(F.lds + 18432 + 3 * 9216);
    LAS bf16* AM = (LAS bf16*)(F.lds + 18432 + 3 * 9216 + 18432);
    const float* GK = wsp<const float>(F, WS_GK);
    { const int r = tid >> 3, d0 = (tid & 7) * 8; const float* gp = GK + (R0 + r) * 256 + h * 64 + d0;
      *(LAS f32x4*)(gc + r * 64 + d0) = *(const f32x4*)gp; *(LAS f32x4*)(gc + r * 64 + d0 + 4) = *(const f32x4*)(gp + 4); }
    __syncthreads();
    { const int seg = tid >> 6, d = tid & 63; float run = 0.f;
#pragma unroll
      for (int i = 0; i < 8; ++i) { run += gc[(seg * 8 + i) * 64 + d]; gc[(seg * 8 + i) * 64 + d] = run; }
      segt[seg * 64 + d] = run; }
    __syncthreads();
    { const int seg = tid >> 6, d = tid & 63; float off = 0.f;
      for (int s2 = 0; s2 < seg; ++s2) off += segt[s2 * 64 + d];
#pragma unroll
      for (int i = 0; i < 8; ++i) gc[(seg * 8 + i) * 64 + d] += off; }
    __syncthreads();
    { const int r = tid >> 3, d0 = (tid & 7) * 8;
      const v4u qv = *(const v4u*)(wsp<const bf16>(F, WS_QG) + (R0 + r) * 256 + h * 64 + d0);
      const v4u kv = *(const v4u*)(wsp<const bf16>(F, WS_KG) + (R0 + r) * 256 + h * 64 + d0);
      float qf[8], kf[8];
#pragma unroll
      for (int i = 0; i < 4; ++i) { qf[2 * i] = bflo(qv[i]); qf[2 * i + 1] = bfhi(qv[i]); kf[2 * i] = bflo(kv[i]); kf[2 * i + 1] = bfhi(kv[i]); }
      float qe[8], ke[8];
#pragma unroll
      for (int i = 0; i < 8; ++i) { const float g = gc[r * 64 + d0 + i], gl = gc[63 * 64 + d0 + i];
          qe[i] = qf[i] * __expf(g); ke[i] = kf[i] * __expf(-g); KST[(d0 + i) * GP + r] = (bf16)f2bf(kf[i] * __expf(gl - g)); }
      v4u qo, ko;
#pragma unroll
      for (int i = 0; i < 4; ++i) { qo[i] = pk2(qe[2 * i], qe[2 * i + 1]); ko[i] = pk2(ke[2 * i], ke[2 * i + 1]); }
      *(LAS v4u*)(QEs + r * GP + d0) = qo; *(LAS v4u*)(KEs + r * GP + d0) = ko;
      *(v4u*)(wsp<bf16>(F, WS_QE) + (R0 + r) * 256 + h * 64 + d0) = qo;
      const int e0 = (tid & 7) * 16;
      const v4u va = *(const v4u*)(wsp<const bf16>(F, WS_VG) + (R0 + r) * 512 + h * 128 + e0);
      const v4u vb = *(const v4u*)(wsp<const bf16>(F, WS_VG) + (R0 + r) * 512 + h * 128 + e0 + 8);
#pragma unroll
      for (int i = 0; i < 4; ++i) { VT[(e0 + 2 * i) * GP + r] = (bf16)(va[i] & 0xffffu); VT[(e0 + 2 * i + 1) * GP + r] = (bf16)(va[i] >> 16);
                                    VT[(e0 + 8 + 2 * i) * GP + r] = (bf16)(vb[i] & 0xffffu); VT[(e0 + 8 + 2 * i + 1) * GP + r] = (bf16)(vb[i] >> 16); }
      if (tid < 64) wsp<float>(F, WS_DEC)[(size_t)chunk * 64 + tid] = __expf(gc[63 * 64 + tid]);
    }
    __syncthreads();
    const int l15 = lane & 15, l4 = lane >> 4;
#pragma unroll
    for (int q = 0; q < 2; ++q) { const int tile = 2 * w + q, ti = tile >> 2, tj = tile & 3;
        cf4 a = {0.f, 0.f, 0.f, 0.f};
        if (tj <= ti) {
#pragma unroll
            for (int kk = 0; kk < 2; ++kk) { const bf16x8 fa = *(const LAS bf16x8*)(QEs + (16 * ti + l15) * GP + kk * 32 + 8 * l4); const bf16x8 fb = *(const LAS bf16x8*)(KEs + (16 * tj + l15) * GP + kk * 32 + 8 * l4); a = MFMA16(fa, fb, a); } }
#pragma unroll
        for (int r = 0; r < 4; ++r) { const int cr = 16 * ti + 4 * l4 + r, cj = 16 * tj + l15; AM[cr * GP + cj] = (bf16)f2bf(cj <= cr ? a[r] : 0.f); } }
    { float* UT = wsp<float>(F, WS_UT) + (size_t)chunk * 8192;
#pragma unroll
      for (int td = 0; td < 4; ++td) { cf4 a = {0.f, 0.f, 0.f, 0.f};
#pragma unroll
          for (int kk = 0; kk < 2; ++kk) { const bf16x8 fa = *(const LAS bf16x8*)(VT + (16 * w + l15) * GP + kk * 32 + 8 * l4); const bf16x8 fb = *(const LAS bf16x8*)(KST + (16 * td + l15) * GP + kk * 32 + 8 * l4); a = MFMA16(fa, fb, a); }
#pragma unroll
          for (int r = 0; r < 4; ++r) UT[(16 * w + 4 * l4 + r) * 64 + 16 * td + l15] = a[r]; } }
    __syncthreads();
    { float* OI = wsp<float>(F, WS_OI);
#pragma unroll
      for (int tc = 0; tc < 4; ++tc) { cf4 a = {0.f, 0.f, 0.f, 0.f};
#pragma unroll
          for (int kk = 0; kk < 2; ++kk) { const bf16x8 fa = *(const LAS bf16x8*)(AM + (16 * tc + l15) * GP + kk * 32 + 8 * l4); const bf16x8 fb = *(const LAS bf16x8*)(VT + (16 * w + l15) * GP + kk * 32 + 8 * l4); a = MFMA16(fa, fb, a); }
#pragma unroll
          for (int r = 0; r < 4; ++r) OI[(R0 + 16 * tc + 4 * l4 + r) * 512 + h * 128 + 16 * w + l15] = a[r]; } }
    __syncthreads();
}
__device__ __forceinline__ void gla_b_phase(Frame& F) {
    const float* UT = wsp<const float>(F, WS_UT); const float* DEC = wsp<const float>(F, WS_DEC); bf16* SP = wsp<bf16>(F, WS_SP);
    for (int gt = F.vcu * 512 + F.tid; gt < 16 * 8192; gt += F.G * 512) {
        const int bh = gt >> 13, ed = gt & 8191, d = gt & 63; float S = 0.f;
#pragma unroll 8
        for (int n = 0; n < 128; ++n) { const size_t ch = (size_t)bh * 128 + n; const float u = UT[ch * 8192 + ed], dc = DEC[ch * 64 + d]; SP[ch * 8192 + ed] = (bf16)f2bf(S); S = S * dc + u; }
    }
}
__device__ __forceinline__ void gla_c_unit(Frame& F, int unit) {
    const int tid = F.tid, lane = F.lane, w = F.wave;
    const int bh = unit >> 6, n2 = unit & 63, b = bh >> 2, h = bh & 3;
    const size_t R0 = (size_t)b * SEQ + (size_t)n2 * 128;
    LAS bf16* QEs = (LAS bf16*)F.lds;
    LAS bf16* SPs = (LAS bf16*)(F.lds + 18432);
    { const int r = tid >> 2, d0 = (tid & 3) * 16; const bf16* src = wsp<const bf16>(F, WS_QE) + (R0 + r) * 256 + h * 64 + d0;
      *(LAS v4u*)(QEs + r * GP + d0) = *(const v4u*)src; *(LAS v4u*)(QEs + r * GP + d0 + 8) = *(const v4u*)(src + 8);
      const bf16* sp = wsp<const bf16>(F, WS_SP) + ((size_t)bh * 128 + 2 * n2) * 8192;
      const int row = tid >> 1, dd = (tid & 1) * 32;
#pragma unroll
      for (int i = 0; i < 4; ++i) *(LAS v4u*)(SPs + row * GP + dd + 8 * i) = *(const v4u*)(sp + (size_t)row * 64 + dd + 8 * i); }
    __syncthreads();
    const int l15 = lane & 15, l4 = lane >> 4, c2 = w >> 2, tc = w & 3;
    cf4 a[8];
#pragma unroll
    for (int te = 0; te < 8; ++te) { a[te] = (cf4){0.f, 0.f, 0.f, 0.f};
#pragma unroll
        for (int kk = 0; kk < 2; ++kk) { const bf16x8 fa = *(const LAS bf16x8*)(QEs + (64 * c2 + 16 * tc + l15) * GP + kk * 32 + 8 * l4); const bf16x8 fb = *(const LAS bf16x8*)(SPs + (128 * c2 + 16 * te + l15) * GP + kk * 32 + 8 * l4); a[te] = MFMA16(fa, fb, a[te]); } }
    const float* OI = wsp<const float>(F, WS_OI); const bf16* RG = wsp<const bf16>(F, WS_RG); bf16* A2 = wsp<bf16>(F, WS_A2);
    float gg[8];
#pragma unroll
    for (int te = 0; te < 8; ++te) gg[te] = F.g_gla_out[16 * te + l15];
#pragma unroll
    for (int r = 0; r < 4; ++r) { const size_t row = R0 + 64 * c2 + 16 * tc + 4 * l4 + r; float ss = 0.f; float o[8];
#pragma unroll
        for (int te = 0; te < 8; ++te) { o[te] = a[te][r] + OI[row * 512 + h * 128 + 16 * te + l15]; ss += o[te] * o[te]; }
        ss += __shfl_xor(ss, 1); ss += __shfl_xor(ss, 2); ss += __shfl_xor(ss, 4); ss += __shfl_xor(ss, 8);
        const float rs = rsqrtf(ss * (1.f / 128.f) + EPS);
#pragma unroll
        for (int te = 0; te < 8; ++te) { const int e = 16 * te + l15; A2[row * 1024 + h * 128 + e] = (bf16)f2bf(o[te] * rs * gg[te] * bf2f(RG[row * 512 + h * 128 + e])); } }
    __syncthreads();
}

namespace att {
constexpr int KSLOT = 8192, VSLOT = 16384, NSLOT = 3;
constexpr int LDS_K = 0, LDS_V = NSLOT * KSLOT, LDS_TBL = LDS_V + NSLOT * VSLOT, LDS_WS = LDS_TBL + 1024, LDS_Q = LDS_WS + 8 * 256, LDS_END = LDS_Q + 8 * 4096;
static_assert(LDS_END <= RING_BYTES, "attention LDS");
__device__ __forceinline__ int crow(int r, int hi) { return (r & 3) + 8 * (r >> 2) + 4 * hi; }
__device__ __forceinline__ void glds16(const void* gsrc, unsigned lds_dst) { unsigned keep;
    asm volatile("s_mov_b32 %0, m0\n\ts_mov_b32 m0, %2\n\ts_nop 0\n\tglobal_load_lds_dwordx4 %1, off\n\ts_mov_b32 m0, %0" : "=&s"(keep) : "v"(gsrc), "s"(lds_dst) : "memory"); }
typedef float f32x2_t __attribute__((ext_vector_type(2))); typedef __bf16 bf16x2_t __attribute__((ext_vector_type(2)));
__device__ __forceinline__ unsigned cvtpk_s(float lo, float hi) { f32x2_t v = {lo, hi}; bf16x2_t b = __builtin_convertvector(v, bf16x2_t); return __builtin_bit_cast(unsigned, b); }
typedef short v4i16_t __attribute__((ext_vector_type(4)));
typedef LAS const char* lds_cptr;
__device__ __forceinline__ s16x4 vtr(lds_cptr p) { return __builtin_bit_cast(s16x4, __builtin_amdgcn_ds_read_tr16_b64_v4i16((LAS v4i16_t*)p)); }
#define MFMA32(a, b, c) __builtin_amdgcn_mfma_f32_32x32x16_bf16((a), (b), (c), 0, 0, 0)
#define ATT_WAIT_BAR(N) asm volatile("s_waitcnt vmcnt(" #N ") lgkmcnt(0)\n\ts_barrier" ::: "memory")

__device__ __forceinline__ void attn_map(f32x16 (&o)[4], int b, int h, int m, int qb, const bf16* QD, const bf16* KD, const bf16* VD, LAS unsigned char* shm) {
    int lane = threadIdx.x & 63; asm volatile("" : "+v"(lane));
    const int tid = threadIdx.x, r32 = lane & 31, hi = lane >> 5; const int wid = __builtin_amdgcn_readfirstlane(tid >> 6);
    const size_t rowbase = (size_t)b * SEQ; const int q0 = qb * 256;
    const bf16* Qw = QD + (rowbase + q0 + wid * 32) * 512 + (h * 2 + m) * 64;
    const bf16* Kh = KD + rowbase * 512 + (h * 2 + m) * 64; const bf16* Vh = VD + rowbase * 512 + h * 128;
    const unsigned lds0 = (unsigned)(uintptr_t)shm;
    const LAS float* tbl = (const LAS float*)(shm + LDS_TBL) + m * 128;
    LAS float* wsf = (LAS float*)(shm + LDS_WS) + wid * 64;
    const bf16* ksrc = Kh + (size_t)lane * 512 + wid * 8;
    const bf16* vsrc = Vh + (size_t)(16 * (wid & 3) + (lane >> 2)) * 512 + (wid >> 2) * 32 + (lane & 3) * 8;
    const unsigned kdst = lds0 + LDS_K + wid * 1024, vdst = lds0 + LDS_V + wid * 1024;
#define DMA_K(t, slot) glds16(ksrc + (size_t)(t) * 64 * 512, (unsigned)__builtin_amdgcn_readfirstlane(kdst + (slot) * KSLOT))
#define DMA_V(t, slot) do { glds16(vsrc + (size_t)(t) * 64 * 512, (unsigned)__builtin_amdgcn_readfirstlane(vdst + (slot) * VSLOT)); \
        glds16(vsrc + (size_t)(t) * 64 * 512 + 64, (unsigned)__builtin_amdgcn_readfirstlane(vdst + (slot) * VSLOT + 8192)); } while (0)
    const int NT = 4 * qb + 4;
    VM_WAIT();
    DMA_K(0, 0); DMA_V(0, 0); DMA_K(1, 1); DMA_K(2, 2);
    const lds_cptr qlds = (lds_cptr)shm + LDS_Q + wid * 4096 + lane * 16;
    { bf16x8 qr[4];
#pragma unroll
      for (int d0 = 0; d0 < 4; ++d0) qr[d0] = *(const bf16x8*)(Qw + (size_t)r32 * 512 + d0 * 16 + hi * 8);
      asm volatile("s_waitcnt vmcnt(0)" : "+v"(qr[0]), "+v"(qr[1]), "+v"(qr[2]), "+v"(qr[3]) :: "memory");
#pragma unroll
      for (int d0 = 0; d0 < 4; ++d0) *(LAS bf16x8*)(shm + LDS_Q + wid * 4096 + lane * 16 + d0 * 1024) = qr[d0]; }
#pragma unroll
    for (int d0 = 0; d0 < 4; ++d0) o[d0] = (f32x16){};
    float lsum = 0.f;
    const int qw0 = q0 + wid * 32, qabs = qw0 + r32;
    const lds_cptr shm3 = (lds_cptr)shm;
    const lds_cptr kp0 = shm3 + LDS_K + hi * 1024 + r32 * 16;
    const lds_cptr vp0 = shm3 + LDS_V + ((lane >> 4) & 1) * 32 + (lane & 3) * 8 + (4 * hi + ((lane & 15) >> 2)) * 64;
#define QK_TILE(C0, C1, kp) do { C0 = (f32x16){}; C1 = (f32x16){}; \
        _Pragma("unroll") for (int d0 = 0; d0 < 4; ++d0) { if (d0 == 2) __builtin_amdgcn_sched_barrier(0); const bf16x8 b0 = *(const LAS bf16x8*)((kp) + d0 * 2048); const bf16x8 b1 = *(const LAS bf16x8*)((kp) + d0 * 2048 + 512); \
            const bf16x8 qf_ = *(const LAS bf16x8*)(qlds + d0 * 1024); C0 = MFMA32(b0, qf_, C0); C1 = MFMA32(b1, qf_, C1); } } while (0)
#define MASK_BIAS(C0, C1, t) do { const int kvb_ = (t) * 64; if (kvb_ + 191 > qw0) { int dbase = qabs - kvb_ - 4 * hi; asm volatile("" : "+v"(dbase)); \
        _Pragma("unroll") for (int r = 0; r < 16; ++r) { const int d0_ = dbase - ((r & 3) + 8 * (r >> 2)); const int d1_ = d0_ - 32; \
            C0[r] = d0_ < 0 ? -INFINITY : C0[r] + tbl[d0_ > 127 ? 127 : d0_]; C1[r] = d1_ < 0 ? -INFINITY : C1[r] + tbl[d1_ > 127 ? 127 : d1_]; } } } while (0)
#define VLOAD(vf, vp, d0) do { _Pragma("unroll") for (int ks = 0; ks < 4; ++ks) { const s16x4 lo_ = vtr((vp) + (d0) * 4096 + ks * 1024), hh_ = vtr((vp) + (d0) * 4096 + ks * 1024 + 512); \
            vf[ks] = (bf16x8){lo_[0], lo_[1], lo_[2], lo_[3], hh_[0], hh_[1], hh_[2], hh_[3]}; } } while (0)
#define PV4(d0, vf) do { _Pragma("unroll") for (int ks = 0; ks < 4; ++ks) o[d0] = MFMA32(__builtin_bit_cast(bf16x8, pw[ks]), vf[ks], o[d0]); } while (0)
#define PACK_SUM(P0, P1) do { float sacc = 0.f; _Pragma("unroll") for (int r = 0; r < 16; ++r) sacc += P0[r] + P1[r]; lsum += sacc; \
        _Pragma("unroll") for (int i = 0; i < 4; ++i) { pw[0][i] = cvtpk_s(P0[2 * i], P0[2 * i + 1]); pw[1][i] = cvtpk_s(P0[8 + 2 * i], P0[9 + 2 * i]); pw[2][i] = cvtpk_s(P1[2 * i], P1[2 * i + 1]); pw[3][i] = cvtpk_s(P1[8 + 2 * i], P1[9 + 2 * i]); } } while (0)
#define EXP_PACK(C, pwa, pwb) do { float sacc = 0.f; _Pragma("unroll") for (int r = 0; r < 16; ++r) { C[r] = __builtin_amdgcn_exp2f(C[r]); sacc += C[r]; } lsum += sacc; \
        _Pragma("unroll") for (int i = 0; i < 4; ++i) { pwa[i] = cvtpk_s(C[2 * i], C[2 * i + 1]); pwb[i] = cvtpk_s(C[8 + 2 * i], C[9 + 2 * i]); } } while (0)
#define KLOAD(kf, kp) do { _Pragma("unroll") for (int d0 = 0; d0 < 4; ++d0) { kf[2 * d0] = *(const LAS bf16x8*)((kp) + d0 * 2048); kf[2 * d0 + 1] = *(const LAS bf16x8*)((kp) + d0 * 2048 + 512); } } while (0)
#define QLOAD(qf) do { _Pragma("unroll") for (int d0 = 0; d0 < 4; ++d0) qf[d0] = *(const LAS bf16x8*)(qlds + d0 * 1024); } while (0)
#define QK8(C0, C1, kf, qf) do { C0 = (f32x16){}; C1 = (f32x16){}; _Pragma("unroll") for (int d0 = 0; d0 < 4; ++d0) { C0 = MFMA32(kf[2 * d0], qf[d0], C0); C1 = MFMA32(kf[2 * d0 + 1], qf[d0], C1); } } while (0)
#define SB() __builtin_amdgcn_sched_barrier(0)
    f32x16 C0, C1; v4u pw[4], pwn[4]; bf16x8 va[4], vb[4], kf[8], qf[4];
    ATT_WAIT_BAR(0);
    KLOAD(kf, kp0); QLOAD(qf);
    ATT_WAIT_BAR(0);
    if (3 < NT) DMA_K(3, 0);
    DMA_V(1, 1);
    QK8(C0, C1, kf, qf);
    MASK_BIAS(C0, C1, 0);
    EXP_PACK(C0, pw[0], pw[1]); EXP_PACK(C1, pw[2], pw[3]);
    KLOAD(kf, kp0 + KSLOT);
    int ks_cur = 1, vs_prev = 0;
    for (int t = 1; t < NT; ++t) {
        if (t + 2 < NT) { ATT_WAIT_BAR(3); } else { ATT_WAIT_BAR(2); }
        { const int vs_new = (vs_prev == 0) ? 2 : vs_prev - 1;
          if (t + 3 < NT) DMA_K(t + 3, ks_cur);
          if (t + 1 < NT) DMA_V(t + 1, vs_new); }
        const int ks_next = (ks_cur == 2) ? 0 : ks_cur + 1;
        const lds_cptr vp = vp0 + vs_prev * VSLOT;
        SB();
        VLOAD(va, vp, 0); VLOAD(vb, vp, 1); QLOAD(qf);
        SB();
        QK8(C0, C1, kf, qf);
        SB();
        MASK_BIAS(C0, C1, t);
        SB();
        PV4(0, va); PV4(1, vb);
        EXP_PACK(C0, pwn[0], pwn[1]);
        SB();
        VLOAD(va, vp, 2); VLOAD(vb, vp, 3);
        KLOAD(kf, kp0 + ks_next * KSLOT);
        SB();
        PV4(2, va); PV4(3, vb);
        EXP_PACK(C1, pwn[2], pwn[3]);
        SB();
#pragma unroll
        for (int i = 0; i < 4; ++i) pw[i] = pwn[i];
        ks_cur = ks_next; vs_prev = (vs_prev == 2) ? 0 : vs_prev + 1;
    }
    ATT_WAIT_BAR(0);
    { const lds_cptr vp = vp0 + vs_prev * VSLOT;
      VLOAD(va, vp, 0); VLOAD(vb, vp, 1); PV4(0, va); PV4(1, vb);
      VLOAD(va, vp, 2); VLOAD(vb, vp, 3); PV4(2, va); PV4(3, vb); }
    { auto rr = __builtin_amdgcn_permlane32_swap(__float_as_uint(lsum), __float_as_uint(lsum), false, false); lsum = __uint_as_float(rr[0]) + __uint_as_float(rr[1]); }
    if (hi == 0) wsf[r32] = lsum;
    LDS_WAIT();
#pragma unroll
    for (int r = 0; r < 16; ++r) { const float rl = 1.0f / wsf[crow(r, hi)];
#pragma unroll
        for (int d0 = 0; d0 < 4; ++d0) o[d0][r] *= rl; }
    ATT_WAIT_BAR(0);
#undef DMA_K
#undef DMA_V
#undef QK_TILE
#undef MASK_BIAS
#undef VLOAD
#undef PV4
#undef PACK_SUM
#undef EXP_PACK
#undef KLOAD
#undef QLOAD
#undef QK8
#undef SB
}
__device__ __forceinline__ int t5_bucket(int n) {
    if (n < 16) return n;
    const float nf = (float)n; int large = 16 + (int)(logf(nf / 16.f) / logf(8.f) * 16.f);
    return large < 31 ? large : 31;
}
__device__ __forceinline__ void attn_unit(Frame& F, int b, int h, int qb, float lam) {
    LAS unsigned char* shm = F.lds;
    int tid = F.tid; asm volatile("" : "+v"(tid));
    const int lane = tid & 63, r32 = lane & 31, hi = lane >> 5, wid = F.wave;
    if (tid < 256) { const int m = tid >> 7, d = tid & 127; const int col = h * 2 + m;
        ((LAS float*)(shm + LDS_TBL))[tid] = (F.rel_bias[t5_bucket(d) * 8 + col] - F.rel_bias[31 * 8 + col]) * LOG2E; }
    __syncthreads();
    const bf16* QD = wsp<const bf16>(F, WS_QD); const bf16* KD = wsp<const bf16>(F, WS_KD); const bf16* VD = wsp<const bf16>(F, WS_VD);
    float* stash = wsp<float>(F, WS_STASH) + (size_t)F.vcu * 32768 + tid * 64;
    f32x16 o[4];
#pragma nounroll
    for (int m = 0; m < 2; ++m) {
        attn_map(o, b, h, m, qb, QD, KD, VD, shm);
        if (m == 0) {
#pragma unroll
            for (int d0 = 0; d0 < 4; ++d0)
#pragma unroll
                for (int r = 0; r < 16; r += 4) *(f32x4*)(stash + d0 * 16 + r) = (f32x4){o[d0][r], o[d0][r + 1], o[d0][r + 2], o[d0][r + 3]};
        } else {
            float ss[16];
#pragma unroll
            for (int r = 0; r < 16; ++r) ss[r] = 0.f;
#pragma unroll
            for (int d0 = 0; d0 < 4; ++d0)
#pragma unroll
                for (int r4 = 0; r4 < 16; r4 += 4) { const f32x4 sv = *(const f32x4*)(stash + d0 * 16 + r4);
#pragma unroll
                    for (int q = 0; q < 4; ++q) { const int r = r4 + q; const float v = sv[q] - lam * o[d0][r]; o[d0][r] = v; ss[r] += v * v; } }
            float gs[4];
#pragma unroll
            for (int d0 = 0; d0 < 4; ++d0) gs[d0] = F.g_subln[32 * d0 + r32] * 0.8f;
            bf16* A2 = wsp<bf16>(F, WS_A2);
            const size_t rowb = (size_t)b * SEQ + (size_t)qb * 256 + wid * 32;
            bf16* a2b = A2 + (rowb + 4 * hi) * 1024 + 512 + h * 128 + r32; asm volatile("" : "+v"(a2b));
#pragma unroll
            for (int r = 0; r < 16; ++r) { float s = ss[r];
                s += __shfl_xor(s, 1); s += __shfl_xor(s, 2); s += __shfl_xor(s, 4); s += __shfl_xor(s, 8); s += __shfl_xor(s, 16);
                const float rs = rsqrtf(s * (1.f / 128.f) + EPS);
                bf16* rowp = a2b + (size_t)((r & 3) + 8 * (r >> 2)) * 1024;
#pragma unroll
                for (int d0 = 0; d0 < 4; ++d0) rowp[32 * d0] = (bf16)f2bf(o[d0][r] * rs * gs[d0]); }
        }
    }
    __syncthreads();
}
}

__device__ __forceinline__ void p7_phase(Frame& F, bool count = true) {
    const int tid = F.tid, lane = F.lane;
    LAS float* wr = (LAS float*)F.lds;
    LAS unsigned* hist = (LAS unsigned*)(F.lds + HIST_OFF);
    { f32x4 t[16]; const int k0 = tid >> 3, e4 = (tid & 7) * 4;
#pragma unroll
      for (int it = 0; it < 16; ++it) t[it] = *(const f32x4*)(F.w_router + (size_t)(k0 + 64 * it) * 32 + e4);
#pragma unroll
      for (int it = 0; it < 16; ++it)
#pragma unroll
          for (int q = 0; q < 4; ++q) wr[(e4 + q) * 1024 + k0 + 64 * it] = t[it][q]; }
    if (tid < 32) hist[tid] = 0u;
    __syncthreads();
    const float* MOD = wsp<const float>(F, WS_MOD);
    const int gw = F.vcu * NWAVES + F.wave, NGW = F.G * NWAVES; const int rpw = (T + NGW - 1) / NGW;
    int curb = -1; f32x4 gsc[4], shv[4], nx[4];
    v2u nm[4]; const bf16* MIX = wsp<const bf16>(F, WS_MIX);
    { const int m0 = (srow(gw, 0, NGW) < T) ? srow(gw, 0, NGW) : 0; const GAS f32x4* xr = (const GAS f32x4*)(F.x + (size_t)m0 * D) + lane; const GAS v2u* mr = (const GAS v2u*)(MIX + (size_t)m0 * D) + lane;
#pragma unroll
      for (int j = 0; j < 4; ++j) { nx[j] = xr[64 * j]; nm[j] = mr[64 * j]; } }
#pragma nounroll
    for (int i = 0; i < rpw; ++i) {
        const int m = srow(gw, i, NGW); if (m >= T) break;
        const int b = m / SEQ;
        if (b != curb) { curb = b;
#pragma unroll
            for (int j = 0; j < 4; ++j) { const int col = 256 * j + 4 * lane; const f32x4 g = *(const f32x4*)(F.g_norm2 + col);
                shv[j] = *(const f32x4*)(MOD + (size_t)b * 6144 + 3072 + col); gsc[j] = g * (*(const f32x4*)(MOD + (size_t)b * 6144 + 4096 + col) + 1.0f); } }
        f32x4 v[4]; float s = 0.f;
#pragma unroll
        for (int j = 0; j < 4; ++j) { v[j] = nx[j] + (f32x4){bflo(nm[j].x), bfhi(nm[j].x), bflo(nm[j].y), bfhi(nm[j].y)}; s += (v[j].x * v[j].x + v[j].y * v[j].y) + (v[j].z * v[j].z + v[j].w * v[j].w); }
        { const int mn_ = srow(gw, i + 1, NGW); const int m2 = (i + 1 < rpw && mn_ < T) ? mn_ : m; const GAS f32x4* xr = (const GAS f32x4*)(F.x + (size_t)m2 * D) + lane; const GAS v2u* mr = (const GAS v2u*)(MIX + (size_t)m2 * D) + lane;
#pragma unroll
          for (int j = 0; j < 4; ++j) { nx[j] = xr[64 * j]; nm[j] = mr[64 * j]; } }
        const float rstd = rsqrtf(wave_sum(s) * (1.f / D) + EPS);
        GAS unsigned* o4 = (GAS unsigned*)(wsp<unsigned char>(F, WS_XN) + (size_t)m * D) + lane;
#pragma unroll
        for (int j = 0; j < 4; ++j) { v[j] = v[j] * rstd * gsc[j] + shv[j]; o4[64 * j] = pk4_fp8(v[j].x, v[j].y, v[j].z, v[j].w); }
        float lg[32];
        { f32x4 wa[8], wb[8];
#define P7_LD(dst, eb) do { _Pragma("unroll") for (int q = 0; q < 8; ++q) dst[q] = *(const LAS f32x4*)(wr + ((eb) * 2 + (q >> 2)) * 1024 + 256 * (q & 3) + 4 * lane); } while (0)
#define P7_DOT(src, eb) do { _Pragma("unroll") for (int rr = 0; rr < 2; ++rr) { f32x2 a2 = {0.f, 0.f}; _Pragma("unroll") for (int j = 0; j < 4; ++j) { const f32x4 w = src[rr * 4 + j]; a2 += v[j].lo * w.lo; a2 += v[j].hi * w.hi; } lg[(eb) * 2 + rr] = a2.x + a2.y; } } while (0)
          P7_LD(wa, 0); __builtin_amdgcn_sched_barrier(0);
#pragma unroll
          for (int eb = 0; eb < 16; eb += 2) {
              P7_LD(wb, eb + 1); __builtin_amdgcn_sched_barrier(0);
              P7_DOT(wa, eb); __builtin_amdgcn_sched_barrier(0);
              if (eb + 2 < 16) { P7_LD(wa, eb + 2); __builtin_amdgcn_sched_barrier(0); }
              P7_DOT(wb, eb + 1); __builtin_amdgcn_sched_barrier(0);
          }
#undef P7_LD
#undef P7_DOT
        }
        const float myl = xreduce<32>(lg, lane) + F.b_router[lane >> 1];
        unsigned key; { const unsigned u = __builtin_bit_cast(unsigned, myl); const unsigned o = (u & 0x80000000u) ? ~u : (u | 0x80000000u); key = (o & ~31u) | (unsigned)(31 - (lane >> 1)); }
        int te[4]; float tv[4];
#pragma unroll
        for (int k = 0; k < 4; ++k) { const unsigned mx = wave_umax(key); te[k] = 31 - (int)(mx & 31u); tv[k] = lane_bcast(myl, 2 * te[k]); key = (key == mx) ? 0u : key; }
        float ex[4], es = 0.f;
#pragma unroll
        for (int k = 0; k < 4; ++k) { ex[k] = __expf(tv[k] - tv[0]); es += ex[k]; }
        if (lane < 4) { const int e = lane == 0 ? te[0] : lane == 1 ? te[1] : lane == 2 ? te[2] : te[3]; const float w = (lane == 0 ? ex[0] : lane == 1 ? ex[1] : lane == 2 ? ex[2] : ex[3]) / es;
            wsp<int>(F, WS_TOPE)[(size_t)m * 4 + lane] = e; wsp<float>(F, WS_TOPW)[(size_t)m * 4 + lane] = w; __hip_atomic_fetch_add(hist + e, 1u, __ATOMIC_RELAXED, __HIP_MEMORY_SCOPE_WORKGROUP); }
    }
    __syncthreads();
    if (tid < 32 && count) __hip_atomic_fetch_add(F.ctl + CW_CNT + tid, hist[tid], RLX_AGENT);
}
__device__ __forceinline__ void moe_tables(Frame& F, int& nMt) {
    LAS unsigned char* te = F.lds + TILEE_OFF;
    if (F.tid == 0) { int t0 = 0;
        for (int e = 0; e < NE; ++e) { const int c = (int)__hip_atomic_load(F.ctl + CW_CNT + e, RLX_AGENT); const int nt = (c + 255) >> 8; for (int j = 0; j < nt; ++j) te[t0 + j] = (unsigned char)e; t0 += nt; }
        F.MISC[16] = (unsigned)t0; }
    __syncthreads();
    nMt = __builtin_amdgcn_readfirstlane((int)F.MISC[16]);
}
__device__ __forceinline__ void p8_phase(Frame& F) {
    const int tid = F.tid, lane = F.lane;
    LAS unsigned* hist = (LAS unsigned*)(F.lds + HIST_OFF);
    if (tid < 96) hist[tid] = 0u;
    __syncthreads();
    const int gw = F.vcu * NWAVES + F.wave, NGW = F.G * NWAVES; const int rpw = (T + NGW - 1) / NGW;
    const int* TOPE = wsp<const int>(F, WS_TOPE);
    for (int i = 0; i < rpw; ++i) { const int m = srow(gw, i, NGW); if (m >= T) break; if (lane < 4) __hip_atomic_fetch_add(hist + TOPE[(size_t)m * 4 + lane], 1u, __ATOMIC_RELAXED, __HIP_MEMORY_SCOPE_WORKGROUP); }
    __syncthreads();
    if (tid < 32) { unsigned pstart = 0; for (int e = 0; e < tid; ++e) { const unsigned c = __hip_atomic_load(F.ctl + CW_CNT + e, RLX_AGENT); pstart += (c + 255u) & ~255u; }
        hist[32 + tid] = pstart + __hip_atomic_fetch_add(F.ctl + CW_FILL + tid, hist[tid], RLX_AGENT); }
    __syncthreads();
    const unsigned char* H2 = wsp<const unsigned char>(F, WS_XN); unsigned char* XS = wsp<unsigned char>(F, WS_XS);
    for (int i = 0; i < rpw; ++i) { const int m = srow(gw, i, NGW); if (m >= T) break;
        int pos = 0;
        if (lane < 4) { const int e = TOPE[(size_t)m * 4 + lane]; pos = (int)(hist[32 + e] + __hip_atomic_fetch_add(hist + 64 + e, 1u, __ATOMIC_RELAXED, __HIP_MEMORY_SCOPE_WORKGROUP));
            wsp<int>(F, WS_POS)[(size_t)m * 4 + lane] = pos; }
        const v4u a = *(const v4u*)(H2 + (size_t)m * D + lane * 16);
#pragma unroll
        for (int k = 0; k < 4; ++k) { const int p = __shfl(pos, k); *(v4u*)(XS + (size_t)p * D + lane * 16) = a; }
    }
}
__device__ __forceinline__ void p11_phase(Frame& F) {
    const int lane = F.lane;
    const float* MOD = wsp<const float>(F, WS_MOD); const unsigned char* CN = wsp<const unsigned char>(F, WS_CN); const int* POS = wsp<const int>(F, WS_POS);
    const int gw = F.vcu * NWAVES + F.wave, NGW = F.G * NWAVES; const int rpw = (T + NGW - 1) / NGW;
    const int nrow = (srow(gw, 0, NGW) < T) ? ((srow(gw, rpw - 1, NGW) < T) ? rpw : 0) : 0;
    int cnt = nrow; if (NGW * 16 != T) { cnt = 0; for (int i = 0; i < rpw; ++i) if (srow(gw, i, NGW) < T) ++cnt; }
    if (cnt == 0) return;
#define RW(i) srow(gw, ((i) < cnt ? (i) : cnt - 1), NGW)
    v4u ca[4], mx0, mx1; f32x4 xv[4]; int pn[4]; f32x4 wcur, wnxt; const float* TOPW = wsp<const float>(F, WS_TOPW); const bf16* MIXp = wsp<const bf16>(F, WS_MIX);
#define P11_LOAD(mm) do { _Pragma("unroll") for (int k = 0; k < 4; ++k) ca[k] = *(const v4u*)(CN + (size_t)pn[k] * D + lane * 16); \
        _Pragma("unroll") for (int q = 0; q < 4; ++q) xv[q] = *(const f32x4*)(F.x + (size_t)(mm) * D + lane * 16 + 4 * q); \
        { const v4u* ms_ = (const v4u*)(MIXp + (size_t)(mm) * D + lane * 16); mx0 = ms_[0]; mx1 = ms_[1]; } } while (0)
    { const int4 p4 = *(const int4*)(POS + (size_t)RW(0) * 4); pn[0] = p4.x; pn[1] = p4.y; pn[2] = p4.z; pn[3] = p4.w; }
    P11_LOAD(RW(0)); wcur = *(const f32x4*)(TOPW + (size_t)RW(0) * 4);
    { const int m2 = RW(1); const int4 p4 = *(const int4*)(POS + (size_t)m2 * 4); pn[0] = p4.x; pn[1] = p4.y; pn[2] = p4.z; pn[3] = p4.w; wnxt = *(const f32x4*)(TOPW + (size_t)m2 * 4); }
#pragma nounroll
    for (int i = 0; i < cnt; ++i) {
        const int m = RW(i);
        const int b = m / SEQ;
        float acc[16];
#pragma unroll
        for (int q = 0; q < 16; ++q) acc[q] = 0.f;
#pragma unroll
        for (int k = 0; k < 4; ++k) { const float wk = wcur[k];
#pragma unroll
            for (int q = 0; q < 4; ++q) { const int wq = (int)ca[k][q];
                acc[4 * q] += wk * __builtin_amdgcn_cvt_f32_fp8(wq, 0); acc[4 * q + 1] += wk * __builtin_amdgcn_cvt_f32_fp8(wq, 1);
                acc[4 * q + 2] += wk * __builtin_amdgcn_cvt_f32_fp8(wq, 2); acc[4 * q + 3] += wk * __builtin_amdgcn_cvt_f32_fp8(wq, 3); } }
        f32x4 ov[4]; const float* gt = MOD + (size_t)b * 6144 + 5120 + lane * 16;
#pragma unroll
        for (int q = 0; q < 4; ++q) { const f32x4 g = *(const f32x4*)(gt + 4 * q); const f32x4 av = {acc[4 * q], acc[4 * q + 1], acc[4 * q + 2], acc[4 * q + 3]};
            const unsigned ma = q < 2 ? mx0[2 * q] : mx1[2 * q - 4], mb = q < 2 ? mx0[2 * q + 1] : mx1[2 * q - 3];
            ov[q] = xv[q] + (f32x4){bflo(ma), bfhi(ma), bflo(mb), bfhi(mb)} + g * av; }
        P11_LOAD(RW(i + 1));
        wcur = wnxt;
        { const int m2 = RW(i + 2); const int4 p4 = *(const int4*)(POS + (size_t)m2 * 4); pn[0] = p4.x; pn[1] = p4.y; pn[2] = p4.z; pn[3] = p4.w; wnxt = *(const f32x4*)(TOPW + (size_t)m2 * 4); }
        float* orow = F.out + (size_t)m * D + lane * 16;
#pragma unroll
        for (int q = 0; q < 4; ++q) *(f32x4*)(orow + 4 * q) = ov[q];
    }
#undef RW
#undef P11_LOAD
}

constexpr int NPHASE = 12;
struct Args { const float* in[25]; float* out; unsigned char* ws; int ph_lo, ph_hi; };
__global__ void __launch_bounds__(NWAVES * 64, 2) fwd_kernel(Args args) {
    extern __shared__ __attribute__((aligned(16))) unsigned char lds[];
    Frame F;
    F.lds = (LAS unsigned char*)lds;
    F.MISC = (volatile LAS unsigned*)(F.lds + MISC_OFF);
    F.tid = threadIdx.x; F.lane = F.tid & 63; F.wave = __builtin_amdgcn_readfirstlane(F.tid >> 6);
    F.G = gridDim.x; { const int bx = blockIdx.x; F.vcu = (F.G % 8 == 0) ? (bx % 8) * (F.G / 8) + bx / 8 : bx; }
    F.ws = args.ws; F.ctl = (gu32*)(args.ws + WS_CTL); F.out = args.out;
    F.x = args.in[0]; F.c = args.in[1]; F.rel_bias = args.in[2]; F.w_ada = args.in[3]; F.b_ada = args.in[4]; F.g_norm1 = args.in[5]; F.w_in = args.in[6];
    F.w_gk_up = args.in[7]; F.b_gk_up = args.in[8]; F.g_gla_out = args.in[9]; F.g_qnorm = args.in[10]; F.g_knorm = args.in[11];
    F.lq1 = args.in[12]; F.lk1 = args.in[13]; F.lq2 = args.in[14]; F.lk2 = args.in[15]; F.g_subln = args.in[16]; F.w_out = args.in[17];
    F.g_norm2 = args.in[18]; F.w_router = args.in[19]; F.b_router = args.in[20]; F.w_gate_up = args.in[21]; F.b_gate_up = args.in[22]; F.w_down = args.in[23]; F.b_down = args.in[24];
    for (int u = F.tid; u < (LDS_BYTES - LDSCTL_OFF) / 4; u += NWAVES * 64) ((LAS unsigned*)(F.lds + LDSCTL_OFF))[u] = 0u;
    __syncthreads();
    const int lo = args.ph_lo, hi = args.ph_hi;
    const bool multi = (hi - lo) > 1;
    XcdBarrier bar; bar.bar = (unsigned*)(F.ctl + CW_BAR); bar.x = 0; bar.st = nullptr;
    if (multi) bar = xcd_barrier_post((unsigned*)(F.ctl + CW_BAR), F.MISC + 8);
#ifndef PHMASK
#define PHMASK 0xFFF
#endif
#define IN(k) (((PHMASK >> (k)) & 1) && lo <= (k) && (k) < hi)
#define SEAM(k) do { if (IN((k) + 1)) xcd_barrier(bar); } while (0)
#ifndef REPEAT_PH
#define REPEAT_PH 0
#endif
#define REPS(k) (((REPEAT_PH >> (k)) & 1) ? 2 : 1)

    if (IN(0)) { for (int rep_ = 0; rep_ < REPS(0); ++rep_) { if (rep_) xcd_barrier(bar); p0_phase(F); } SEAM(0); }
    if (IN(1)) { for (int rep_ = 0; rep_ < REPS(1); ++rep_) { if (rep_) xcd_barrier(bar); p1_phase(F); } SEAM(1); }
    if (IN(2)) {
        pg8::Gemm g{wsp<const bf16>(F, WS_XN), wsp<const bf16>(F, WS_WIN), T, NIN, D, 0};
        pg8::StaticOrder S; S.init(T / 256, NIN / 256, F.G, (int)blockIdx.x, nullptr, REPS(2));
        EpiInProj E{wsp<bf16>(F, WS_QG), wsp<bf16>(F, WS_KG), wsp<bf16>(F, WS_VG), wsp<bf16>(F, WS_RG), wsp<bf16>(F, WS_QD), wsp<bf16>(F, WS_KD), wsp<bf16>(F, WS_VD), F.g_qnorm, F.g_knorm};
        pg8::gemm_phase<EpiInProj, pg8::StaticOrder>(F.lds, g, S, E);
        SEAM(2);
    }
    if (IN(3)) { for (int rep_ = 0; rep_ < REPS(3); ++rep_) { if (rep_) xcd_barrier(bar); for (int c = F.vcu; c < NCHUNK; c += F.G) gla_a_unit(F, c); } SEAM(3); }
    if (IN(4)) { for (int rep_ = 0; rep_ < REPS(4); ++rep_) { if (rep_) xcd_barrier(bar); gla_b_phase(F); } SEAM(4); }
    if (IN(5)) for (int rep_ = 0; rep_ < REPS(5); ++rep_) { if (rep_) xcd_barrier(bar);
#ifndef NO_GLAC
        for (int u = F.vcu; u < NCHUNK / 2; u += F.G) gla_c_unit(F, u);
#endif
        float lam;
        { float a1 = F.lq1[F.lane] * F.lk1[F.lane], a2 = F.lq2[F.lane] * F.lk2[F.lane]; a1 = wave_sum(a1); a2 = wave_sum(a2); lam = __expf(a1) - __expf(a2) + 0.2f; }
#ifndef NO_ATT
        for (int p = F.vcu; p < 256; p += F.G) { const int bh = p >> 4, s = p & 15;
#pragma nounroll
            for (int j = 0; j < 2; ++j) att::attn_unit(F, bh >> 2, bh & 3, j ? s : 31 - s, lam); }
#endif
        SEAM(5);
    }
    if (IN(6)) {
        pg8::Gemm g{wsp<const bf16>(F, WS_A2), wsp<const bf16>(F, WS_WOUT), T, D, D, 0};
        pg8::StaticOrder S; S.init(T / 256, D / 256, F.G, (int)blockIdx.x, nullptr, REPS(6));
        EpiOutProj E{wsp<bf16>(F, WS_MIX), wsp<const float>(F, WS_MOD)};
        pg8::gemm_phase<EpiOutProj, pg8::StaticOrder>(F.lds, g, S, E);
        SEAM(6);
    }
    if (IN(7)) { for (int rep_ = 0; rep_ < REPS(7); ++rep_) { if (rep_) xcd_barrier(bar); p7_phase(F, rep_ == 0); } SEAM(7); }
    if (IN(8)) { p8_phase(F); SEAM(8); }
    if (IN(9)) {
        int nMt; moe_tables(F, nMt);
        pg8::Gemm g{wsp<const bf16>(F, WS_XS), wsp<const bf16>(F, WS_WGU), PMAX, 2048, D / 2, (size_t)2048 * 512};
        pg8::StaticOrder S; S.init(nMt, 8, F.G, (int)blockIdx.x, F.lds + TILEE_OFF, REPS(9));
        EpiSwiGLU E{wsp<unsigned char>(F, WS_Y), F.b_gate_up};
        pg8::gemm_phase<EpiSwiGLU, pg8::StaticOrder, true>(F.lds, g, S, E);
        SEAM(9);
    }
    if (IN(10)) {
        int nMt; moe_tables(F, nMt);
        pg8::Gemm g{wsp<const bf16>(F, WS_Y), wsp<const bf16>(F, WS_WD), PMAX, 1024, FF / 2, (size_t)1024 * 512};
        pg8::StaticOrder S; S.init(nMt, 4, F.G, (int)blockIdx.x, F.lds + TILEE_OFF, REPS(10));
        EpiDown E{wsp<unsigned char>(F, WS_CN), F.b_down};
        pg8::gemm_phase<EpiDown, pg8::StaticOrder, true>(F.lds, g, S, E);
        SEAM(10);
    }
    if (IN(11)) { p11_phase(F); }
#undef IN
#undef SEAM
}

extern "C" void kernel_launch(void* const* d_in, const int* in_sizes, int n_in, void* d_out, int out_size, void* d_ws, size_t ws_size, hipStream_t stream) {
    static int grid = 0;
    if (grid == 0) {
        if (n_in != 25 || in_sizes[0] != T * D || out_size != T * D || ws_size < WS_END) { fprintf(stderr, "kernel_launch: unexpected shapes (n_in %d, in0 %d, out %d, ws %zu); nothing launched\n", n_in, n_in > 0 ? in_sizes[0] : -1, out_size, ws_size); grid = -1; return; }
        int dev = 0, cus = 0, per_cu = 0;
        if (hipGetDevice(&dev) != hipSuccess || hipDeviceGetAttribute(&cus, hipDeviceAttributeMultiprocessorCount, dev) != hipSuccess) { grid = -1; return; }
        if (hipFuncSetAttribute((const void*)fwd_kernel, hipFuncAttributeMaxDynamicSharedMemorySize, LDS_BYTES) != hipSuccess) { fprintf(stderr, "kernel_launch: hipFuncSetAttribute failed\n"); grid = -1; return; }
        if (hipOccupancyMaxActiveBlocksPerMultiprocessor(&per_cu, (const void*)fwd_kernel, NWAVES * 64, LDS_BYTES) != hipSuccess || per_cu < 1)
            fprintf(stderr, "kernel_launch: note: occupancy query reports %d workgroups per CU\n", per_cu);
        (void)hipGetLastError();
        grid = cus;
    }
    if (grid < 0) return;
    if (hipMemsetAsync((char*)d_ws + WS_CTL, 0, CTL_ZERO_BYTES, stream) != hipSuccess) { fprintf(stderr, "kernel_launch: memset failed\n"); return; }
    Args a{};
    for (int i = 0; i < 25; ++i) a.in[i] = (const float*)d_in[i];
    a.out = (float*)d_out; a.ws = (unsigned char*)d_ws;
#if MK_N_LAUNCHES == 1
    a.ph_lo = 0; a.ph_hi = NPHASE;
    hipLaunchKernelGGL(fwd_kernel, dim3(grid), dim3(NWAVES * 64), LDS_BYTES, stream, a);
#else
    for (int p = 0; p < NPHASE; ++p) { a.ph_lo = p; a.ph_hi = p + 1; hipLaunchKernelGGL(fwd_kernel, dim3(grid), dim3(NWAVES * 64), LDS_BYTES, stream, a); }
#endif
    const hipError_t le = hipPeekAtLastError();
    if (le != hipSuccess) fprintf(stderr, "kernel_launch: launch failed: %s\n", hipGetErrorName(le));
}
```

```cpp
#include <hip/hip_runtime.h>
#include <cstdio>
#include <cstdint>

#ifndef MK_N_LAUNCHES
#define MK_N_LAUNCHES 1
#endif

namespace pg8 {
#define PG8_LAS __attribute__((address_space(3)))
typedef unsigned short bf16_t;
typedef short bf16x8 __attribute__((ext_vector_type(8)));
typedef float f32x4 __attribute__((ext_vector_type(4)));
typedef unsigned u32x4 __attribute__((ext_vector_type(4)));
typedef int i32x4 __attribute__((ext_vector_type(4)));
typedef int i32x8 __attribute__((ext_vector_type(8)));
typedef float f32x16 __attribute__((ext_vector_type(16)));
constexpr int BM = 256, BK = 64, HALF = 128, HTB = HALF * BK * 2, STAGE_BYTES = 8 * HTB, NXCD = 8, WGM = 8;

__host__ __device__ __forceinline__ int lds_byte(int r, int c) { const int st = (r >> 4) * 2 + (c >> 5), rr = r & 15, cc = c & 31, ob = rr * 64 + cc * 2; return st * 1024 + (ob ^ (((ob >> 9) & 1) << 5)); }
__host__ __device__ __forceinline__ void stage_rc(int b, int& R, int& C) { const int st = b / 1024, sb = b % 1024, swz = sb ^ (((sb >> 9) & 1) << 5); R = (st >> 1) * 16 + swz / 64; C = (st & 1) * 32 + (swz % 64) / 2; }
__host__ __device__ __forceinline__ int perm32(int rho) { const int n = rho >> 4, i = rho & 15; return 8 * (i >> 2) + 4 * n + (i & 3); }

struct Unit { int pm, pn, e; };
struct Gemm { const bf16_t* A; const bf16_t* Bt; int M, N, K; size_t estride; };

struct StaticOrder {
    int nM, nN, nwg, G, c, rep; const PG8_LAS unsigned char* tile_e;
    __device__ void init(int nM_, int nN_, int G_, int c_, const PG8_LAS unsigned char* te, int rep_ = 1) { nM = nM_; nN = nN_; nwg = nM * nN; G = G_; c = c_; tile_e = te; rep = rep_; }
    __device__ bool next(int i, Unit& u) const {
        long L = (long)i * G + c; if (L >= (long)nwg * rep) return false; if (rep > 1) L %= nwg;
        int wgid = (int)L; { const int q = nwg / NXCD, r = nwg % NXCD, xcd = wgid % NXCD, off = wgid / NXCD; wgid = (xcd < r ? xcd * (q + 1) : r * (q + 1) + (xcd - r) * q) + off; }
        const int nig = WGM * nN, gid = wgid / nig, fm = gid * WGM, gsz = (nM - fm) < WGM ? (nM - fm) : WGM;
        u.pm = fm + ((wgid % nig) % gsz); u.pn = (wgid % nig) / gsz; u.e = tile_e ? __builtin_amdgcn_readfirstlane((int)tile_e[u.pm]) : 0; return true;
    }
};

__device__ __forceinline__ unsigned cvt_pk_bf16(float lo, float hi) { unsigned r; asm volatile("v_cvt_pk_bf16_f32 %0, %1, %2" : "=v"(r) : "v"(lo), "v"(hi)); return r; }

template <class Epi, class Sched, bool FP8 = false>
__device__ __forceinline__ void gemm_phase(PG8_LAS unsigned char* lds, const Gemm g, const Sched& S, const Epi& E) {
    const int tid = threadIdx.x, wid = __builtin_amdgcn_readfirstlane(tid >> 6), lane = tid & 63, wr = wid >> 2, wc = wid & 3, fr = lane & 15, fq = lane >> 4;
    const int K = g.K, nt = K / BK;
    unsigned voffA[2], voffB[2];
#pragma unroll
    for (int i = 0; i < 2; ++i) { int R, C; stage_rc(tid * 16 + i * 8192, R, C); const int Rb = Epi::PERM ? ((R & ~31) + perm32(R & 31)) : R;
        voffA[i] = (unsigned)(R * K + C) * 2u; voffB[i] = (unsigned)(Rb * K + C) * 2u; }
    const size_t kstep = (size_t)(BK * 2);
    const size_t hstep = (size_t)HALF * K * 2;
    const size_t tstep = 2 * hstep;
    const size_t estep = g.estride * 2;
    const unsigned ldsw = (unsigned)wid * 1024u;
    const int aoff = lds_byte(wr * 64 + fr, fq * 8), boff = lds_byte(wc * 32 + fr, fq * 8);
#define PG8_SA(b, h) (((b) * 2 + (h)) * HTB)
#define PG8_SB(b, h) ((4 + (b) * 2 + (h)) * HTB)
#define PG8_STAGE(bufoff, gbase, voff) do { _Pragma("unroll") for (int _i = 0; _i < 2; ++_i) \
        __builtin_amdgcn_global_load_lds((const unsigned*)((const char*)(gbase) + (voff)[_i]), (PG8_LAS unsigned*)(lds + (bufoff) + ldsw + _i * 8192), 16, 0, 0); } while (0)
#define PG8_LDA(dst, b, h) do { _Pragma("unroll") for (int m = 0; m < 4; ++m) dst[m] = PG8_CAT2(*(const PG8_LAS i32x4*)(lds + PG8_SA(b, h) + aoff + m * 2048), *(const PG8_LAS i32x4*)(lds + PG8_SA(b, h) + aoff + m * 2048 + 1024)); } while (0)
#define PG8_LDB(dst, b, h) do { _Pragma("unroll") for (int n = 0; n < 2; ++n) dst[n] = PG8_CAT2(*(const PG8_LAS i32x4*)(lds + PG8_SB(b, h) + boff + n * 2048), *(const PG8_LAS i32x4*)(lds + PG8_SB(b, h) + boff + n * 2048 + 1024)); } while (0)
#define PG8_CAT2(x, y) __builtin_shufflevector((x), (y), 0, 1, 2, 3, 4, 5, 6, 7)
#define PG8_LO(x) __builtin_bit_cast(bf16x8, __builtin_shufflevector((x), (x), 0, 1, 2, 3))
#define PG8_HI(x) __builtin_bit_cast(bf16x8, __builtin_shufflevector((x), (x), 4, 5, 6, 7))
#define PG8_X4(v, m) ((f32x4){(v)[4 * (m)], (v)[4 * (m) + 1], (v)[4 * (m) + 2], (v)[4 * (m) + 3]})
#define PG8_INS(v, r, m) do { (v)[4 * (m)] = (r)[0]; (v)[4 * (m) + 1] = (r)[1]; (v)[4 * (m) + 2] = (r)[2]; (v)[4 * (m) + 3] = (r)[3]; } while (0)
#define PG8_MMA(ai, bj, At, Bt) do { __builtin_amdgcn_s_setprio(1); _Pragma("unroll") for (int m = 0; m < 4; ++m) _Pragma("unroll") for (int n = 0; n < 2; ++n) { \
        if constexpr (FP8) { const f32x4 r_ = __builtin_amdgcn_mfma_scale_f32_16x16x128_f8f6f4(Bt[n], At[m], PG8_X4(acc16[ai][bj][n], m), 0, 0, 0, 0x7F7F7F7F, 0, 0x7F7F7F7F); PG8_INS(acc16[ai][bj][n], r_, m); } \
        else { acc[ai][bj][m][n] = __builtin_amdgcn_mfma_f32_16x16x32_bf16(PG8_LO(Bt[n]), PG8_LO(At[m]), acc[ai][bj][m][n], 0, 0, 0); \
               acc[ai][bj][m][n] = __builtin_amdgcn_mfma_f32_16x16x32_bf16(PG8_HI(Bt[n]), PG8_HI(At[m]), acc[ai][bj][m][n], 0, 0, 0); } } \
        __builtin_amdgcn_s_setprio(0); } while (0)
#define PG8_WAIT_V(n) asm volatile("s_waitcnt vmcnt(" #n ")" ::: "memory")
#define PG8_WAIT_L(n) asm volatile("s_waitcnt lgkmcnt(" #n ")" ::: "memory")
#define PG8_BAR __builtin_amdgcn_s_barrier()
#define PG8_SCHED __builtin_amdgcn_sched_barrier(0)
    Unit cur, nxt; int ui = 0;
    if (!S.next(0, cur)) return;
    f32x4 acc[2][2][4][2];
#pragma unroll
    for (int a = 0; a < 2; ++a)
#pragma unroll
        for (int b = 0; b < 2; ++b)
#pragma unroll
            for (int m = 0; m < 4; ++m)
#pragma unroll
                for (int n = 0; n < 2; ++n) acc[a][b][m][n] = (f32x4){0.f, 0.f, 0.f, 0.f};
    f32x16 acc16[2][2][2];
#pragma unroll
    for (int a = 0; a < 2; ++a)
#pragma unroll
        for (int b = 0; b < 2; ++b)
#pragma unroll
            for (int n = 0; n < 2; ++n) acc16[a][b][n] = (f32x16){};
    i32x8 At[4], B0[2], B1[2];
    const char* cA = (const char*)g.A + (size_t)cur.pm * tstep; const char* cB = (const char*)g.Bt + (size_t)cur.e * estep + (size_t)cur.pn * tstep;
    PG8_STAGE(PG8_SB(0, 0), cB, voffB); PG8_STAGE(PG8_SB(0, 1), cB + hstep, voffB); PG8_STAGE(PG8_SA(0, 0), cA, voffA); PG8_STAGE(PG8_SA(0, 1), cA + hstep, voffA);
    if (wr == 1) PG8_BAR;
    PG8_WAIT_V(2); PG8_BAR;
    PG8_STAGE(PG8_SB(1, 0), cB + kstep, voffB); PG8_STAGE(PG8_SA(1, 0), cA + kstep, voffA); PG8_STAGE(PG8_SB(1, 1), cB + hstep + kstep, voffB);
    PG8_WAIT_V(6); PG8_BAR;
    for (;;) {
        const bool has_next = S.next(ui + 1, nxt);
        const char* nA = has_next ? (const char*)g.A + (size_t)nxt.pm * tstep : cA; const char* nB = has_next ? (const char*)g.Bt + (size_t)nxt.e * estep + (size_t)nxt.pn * tstep : cB;
#pragma nounroll
        for (int t = 0; t < nt; t += 2) {
            const bool last = (t == nt - 2);
            const char* a1 = cA + (size_t)(t + 1) * kstep;
            const char* a2 = last ? nA : cA + (size_t)(t + 2) * kstep; const char* b2 = last ? nB : cB + (size_t)(t + 2) * kstep;
            const char* a3 = a2 + kstep; const char* b3 = b2 + kstep;
            PG8_LDB(B0, 0, 0); PG8_LDB(B1, 0, 1); PG8_SCHED; PG8_LDA(At, 0, 0); PG8_STAGE(PG8_SA(1, 1), a1 + hstep, voffA);
            PG8_WAIT_V(8); PG8_WAIT_L(0); PG8_BAR; PG8_MMA(0, 0, At, B0); PG8_MMA(0, 1, At, B1); PG8_BAR; PG8_SCHED;
            PG8_LDA(At, 0, 1); PG8_STAGE(PG8_SB(0, 0), b2, voffB); PG8_STAGE(PG8_SB(0, 1), b2 + hstep, voffB); PG8_STAGE(PG8_SA(0, 0), a2, voffA);
            PG8_WAIT_V(8); PG8_WAIT_L(0); PG8_BAR; PG8_MMA(1, 0, At, B0); PG8_MMA(1, 1, At, B1); PG8_BAR; PG8_SCHED;
            PG8_LDB(B0, 1, 0); PG8_LDB(B1, 1, 1); PG8_SCHED; PG8_LDA(At, 1, 0); PG8_STAGE(PG8_SA(0, 1), a2 + hstep, voffA);
            PG8_WAIT_V(8); PG8_WAIT_L(0); PG8_BAR; PG8_MMA(0, 0, At, B0); PG8_MMA(0, 1, At, B1); PG8_BAR; PG8_SCHED;
            PG8_LDA(At, 1, 1); PG8_STAGE(PG8_SB(1, 0), b3, voffB); PG8_STAGE(PG8_SB(1, 1), b3 + hstep, voffB); PG8_STAGE(PG8_SA(1, 0), a3, voffA);
            PG8_WAIT_V(8); PG8_WAIT_L(0); PG8_BAR; PG8_MMA(1, 0, At, B0); PG8_MMA(1, 1, At, B1); PG8_BAR; PG8_SCHED;
        }
        if (wr == 0) PG8_BAR;
        if constexpr (FP8) {
#pragma unroll
            for (int a = 0; a < 2; ++a)
#pragma unroll
                for (int b = 0; b < 2; ++b)
#pragma unroll
                    for (int m = 0; m < 4; ++m)
#pragma unroll
                        for (int n = 0; n < 2; ++n) acc[a][b][m][n] = PG8_X4(acc16[a][b][n], m);
        }
        { int t2 = threadIdx.x; asm volatile("" : "+v"(t2)); E(acc, cur, wr, wc, t2 & 15, (t2 >> 4) & 3); }
        if (!has_next) break;
#pragma unroll
        for (int a = 0; a < 2; ++a)
#pragma unroll
            for (int b = 0; b < 2; ++b)
#pragma unroll
                for (int m = 0; m < 4; ++m)
#pragma unroll
                    for (int n = 0; n < 2; ++n) acc[a][b][m][n] = (f32x4){0.f, 0.f, 0.f, 0.f};
        if constexpr (FP8) {
#pragma unroll
            for (int a = 0; a < 2; ++a)
#pragma unroll
                for (int b = 0; b < 2; ++b)
#pragma unroll
                    for (int n = 0; n < 2; ++n) acc16[a][b][n] = (f32x16){};
        }
        cur = nxt; cA = nA; cB = nB; ++ui;
        if (wr == 1) PG8_BAR;
    }
    PG8_WAIT_V(0);
    PG8_BAR;
#undef PG8_SA
#undef PG8_SB
#undef PG8_STAGE
#undef PG8_LDA
#undef PG8_LDB
#undef PG8_MMA
#undef PG8_X4
#undef PG8_INS
#undef PG8_CAT2
#undef PG8_LO
#undef PG8_HI
#undef PG8_WAIT_V
#undef PG8_WAIT_L
#undef PG8_BAR
#undef PG8_SCHED
}
}

constexpr int NWAVES = 8;
constexpr int BATCH = 4, SEQ = 8192, D = 1024, T = BATCH * SEQ;
constexpr int INW = 3088, NIN = 3072;
constexpr int NE = 32, TOPK = 4, FF = 1024;
constexpr int PMAX = (T * TOPK / 256 + NE) * 256;
constexpr int NCHUNK = BATCH * 4 * (SEQ / 64);
constexpr float EPS = 1e-6f;
constexpr float LOG2E = 1.4426950408889634f;
constexpr float C2 = 0.125f * LOG2E;
constexpr float WSCALE = 32.f, WSCALE_INV = 1.f / 32.f;

constexpr size_t MiB = 1u << 20;
constexpr size_t WS_CTL = 0, CTL_ZERO_BYTES = 1 * MiB;
constexpr size_t WS_MODP = 1 * MiB;
constexpr size_t WS_MOD = 2 * MiB;
constexpr size_t WS_TOPE = 3 * MiB;
constexpr size_t WS_TOPW = 3 * MiB + 512 * 1024;
constexpr size_t WS_POS = 4 * MiB;
constexpr size_t WS_ROWW = 4 * MiB + 512 * 1024;
constexpr size_t WS_DEC = 6 * MiB;
constexpr size_t WS_WGU = 8 * MiB;
constexpr size_t WS_WD = 136 * MiB;
constexpr size_t WS_XN = 200 * MiB;
constexpr size_t WS_WIN = 264 * MiB;
constexpr size_t WS_WOUT = 270 * MiB;
constexpr size_t WS_GK = 272 * MiB;
constexpr size_t WS_QG = 304 * MiB;
constexpr size_t WS_KG = 320 * MiB;
constexpr size_t WS_VG = 336 * MiB;
constexpr size_t WS_RG = 368 * MiB;
constexpr size_t WS_QD = 400 * MiB;
constexpr size_t WS_KD = 432 * MiB;
constexpr size_t WS_VD = 464 * MiB;
constexpr size_t WS_UT = 496 * MiB;
constexpr size_t WS_SP = 560 * MiB;
constexpr size_t WS_OI = 592 * MiB;
constexpr size_t WS_QE = 656 * MiB;
constexpr size_t WS_A2 = 672 * MiB;
constexpr size_t WS_STASH = 736 * MiB;
constexpr size_t WS_XS = 264 * MiB;
constexpr size_t WS_Y = 400 * MiB;
constexpr size_t WS_CN = 536 * MiB;
constexpr size_t WS_MIX = 808 * MiB;
constexpr size_t WS_END = 872 * MiB;
static_assert(WS_XS + (size_t)PMAX * 1024 <= WS_Y && WS_Y + (size_t)PMAX * 1024 <= WS_CN && WS_CN + (size_t)PMAX * 1024 * 2 <= WS_MIX, "ws map");
constexpr int CW_BAR = 4096;
constexpr int CW_CNT = 16384;
constexpr int CW_FILL = 16384 + 64;

constexpr int RING_BYTES = 131072;
constexpr int LDSCTL_OFF = RING_BYTES, MISC_OFF = LDSCTL_OFF + 320;
constexpr int TILEE_OFF = MISC_OFF + 128;
constexpr int HIST_OFF = TILEE_OFF + 1024;
constexpr int LDS_BYTES = 147456;
static_assert(HIST_OFF + 512 <= LDS_BYTES, "LDS map");

#define GAS __attribute__((address_space(1)))
#define LAS __attribute__((address_space(3)))
typedef unsigned short bf16;
typedef unsigned v4u __attribute__((ext_vector_type(4)));
typedef unsigned v2u __attribute__((ext_vector_type(2)));
typedef float f32x4 __attribute__((ext_vector_type(4)));
typedef float f32x16 __attribute__((ext_vector_type(16)));
typedef short bf16x8 __attribute__((ext_vector_type(8)));
typedef short s16x4 __attribute__((ext_vector_type(4)));
typedef GAS unsigned gu32;
#define RLX_AGENT __ATOMIC_RELAXED, __HIP_MEMORY_SCOPE_AGENT
#define LDS_WAIT() asm volatile("s_waitcnt lgkmcnt(0)" ::: "memory")
#define VM_WAIT() asm volatile("s_waitcnt vmcnt(0)" ::: "memory")
__device__ __forceinline__ unsigned f2bf(float f) { unsigned u = __builtin_bit_cast(unsigned, f); return (u + 0x7fffu + ((u >> 16) & 1u)) >> 16; }
__device__ __forceinline__ unsigned pk2(float lo, float hi) { return f2bf(lo) | (f2bf(hi) << 16); }
__device__ __forceinline__ float bf2f(unsigned short h) { return __builtin_bit_cast(float, (unsigned)h << 16); }
__device__ __forceinline__ float bflo(unsigned u) { return __builtin_bit_cast(float, u << 16); }
__device__ __forceinline__ float bfhi(unsigned u) { return __builtin_bit_cast(float, u & 0xffff0000u); }
__device__ __forceinline__ float wave_sum(float v) {
#pragma unroll
    for (int o = 1; o < 64; o <<= 1) v += __shfl_xor(v, o);
    return v;
}
__device__ __forceinline__ float sigmoidf_(float x) { return 1.f / (1.f + __expf(-x)); }
typedef float f32x2 __attribute__((ext_vector_type(2)));
__device__ __forceinline__ unsigned wave_umax(unsigned v) {
    v = max(v, (unsigned)__builtin_amdgcn_update_dpp(0, (int)v, 0x111, 0xf, 0xf, true));
    v = max(v, (unsigned)__builtin_amdgcn_update_dpp(0, (int)v, 0x112, 0xf, 0xf, true));
    v = max(v, (unsigned)__builtin_amdgcn_update_dpp(0, (int)v, 0x114, 0xf, 0xf, true));
    v = max(v, (unsigned)__builtin_amdgcn_update_dpp(0, (int)v, 0x118, 0xf, 0xf, true));
    v = max(v, (unsigned)__builtin_amdgcn_update_dpp(0, (int)v, 0x142, 0xa, 0xf, false));
    v = max(v, (unsigned)__builtin_amdgcn_update_dpp(0, (int)v, 0x143, 0xc, 0xf, false));
    return (unsigned)__builtin_amdgcn_readlane((int)v, 63);
}
template <int CNT, int S, int N> __device__ __forceinline__ void xreduce_step(float (&v)[N], int lane) {
    if constexpr (CNT > 1) { constexpr int half = CNT / 2; const bool up = (lane & S) != 0;
#pragma unroll
        for (int i = 0; i < half; ++i) { const float send = up ? v[i] : v[i + half], keep = up ? v[i + half] : v[i]; v[i] = keep + __shfl_xor(send, S); }
        xreduce_step<half, S / 2, N>(v, lane); }
}
template <int S> __device__ __forceinline__ float xreduce_tail(float r) { if constexpr (S >= 1) { r += __shfl_xor(r, S); return xreduce_tail<S / 2>(r); } else return r; }
template <int N> __device__ __forceinline__ float xreduce(float (&v)[N], int lane) {
    xreduce_step<N, 32, N>(v, lane);
    return xreduce_tail<(N == 32 ? 1 : N == 16 ? 2 : N == 8 ? 4 : 8)>(v[0]);
}
__device__ __forceinline__ float lane_bcast(float v, int l) { return __builtin_bit_cast(float, __builtin_amdgcn_readlane(__builtin_bit_cast(int, v), l)); }

#define XB_TMO      128
#define XB_XCNT(j)  (256  + 64 * (j))
#define XB_XSUB(j)  (1280 + 64 * (j))
#define XB_XGEN(j)  (2304 + 64 * (j))
#define XB_TOP      3328
#define XB_TOPGEN   3392
#define XCD_BAR_WORDS 3456
#define XB_SPIN_CAP (1u << 18)
__device__ __forceinline__ unsigned xb_ld(unsigned* p)              { return __hip_atomic_load(p, __ATOMIC_RELAXED, __HIP_MEMORY_SCOPE_AGENT); }
__device__ __forceinline__ unsigned xb_add(unsigned* p, unsigned v) { return __hip_atomic_fetch_add(p, v, __ATOMIC_RELAXED, __HIP_MEMORY_SCOPE_AGENT); }
__device__ __forceinline__ unsigned xb_xcc_id() { return (unsigned)__builtin_amdgcn_s_getreg((3 << 11) | 20) & 0xFu; }
#define XB_SPIN(cond, bar) do { unsigned _sp = 0; while (cond) { __builtin_amdgcn_s_sleep(1); \
    if ((++_sp & 255u) == 0u) { if (xb_ld(&(bar)[XB_TMO])) break; if (_sp > XB_SPIN_CAP) { atomicAdd(&(bar)[XB_TMO], 1u); break; } } } } while (0)
struct XcdBarrier { unsigned* bar; unsigned x; volatile LAS unsigned* st; };
__device__ __forceinline__ XcdBarrier xcd_barrier_post(unsigned* bar, volatile LAS unsigned* st) {
    XcdBarrier b; b.bar = bar; b.x = xb_xcc_id(); b.st = st;
    if (threadIdx.x == 0) (void)xb_add(&bar[XB_XCNT(b.x)], 1u);
    return b;
}
__device__ __forceinline__ void xcd_barrier_complete(unsigned* bar, unsigned x, unsigned& nloc, unsigned& nx) {
    const unsigned G = gridDim.x * gridDim.y * gridDim.z;
    unsigned sum, cnt, mine, sp = 0u;
    for (;;) {
        sum = 0u; cnt = 0u; mine = 0u;
#pragma unroll
        for (unsigned j = 0; j < 16; ++j) { const unsigned c = xb_ld(&bar[XB_XCNT(j)]); sum += c; cnt += (c > 0u) ? 1u : 0u; mine = (j == x) ? c : mine; }
        if (sum == G) break;
        __builtin_amdgcn_s_sleep(1);
        if ((++sp & 255u) == 0u) { if (xb_ld(&bar[XB_TMO])) break; if (sp > XB_SPIN_CAP) { atomicAdd(&bar[XB_TMO], 1u); break; } }
    }
    nloc = mine > 0u ? mine : 1u; nx = cnt > 0u ? cnt : 1u;
}
__device__ __forceinline__ void xcd_barrier(const XcdBarrier& b) {
    asm volatile("s_waitcnt vmcnt(0)" ::: "memory");
    __syncthreads();
    if (threadIdx.x == 0) {
        unsigned* bar = b.bar;
        __builtin_amdgcn_s_waitcnt(0);
        unsigned nloc = b.st[0], nx = b.st[1];
        if (nloc == 0u) { xcd_barrier_complete(bar, b.x, nloc, nx); b.st[0] = nloc; b.st[1] = nx; }
        const unsigned old = xb_add(&bar[XB_XSUB(b.x)], 1u);
        const unsigned gen = old / nloc;
        if (old + 1u == (gen + 1u) * nloc) {
            __builtin_amdgcn_fence(__ATOMIC_RELEASE, "agent");
            asm volatile("s_waitcnt vmcnt(0)" ::: "memory");
            const unsigned og = xb_add(&bar[XB_TOP], 1u);
            const unsigned tg = og / nx;
            if (og + 1u == (tg + 1u) * nx) xb_add(&bar[XB_TOPGEN], 1u);
            else XB_SPIN(xb_ld(&bar[XB_TOPGEN]) == tg, bar);
            __builtin_amdgcn_fence(__ATOMIC_ACQUIRE, "agent");
            xb_add(&bar[XB_XGEN(b.x)], 1u);
            asm volatile("s_waitcnt vmcnt(0)" ::: "memory");
        } else {
            XB_SPIN(xb_ld(&bar[XB_XGEN(b.x)]) == gen, bar);
            __builtin_amdgcn_fence(__ATOMIC_ACQUIRE, "agent");
            asm volatile("s_waitcnt vmcnt(0)" ::: "memory");
        }
    }
    __syncthreads();
}

struct Frame {
    LAS unsigned char* lds;
    volatile LAS unsigned* MISC;
    gu32* ctl;
    int tid, lane, wave;
    int vcu, G;
    unsigned char* ws;
    const float *x, *c, *rel_bias, *w_ada, *b_ada, *g_norm1, *w_in, *w_gk_up, *b_gk_up, *g_gla_out, *g_qnorm, *g_knorm, *lq1, *lk1, *lq2, *lk2, *g_subln, *w_out,
                *g_norm2, *w_router, *b_router, *w_gate_up, *b_gate_up, *w_down, *b_down;
    float* out;
};
template <class Tp> __device__ __forceinline__ Tp* wsp(const Frame& F, size_t off) { return (Tp*)(F.ws + off); }

__device__ __forceinline__ void tr_item(const float* W, int ldw, int k0, int src0, bf16* WT, int K, int drow0, LAS float* scr, int lane) {
#pragma unroll 8
    for (int i = 0; i < 32; ++i) { const int kk = 2 * i + (lane >> 5); scr[kk * 33 + (lane & 31)] = W[(size_t)(k0 + kk) * ldw + src0 + (lane & 31)]; }
    LDS_WAIT(); asm volatile("" ::: "memory");
    const int c = lane & 7;
#pragma unroll
    for (int j = 0; j < 4; ++j) { const int n = (lane >> 3) + 8 * j; const LAS float* s = scr + (8 * c) * 33 + n;
        v4u o; o.x = pk2(s[0 * 33], s[1 * 33]); o.y = pk2(s[2 * 33], s[3 * 33]); o.z = pk2(s[4 * 33], s[5 * 33]); o.w = pk2(s[6 * 33], s[7 * 33]);
        *(GAS v4u*)(WT + (size_t)(drow0 + n) * K + k0 + 8 * c) = o; }
    LDS_WAIT(); asm volatile("" ::: "memory");
}
__device__ __forceinline__ unsigned pk4_fp8(float a, float b, float c, float d) { int p = __builtin_amdgcn_cvt_pk_fp8_f32(a, b, 0, false); p = __builtin_amdgcn_cvt_pk_fp8_f32(c, d, p, true); return (unsigned)p; }
__device__ __forceinline__ void tr_item_fp8(const float* W, int ldw, int k0, int src0, unsigned char* WT, int K, int drow0, float sc, LAS float* scr, int lane) {
    { float tmp[32]; const float* wp = W + (size_t)(k0 + (lane >> 5)) * ldw + src0 + (lane & 31);
#pragma unroll
      for (int i = 0; i < 32; ++i) tmp[i] = __builtin_nontemporal_load(wp + (size_t)(2 * i) * ldw);
#pragma unroll
      for (int i = 0; i < 32; ++i) scr[(2 * i + (lane >> 5)) * 33 + (lane & 31)] = tmp[i] * sc; }
    LDS_WAIT(); asm volatile("" ::: "memory");
    const int c = lane & 3;
#pragma unroll
    for (int j = 0; j < 2; ++j) { const int n = (lane >> 2) + 16 * j; const LAS float* s = scr + (16 * c) * 33 + n;
        v4u o;
#pragma unroll
        for (int q = 0; q < 4; ++q) o[q] = pk4_fp8(s[(4 * q) * 33], s[(4 * q + 1) * 33], s[(4 * q + 2) * 33], s[(4 * q + 3) * 33]);
        *(GAS v4u*)(WT + (size_t)(drow0 + n) * K + k0 + 16 * c) = o; }
    LDS_WAIT(); asm volatile("" ::: "memory");
}
__device__ __forceinline__ int win_src0(int ng) {
    const int pn = ng >> 3, gi = ng & 7, bj = gi >> 2, wc = gi & 3;
    if (pn < 6) return pn * 256 + gi * 32;
    if (pn < 10) { const int base = (pn < 8) ? 1552 : 2064; const int gq = 4 * ((pn - 6) & 1) + wc; return base + 64 * gq + 32 * bj; }
    return 2576 + (pn - 10) * 256 + gi * 32;
}
__device__ __forceinline__ void p0_phase(Frame& F) {
    LAS float* scr = (LAS float*)(F.lds + F.wave * 16384);
    const int gw = F.vcu * NWAVES + F.wave, NGW = F.G * NWAVES, lane = F.lane;
    for (int it = gw; it < 768; it += NGW) {
        const int cg = it % 96, ks = it / 96, j = cg * 64 + lane;
#pragma unroll
        for (int q = 0; q < 8; ++q) { const int idx = q * 64 + lane, b = idx >> 7, kk = idx & 127; const float cv = F.c[b * 1024 + ks * 128 + kk]; scr[idx] = cv * sigmoidf_(cv); }
        LDS_WAIT(); asm volatile("" ::: "memory");
        float a0 = 0.f, a1 = 0.f, a2 = 0.f, a3 = 0.f;
        const float* wp = F.w_ada + (size_t)(ks * 128) * 6144 + j;
#pragma unroll 32
        for (int kk = 0; kk < 128; ++kk) { const float w = wp[(size_t)kk * 6144]; a0 += scr[kk] * w; a1 += scr[128 + kk] * w; a2 += scr[256 + kk] * w; a3 += scr[384 + kk] * w; }
        float* mp = wsp<float>(F, WS_MODP) + (size_t)(ks * 4) * 6144 + j;
        mp[0] = a0; mp[6144] = a1; mp[2 * 6144] = a2; mp[3 * 6144] = a3;
        LDS_WAIT(); asm volatile("" ::: "memory");
    }
    constexpr int I_IN = 96 * 16, I_OUT = 32 * 16, I_GU = 32 * 64 * 16, I_D = 32 * 32 * 16;
    constexpr int NITEMS = I_IN + I_OUT + I_GU + I_D;
    for (int it = gw; it < NITEMS; it += NGW) {
        int r = it;
        if (r < I_IN) { const int kb = r / 96, ng = r % 96; tr_item(F.w_in, INW, kb * 64, win_src0(ng), wsp<bf16>(F, WS_WIN), 1024, ng * 32, scr, lane); continue; } r -= I_IN;
        if (r < I_OUT) { const int kb = r / 32, ng = r % 32; tr_item(F.w_out, 1024, kb * 64, ng * 32, wsp<bf16>(F, WS_WOUT), 1024, ng * 32, scr, lane); continue; } r -= I_OUT;
        if (r < I_GU) { const int e = r / 1024, q = r % 1024, kb = q / 64, dg = q % 64, pn = dg >> 3, gi = dg & 7, bj = gi >> 2, j32 = gi & 3;
            tr_item_fp8(F.w_gate_up + (size_t)e * 1024 * 2048, 2048, kb * 64, bj * 1024 + pn * 128 + j32 * 32, wsp<unsigned char>(F, WS_WGU) + (size_t)e * 2048 * 1024, 1024, dg * 32, WSCALE, scr, lane); continue; } r -= I_GU;
        { const int e = r / 512, q = r % 512, kb = q / 32, ng = q % 32;
            tr_item_fp8(F.w_down + (size_t)e * 1024 * 1024, 1024, kb * 64, ng * 32, wsp<unsigned char>(F, WS_WD) + (size_t)e * 1024 * 1024, 1024, ng * 32, WSCALE, scr, lane); }
    }
}

#ifndef SPREAD_ROWS
#define SPREAD_ROWS 0
#endif
__device__ __forceinline__ int srow(int gw, int i, int NGW) { return (SPREAD_ROWS && NGW * 16 == T) ? ((gw >> 9) * SEQ + i * 512 + (gw & 511)) : (gw * ((T + NGW - 1) / NGW) + i); }
__device__ __forceinline__ f32x4 mod_from_partials(const Frame& F, int b, int col) {
    const float* mp = wsp<const float>(F, WS_MODP) + (size_t)b * 6144 + col;
    f32x4 s = *(const f32x4*)(F.b_ada + col);
#pragma unroll
    for (int ks = 0; ks < 8; ++ks) s += *(const f32x4*)(mp + (size_t)ks * 4 * 6144);
    return s;
}
typedef float cf4p __attribute__((ext_vector_type(4)));
__device__ __forceinline__ void p1_phase(Frame& F) {
    const int tid = F.tid, lane = F.lane;
    constexpr int WLP = 1032;
    LAS bf16* wloT = (LAS bf16*)(F.lds);
    LAS bf16* wupT = (LAS bf16*)(F.lds + 36864);
    LAS float* bup = (LAS float*)(F.lds + 36864 + 16384);
    LAS float* tsc = (LAS float*)(F.lds + 36864 + 16384 + 1024) + F.wave * 288;
    { f32x4 t[8]; const int k0 = tid >> 2, r4 = (tid & 3) * 4;
#pragma unroll
      for (int it = 0; it < 8; ++it) t[it] = *(const f32x4*)(F.w_in + (size_t)(k0 + 128 * it) * INW + 1536 + r4);
#pragma unroll
      for (int it = 0; it < 8; ++it)
#pragma unroll
          for (int q = 0; q < 4; ++q) wloT[(r4 + q) * WLP + k0 + 128 * it] = (bf16)f2bf(t[it][q]); }
    { float t[8]; const int c = tid & 255, rh = tid >> 8;
#pragma unroll
      for (int j = 0; j < 8; ++j) t[j] = F.w_gk_up[(8 * rh + j) * 256 + c];
      v4u o; o.x = pk2(t[0], t[1]); o.y = pk2(t[2], t[3]); o.z = pk2(t[4], t[5]); o.w = pk2(t[6], t[7]);
      *(LAS v4u*)(wupT + c * 32 + 8 * rh) = o; *(LAS v4u*)(wupT + c * 32 + 16 + 8 * rh) = (v4u){0u, 0u, 0u, 0u}; }
    if (tid < 256) bup[tid] = F.b_gk_up[tid];
    { const int gt = F.vcu * 512 + tid; if (gt < 4 * 6144 / 4) { const int i = gt * 4, b = i / 6144, col = i % 6144; *(f32x4*)(wsp<float>(F, WS_MOD) + i) = mod_from_partials(F, b, col); } }
    __syncthreads();
    const int gw = F.vcu * NWAVES + F.wave, NGW = F.G * NWAVES;
    int curb = -1; f32x4 gsc[4], shv[4];
    for (int grp = gw; grp < T / 16; grp += NGW) {
#define ROWI(i) srow(grp, (i), T / 16)
        const int m0 = ROWI(0);
        f32x4 nx[4];
        { const GAS f32x4* xr = (const GAS f32x4*)(F.x + (size_t)m0 * D) + lane;
#pragma unroll
          for (int j = 0; j < 4; ++j) nx[j] = xr[64 * j]; }
        { const int b = m0 / SEQ;
          if (b != curb) { curb = b;
#pragma unroll
              for (int j = 0; j < 4; ++j) { const int col = 256 * j + 4 * lane; const f32x4 g = *(const f32x4*)(F.g_norm1 + col);
                  shv[j] = mod_from_partials(F, b, col); gsc[j] = g * (mod_from_partials(F, b, 1024 + col) + 1.0f); } } }
#pragma nounroll
        for (int i = 0; i < 16; ++i) {
            const int m = ROWI(i);
            f32x4 v[4]; float s = 0.f;
#pragma unroll
            for (int j = 0; j < 4; ++j) { v[j] = nx[j]; s += (v[j].x * v[j].x + v[j].y * v[j].y) + (v[j].z * v[j].z + v[j].w * v[j].w); }
            { const GAS f32x4* xr = (const GAS f32x4*)(F.x + (size_t)ROWI(i + 1 < 16 ? i + 1 : i) * D) + lane;
#pragma unroll
              for (int j = 0; j < 4; ++j) nx[j] = xr[64 * j]; }
            const float rstd = rsqrtf(wave_sum(s) * (1.f / D) + EPS);
            GAS v2u* o8 = (GAS v2u*)(wsp<bf16>(F, WS_XN) + (size_t)m * D) + lane;
#pragma unroll
            for (int j = 0; j < 4; ++j) { v[j] = v[j] * rstd * gsc[j] + shv[j]; v2u o; o.x = pk2(v[j].x, v[j].y); o.y = pk2(v[j].z, v[j].w); o8[64 * j] = o; }
        }
        __builtin_amdgcn_fence(__ATOMIC_RELEASE, "workgroup"); asm volatile("s_waitcnt vmcnt(0)" ::: "memory"); __builtin_amdgcn_fence(__ATOMIC_ACQUIRE, "workgroup");
        int lb = lane; asm volatile("" : "+v"(lb));
        const int l15 = lb & 15, q4 = lb >> 4;
        cf4p acc = {0.f, 0.f, 0.f, 0.f};
        { const bf16* arow = wsp<const bf16>(F, WS_XN) + (size_t)ROWI(l15) * D + 8 * q4; const LAS bf16* brow = wloT + l15 * WLP + 8 * q4;
#pragma unroll 4
          for (int sI = 0; sI < 32; ++sI) { const bf16x8 fa = *(const bf16x8*)(arow + 32 * sI); const bf16x8 fb = *(const LAS bf16x8*)(brow + 32 * sI);
              acc = __builtin_amdgcn_mfma_f32_16x16x32_bf16(fa, fb, acc, 0, 0, 0); } }
#pragma unroll
        for (int r = 0; r < 4; ++r) tsc[(4 * q4 + r) * 17 + l15] = acc[r];
        LDS_WAIT(); asm volatile("" ::: "memory");
        bf16x8 fa2;
        { float t8[8];
#pragma unroll
          for (int j = 0; j < 8; ++j) t8[j] = (q4 < 2) ? tsc[l15 * 17 + 8 * (q4 & 1) + j] : 0.f;
          v4u pk; pk.x = pk2(t8[0], t8[1]); pk.y = pk2(t8[2], t8[3]); pk.z = pk2(t8[4], t8[5]); pk.w = pk2(t8[6], t8[7]); fa2 = __builtin_bit_cast(bf16x8, pk); }
        float* GK = wsp<float>(F, WS_GK);
#pragma unroll 4
        for (int t = 0; t < 16; ++t) { const bf16x8 fb2 = *(const LAS bf16x8*)(wupT + (16 * t + l15) * 32 + 8 * q4);
            cf4p z = {0.f, 0.f, 0.f, 0.f}; z = __builtin_amdgcn_mfma_f32_16x16x32_bf16(fa2, fb2, z, 0, 0, 0);
            const float bb = bup[16 * t + l15];
#pragma unroll
            for (int r = 0; r < 4; ++r) { const float zz = z[r] + bb; GK[(size_t)ROWI(4 * q4 + r) * 256 + 16 * t + l15] = (fminf(zz, 0.f) - __logf(1.f + __expf(-fabsf(zz)))) * (1.f / 16.f); } }
        LDS_WAIT(); asm volatile("" ::: "memory");
#undef ROWI
    }
}

using pg8::Unit;
typedef pg8::f32x4 af4;
struct EpiInProj {
    static constexpr bool PERM = true;
    bf16 *QG, *KG, *VG, *RG, *QD, *KD, *VD; const float *gq, *gk;
    __device__ __forceinline__ void operator()(const af4 (&acc)[2][2][4][2], const Unit& u, int wr, int wc, int fr, int fq) const {
        const int pn = u.pn; const int row0 = u.pm * 256 + wr * 64 + fr;
        if (pn >= 6 && pn < 10) {
            const bool isq = pn < 8; bf16* base = isq ? QD : KD; const float* g = isq ? gq : gk; const float sc = isq ? C2 : 1.f;
            const int grp = 4 * ((pn - 6) & 1) + wc;
            af4 gv[2][2];
#pragma unroll
            for (int bj = 0; bj < 2; ++bj)
#pragma unroll
                for (int n = 0; n < 2; ++n) gv[bj][n] = *(const af4*)(g + 32 * bj + 8 * fq + 4 * n) * sc;
#pragma unroll
            for (int ai = 0; ai < 2; ++ai)
#pragma unroll
                for (int m = 0; m < 4; ++m) {
                    float ss = 0.f;
#pragma unroll
                    for (int bj = 0; bj < 2; ++bj)
#pragma unroll
                        for (int n = 0; n < 2; ++n) { const af4 v = acc[ai][bj][m][n]; ss += (v[0] * v[0] + v[1] * v[1]) + (v[2] * v[2] + v[3] * v[3]); }
                    ss += __shfl_xor(ss, 16); ss += __shfl_xor(ss, 32);
                    const float rs = rsqrtf(ss * (1.f / 64.f) + EPS);
                    bf16* rowp = base + (size_t)(row0 + ai * 128 + m * 16) * 512 + grp * 64 + 8 * fq;
#pragma unroll
                    for (int bj = 0; bj < 2; ++bj) { const af4 v0 = acc[ai][bj][m][0] * rs * gv[bj][0], v1 = acc[ai][bj][m][1] * rs * gv[bj][1];
                        pg8::u32x4 w; w.x = pg8::cvt_pk_bf16(v0[0], v0[1]); w.y = pg8::cvt_pk_bf16(v0[2], v0[3]); w.z = pg8::cvt_pk_bf16(v1[0], v1[1]); w.w = pg8::cvt_pk_bf16(v1[2], v1[3]);
                        *(pg8::u32x4*)(rowp + 32 * bj) = w; }
                }
        } else {
            bf16* base; int pitch, colt; int act = 0;
            if (pn == 0) { base = QG; pitch = 256; colt = 0; act = 1; }
            else if (pn == 1) { base = KG; pitch = 256; colt = 0; }
            else if (pn < 4) { base = VG; pitch = 512; colt = (pn - 2) * 256; }
            else if (pn < 6) { base = RG; pitch = 512; colt = (pn - 4) * 256; act = 2; }
            else { base = VD; pitch = 512; colt = (pn - 10) * 256; }
            const int col0 = colt + wc * 32 + 8 * fq;
#pragma unroll
            for (int ai = 0; ai < 2; ++ai)
#pragma unroll
                for (int m = 0; m < 4; ++m) { bf16* rowp = base + (size_t)(row0 + ai * 128 + m * 16) * pitch + col0;
#pragma unroll
                    for (int bj = 0; bj < 2; ++bj) { af4 v0 = acc[ai][bj][m][0], v1 = acc[ai][bj][m][1];
                        if (act == 1) { v0 = v0 * 0.125f; v1 = v1 * 0.125f; }
                        if (act == 2) {
#pragma unroll
                            for (int q = 0; q < 4; ++q) { v0[q] = v0[q] * sigmoidf_(v0[q]); v1[q] = v1[q] * sigmoidf_(v1[q]); } }
                        pg8::u32x4 w; w.x = pg8::cvt_pk_bf16(v0[0], v0[1]); w.y = pg8::cvt_pk_bf16(v0[2], v0[3]); w.z = pg8::cvt_pk_bf16(v1[0], v1[1]); w.w = pg8::cvt_pk_bf16(v1[2], v1[3]);
                        *(pg8::u32x4*)(rowp + bj * 128) = w; } }
        }
    }
};
struct EpiOutProj {
    static constexpr bool PERM = true;
    bf16* mix; const float* mod;
    __device__ __forceinline__ void operator()(const af4 (&acc)[2][2][4][2], const Unit& u, int wr, int wc, int fr, int fq) const {
        const int b = (u.pm * 256) / SEQ; const int col0 = u.pn * 256 + wc * 32 + 8 * fq;
        af4 gt[2][2];
#pragma unroll
        for (int bj = 0; bj < 2; ++bj)
#pragma unroll
            for (int n = 0; n < 2; ++n) gt[bj][n] = *(const af4*)(mod + (size_t)b * 6144 + 2048 + col0 + bj * 128 + 4 * n);
#pragma unroll
        for (int ai = 0; ai < 2; ++ai)
#pragma unroll
            for (int m = 0; m < 4; ++m) { bf16* rowp = mix + (size_t)(u.pm * 256 + ai * 128 + wr * 64 + m * 16 + fr) * D + col0;
#pragma unroll
                for (int bj = 0; bj < 2; ++bj) { const af4 v0 = acc[ai][bj][m][0] * gt[bj][0], v1 = acc[ai][bj][m][1] * gt[bj][1];
                    pg8::u32x4 w; w.x = pg8::cvt_pk_bf16(v0[0], v0[1]); w.y = pg8::cvt_pk_bf16(v0[2], v0[3]); w.z = pg8::cvt_pk_bf16(v1[0], v1[1]); w.w = pg8::cvt_pk_bf16(v1[2], v1[3]);
                    *(pg8::u32x4*)(rowp + bj * 128) = w; } }
    }
};
struct EpiSwiGLU {
    static constexpr bool PERM = false;
    unsigned char* Y; const float* bgu;
    __device__ __forceinline__ void operator()(const af4 (&acc)[2][2][4][2], const Unit& u, int wr, int wc, int fr, int fq) const {
        const int f0 = u.pn * 128 + wc * 32 + 4 * fq; const float* bb = bgu + (size_t)u.e * 2048 + f0;
        af4 bg[2], bu[2];
#pragma unroll
        for (int n = 0; n < 2; ++n) { bg[n] = *(const af4*)(bb + 16 * n); bu[n] = *(const af4*)(bb + 1024 + 16 * n); }
#pragma unroll
        for (int ai = 0; ai < 2; ++ai)
#pragma unroll
            for (int m = 0; m < 4; ++m) { unsigned char* rowp = Y + (size_t)(u.pm * 256 + ai * 128 + wr * 64 + m * 16 + fr) * FF + f0;
#pragma unroll
                for (int n = 0; n < 2; ++n) { const af4 g = acc[ai][0][m][n] * WSCALE_INV + bg[n], up = acc[ai][1][m][n] * WSCALE_INV + bu[n]; af4 y;
#pragma unroll
                    for (int q = 0; q < 4; ++q) { const float gg = fminf(g[q], 7.f), uu = fminf(fmaxf(up[q], -7.f), 7.f); y[q] = (uu + 1.f) * gg * sigmoidf_(1.702f * gg); }
                    *(unsigned*)(rowp + 16 * n) = pk4_fp8(y[0], y[1], y[2], y[3]); } }
    }
};
struct EpiDown {
    static constexpr bool PERM = true;
    unsigned char* Cn; const float* bd;
    __device__ __forceinline__ void operator()(const af4 (&acc)[2][2][4][2], const Unit& u, int wr, int wc, int fr, int fq) const {
        const int col0 = u.pn * 256 + wc * 32 + 8 * fq; const float* bb = bd + (size_t)u.e * 1024 + col0;
        af4 bv[2][2];
#pragma unroll
        for (int bj = 0; bj < 2; ++bj)
#pragma unroll
            for (int n = 0; n < 2; ++n) bv[bj][n] = *(const af4*)(bb + bj * 128 + 4 * n);
#pragma unroll
        for (int ai = 0; ai < 2; ++ai)
#pragma unroll
            for (int m = 0; m < 4; ++m) { const int row = u.pm * 256 + ai * 128 + wr * 64 + m * 16 + fr; unsigned char* rowp = Cn + (size_t)row * 1024 + col0;
#pragma unroll
                for (int bj = 0; bj < 2; ++bj) { const af4 v0 = acc[ai][bj][m][0] * WSCALE_INV + bv[bj][0], v1 = acc[ai][bj][m][1] * WSCALE_INV + bv[bj][1];
                    v2u w; w.x = pk4_fp8(v0[0], v0[1], v0[2], v0[3]); w.y = pk4_fp8(v1[0], v1[1], v1[2], v1[3]); *(v2u*)(rowp + bj * 128) = w; } }
    }
};

typedef float cf4 __attribute__((ext_vector_type(4)));
#define MFMA16(a, b, c) __builtin_amdgcn_mfma_f32_16x16x32_bf16((a), (b), (c), 0, 0, 0)
constexpr int GP = 72;
__device__ __forceinline__ void gla_a_unit(Frame& F, int chunk) {
    const int tid = F.tid, lane = F.lane, w = F.wave;
    const int bh = chunk >> 7, n = chunk & 127, b = bh >> 2, h = bh & 3;
    const size_t R0 = (size_t)b * SEQ + (size_t)n * 64;
    LAS float* gc = (LAS float*)F.lds;
    LAS float* segt = (LAS float*)(F.lds + 16384);
    LAS bf16* QEs = (LAS bf16*)(F.lds + 18432);
    LAS bf16* KEs = (LAS bf16*)(F.lds + 18432 + 9216);
    LAS bf16* KST = (LAS bf16*)(F.lds + 18432 + 2 * 9216);
    LAS bf16* VT = (LAS bf16*)(F.lds + 18432 + 3 * 9216);
    LAS bf16* AM = (LAS bf16*)(F.lds + 18432 + 3 * 9216 + 18432);
    const float* GK = wsp<const float>(F, WS_GK);
    { const int r = tid >> 3, d0 = (tid & 7) * 8; const float* gp = GK + (R0 + r) * 256 + h * 64 + d0;
      *(LAS f32x4*)(gc + r * 64 + d0) = *(const f32x4*)gp; *(LAS f32x4*)(gc + r * 64 + d0 + 4) = *(const f32x4*)(gp + 4); }
    __syncthreads();
    { const int seg = tid >> 6, d = tid & 63; float run = 0.f;
#pragma unroll
      for (int i = 0; i < 8; ++i) { run += gc[(seg * 8 + i) * 64 + d]; gc[(seg * 8 + i) * 64 + d] = run; }
      segt[seg * 64 + d] = run; }
    __syncthreads();
    { const int seg = tid >> 6, d = tid & 63; float off = 0.f;
      for (int s2 = 0; s2 < seg; ++s2) off += segt[s2 * 64 + d];
#pragma unroll
      for (int i = 0; i < 8; ++i) gc[(seg * 8 + i) * 64 + d] += off; }
    __syncthreads();
    { const int r = tid >> 3, d0 = (tid & 7) * 8;
      const v4u qv = *(const v4u*)(wsp<const bf16>(F, WS_QG) + (R0 + r) * 256 + h * 64 + d0);
      const v4u kv = *(const v4u*)(wsp<const bf16>(F, WS_KG) + (R0 + r) * 256 + h * 64 + d0);
      float qf[8], kf[8];
#pragma unroll
      for (int i = 0; i < 4; ++i) { qf[2 * i] = bflo(qv[i]); qf[2 * i + 1] = bfhi(qv[i]); kf[2 * i] = bflo(kv[i]); kf[2 * i + 1] = bfhi(kv[i]); }
      float qe[8], ke[8];
#pragma unroll
      for (int i = 0; i < 8; ++i) { const float g = gc[r * 64 + d0 + i], gl = gc[63 * 64 + d0 + i];
          qe[i] = qf[i] * __expf(g); ke[i] = kf[i] * __expf(-g); KST[(d0 + i) * GP + r] = (bf16)f2bf(kf[i] * __expf(gl - g)); }
      v4u qo, ko;
#pragma unroll
      for (int i = 0; i < 4; ++i) { qo[i] = pk2(qe[2 * i], qe[2 * i + 1]); ko[i] = pk2(ke[2 * i], ke[2 * i + 1]); }
      *(LAS v4u*)(QEs + r * GP + d0) = qo; *(LAS v4u*)(KEs + r * GP + d0) = ko;
      *(v4u*)(wsp<bf16>(F, WS_QE) + (R0 + r) * 256 + h * 64 + d0) = qo;
      const int e0 = (tid & 7) * 16;
      const v4u va = *(const v4u*)(wsp<const bf16>(F, WS_VG) + (R0 + r) * 512 + h * 128 + e0);
      const v4u vb = *(const v4u*)(wsp<const bf16>(F, WS_VG) + (R0 + r) * 512 + h * 128 + e0 + 8);
#pragma unroll
      for (int i = 0; i < 4; ++i) { VT[(e0 + 2 * i) * GP + r] = (bf16)(va[i] & 0xffffu); VT[(e0 + 2 * i + 1) * GP + r] = (bf16)(va[i] >> 16);
                                    VT[(e0 + 8 + 2 * i) * GP + r] = (bf16)(vb[i] & 0xffffu); VT[(e0 + 8 + 2 * i + 1) * GP + r] = (bf16)(vb[i] >> 16); }
      if (tid < 64) wsp<float>(F, WS_DEC)[(size_t)chunk * 64 + tid] = __expf(gc[63 * 64 + tid]);
    }
    __syncthreads();
    const int l15 = lane & 15, l4 = lane >> 4;
#pragma unroll
    for (int q = 0; q < 2; ++q) { const int tile = 2 * w + q, ti = tile >> 2, tj = tile & 3;
        cf4 a = {0.f, 0.f, 0.f, 0.f};
        if (tj <= ti) {
#pragma unroll
            for (int kk = 0; kk < 2; ++kk) { const bf16x8 fa = *(const LAS bf16x8*)(QEs + (16 * ti + l15) * GP + kk * 32 + 8 * l4); const bf16x8 fb = *(const LAS bf16x8*)(KEs + (16 * tj + l15) * GP + kk * 32 + 8 * l4); a = MFMA16(fa, fb, a); } }
#pragma unroll
        for (int r = 0; r < 4; ++r) { const int cr = 16 * ti + 4 * l4 + r, cj = 16 * tj + l15; AM[cr * GP + cj] = (bf16)f2bf(cj <= cr ? a[r] : 0.f); } }
    { float* UT = wsp<float>(F, WS_UT) + (size_t)chunk * 8192;
#pragma unroll
      for (int td = 0; td < 4; ++td) { cf4 a = {0.f, 0.f, 0.f, 0.f};
#pragma unroll
          for (int kk = 0; kk < 2; ++kk) { const bf16x8 fa = *(const LAS bf16x8*)(VT + (16 * w + l15) * GP + kk * 32 + 8 * l4); const bf16x8 fb = *(const LAS bf16x8*)(KST + (16 * td + l15) * GP + kk * 32 + 8 * l4); a = MFMA16(fa, fb, a); }
#pragma unroll
          for (int r = 0; r < 4; ++r) UT[(16 * w + 4 * l4 + r) * 64 + 16 * td + l15] = a[r]; } }
    __syncthreads();
    { float* OI = wsp<float>(F, WS_OI);
#pragma unroll
      for (int tc = 0; tc < 4; ++tc) { cf4 a = {0.f, 0.f, 0.f, 0.f};
#pragma unroll
          for (int kk = 0; kk < 2; ++kk) { const bf16x8 fa = *(const LAS bf16x8*)(AM + (16 * tc + l15) * GP + kk * 32 + 8 * l4); const bf16x8 fb = *(const LAS bf16x8*)(VT + (16 * w + l15) * GP + kk * 32 + 8 * l4); a = MFMA16(fa, fb, a); }
#pragma unroll
          for (int r = 0; r < 4; ++r) OI[(R0 + 16 * tc + 4 * l4 + r) * 512 + h * 128 + 16 * w + l15] = a[r]; } }
    __syncthreads();
}
__device__ __forceinline__ void gla_b_phase(Frame& F) {
    const float* UT = wsp<const float>(F, WS_UT); const float* DEC = wsp<const float>(F, WS_DEC); bf16* SP = wsp<bf16>(F, WS_SP);
    for (int gt = F.vcu * 512 + F.tid; gt < 16 * 8192; gt += F.G * 512) {
        const int bh = gt >> 13, ed = gt & 8191, d = gt & 63; float S = 0.f;
#pragma unroll 8
        for (int n = 0; n < 128; ++n) { const size_t ch = (size_t)bh * 128 + n; const float u = UT[ch * 8192 + ed], dc = DEC[ch * 64 + d]; SP[ch * 8192 + ed] = (bf16)f2bf(S); S = S * dc + u; }
    }
}
__device__ __forceinline__ void gla_c_unit(Frame& F, int unit) {
    const int tid = F.tid, lane = F.lane, w = F.wave;
    const int bh = unit >> 6, n2 = unit & 63, b = bh >> 2, h = bh & 3;
    const size_t R0 = (size_t)b * SEQ + (size_t)n2 * 128;
    LAS bf16* QEs = (LAS bf16*)F.lds;
    LAS bf16* SPs = (LAS bf16*)(F.lds + 18432);
    { const int r = tid >> 2, d0 = (tid & 3) * 16; const bf16* src = wsp<const bf16>(F, WS_QE) + (R0 + r) * 256 + h * 64 + d0;
      *(LAS v4u*)(QEs + r * GP + d0) = *(const v4u*)src; *(LAS v4u*)(QEs + r * GP + d0 + 8) = *(const v4u*)(src + 8);
      const bf16* sp = wsp<const bf16>(F, WS_SP) + ((size_t)bh * 128 + 2 * n2) * 8192;
      const int row = tid >> 1, dd = (tid & 1) * 32;
#pragma unroll
      for (int i = 0; i < 4; ++i) *(LAS v4u*)(SPs + row * GP + dd + 8 * i) = *(const v4u*)(sp + (size_t)row * 64 + dd + 8 * i); }
    __syncthreads();
    const int l15 = lane & 15, l4 = lane >> 4, c2 = w >> 2, tc = w & 3;
    cf4 a[8];
#pragma unroll
    for (int te = 0; te < 8; ++te) { a[te] = (cf4){0.f, 0.f, 0.f, 0.f};
#pragma unroll
        for (int kk = 0; kk < 2; ++kk) { const bf16x8 fa = *(const LAS bf16x8*)(QEs + (64 * c2 + 16 * tc + l15) * GP + kk * 32 + 8 * l4); const bf16x8 fb = *(const LAS bf16x8*)(SPs + (128 * c2 + 16 * te + l15) * GP + kk * 32 + 8 * l4); a[te] = MFMA16(fa, fb, a[te]); } }
    const float* OI = wsp<const float>(F, WS_OI); const bf16* RG = wsp<const bf16>(F, WS_RG); bf16* A2 = wsp<bf16>(F, WS_A2);
    float gg[8];
#pragma unroll
    for (int te = 0; te < 8; ++te) gg[te] = F.g_gla_out[16 * te + l15];
#pragma unroll
    for (int r = 0; r < 4; ++r) { const size_t row = R0 + 64 * c2 + 16 * tc + 4 * l4 + r; float ss = 0.f; float o[8];
#pragma unroll
        for (int te = 0; te < 8; ++te) { o[te] = a[te][r] + OI[row * 512 + h * 128 + 16 * te + l15]; ss += o[te] * o[te]; }
        ss += __shfl_xor(ss, 1); ss += __shfl_xor(ss, 2); ss += __shfl_xor(ss, 4); ss += __shfl_xor(ss, 8);
        const float rs = rsqrtf(ss * (1.f / 128.f) + EPS);
#pragma unroll
        for (int te = 0; te < 8; ++te) { const int e = 16 * te + l15; A2[row * 1024 + h * 128 + e] = (bf16)f2bf(o[te] * rs * gg[te] * bf2f(RG[row * 512 + h * 128 + e])); } }
    __syncthreads();
}

namespace att {
constexpr int KSLOT = 8192, VSLOT = 16384, NSLOT = 3;
constexpr int LDS_K = 0, LDS_V = NSLOT * KSLOT, LDS_TBL = LDS_V + NSLOT * VSLOT, LDS_WS = LDS_TBL + 1024, LDS_Q = LDS_WS + 8 * 256, LDS_END = LDS_Q + 8 * 4096;
static_assert(LDS_END <= RING_BYTES, "attention LDS");
__device__ __forceinline__ int crow(int r, int hi) { return (r & 3) + 8 * (r >> 2) + 4 * hi; }
__device__ __forceinline__ void glds16(const void* gsrc, unsigned lds_dst) { unsigned keep;
    asm volatile("s_mov_b32 %0, m0\n\ts_mov_b32 m0, %2\n\ts_nop 0\n\tglobal_load_lds_dwordx4 %1, off\n\ts_mov_b32 m0, %0" : "=&s"(keep) : "v"(gsrc), "s"(lds_dst) : "memory"); }
typedef float f32x2_t __attribute__((ext_vector_type(2))); typedef __bf16 bf16x2_t __attribute__((ext_vector_type(2)));
__device__ __forceinline__ unsigned cvtpk_s(float lo, float hi) { f32x2_t v = {lo, hi}; bf16x2_t b = __builtin_convertvector(v, bf16x2_t); return __builtin_bit_cast(unsigned, b); }
typedef short v4i16_t __attribute__((ext_vector_type(4)));
typedef LAS const char* lds_cptr;
__device__ __forceinline__ s16x4 vtr(lds_cptr p) { return __builtin_bit_cast(s16x4, __builtin_amdgcn_ds_read_tr16_b64_v4i16((LAS v4i16_t*)p)); }
#define MFMA32(a, b, c) __builtin_amdgcn_mfma_f32_32x32x16_bf16((a), (b), (c), 0, 0, 0)
#define ATT_WAIT_BAR(N) asm volatile("s_waitcnt vmcnt(" #N ") lgkmcnt(0)\n\ts_barrier" ::: "memory")

__device__ __forceinline__ void attn_map(f32x16 (&o)[4], int b, int h, int m, int qb, const bf16* QD, const bf16* KD, const bf16* VD, LAS unsigned char* shm) {
    int lane = threadIdx.x & 63; asm volatile("" : "+v"(lane));
    const int tid = threadIdx.x, r32 = lane & 31, hi = lane >> 5; const int wid = __builtin_amdgcn_readfirstlane(tid >> 6);
    const size_t rowbase = (size_t)b * SEQ; const int q0 = qb * 256;
    const bf16* Qw = QD + (rowbase + q0 + wid * 32) * 512 + (h * 2 + m) * 64;
    const bf16* Kh = KD + rowbase * 512 + (h * 2 + m) * 64; const bf16* Vh = VD + rowbase * 512 + h * 128;
    const unsigned lds0 = (unsigned)(uintptr_t)shm;
    const LAS float* tbl = (const LAS float*)(shm + LDS_TBL) + m * 128;
    LAS float* wsf = (LAS float*)(shm + LDS_WS) + wid * 64;
    const bf16* ksrc = Kh + (size_t)lane * 512 + wid * 8;
    const bf16* vsrc = Vh + (size_t)(16 * (wid & 3) + (lane >> 2)) * 512 + (wid >> 2) * 32 + (lane & 3) * 8;
    const unsigned kdst = lds0 + LDS_K + wid * 1024, vdst = lds0 + LDS_V + wid * 1024;
#define DMA_K(t, slot) glds16(ksrc + (size_t)(t) * 64 * 512, (unsigned)__builtin_amdgcn_readfirstlane(kdst + (slot) * KSLOT))
#define DMA_V(t, slot) do { glds16(vsrc + (size_t)(t) * 64 * 512, (unsigned)__builtin_amdgcn_readfirstlane(vdst + (slot) * VSLOT)); \
        glds16(vsrc + (size_t)(t) * 64 * 512 + 64, (unsigned)__builtin_amdgcn_readfirstlane(vdst + (slot) * VSLOT + 8192)); } while (0)
    const int NT = 4 * qb + 4;
    VM_WAIT();
    DMA_K(0, 0); DMA_V(0, 0); DMA_K(1, 1); DMA_K(2, 2);
    const lds_cptr qlds = (lds_cptr)shm + LDS_Q + wid * 4096 + lane * 16;
    { bf16x8 qr[4];
#pragma unroll
      for (int d0 = 0; d0 < 4; ++d0) qr[d0] = *(const bf16x8*)(Qw + (size_t)r32 * 512 + d0 * 16 + hi * 8);
      asm volatile("s_waitcnt vmcnt(0)" : "+v"(qr[0]), "+v"(qr[1]), "+v"(qr[2]), "+v"(qr[3]) :: "memory");
#pragma unroll
      for (int d0 = 0; d0 < 4; ++d0) *(LAS bf16x8*)(shm + LDS_Q + wid * 4096 + lane * 16 + d0 * 1024) = qr[d0]; }
#pragma unroll
    for (int d0 = 0; d0 < 4; ++d0) o[d0] = (f32x16){};
    float lsum = 0.f;
    const int qw0 = q0 + wid * 32, qabs = qw0 + r32;
    const lds_cptr shm3 = (lds_cptr)shm;
    const lds_cptr kp0 = shm3 + LDS_K + hi * 1024 + r32 * 16;
    const lds_cptr vp0 = shm3 + LDS_V + ((lane >> 4) & 1) * 32 + (lane & 3) * 8 + (4 * hi + ((lane & 15) >> 2)) * 64;
#define QK_TILE(C0, C1, kp) do { C0 = (f32x16){}; C1 = (f32x16){}; \
        _Pragma("unroll") for (int d0 = 0; d0 < 4; ++d0) { if (d0 == 2) __builtin_amdgcn_sched_barrier(0); const bf16x8 b0 = *(const LAS bf16x8*)((kp) + d0 * 2048); const bf16x8 b1 = *(const LAS bf16x8*)((kp) + d0 * 2048 + 512); \
            const bf16x8 qf_ = *(const LAS bf16x8*)(qlds + d0 * 1024); C0 = MFMA32(b0, qf_, C0); C1 = MFMA32(b1, qf_, C1); } } while (0)
#define MASK_BIAS(C0, C1, t) do { const int kvb_ = (t) * 64; if (kvb_ + 191 > qw0) { int dbase = qabs - kvb_ - 4 * hi; asm volatile("" : "+v"(dbase)); \
        _Pragma("unroll") for (int r = 0; r < 16; ++r) { const int d0_ = dbase - ((r & 3) + 8 * (r >> 2)); const int d1_ = d0_ - 32; \
            C0[r] = d0_ < 0 ? -INFINITY : C0[r] + tbl[d0_ > 127 ? 127 : d0_]; C1[r] = d1_ < 0 ? -INFINITY : C1[r] + tbl[d1_ > 127 ? 127 : d1_]; } } } while (0)
#define VLOAD(vf, vp, d0) do { _Pragma("unroll") for (int ks = 0; ks < 4; ++ks) { const s16x4 lo_ = vtr((vp) + (d0) * 4096 + ks * 1024), hh_ = vtr((vp) + (d0) * 4096 + ks * 1024 + 512); \
            vf[ks] = (bf16x8){lo_[0], lo_[1], lo_[2], lo_[3], hh_[0], hh_[1], hh_[2], hh_[3]}; } } while (0)
#define PV4(d0, vf) do { _Pragma("unroll") for (int ks = 0; ks < 4; ++ks) o[d0] = MFMA32(__builtin_bit_cast(bf16x8, pw[ks]), vf[ks], o[d0]); } while (0)
#define PACK_SUM(P0, P1) do { float sacc = 0.f; _Pragma("unroll") for (int r = 0; r < 16; ++r) sacc += P0[r] + P1[r]; lsum += sacc; \
        _Pragma("unroll") for (int i = 0; i < 4; ++i) { pw[0][i] = cvtpk_s(P0[2 * i], P0[2 * i + 1]); pw[1][i] = cvtpk_s(P0[8 + 2 * i], P0[9 + 2 * i]); pw[2][i] = cvtpk_s(P1[2 * i], P1[2 * i + 1]); pw[3][i] = cvtpk_s(P1[8 + 2 * i], P1[9 + 2 * i]); } } while (0)
#define EXP_PACK(C, pwa, pwb) do { float sacc = 0.f; _Pragma("unroll") for (int r = 0; r < 16; ++r) { C[r] = __builtin_amdgcn_exp2f(C[r]); sacc += C[r]; } lsum += sacc; \
        _Pragma("unroll") for (int i = 0; i < 4; ++i) { pwa[i] = cvtpk_s(C[2 * i], C[2 * i + 1]); pwb[i] = cvtpk_s(C[8 + 2 * i], C[9 + 2 * i]); } } while (0)
#define KLOAD(kf, kp) do { _Pragma("unroll") for (int d0 = 0; d0 < 4; ++d0) { kf[2 * d0] = *(const LAS bf16x8*)((kp) + d0 * 2048); kf[2 * d0 + 1] = *(const LAS bf16x8*)((kp) + d0 * 2048 + 512); } } while (0)
#define QLOAD(qf) do { _Pragma("unroll") for (int d0 = 0; d0 < 4; ++d0) qf[d0] = *(const LAS bf16x8*)(qlds + d0 * 1024); } while (0)
#define QK8(C0, C1, kf, qf) do { C0 = (f32x16){}; C1 = (f32x16){}; _Pragma("unroll") for (int d0 = 0; d0 < 4; ++d0) { C0 = MFMA32(kf[2 * d0], qf[d0], C0); C1 = MFMA32(kf[2 * d0 + 1], qf[d0], C1); } } while (0)
#define SB() __builtin_amdgcn_sched_barrier(0)
    f32x16 C0, C1; v4u pw[4], pwn[4]; bf16x8 va[4], vb[4], kf[8], qf[4];
    ATT_WAIT_BAR(0);
    KLOAD(kf, kp0); QLOAD(qf);
    ATT_WAIT_BAR(0);
    if (3 < NT) DMA_K(3, 0);
    DMA_V(1, 1);
    QK8(C0, C1, kf, qf);
    MASK_BIAS(C0, C1, 0);
    EXP_PACK(C0, pw[0], pw[1]); EXP_PACK(C1, pw[2], pw[3]);
    KLOAD(kf, kp0 + KSLOT);
    int ks_cur = 1, vs_prev = 0;
    for (int t = 1; t < NT; ++t) {
        if (t + 2 < NT) { ATT_WAIT_BAR(3); } else { ATT_WAIT_BAR(2); }
        { const int vs_new = (vs_prev == 0) ? 2 : vs_prev - 1;
          if (t + 3 < NT) DMA_K(t + 3, ks_cur);
          if (t + 1 < NT) DMA_V(t + 1, vs_new); }
        const int ks_next = (ks_cur == 2) ? 0 : ks_cur + 1;
        const lds_cptr vp = vp0 + vs_prev * VSLOT;
        SB();
        VLOAD(va, vp, 0); VLOAD(vb, vp, 1);
        SB();
        QK8(C0, C1, kf, qf);
        SB();
        MASK_BIAS(C0, C1, t);
        SB();
        PV4(0, va); PV4(1, vb);
        EXP_PACK(C0, pwn[0], pwn[1]);
        SB();
        VLOAD(va, vp, 2); VLOAD(vb, vp, 3);
        KLOAD(kf, kp0 + ks_next * KSLOT);
        SB();
        PV4(2, va); PV4(3, vb);
        EXP_PACK(C1, pwn[2], pwn[3]);
        SB();
#pragma unroll
        for (int i = 0; i < 4; ++i) pw[i] = pwn[i];
        ks_cur = ks_next; vs_prev = (vs_prev == 2) ? 0 : vs_prev + 1;
    }
    ATT_WAIT_BAR(0);
    { const lds_cptr vp = vp0 + vs_prev * VSLOT;
      VLOAD(va, vp, 0); VLOAD(vb, vp, 1); PV4(0, va); PV4(1, vb);
      VLOAD(va, vp, 2); VLOAD(vb, vp, 3); PV4(2, va); PV4(3, vb); }
    { auto rr = __builtin_amdgcn_permlane32_swap(__float_as_uint(lsum), __float_as_uint(lsum), false, false); lsum = __uint_as_float(rr[0]) + __uint_as_float(rr[1]); }
    if (hi == 0) wsf[r32] = lsum;
    LDS_WAIT();
#pragma unroll
    for (int r = 0; r < 16; ++r) { const float rl = 1.0f / wsf[crow(r, hi)];
#pragma unroll
        for (int d0 = 0; d0 < 4; ++d0) o[d0][r] *= rl; }
    ATT_WAIT_BAR(0);
#undef DMA_K
#undef DMA_V
#undef QK_TILE
#undef MASK_BIAS
#undef VLOAD
#undef PV4
#undef PACK_SUM
#undef EXP_PACK
#undef KLOAD
#undef QLOAD
#undef QK8
#undef SB
}
__device__ __forceinline__ int t5_bucket(int n) {
    if (n < 16) return n;
    const float nf = (float)n; int large = 16 + (int)(logf(nf / 16.f) / logf(8.f) * 16.f);
    return large < 31 ? large : 31;
}
__device__ __forceinline__ void attn_unit(Frame& F, int b, int h, int qb, float lam) {
    LAS unsigned char* shm = F.lds;
    int tid = F.tid; asm volatile("" : "+v"(tid));
    const int lane = tid & 63, r32 = lane & 31, hi = lane >> 5, wid = F.wave;
    if (tid < 256) { const int m = tid >> 7, d = tid & 127; const int col = h * 2 + m;
        ((LAS float*)(shm + LDS_TBL))[tid] = (F.rel_bias[t5_bucket(d) * 8 + col] - F.rel_bias[31 * 8 + col]) * LOG2E; }
    __syncthreads();
    const bf16* QD = wsp<const bf16>(F, WS_QD); const bf16* KD = wsp<const bf16>(F, WS_KD); const bf16* VD = wsp<const bf16>(F, WS_VD);
    float* stash = wsp<float>(F, WS_STASH) + (size_t)F.vcu * 32768 + tid * 64;
    f32x16 o[4];
#pragma nounroll
    for (int m = 0; m < 2; ++m) {
        attn_map(o, b, h, m, qb, QD, KD, VD, shm);
        if (m == 0) {
#pragma unroll
            for (int d0 = 0; d0 < 4; ++d0)
#pragma unroll
                for (int r = 0; r < 16; r += 4) *(f32x4*)(stash + d0 * 16 + r) = (f32x4){o[d0][r], o[d0][r + 1], o[d0][r + 2], o[d0][r + 3]};
        } else {
            float ss[16];
#pragma unroll
            for (int r = 0; r < 16; ++r) ss[r] = 0.f;
#pragma unroll
            for (int d0 = 0; d0 < 4; ++d0)
#pragma unroll
                for (int r4 = 0; r4 < 16; r4 += 4) { const f32x4 sv = *(const f32x4*)(stash + d0 * 16 + r4);
#pragma unroll
                    for (int q = 0; q < 4; ++q) { const int r = r4 + q; const float v = sv[q] - lam * o[d0][r]; o[d0][r] = v; ss[r] += v * v; } }
            float gs[4];
#pragma unroll
            for (int d0 = 0; d0 < 4; ++d0) gs[d0] = F.g_subln[32 * d0 + r32] * 0.8f;
            bf16* A2 = wsp<bf16>(F, WS_A2);
            const size_t rowb = (size_t)b * SEQ + (size_t)qb * 256 + wid * 32;
            bf16* a2b = A2 + (rowb + 4 * hi) * 1024 + 512 + h * 128 + r32; asm volatile("" : "+v"(a2b));
#pragma unroll
            for (int r = 0; r < 16; ++r) { float s = ss[r];
                s += __shfl_xor(s, 1); s += __shfl_xor(s, 2); s += __shfl_xor(s, 4); s += __shfl_xor(s, 8); s += __shfl_xor(s, 16);
                const float rs = rsqrtf(s * (1.f / 128.f) + EPS);
                bf16* rowp = a2b + (size_t)((r & 3) + 8 * (r >> 2)) * 1024;
#pragma unroll
                for (int d0 = 0; d0 < 4; ++d0) rowp[32 * d0] = (bf16)f2bf(o[d0][r] * rs * gs[d0]); }
        }
    }
    __syncthreads();
}
}

__device__ __forceinline__ void p7_phase(Frame& F, bool count = true) {
    const int tid = F.tid, lane = F.lane;
    LAS float* wr = (LAS float*)F.lds;
    LAS unsigned* hist = (LAS unsigned*)(F.lds + HIST_OFF);
    { f32x4 t[16]; const int k0 = tid >> 3, e4 = (tid & 7) * 4;
#pragma unroll
      for (int it = 0; it < 16; ++it) t[it] = *(const f32x4*)(F.w_router + (size_t)(k0 + 64 * it) * 32 + e4);
#pragma unroll
      for (int it = 0; it < 16; ++it)
#pragma unroll
          for (int q = 0; q < 4; ++q) wr[(e4 + q) * 1024 + k0 + 64 * it] = t[it][q]; }
    if (tid < 32) hist[tid] = 0u;
    __syncthreads();
    const float* MOD = wsp<const float>(F, WS_MOD);
    const int gw = F.vcu * NWAVES + F.wave, NGW = F.G * NWAVES; const int rpw = (T + NGW - 1) / NGW;
    int curb = -1; f32x4 gsc[4], shv[4], nx[4];
    v2u nm[4]; const bf16* MIX = wsp<const bf16>(F, WS_MIX);
    { const int m0 = (srow(gw, 0, NGW) < T) ? srow(gw, 0, NGW) : 0; const GAS f32x4* xr = (const GAS f32x4*)(F.x + (size_t)m0 * D) + lane; const GAS v2u* mr = (const GAS v2u*)(MIX + (size_t)m0 * D) + lane;
#pragma unroll
      for (int j = 0; j < 4; ++j) { nx[j] = xr[64 * j]; nm[j] = mr[64 * j]; } }
#pragma nounroll
    for (int i = 0; i < rpw; ++i) {
        const int m = srow(gw, i, NGW); if (m >= T) break;
        const int b = m / SEQ;
        if (b != curb) { curb = b;
#pragma unroll
            for (int j = 0; j < 4; ++j) { const int col = 256 * j + 4 * lane; const f32x4 g = *(const f32x4*)(F.g_norm2 + col);
                shv[j] = *(const f32x4*)(MOD + (size_t)b * 6144 + 3072 + col); gsc[j] = g * (*(const f32x4*)(MOD + (size_t)b * 6144 + 4096 + col) + 1.0f); } }
        f32x4 v[4]; float s = 0.f;
#pragma unroll
        for (int j = 0; j < 4; ++j) { v[j] = nx[j] + (f32x4){bflo(nm[j].x), bfhi(nm[j].x), bflo(nm[j].y), bfhi(nm[j].y)}; s += (v[j].x * v[j].x + v[j].y * v[j].y) + (v[j].z * v[j].z + v[j].w * v[j].w); }
        { const int mn_ = srow(gw, i + 1, NGW); const int m2 = (i + 1 < rpw && mn_ < T) ? mn_ : m; const GAS f32x4* xr = (const GAS f32x4*)(F.x + (size_t)m2 * D) + lane; const GAS v2u* mr = (const GAS v2u*)(MIX + (size_t)m2 * D) + lane;
#pragma unroll
          for (int j = 0; j < 4; ++j) { nx[j] = xr[64 * j]; nm[j] = mr[64 * j]; } }
        const float rstd = rsqrtf(wave_sum(s) * (1.f / D) + EPS);
        GAS unsigned* o4 = (GAS unsigned*)(wsp<unsigned char>(F, WS_XN) + (size_t)m * D) + lane;
#pragma unroll
        for (int j = 0; j < 4; ++j) { v[j] = v[j] * rstd * gsc[j] + shv[j]; o4[64 * j] = pk4_fp8(v[j].x, v[j].y, v[j].z, v[j].w); }
        float lg[32];
        { f32x4 wa[8], wb[8];
#define P7_LD(dst, eb) do { _Pragma("unroll") for (int q = 0; q < 8; ++q) dst[q] = *(const LAS f32x4*)(wr + ((eb) * 2 + (q >> 2)) * 1024 + 256 * (q & 3) + 4 * lane); } while (0)
#define P7_DOT(src, eb) do { _Pragma("unroll") for (int rr = 0; rr < 2; ++rr) { f32x2 a2 = {0.f, 0.f}; _Pragma("unroll") for (int j = 0; j < 4; ++j) { const f32x4 w = src[rr * 4 + j]; a2 += v[j].lo * w.lo; a2 += v[j].hi * w.hi; } lg[(eb) * 2 + rr] = a2.x + a2.y; } } while (0)
          P7_LD(wa, 0); __builtin_amdgcn_sched_barrier(0);
#pragma unroll
          for (int eb = 0; eb < 16; eb += 2) {
              P7_LD(wb, eb + 1); __builtin_amdgcn_sched_barrier(0);
              P7_DOT(wa, eb); __builtin_amdgcn_sched_barrier(0);
              if (eb + 2 < 16) { P7_LD(wa, eb + 2); __builtin_amdgcn_sched_barrier(0); }
              P7_DOT(wb, eb + 1); __builtin_amdgcn_sched_barrier(0);
          }
#undef P7_LD
#undef P7_DOT
        }
        const float myl = xreduce<32>(lg, lane) + F.b_router[lane >> 1];
        unsigned key; { const unsigned u = __builtin_bit_cast(unsigned, myl); const unsigned o = (u & 0x80000000u) ? ~u : (u | 0x80000000u); key = (o & ~31u) | (unsigned)(31 - (lane >> 1)); }
        int te[4]; float tv[4];
#pragma unroll
        for (int k = 0; k < 4; ++k) { const unsigned mx = wave_umax(key); te[k] = 31 - (int)(mx & 31u); tv[k] = lane_bcast(myl, 2 * te[k]); key = (key == mx) ? 0u : key; }
        float ex[4], es = 0.f;
#pragma unroll
        for (int k = 0; k < 4; ++k) { ex[k] = __expf(tv[k] - tv[0]); es += ex[k]; }
        if (lane < 4) { const int e = lane == 0 ? te[0] : lane == 1 ? te[1] : lane == 2 ? te[2] : te[3]; const float w = (lane == 0 ? ex[0] : lane == 1 ? ex[1] : lane == 2 ? ex[2] : ex[3]) / es;
            wsp<int>(F, WS_TOPE)[(size_t)m * 4 + lane] = e; wsp<float>(F, WS_TOPW)[(size_t)m * 4 + lane] = w; __hip_atomic_fetch_add(hist + e, 1u, __ATOMIC_RELAXED, __HIP_MEMORY_SCOPE_WORKGROUP); }
    }
    __syncthreads();
    if (tid < 32 && count) __hip_atomic_fetch_add(F.ctl + CW_CNT + tid, hist[tid], RLX_AGENT);
}
__device__ __forceinline__ void moe_tables(Frame& F, int& nMt) {
    LAS unsigned char* te = F.lds + TILEE_OFF;
    LAS unsigned* nt = (LAS unsigned*)(F.lds + HIST_OFF);
    if (F.tid < 32) nt[F.tid] = ((unsigned)__hip_atomic_load(F.ctl + CW_CNT + F.tid, RLX_AGENT) + 255u) >> 8;
    __syncthreads();
    { int start = 0, mine0 = -1, mine1 = -1; const int t0 = F.tid, t1 = F.tid + 512;
#pragma unroll 8
      for (int e = 0; e < NE; ++e) { const int n = (int)nt[e]; if (t0 >= start && t0 < start + n) mine0 = e; if (t1 >= start && t1 < start + n) mine1 = e; start += n; }
      if (mine0 >= 0) te[t0] = (unsigned char)mine0;
      if (mine1 >= 0) te[t1] = (unsigned char)mine1;
      if (F.tid == 0) F.MISC[16] = (unsigned)start; }
    __syncthreads();
    nMt = __builtin_amdgcn_readfirstlane((int)F.MISC[16]);
}
__device__ __forceinline__ void p8_phase(Frame& F) {
    const int tid = F.tid, lane = F.lane;
    LAS unsigned* hist = (LAS unsigned*)(F.lds + HIST_OFF);
    if (tid < 128) hist[tid] = 0u;
    __syncthreads();
    const int gw = F.vcu * NWAVES + F.wave, NGW = F.G * NWAVES; const int rpw = (T + NGW - 1) / NGW;
    const int* TOPE = wsp<const int>(F, WS_TOPE);
    const int mw0 = gw * rpw;
    for (int c = 0; c < rpw; c += 16) { const int m = mw0 + c + (lane >> 2); if (c + (lane >> 2) < rpw && m < T) __hip_atomic_fetch_add(hist + TOPE[(size_t)m * 4 + (lane & 3)], 1u, __ATOMIC_RELAXED, __HIP_MEMORY_SCOPE_WORKGROUP); }
    __syncthreads();
    if (tid < 32) hist[96 + tid] = (__hip_atomic_load(F.ctl + CW_CNT + tid, RLX_AGENT) + 255u) & ~255u;
    __syncthreads();
    if (tid < 32) { unsigned pstart = 0; for (int e = 0; e < tid; ++e) pstart += hist[96 + e];
        hist[32 + tid] = pstart + __hip_atomic_fetch_add(F.ctl + CW_FILL + tid, hist[tid], RLX_AGENT); }
    __syncthreads();
    const unsigned char* H2 = wsp<const unsigned char>(F, WS_XN); unsigned char* XS = wsp<unsigned char>(F, WS_XS);
    for (int c = 0; c < rpw; c += 16) {
        const int mr = mw0 + c + (lane >> 2); const bool ok = (c + (lane >> 2) < rpw) && (mr < T);
        int pos = 0;
        if (ok) { const int e = TOPE[(size_t)mr * 4 + (lane & 3)]; pos = (int)(hist[32 + e] + __hip_atomic_fetch_add(hist + 64 + e, 1u, __ATOMIC_RELAXED, __HIP_MEMORY_SCOPE_WORKGROUP));
            wsp<int>(F, WS_POS)[(size_t)mr * 4 + (lane & 3)] = pos; }
        v4u rowv[16];
#pragma unroll
        for (int i = 0; i < 16; ++i) { const int m = mw0 + c + i; const int mm = (c + i < rpw && m < T) ? m : mw0; rowv[i] = *(const v4u*)(H2 + (size_t)mm * D + lane * 16); }
#pragma unroll
        for (int i = 0; i < 16; ++i) { const int m = mw0 + c + i; const bool rok = (c + i < rpw) && (m < T);
#pragma unroll
            for (int k = 0; k < 4; ++k) { const int p = __shfl(pos, 4 * i + k); if (rok) *(v4u*)(XS + (size_t)p * D + lane * 16) = rowv[i]; } }
    }
}
__device__ __forceinline__ void p11_phase(Frame& F) {
    const int lane = F.lane;
    const float* MOD = wsp<const float>(F, WS_MOD); const unsigned char* CN = wsp<const unsigned char>(F, WS_CN); const int* POS = wsp<const int>(F, WS_POS);
    const int gw = F.vcu * NWAVES + F.wave, NGW = F.G * NWAVES; const int rpw = (T + NGW - 1) / NGW;
    const int nrow = (srow(gw, 0, NGW) < T) ? ((srow(gw, rpw - 1, NGW) < T) ? rpw : 0) : 0;
    int cnt = nrow; if (NGW * 16 != T) { cnt = 0; for (int i = 0; i < rpw; ++i) if (srow(gw, i, NGW) < T) ++cnt; }
    if (cnt == 0) return;
#define RW(i) srow(gw, ((i) < cnt ? (i) : cnt - 1), NGW)
    v4u ca[4], mx0, mx1; f32x4 xv[4]; int pn[4]; f32x4 wcur, wnxt; const float* TOPW = wsp<const float>(F, WS_TOPW); const bf16* MIXp = wsp<const bf16>(F, WS_MIX);
#define P11_LOAD(mm) do { _Pragma("unroll") for (int k = 0; k < 4; ++k) ca[k] = *(const v4u*)(CN + (size_t)pn[k] * D + lane * 16); \
        _Pragma("unroll") for (int q = 0; q < 4; ++q) xv[q] = *(const f32x4*)(F.x + (size_t)(mm) * D + lane * 16 + 4 * q); \
        { const v4u* ms_ = (const v4u*)(MIXp + (size_t)(mm) * D + lane * 16); mx0 = ms_[0]; mx1 = ms_[1]; } } while (0)
    { const int4 p4 = *(const int4*)(POS + (size_t)RW(0) * 4); pn[0] = p4.x; pn[1] = p4.y; pn[2] = p4.z; pn[3] = p4.w; }
    P11_LOAD(RW(0)); wcur = *(const f32x4*)(TOPW + (size_t)RW(0) * 4);
    { const int m2 = RW(1); const int4 p4 = *(const int4*)(POS + (size_t)m2 * 4); pn[0] = p4.x; pn[1] = p4.y; pn[2] = p4.z; pn[3] = p4.w; wnxt = *(const f32x4*)(TOPW + (size_t)m2 * 4); }
#pragma nounroll
    for (int i = 0; i < cnt; ++i) {
        const int m = RW(i);
        const int b = m / SEQ;
        float acc[16];
#pragma unroll
        for (int q = 0; q < 16; ++q) acc[q] = 0.f;
#pragma unroll
        for (int k = 0; k < 4; ++k) { const float wk = wcur[k];
#pragma unroll
            for (int q = 0; q < 4; ++q) { const int wq = (int)ca[k][q];
                acc[4 * q] += wk * __builtin_amdgcn_cvt_f32_fp8(wq, 0); acc[4 * q + 1] += wk * __builtin_amdgcn_cvt_f32_fp8(wq, 1);
                acc[4 * q + 2] += wk * __builtin_amdgcn_cvt_f32_fp8(wq, 2); acc[4 * q + 3] += wk * __builtin_amdgcn_cvt_f32_fp8(wq, 3); } }
        f32x4 ov[4]; const float* gt = MOD + (size_t)b * 6144 + 5120 + lane * 16;
#pragma unroll
        for (int q = 0; q < 4; ++q) { const f32x4 g = *(const f32x4*)(gt + 4 * q); const f32x4 av = {acc[4 * q], acc[4 * q + 1], acc[4 * q + 2], acc[4 * q + 3]};
            const unsigned ma = q < 2 ? mx0[2 * q] : mx1[2 * q - 4], mb = q < 2 ? mx0[2 * q + 1] : mx1[2 * q - 3];
            ov[q] = xv[q] + (f32x4){bflo(ma), bfhi(ma), bflo(mb), bfhi(mb)} + g * av; }
        P11_LOAD(RW(i + 1));
        wcur = wnxt;
        { const int m2 = RW(i + 2); const int4 p4 = *(const int4*)(POS + (size_t)m2 * 4); pn[0] = p4.x; pn[1] = p4.y; pn[2] = p4.z; pn[3] = p4.w; wnxt = *(const f32x4*)(TOPW + (size_t)m2 * 4); }
        float* orow = F.out + (size_t)m * D + lane * 16;
#pragma unroll
        for (int q = 0; q < 4; ++q) *(f32x4*)(orow + 4 * q) = ov[q];
    }
#undef RW
#undef P11_LOAD
}

constexpr int NPHASE = 12;
struct Args { const float* in[25]; float* out; unsigned char* ws; int ph_lo, ph_hi; };
__global__ void __launch_bounds__(NWAVES * 64, 2) fwd_kernel(Args args) {
    extern __shared__ __attribute__((aligned(16))) unsigned char lds[];
    Frame F;
    F.lds = (LAS unsigned char*)lds;
    F.MISC = (volatile LAS unsigned*)(F.lds + MISC_OFF);
    F.tid = threadIdx.x; F.lane = F.tid & 63; F.wave = __builtin_amdgcn_readfirstlane(F.tid >> 6);
    F.G = gridDim.x; { const int bx = blockIdx.x; F.vcu = (F.G % 8 == 0) ? (bx % 8) * (F.G / 8) + bx / 8 : bx; }
    F.ws = args.ws; F.ctl = (gu32*)(args.ws + WS_CTL); F.out = args.out;
    F.x = args.in[0]; F.c = args.in[1]; F.rel_bias = args.in[2]; F.w_ada = args.in[3]; F.b_ada = args.in[4]; F.g_norm1 = args.in[5]; F.w_in = args.in[6];
    F.w_gk_up = args.in[7]; F.b_gk_up = args.in[8]; F.g_gla_out = args.in[9]; F.g_qnorm = args.in[10]; F.g_knorm = args.in[11];
    F.lq1 = args.in[12]; F.lk1 = args.in[13]; F.lq2 = args.in[14]; F.lk2 = args.in[15]; F.g_subln = args.in[16]; F.w_out = args.in[17];
    F.g_norm2 = args.in[18]; F.w_router = args.in[19]; F.b_router = args.in[20]; F.w_gate_up = args.in[21]; F.b_gate_up = args.in[22]; F.w_down = args.in[23]; F.b_down = args.in[24];
    for (int u = F.tid; u < (LDS_BYTES - LDSCTL_OFF) / 4; u += NWAVES * 64) ((LAS unsigned*)(F.lds + LDSCTL_OFF))[u] = 0u;
    __syncthreads();
    const int lo = args.ph_lo, hi = args.ph_hi;
    const bool multi = (hi - lo) > 1;
    XcdBarrier bar; bar.bar = (unsigned*)(F.ctl + CW_BAR); bar.x = 0; bar.st = nullptr;
    if (multi) bar = xcd_barrier_post((unsigned*)(F.ctl + CW_BAR), F.MISC + 8);
#ifndef PHMASK
#define PHMASK 0xFFF
#endif
#define IN(k) (((PHMASK >> (k)) & 1) && lo <= (k) && (k) < hi)
#define SEAM(k) do { if (IN((k) + 1)) xcd_barrier(bar); } while (0)
#ifndef REPEAT_PH
#define REPEAT_PH 0
#endif
#define REPS(k) (((REPEAT_PH >> (k)) & 1) ? 2 : 1)

    if (IN(0)) { for (int rep_ = 0; rep_ < REPS(0); ++rep_) { if (rep_) xcd_barrier(bar); p0_phase(F); } SEAM(0); }
    if (IN(1)) { for (int rep_ = 0; rep_ < REPS(1); ++rep_) { if (rep_) xcd_barrier(bar); p1_phase(F); } SEAM(1); }
    if (IN(2)) {
        pg8::Gemm g{wsp<const bf16>(F, WS_XN), wsp<const bf16>(F, WS_WIN), T, NIN, D, 0};
        pg8::StaticOrder S; S.init(T / 256, NIN / 256, F.G, (int)blockIdx.x, nullptr, REPS(2));
        EpiInProj E{wsp<bf16>(F, WS_QG), wsp<bf16>(F, WS_KG), wsp<bf16>(F, WS_VG), wsp<bf16>(F, WS_RG), wsp<bf16>(F, WS_QD), wsp<bf16>(F, WS_KD), wsp<bf16>(F, WS_VD), F.g_qnorm, F.g_knorm};
        pg8::gemm_phase<EpiInProj, pg8::StaticOrder>(F.lds, g, S, E);
        SEAM(2);
    }
    if (IN(3)) { for (int rep_ = 0; rep_ < REPS(3); ++rep_) { if (rep_) xcd_barrier(bar); for (int c = F.vcu; c < NCHUNK; c += F.G) gla_a_unit(F, c); } SEAM(3); }
    if (IN(4)) { for (int rep_ = 0; rep_ < REPS(4); ++rep_) { if (rep_) xcd_barrier(bar); gla_b_phase(F); } SEAM(4); }
    if (IN(5)) for (int rep_ = 0; rep_ < REPS(5); ++rep_) { if (rep_) xcd_barrier(bar);
#ifndef NO_GLAC
        for (int u = F.vcu; u < NCHUNK / 2; u += F.G) gla_c_unit(F, u);
#endif
        float lam;
        { float a1 = F.lq1[F.lane] * F.lk1[F.lane], a2 = F.lq2[F.lane] * F.lk2[F.lane]; a1 = wave_sum(a1); a2 = wave_sum(a2); lam = __expf(a1) - __expf(a2) + 0.2f; }
#ifndef NO_ATT
        for (int p = F.vcu; p < 256; p += F.G) { const int bh = p >> 4, s = p & 15;
#pragma nounroll
            for (int j = 0; j < 2; ++j) att::attn_unit(F, bh >> 2, bh & 3, j ? s : 31 - s, lam); }
#endif
        SEAM(5);
    }
    if (IN(6)) {
        pg8::Gemm g{wsp<const bf16>(F, WS_A2), wsp<const bf16>(F, WS_WOUT), T, D, D, 0};
        pg8::StaticOrder S; S.init(T / 256, D / 256, F.G, (int)blockIdx.x, nullptr, REPS(6));
        EpiOutProj E{wsp<bf16>(F, WS_MIX), wsp<const float>(F, WS_MOD)};
        pg8::gemm_phase<EpiOutProj, pg8::StaticOrder>(F.lds, g, S, E);
        SEAM(6);
    }
    if (IN(7)) { for (int rep_ = 0; rep_ < REPS(7); ++rep_) { if (rep_) xcd_barrier(bar); p7_phase(F, rep_ == 0); } SEAM(7); }
    if (IN(8)) { p8_phase(F); SEAM(8); }
    if (IN(9)) {
        int nMt; moe_tables(F, nMt);
        pg8::Gemm g{wsp<const bf16>(F, WS_XS), wsp<const bf16>(F, WS_WGU), PMAX, 2048, D / 2, (size_t)2048 * 512};
        pg8::StaticOrder S; S.init(nMt, 8, F.G, (int)blockIdx.x, F.lds + TILEE_OFF, REPS(9));
        EpiSwiGLU E{wsp<unsigned char>(F, WS_Y), F.b_gate_up};
        pg8::gemm_phase<EpiSwiGLU, pg8::StaticOrder, true>(F.lds, g, S, E);
        SEAM(9);
    }
    if (IN(10)) {
        int nMt; moe_tables(F, nMt);
        pg8::Gemm g{wsp<const bf16>(F, WS_Y), wsp<const bf16>(F, WS_WD), PMAX, 1024, FF / 2, (size_t)1024 * 512};
        pg8::StaticOrder S; S.init(nMt, 4, F.G, (int)blockIdx.x, F.lds + TILEE_OFF, REPS(10));
        EpiDown E{wsp<unsigned char>(F, WS_CN), F.b_down};
        pg8::gemm_phase<EpiDown, pg8::StaticOrder, true>(F.lds, g, S, E);
        SEAM(10);
    }
    if (IN(11)) { p11_phase(F); }
#undef IN
#undef SEAM
}

extern "C" void kernel_launch(void* const* d_in, const int* in_sizes, int n_in, void* d_out, int out_size, void* d_ws, size_t ws_size, hipStream_t stream) {
    static int grid = 0;
    if (grid == 0) {
        if (n_in != 25 || in_sizes[0] != T * D || out_size != T * D || ws_size < WS_END) { fprintf(stderr, "kernel_launch: unexpected shapes (n_in %d, in0 %d, out %d, ws %zu); nothing launched\n", n_in, n_in > 0 ? in_sizes[0] : -1, out_size, ws_size); grid = -1; return; }
        int dev = 0, cus = 0, per_cu = 0;
        if (hipGetDevice(&dev) != hipSuccess || hipDeviceGetAttribute(&cus, hipDeviceAttributeMultiprocessorCount, dev) != hipSuccess) { grid = -1; return; }
        if (hipFuncSetAttribute((const void*)fwd_kernel, hipFuncAttributeMaxDynamicSharedMemorySize, LDS_BYTES) != hipSuccess) { fprintf(stderr, "kernel_launch: hipFuncSetAttribute failed\n"); grid = -1; return; }
        if (hipOccupancyMaxActiveBlocksPerMultiprocessor(&per_cu, (const void*)fwd_kernel, NWAVES * 64, LDS_BYTES) != hipSuccess || per_cu < 1)
            fprintf(stderr, "kernel_launch: note: occupancy query reports %d workgroups per CU\n", per_cu);
        (void)hipGetLastError();
        grid = cus;
    }
    if (grid < 0) return;
    if (hipMemsetAsync((char*)d_ws + WS_CTL, 0, CTL_ZERO_BYTES, stream) != hipSuccess) { fprintf(stderr, "kernel_launch: memset failed\n"); return; }
    Args a{};
    for (int i = 0; i < 25; ++i) a.in[i] = (const float*)d_in[i];
    a.out = (float*)d_out; a.ws = (unsigned char*)d_ws;
#if MK_N_LAUNCHES == 1
    a.ph_lo = 0; a.ph_hi = NPHASE;
    hipLaunchKernelGGL(fwd_kernel, dim3(grid), dim3(NWAVES * 64), LDS_BYTES, stream, a);
#else
    for (int p = 0; p < NPHASE; ++p) { a.ph_lo = p; a.ph_hi = p + 1; hipLaunchKernelGGL(fwd_kernel, dim3(grid), dim3(NWAVES * 64), LDS_BYTES, stream, a); }
#endif
    const hipError_t le = hipPeekAtLastError();
    if (le != hipSuccess) fprintf(stderr, "kernel_launch: launch failed: %s\n", hipGetErrorName(le));
}
```

```cpp
#include <hip/hip_runtime.h>
#include <cstdio>
#include <cstdint>

#ifndef MK_N_LAUNCHES
#define MK_N_LAUNCHES 1
#endif

namespace pg8 {
#define PG8_LAS __attribute__((address_space(3)))
typedef unsigned short bf16_t;
typedef short bf16x8 __attribute__((ext_vector_type(8)));
typedef float f32x4 __attribute__((ext_vector_type(4)));
typedef unsigned u32x4 __attribute__((ext_vector_type(4)));
typedef int i32x4 __attribute__((ext_vector_type(4)));
typedef int i32x8 __attribute__((ext_vector_type(8)));
typedef float f32x16 __attribute__((ext_vector_type(16)));
constexpr int BM = 256, BK = 64, HALF = 128, HTB = HALF * BK * 2, STAGE_BYTES = 8 * HTB, NXCD = 8, WGM = 8;

__host__ __device__ __forceinline__ int lds_byte(int r, int c) { const int st = (r >> 4) * 2 + (c >> 5), rr = r & 15, cc = c & 31, ob = rr * 64 + cc * 2; return st * 1024 + (ob ^ (((ob >> 9) & 1) << 5)); }
__host__ __device__ __forceinline__ void stage_rc(int b, int& R, int& C) { const int st = b / 1024, sb = b % 1024, swz = sb ^ (((sb >> 9) & 1) << 5); R = (st >> 1) * 16 + swz / 64; C = (st & 1) * 32 + (swz % 64) / 2; }
__host__ __device__ __forceinline__ int perm32(int rho) { const int n = rho >> 4, i = rho & 15; return 8 * (i >> 2) + 4 * n + (i & 3); }

struct Unit { int pm, pn, e; };
struct Gemm { const bf16_t* A; const bf16_t* Bt; int M, N, K; size_t estride; };

struct StaticOrder {
    int nM, nN, nwg, G, c, rep; const PG8_LAS unsigned char* tile_e;
    __device__ void init(int nM_, int nN_, int G_, int c_, const PG8_LAS unsigned char* te, int rep_ = 1) { nM = nM_; nN = nN_; nwg = nM * nN; G = G_; c = c_; tile_e = te; rep = rep_; }
    __device__ bool next(int i, Unit& u) const {
        long L = (long)i * G + c; if (L >= (long)nwg * rep) return false; if (rep > 1) L %= nwg;
        int wgid = (int)L; { const int q = nwg / NXCD, r = nwg % NXCD, xcd = wgid % NXCD, off = wgid / NXCD; wgid = (xcd < r ? xcd * (q + 1) : r * (q + 1) + (xcd - r) * q) + off; }
        const int nig = WGM * nN, gid = wgid / nig, fm = gid * WGM, gsz = (nM - fm) < WGM ? (nM - fm) : WGM;
        u.pm = fm + ((wgid % nig) % gsz); u.pn = (wgid % nig) / gsz; u.e = tile_e ? __builtin_amdgcn_readfirstlane((int)tile_e[u.pm]) : 0; return true;
    }
};

__device__ __forceinline__ unsigned cvt_pk_bf16(float lo, float hi) { unsigned r; asm volatile("v_cvt_pk_bf16_f32 %0, %1, %2" : "=v"(r) : "v"(lo), "v"(hi)); return r; }

template <class Epi, class Sched, bool FP8 = false>
__device__ __forceinline__ void gemm_phase(PG8_LAS unsigned char* lds, const Gemm g, const Sched& S, const Epi& E) {
    const int tid = threadIdx.x, wid = __builtin_amdgcn_readfirstlane(tid >> 6), lane = tid & 63, wr = wid >> 2, wc = wid & 3, fr = lane & 15, fq = lane >> 4;
    const int K = g.K, nt = K / BK;
    unsigned voffA[2], voffB[2];
#pragma unroll
    for (int i = 0; i < 2; ++i) { int R, C; stage_rc(tid * 16 + i * 8192, R, C); const int Rb = Epi::PERM ? ((R & ~31) + perm32(R & 31)) : R;
        voffA[i] = (unsigned)(R * K + C) * 2u; voffB[i] = (unsigned)(Rb * K + C) * 2u; }
    const size_t kstep = (size_t)(BK * 2);
    const size_t hstep = (size_t)HALF * K * 2;
    const size_t tstep = 2 * hstep;
    const size_t estep = g.estride * 2;
    const unsigned ldsw = (unsigned)wid * 1024u;
    const int aoff = lds_byte(wr * 64 + fr, fq * 8), boff = lds_byte(wc * 32 + fr, fq * 8);
#define PG8_SA(b, h) (((b) * 2 + (h)) * HTB)
#define PG8_SB(b, h) ((4 + (b) * 2 + (h)) * HTB)
#define PG8_STAGE(bufoff, gbase, voff) do { _Pragma("unroll") for (int _i = 0; _i < 2; ++_i) \
        __builtin_amdgcn_global_load_lds((const unsigned*)((const char*)(gbase) + (voff)[_i]), (PG8_LAS unsigned*)(lds + (bufoff) + ldsw + _i * 8192), 16, 0, 0); } while (0)
#define PG8_LDA(dst, b, h) do { _Pragma("unroll") for (int m = 0; m < 4; ++m) dst[m] = PG8_CAT2(*(const PG8_LAS i32x4*)(lds + PG8_SA(b, h) + aoff + m * 2048), *(const PG8_LAS i32x4*)(lds + PG8_SA(b, h) + aoff + m * 2048 + 1024)); } while (0)
#define PG8_LDB(dst, b, h) do { _Pragma("unroll") for (int n = 0; n < 2; ++n) dst[n] = PG8_CAT2(*(const PG8_LAS i32x4*)(lds + PG8_SB(b, h) + boff + n * 2048), *(const PG8_LAS i32x4*)(lds + PG8_SB(b, h) + boff + n * 2048 + 1024)); } while (0)
#define PG8_CAT2(x, y) __builtin_shufflevector((x), (y), 0, 1, 2, 3, 4, 5, 6, 7)
#define PG8_LO(x) __builtin_bit_cast(bf16x8, __builtin_shufflevector((x), (x), 0, 1, 2, 3))
#define PG8_HI(x) __builtin_bit_cast(bf16x8, __builtin_shufflevector((x), (x), 4, 5, 6, 7))
#define PG8_X4(v, m) ((f32x4){(v)[4 * (m)], (v)[4 * (m) + 1], (v)[4 * (m) + 2], (v)[4 * (m) + 3]})
#define PG8_INS(v, r, m) do { (v)[4 * (m)] = (r)[0]; (v)[4 * (m) + 1] = (r)[1]; (v)[4 * (m) + 2] = (r)[2]; (v)[4 * (m) + 3] = (r)[3]; } while (0)
#define PG8_MMA(ai, bj, At, Bt) do { __builtin_amdgcn_s_setprio(1); _Pragma("unroll") for (int m = 0; m < 4; ++m) _Pragma("unroll") for (int n = 0; n < 2; ++n) { \
        if constexpr (FP8) { const f32x4 r_ = __builtin_amdgcn_mfma_scale_f32_16x16x128_f8f6f4(Bt[n], At[m], PG8_X4(acc16[ai][bj][n], m), 0, 0, 0, 0x7F7F7F7F, 0, 0x7F7F7F7F); PG8_INS(acc16[ai][bj][n], r_, m); } \
        else { acc[ai][bj][m][n] = __builtin_amdgcn_mfma_f32_16x16x32_bf16(PG8_LO(Bt[n]), PG8_LO(At[m]), acc[ai][bj][m][n], 0, 0, 0); \
               acc[ai][bj][m][n] = __builtin_amdgcn_mfma_f32_16x16x32_bf16(PG8_HI(Bt[n]), PG8_HI(At[m]), acc[ai][bj][m][n], 0, 0, 0); } } \
        __builtin_amdgcn_s_setprio(0); } while (0)
#define PG8_WAIT_V(n) asm volatile("s_waitcnt vmcnt(" #n ")" ::: "memory")
#define PG8_WAIT_L(n) asm volatile("s_waitcnt lgkmcnt(" #n ")" ::: "memory")
#define PG8_BAR __builtin_amdgcn_s_barrier()
#define PG8_SCHED __builtin_amdgcn_sched_barrier(0)
    Unit cur, nxt; int ui = 0;
    if (!S.next(0, cur)) return;
    f32x4 acc[2][2][4][2];
#pragma unroll
    for (int a = 0; a < 2; ++a)
#pragma unroll
        for (int b = 0; b < 2; ++b)
#pragma unroll
            for (int m = 0; m < 4; ++m)
#pragma unroll
                for (int n = 0; n < 2; ++n) acc[a][b][m][n] = (f32x4){0.f, 0.f, 0.f, 0.f};
    f32x16 acc16[2][2][2];
#pragma unroll
    for (int a = 0; a < 2; ++a)
#pragma unroll
        for (int b = 0; b < 2; ++b)
#pragma unroll
            for (int n = 0; n < 2; ++n) acc16[a][b][n] = (f32x16){};
    i32x8 At[4], B0[2], B1[2];
    const char* cA = (const char*)g.A + (size_t)cur.pm * tstep; const char* cB = (const char*)g.Bt + (size_t)cur.e * estep + (size_t)cur.pn * tstep;
    PG8_STAGE(PG8_SB(0, 0), cB, voffB); PG8_STAGE(PG8_SB(0, 1), cB + hstep, voffB); PG8_STAGE(PG8_SA(0, 0), cA, voffA); PG8_STAGE(PG8_SA(0, 1), cA + hstep, voffA);
    if (wr == 1) PG8_BAR;
    PG8_WAIT_V(2); PG8_BAR;
    PG8_STAGE(PG8_SB(1, 0), cB + kstep, voffB); PG8_STAGE(PG8_SA(1, 0), cA + kstep, voffA); PG8_STAGE(PG8_SB(1, 1), cB + hstep + kstep, voffB);
    PG8_WAIT_V(6); PG8_BAR;
    for (;;) {
        const bool has_next = S.next(ui + 1, nxt);
        const char* nA = has_next ? (const char*)g.A + (size_t)nxt.pm * tstep : cA; const char* nB = has_next ? (const char*)g.Bt + (size_t)nxt.e * estep + (size_t)nxt.pn * tstep : cB;
#pragma nounroll
        for (int t = 0; t < nt; t += 2) {
            const bool last = (t == nt - 2);
            const char* a1 = cA + (size_t)(t + 1) * kstep;
            const char* a2 = last ? nA : cA + (size_t)(t + 2) * kstep; const char* b2 = last ? nB : cB + (size_t)(t + 2) * kstep;
            const char* a3 = a2 + kstep; const char* b3 = b2 + kstep;
            PG8_LDB(B0, 0, 0); PG8_LDB(B1, 0, 1); PG8_SCHED; PG8_LDA(At, 0, 0); PG8_STAGE(PG8_SA(1, 1), a1 + hstep, voffA);
            PG8_WAIT_V(8); PG8_WAIT_L(0); PG8_BAR; PG8_MMA(0, 0, At, B0); PG8_MMA(0, 1, At, B1); PG8_BAR; PG8_SCHED;
            PG8_LDA(At, 0, 1); PG8_STAGE(PG8_SB(0, 0), b2, voffB); PG8_STAGE(PG8_SB(0, 1), b2 + hstep, voffB); PG8_STAGE(PG8_SA(0, 0), a2, voffA);
            PG8_WAIT_V(8); PG8_WAIT_L(0); PG8_BAR; PG8_MMA(1, 0, At, B0); PG8_MMA(1, 1, At, B1); PG8_BAR; PG8_SCHED;
            PG8_LDB(B0, 1, 0); PG8_LDB(B1, 1, 1); PG8_SCHED; PG8_LDA(At, 1, 0); PG8_STAGE(PG8_SA(0, 1), a2 + hstep, voffA);
            PG8_WAIT_V(8); PG8_WAIT_L(0); PG8_BAR; PG8_MMA(0, 0, At, B0); PG8_MMA(0, 1, At, B1); PG8_BAR; PG8_SCHED;
            PG8_LDA(At, 1, 1); PG8_STAGE(PG8_SB(1, 0), b3, voffB); PG8_STAGE(PG8_SB(1, 1), b3 + hstep, voffB); PG8_STAGE(PG8_SA(1, 0), a3, voffA);
            PG8_WAIT_V(8); PG8_WAIT_L(0); PG8_BAR; PG8_MMA(1, 0, At, B0); PG8_MMA(1, 1, At, B1); PG8_BAR; PG8_SCHED;
        }
        if (wr == 0) PG8_BAR;
        if constexpr (FP8) {
#pragma unroll
            for (int a = 0; a < 2; ++a)
#pragma unroll
                for (int b = 0; b < 2; ++b)
#pragma unroll
                    for (int m = 0; m < 4; ++m)
#pragma unroll
                        for (int n = 0; n < 2; ++n) acc[a][b][m][n] = PG8_X4(acc16[a][b][n], m);
        }
        { int t2 = threadIdx.x; asm volatile("" : "+v"(t2)); E(acc, cur, wr, wc, t2 & 15, (t2 >> 4) & 3); }
        if (!has_next) break;
#pragma unroll
        for (int a = 0; a < 2; ++a)
#pragma unroll
            for (int b = 0; b < 2; ++b)
#pragma unroll
                for (int m = 0; m < 4; ++m)
#pragma unroll
                    for (int n = 0; n < 2; ++n) acc[a][b][m][n] = (f32x4){0.f, 0.f, 0.f, 0.f};
        if constexpr (FP8) {
#pragma unroll
            for (int a = 0; a < 2; ++a)
#pragma unroll
                for (int b = 0; b < 2; ++b)
#pragma unroll
                    for (int n = 0; n < 2; ++n) acc16[a][b][n] = (f32x16){};
        }
        cur = nxt; cA = nA; cB = nB; ++ui;
        if (wr == 1) PG8_BAR;
    }
    PG8_WAIT_V(0);
    PG8_BAR;
#undef PG8_SA
#undef PG8_SB
#undef PG8_STAGE
#undef PG8_LDA
#undef PG8_LDB
#undef PG8_MMA
#undef PG8_X4
#undef PG8_INS
#undef PG8_CAT2
#undef PG8_LO
#undef PG8_HI
#undef PG8_WAIT_V
#undef PG8_WAIT_L
#undef PG8_BAR
#undef PG8_SCHED
}
}

constexpr int NWAVES = 8;
constexpr int BATCH = 4, SEQ = 8192, D = 1024, T = BATCH * SEQ;
constexpr int INW = 3088, NIN = 3072;
constexpr int NE = 32, TOPK = 4, FF = 1024;
constexpr int PMAX = (T * TOPK / 256 + NE) * 256;
constexpr int NCHUNK = BATCH * 4 * (SEQ / 64);
constexpr float EPS = 1e-6f;
constexpr float LOG2E = 1.4426950408889634f;
constexpr float C2 = 0.125f * LOG2E;
constexpr float WSCALE = 32.f, WSCALE_INV = 1.f / 32.f;

constexpr size_t MiB = 1u << 20;
constexpr size_t WS_CTL = 0, CTL_ZERO_BYTES = 1 * MiB;
constexpr size_t WS_MODP = 1 * MiB;
constexpr size_t WS_MOD = 2 * MiB;
constexpr size_t WS_TOPE = 3 * MiB;
constexpr size_t WS_TOPW = 3 * MiB + 512 * 1024;
constexpr size_t WS_POS = 4 * MiB;
constexpr size_t WS_ROWW = 4 * MiB + 512 * 1024;
constexpr size_t WS_DEC = 6 * MiB;
constexpr size_t WS_WGU = 8 * MiB;
constexpr size_t WS_WD = 136 * MiB;
constexpr size_t WS_XN = 200 * MiB;
constexpr size_t WS_WIN = 264 * MiB;
constexpr size_t WS_WOUT = 270 * MiB;
constexpr size_t WS_GK = 272 * MiB;
constexpr size_t WS_QG = 304 * MiB;
constexpr size_t WS_KG = 320 * MiB;
constexpr size_t WS_VG = 336 * MiB;
constexpr size_t WS_RG = 368 * MiB;
constexpr size_t WS_QD = 400 * MiB;
constexpr size_t WS_KD = 432 * MiB;
constexpr size_t WS_VD = 464 * MiB;
constexpr size_t WS_UT = 496 * MiB;
constexpr size_t WS_SP = 560 * MiB;
constexpr size_t WS_OI = 592 * MiB;
constexpr size_t WS_QE = 656 * MiB;
constexpr size_t WS_A2 = 672 * MiB;
constexpr size_t WS_STASH = 736 * MiB;
constexpr size_t WS_XS = 264 * MiB;
constexpr size_t WS_Y = 400 * MiB;
constexpr size_t WS_CN = 536 * MiB;
constexpr size_t WS_MIX = 808 * MiB;
constexpr size_t WS_END = 872 * MiB;
static_assert(WS_XS + (size_t)PMAX * 1024 <= WS_Y && WS_Y + (size_t)PMAX * 1024 <= WS_CN && WS_CN + (size_t)PMAX * 1024 * 2 <= WS_MIX, "ws map");
constexpr int CW_BAR = 4096;
constexpr int CW_CNT = 16384;
constexpr int CW_FILL = 16384 + 64;

constexpr int RING_BYTES = 131072;
constexpr int LDSCTL_OFF = RING_BYTES, MISC_OFF = LDSCTL_OFF + 320;
constexpr int TILEE_OFF = MISC_OFF + 128;
constexpr int HIST_OFF = TILEE_OFF + 1024;
constexpr int LDS_BYTES = 147456;
static_assert(HIST_OFF + 512 <= LDS_BYTES, "LDS map");

#define GAS __attribute__((address_space(1)))
#define LAS __attribute__((address_space(3)))
typedef unsigned short bf16;
typedef unsigned v4u __attribute__((ext_vector_type(4)));
typedef unsigned v2u __attribute__((ext_vector_type(2)));
typedef float f32x4 __attribute__((ext_vector_type(4)));
typedef float f32x16 __attribute__((ext_vector_type(16)));
typedef short bf16x8 __attribute__((ext_vector_type(8)));
typedef short s16x4 __attribute__((ext_vector_type(4)));
typedef GAS unsigned gu32;
#define RLX_AGENT __ATOMIC_RELAXED, __HIP_MEMORY_SCOPE_AGENT
#define LDS_WAIT() asm volatile("s_waitcnt lgkmcnt(0)" ::: "memory")
#define VM_WAIT() asm volatile("s_waitcnt vmcnt(0)" ::: "memory")
__device__ __forceinline__ unsigned f2bf(float f) { unsigned u = __builtin_bit_cast(unsigned, f); return (u + 0x7fffu + ((u >> 16) & 1u)) >> 16; }
__device__ __forceinline__ unsigned pk2(float lo, float hi) { return f2bf(lo) | (f2bf(hi) << 16); }
__device__ __forceinline__ float bf2f(unsigned short h) { return __builtin_bit_cast(float, (unsigned)h << 16); }
__device__ __forceinline__ float bflo(unsigned u) { return __builtin_bit_cast(float, u << 16); }
__device__ __forceinline__ float bfhi(unsigned u) { return __builtin_bit_cast(float, u & 0xffff0000u); }
__device__ __forceinline__ float wave_sum(float v) {
#pragma unroll
    for (int o = 1; o < 64; o <<= 1) v += __shfl_xor(v, o);
    return v;
}
__device__ __forceinline__ float sigmoidf_(float x) { return 1.f / (1.f + __expf(-x)); }
typedef float f32x2 __attribute__((ext_vector_type(2)));
__device__ __forceinline__ unsigned wave_umax(unsigned v) {
    v = max(v, (unsigned)__builtin_amdgcn_update_dpp(0, (int)v, 0x111, 0xf, 0xf, true));
    v = max(v, (unsigned)__builtin_amdgcn_update_dpp(0, (int)v, 0x112, 0xf, 0xf, true));
    v = max(v, (unsigned)__builtin_amdgcn_update_dpp(0, (int)v, 0x114, 0xf, 0xf, true));
    v = max(v, (unsigned)__builtin_amdgcn_update_dpp(0, (int)v, 0x118, 0xf, 0xf, true));
    v = max(v, (unsigned)__builtin_amdgcn_update_dpp(0, (int)v, 0x142, 0xa, 0xf, false));
    v = max(v, (unsigned)__builtin_amdgcn_update_dpp(0, (int)v, 0x143, 0xc, 0xf, false));
    return (unsigned)__builtin_amdgcn_readlane((int)v, 63);
}
template <int CNT, int S, int N> __device__ __forceinline__ void xreduce_step(float (&v)[N], int lane) {
    if constexpr (CNT > 1) { constexpr int half = CNT / 2; const bool up = (lane & S) != 0;
#pragma unroll
        for (int i = 0; i < half; ++i) { const float send = up ? v[i] : v[i + half], keep = up ? v[i + half] : v[i]; v[i] = keep + __shfl_xor(send, S); }
        xreduce_step<half, S / 2, N>(v, lane); }
}
template <int S> __device__ __forceinline__ float xreduce_tail(float r) { if constexpr (S >= 1) { r += __shfl_xor(r, S); return xreduce_tail<S / 2>(r); } else return r; }
template <int N> __device__ __forceinline__ float xreduce(float (&v)[N], int lane) {
    xreduce_step<N, 32, N>(v, lane);
    return xreduce_tail<(N == 32 ? 1 : N == 16 ? 2 : N == 8 ? 4 : 8)>(v[0]);
}
__device__ __forceinline__ float lane_bcast(float v, int l) { return __builtin_bit_cast(float, __builtin_amdgcn_readlane(__builtin_bit_cast(int, v), l)); }

#define XB_TMO      128
#define XB_XCNT(j)  (256  + 64 * (j))
#define XB_XSUB(j)  (1280 + 64 * (j))
#define XB_XGEN(j)  (2304 + 64 * (j))
#define XB_TOP      3328
#define XB_TOPGEN   3392
#define XCD_BAR_WORDS 3456
#define XB_SPIN_CAP (1u << 18)
__device__ __forceinline__ unsigned xb_ld(unsigned* p)              { return __hip_atomic_load(p, __ATOMIC_RELAXED, __HIP_MEMORY_SCOPE_AGENT); }
__device__ __forceinline__ unsigned xb_add(unsigned* p, unsigned v) { return __hip_atomic_fetch_add(p, v, __ATOMIC_RELAXED, __HIP_MEMORY_SCOPE_AGENT); }
__device__ __forceinline__ unsigned xb_xcc_id() { return (unsigned)__builtin_amdgcn_s_getreg((3 << 11) | 20) & 0xFu; }
#define XB_SPIN(cond, bar) do { unsigned _sp = 0; while (cond) { __builtin_amdgcn_s_sleep(1); \
    if ((++_sp & 255u) == 0u) { if (xb_ld(&(bar)[XB_TMO])) break; if (_sp > XB_SPIN_CAP) { atomicAdd(&(bar)[XB_TMO], 1u); break; } } } } while (0)
struct XcdBarrier { unsigned* bar; unsigned x; volatile LAS unsigned* st; };
__device__ __forceinline__ XcdBarrier xcd_barrier_post(unsigned* bar, volatile LAS unsigned* st) {
    XcdBarrier b; b.bar = bar; b.x = xb_xcc_id(); b.st = st;
    if (threadIdx.x == 0) (void)xb_add(&bar[XB_XCNT(b.x)], 1u);
    return b;
}
__device__ __forceinline__ void xcd_barrier_complete(unsigned* bar, unsigned x, unsigned& nloc, unsigned& nx) {
    const unsigned G = gridDim.x * gridDim.y * gridDim.z;
    unsigned sum, cnt, mine, sp = 0u;
    for (;;) {
        sum = 0u; cnt = 0u; mine = 0u;
#pragma unroll
        for (unsigned j = 0; j < 16; ++j) { const unsigned c = xb_ld(&bar[XB_XCNT(j)]); sum += c; cnt += (c > 0u) ? 1u : 0u; mine = (j == x) ? c : mine; }
        if (sum == G) break;
        __builtin_amdgcn_s_sleep(1);
        if ((++sp & 255u) == 0u) { if (xb_ld(&bar[XB_TMO])) break; if (sp > XB_SPIN_CAP) { atomicAdd(&bar[XB_TMO], 1u); break; } }
    }
    nloc = mine > 0u ? mine : 1u; nx = cnt > 0u ? cnt : 1u;
}
__device__ __forceinline__ void xcd_barrier(const XcdBarrier& b) {
    asm volatile("s_waitcnt vmcnt(0)" ::: "memory");
    __syncthreads();
    if (threadIdx.x == 0) {
        unsigned* bar = b.bar;
        __builtin_amdgcn_s_waitcnt(0);
        unsigned nloc = b.st[0], nx = b.st[1];
        if (nloc == 0u) { xcd_barrier_complete(bar, b.x, nloc, nx); b.st[0] = nloc; b.st[1] = nx; }
        const unsigned old = xb_add(&bar[XB_XSUB(b.x)], 1u);
        const unsigned gen = old / nloc;
        if (old + 1u == (gen + 1u) * nloc) {
            __builtin_amdgcn_fence(__ATOMIC_RELEASE, "agent");
            asm volatile("s_waitcnt vmcnt(0)" ::: "memory");
            const unsigned og = xb_add(&bar[XB_TOP], 1u);
            const unsigned tg = og / nx;
            if (og + 1u == (tg + 1u) * nx) xb_add(&bar[XB_TOPGEN], 1u);
            else XB_SPIN(xb_ld(&bar[XB_TOPGEN]) == tg, bar);
            __builtin_amdgcn_fence(__ATOMIC_ACQUIRE, "agent");
            xb_add(&bar[XB_XGEN(b.x)], 1u);
            asm volatile("s_waitcnt vmcnt(0)" ::: "memory");
        } else {
            XB_SPIN(xb_ld(&bar[XB_XGEN(b.x)]) == gen, bar);
            __builtin_amdgcn_fence(__ATOMIC_ACQUIRE, "agent");
            asm volatile("s_waitcnt vmcnt(0)" ::: "memory");
        }
    }
    __syncthreads();
}

struct Frame {
    LAS unsigned char* lds;
    volatile LAS unsigned* MISC;
    gu32* ctl;
    int tid, lane, wave;
    int vcu, G;
    unsigned char* ws;
    const float *x, *c, *rel_bias, *w_ada, *b_ada, *g_norm1, *w_in, *w_gk_up, *b_gk_up, *g_gla_out, *g_qnorm, *g_knorm, *lq1, *lk1, *lq2, *lk2, *g_subln, *w_out,
                *g_norm2, *w_router, *b_router, *w_gate_up, *b_gate_up, *w_down, *b_down;
    float* out;
};
template <class Tp> __device__ __forceinline__ Tp* wsp(const Frame& F, size_t off) { return (Tp*)(F.ws + off); }

__device__ __forceinline__ void tr_item(const float* W, int ldw, int k0, int src0, bf16* WT, int K, int drow0, LAS float* scr, int lane) {
#pragma unroll 8
    for (int i = 0; i < 32; ++i) { const int kk = 2 * i + (lane >> 5); scr[kk * 33 + (lane & 31)] = W[(size_t)(k0 + kk) * ldw + src0 + (lane & 31)]; }
    LDS_WAIT(); asm volatile("" ::: "memory");
    const int c = lane & 7;
#pragma unroll
    for (int j = 0; j < 4; ++j) { const int n = (lane >> 3) + 8 * j; const LAS float* s = scr + (8 * c) * 33 + n;
        v4u o; o.x = pk2(s[0 * 33], s[1 * 33]); o.y = pk2(s[2 * 33], s[3 * 33]); o.z = pk2(s[4 * 33], s[5 * 33]); o.w = pk2(s[6 * 33], s[7 * 33]);
        *(GAS v4u*)(WT + (size_t)(drow0 + n) * K + k0 + 8 * c) = o; }
    LDS_WAIT(); asm volatile("" ::: "memory");
}
__device__ __forceinline__ unsigned pk4_fp8(float a, float b, float c, float d) { int p = __builtin_amdgcn_cvt_pk_fp8_f32(a, b, 0, false); p = __builtin_amdgcn_cvt_pk_fp8_f32(c, d, p, true); return (unsigned)p; }
__device__ __forceinline__ void tr_item_fp8(const float* W, int ldw, int k0, int src0, unsigned char* WT, int K, int drow0, float sc, LAS float* scr, int lane) {
    { float tmp[32]; const float* wp = W + (size_t)(k0 + (lane >> 5)) * ldw + src0 + (lane & 31);
#pragma unroll
      for (int i = 0; i < 32; ++i) tmp[i] = __builtin_nontemporal_load(wp + (size_t)(2 * i) * ldw);
#pragma unroll
      for (int i = 0; i < 32; ++i) scr[(2 * i + (lane >> 5)) * 33 + (lane & 31)] = tmp[i] * sc; }
    LDS_WAIT(); asm volatile("" ::: "memory");
    const int c = lane & 3;
#pragma unroll
    for (int j = 0; j < 2; ++j) { const int n = (lane >> 2) + 16 * j; const LAS float* s = scr + (16 * c) * 33 + n;
        v4u o;
#pragma unroll
        for (int q = 0; q < 4; ++q) o[q] = pk4_fp8(s[(4 * q) * 33], s[(4 * q + 1) * 33], s[(4 * q + 2) * 33], s[(4 * q + 3) * 33]);
        *(GAS v4u*)(WT + (size_t)(drow0 + n) * K + k0 + 16 * c) = o; }
    LDS_WAIT(); asm volatile("" ::: "memory");
}
__device__ __forceinline__ int win_src0(int ng) {
    const int pn = ng >> 3, gi = ng & 7, bj = gi >> 2, wc = gi & 3;
    if (pn < 6) return pn * 256 + gi * 32;
    if (pn < 10) { const int base = (pn < 8) ? 1552 : 2064; const int gq = 4 * ((pn - 6) & 1) + wc; return base + 64 * gq + 32 * bj; }
    return 2576 + (pn - 10) * 256 + gi * 32;
}
__device__ __forceinline__ void p0_phase(Frame& F) {
    LAS float* scr = (LAS float*)(F.lds + F.wave * 16384);
    const int gw = F.vcu * NWAVES + F.wave, NGW = F.G * NWAVES, lane = F.lane;
    for (int it = gw; it < 768; it += NGW) {
        const int cg = it % 96, ks = it / 96, j = cg * 64 + lane;
#pragma unroll
        for (int q = 0; q < 8; ++q) { const int idx = q * 64 + lane, b = idx >> 7, kk = idx & 127; const float cv = F.c[b * 1024 + ks * 128 + kk]; scr[idx] = cv * sigmoidf_(cv); }
        LDS_WAIT(); asm volatile("" ::: "memory");
        float a0 = 0.f, a1 = 0.f, a2 = 0.f, a3 = 0.f;
        const float* wp = F.w_ada + (size_t)(ks * 128) * 6144 + j;
#pragma unroll 32
        for (int kk = 0; kk < 128; ++kk) { const float w = wp[(size_t)kk * 6144]; a0 += scr[kk] * w; a1 += scr[128 + kk] * w; a2 += scr[256 + kk] * w; a3 += scr[384 + kk] * w; }
        float* mp = wsp<float>(F, WS_MODP) + (size_t)(ks * 4) * 6144 + j;
        mp[0] = a0; mp[6144] = a1; mp[2 * 6144] = a2; mp[3 * 6144] = a3;
        LDS_WAIT(); asm volatile("" ::: "memory");
    }
    constexpr int I_IN = 96 * 16, I_OUT = 32 * 16, I_GU = 32 * 64 * 16, I_D = 32 * 32 * 16;
    constexpr int NITEMS = I_IN + I_OUT + I_GU + I_D;
    for (int it = gw; it < NITEMS; it += NGW) {
        int r = it;
        if (r < I_IN) { const int kb = r / 96, ng = r % 96; tr_item(F.w_in, INW, kb * 64, win_src0(ng), wsp<bf16>(F, WS_WIN), 1024, ng * 32, scr, lane); continue; } r -= I_IN;
        if (r < I_OUT) { const int kb = r / 32, ng = r % 32; tr_item(F.w_out, 1024, kb * 64, ng * 32, wsp<bf16>(F, WS_WOUT), 1024, ng * 32, scr, lane); continue; } r -= I_OUT;
        if (r < I_GU) { const int e = r / 1024, q = r % 1024, kb = q / 64, dg = q % 64, pn = dg >> 3, gi = dg & 7, bj = gi >> 2, j32 = gi & 3;
            tr_item_fp8(F.w_gate_up + (size_t)e * 1024 * 2048, 2048, kb * 64, bj * 1024 + pn * 128 + j32 * 32, wsp<unsigned char>(F, WS_WGU) + (size_t)e * 2048 * 1024, 1024, dg * 32, WSCALE, scr, lane); continue; } r -= I_GU;
        { const int e = r / 512, q = r % 512, kb = q / 32, ng = q % 32;
            tr_item_fp8(F.w_down + (size_t)e * 1024 * 1024, 1024, kb * 64, ng * 32, wsp<unsigned char>(F, WS_WD) + (size_t)e * 1024 * 1024, 1024, ng * 32, WSCALE, scr, lane); }
    }
}

#ifndef SPREAD_ROWS
#define SPREAD_ROWS 0
#endif
__device__ __forceinline__ int srow(int gw, int i, int NGW) { return (SPREAD_ROWS && NGW * 16 == T) ? ((gw >> 9) * SEQ + i * 512 + (gw & 511)) : (gw * ((T + NGW - 1) / NGW) + i); }
__device__ __forceinline__ f32x4 mod_from_partials(const Frame& F, int b, int col) {
    const float* mp = wsp<const float>(F, WS_MODP) + (size_t)b * 6144 + col;
    f32x4 s = *(const f32x4*)(F.b_ada + col);
#pragma unroll
    for (int ks = 0; ks < 8; ++ks) s += *(const f32x4*)(mp + (size_t)ks * 4 * 6144);
    return s;
}
typedef float cf4p __attribute__((ext_vector_type(4)));
__device__ __forceinline__ void p1_phase(Frame& F) {
    const int tid = F.tid, lane = F.lane;
    constexpr int WLP = 1032;
    LAS bf16* wloT = (LAS bf16*)(F.lds);
    LAS bf16* wupT = (LAS bf16*)(F.lds + 36864);
    LAS float* bup = (LAS float*)(F.lds + 36864 + 16384);
    LAS float* tsc = (LAS float*)(F.lds + 36864 + 16384 + 1024) + F.wave * 288;
    { f32x4 t[8]; const int k0 = tid >> 2, r4 = (tid & 3) * 4;
#pragma unroll
      for (int it = 0; it < 8; ++it) t[it] = *(const f32x4*)(F.w_in + (size_t)(k0 + 128 * it) * INW + 1536 + r4);
#pragma unroll
      for (int it = 0; it < 8; ++it)
#pragma unroll
          for (int q = 0; q < 4; ++q) wloT[(r4 + q) * WLP + k0 + 128 * it] = (bf16)f2bf(t[it][q]); }
    { float t[8]; const int c = tid & 255, rh = tid >> 8;
#pragma unroll
      for (int j = 0; j < 8; ++j) t[j] = F.w_gk_up[(8 * rh + j) * 256 + c];
      v4u o; o.x = pk2(t[0], t[1]); o.y = pk2(t[2], t[3]); o.z = pk2(t[4], t[5]); o.w = pk2(t[6], t[7]);
      *(LAS v4u*)(wupT + c * 32 + 8 * rh) = o; *(LAS v4u*)(wupT + c * 32 + 16 + 8 * rh) = (v4u){0u, 0u, 0u, 0u}; }
    if (tid < 256) bup[tid] = F.b_gk_up[tid];
    { const int gt = F.vcu * 512 + tid; if (gt < 4 * 6144 / 4) { const int i = gt * 4, b = i / 6144, col = i % 6144; *(f32x4*)(wsp<float>(F, WS_MOD) + i) = mod_from_partials(F, b, col); } }
    __syncthreads();
    const int gw = F.vcu * NWAVES + F.wave, NGW = F.G * NWAVES;
    int curb = -1; f32x4 gsc[4], shv[4];
    for (int grp = gw; grp < T / 16; grp += NGW) {
#define ROWI(i) srow(grp, (i), T / 16)
        const int m0 = ROWI(0);
        f32x4 nx[4];
        { const GAS f32x4* xr = (const GAS f32x4*)(F.x + (size_t)m0 * D) + lane;
#pragma unroll
          for (int j = 0; j < 4; ++j) nx[j] = xr[64 * j]; }
        { const int b = m0 / SEQ;
          if (b != curb) { curb = b;
#pragma unroll
              for (int j = 0; j < 4; ++j) { const int col = 256 * j + 4 * lane; const f32x4 g = *(const f32x4*)(F.g_norm1 + col);
                  shv[j] = mod_from_partials(F, b, col); gsc[j] = g * (mod_from_partials(F, b, 1024 + col) + 1.0f); } } }
#pragma nounroll
        for (int i = 0; i < 16; ++i) {
            const int m = ROWI(i);
            f32x4 v[4]; float s = 0.f;
#pragma unroll
            for (int j = 0; j < 4; ++j) { v[j] = nx[j]; s += (v[j].x * v[j].x + v[j].y * v[j].y) + (v[j].z * v[j].z + v[j].w * v[j].w); }
            { const GAS f32x4* xr = (const GAS f32x4*)(F.x + (size_t)ROWI(i + 1 < 16 ? i + 1 : i) * D) + lane;
#pragma unroll
              for (int j = 0; j < 4; ++j) nx[j] = xr[64 * j]; }
            const float rstd = rsqrtf(wave_sum(s) * (1.f / D) + EPS);
            GAS v2u* o8 = (GAS v2u*)(wsp<bf16>(F, WS_XN) + (size_t)m * D) + lane;
#pragma unroll
            for (int j = 0; j < 4; ++j) { v[j] = v[j] * rstd * gsc[j] + shv[j]; v2u o; o.x = pk2(v[j].x, v[j].y); o.y = pk2(v[j].z, v[j].w); o8[64 * j] = o; }
        }
        __builtin_amdgcn_fence(__ATOMIC_RELEASE, "workgroup"); asm volatile("s_waitcnt vmcnt(0)" ::: "memory"); __builtin_amdgcn_fence(__ATOMIC_ACQUIRE, "workgroup");
        int lb = lane; asm volatile("" : "+v"(lb));
        const int l15 = lb & 15, q4 = lb >> 4;
        cf4p acc = {0.f, 0.f, 0.f, 0.f};
        { const bf16* arow = wsp<const bf16>(F, WS_XN) + (size_t)ROWI(l15) * D + 8 * q4; const LAS bf16* brow = wloT + l15 * WLP + 8 * q4;
#pragma unroll 4
          for (int sI = 0; sI < 32; ++sI) { const bf16x8 fa = *(const bf16x8*)(arow + 32 * sI); const bf16x8 fb = *(const LAS bf16x8*)(brow + 32 * sI);
              acc = __builtin_amdgcn_mfma_f32_16x16x32_bf16(fa, fb, acc, 0, 0, 0); } }
#pragma unroll
        for (int r = 0; r < 4; ++r) tsc[(4 * q4 + r) * 17 + l15] = acc[r];
        LDS_WAIT(); asm volatile("" ::: "memory");
        bf16x8 fa2;
        { float t8[8];
#pragma unroll
          for (int j = 0; j < 8; ++j) t8[j] = (q4 < 2) ? tsc[l15 * 17 + 8 * (q4 & 1) + j] : 0.f;
          v4u pk; pk.x = pk2(t8[0], t8[1]); pk.y = pk2(t8[2], t8[3]); pk.z = pk2(t8[4], t8[5]); pk.w = pk2(t8[6], t8[7]); fa2 = __builtin_bit_cast(bf16x8, pk); }
        float* GK = wsp<float>(F, WS_GK);
#pragma unroll 4
        for (int t = 0; t < 16; ++t) { const bf16x8 fb2 = *(const LAS bf16x8*)(wupT + (16 * t + l15) * 32 + 8 * q4);
            cf4p z = {0.f, 0.f, 0.f, 0.f}; z = __builtin_amdgcn_mfma_f32_16x16x32_bf16(fa2, fb2, z, 0, 0, 0);
            const float bb = bup[16 * t + l15];
#pragma unroll
            for (int r = 0; r < 4; ++r) { const float zz = z[r] + bb; GK[(size_t)ROWI(4 * q4 + r) * 256 + 16 * t + l15] = (fminf(zz, 0.f) - __logf(1.f + __expf(-fabsf(zz)))) * (1.f / 16.f); } }
        LDS_WAIT(); asm volatile("" ::: "memory");
#undef ROWI
    }
}

using pg8::Unit;
typedef pg8::f32x4 af4;
struct EpiInProj {
    static constexpr bool PERM = true;
    bf16 *QG, *KG, *VG, *RG, *QD, *KD, *VD; const float *gq, *gk;
    __device__ __forceinline__ void operator()(const af4 (&acc)[2][2][4][2], const Unit& u, int wr, int wc, int fr, int fq) const {
        const int pn = u.pn; const int row0 = u.pm * 256 + wr * 64 + fr;
        if (pn >= 6 && pn < 10) {
            const bool isq = pn < 8; bf16* base = isq ? QD : KD; const float* g = isq ? gq : gk; const float sc = isq ? C2 : 1.f;
            const int grp = 4 * ((pn - 6) & 1) + wc;
            af4 gv[2][2];
#pragma unroll
            for (int bj = 0; bj < 2; ++bj)
#pragma unroll
                for (int n = 0; n < 2; ++n) gv[bj][n] = *(const af4*)(g + 32 * bj + 8 * fq + 4 * n) * sc;
#pragma unroll
            for (int ai = 0; ai < 2; ++ai)
#pragma unroll
                for (int m = 0; m < 4; ++m) {
                    float ss = 0.f;
#pragma unroll
                    for (int bj = 0; bj < 2; ++bj)
#pragma unroll
                        for (int n = 0; n < 2; ++n) { const af4 v = acc[ai][bj][m][n]; ss += (v[0] * v[0] + v[1] * v[1]) + (v[2] * v[2] + v[3] * v[3]); }
                    ss += __shfl_xor(ss, 16); ss += __shfl_xor(ss, 32);
                    const float rs = rsqrtf(ss * (1.f / 64.f) + EPS);
                    bf16* rowp = base + (size_t)(row0 + ai * 128 + m * 16) * 512 + grp * 64 + 8 * fq;
#pragma unroll
                    for (int bj = 0; bj < 2; ++bj) { const af4 v0 = acc[ai][bj][m][0] * rs * gv[bj][0], v1 = acc[ai][bj][m][1] * rs * gv[bj][1];
                        pg8::u32x4 w; w.x = pg8::cvt_pk_bf16(v0[0], v0[1]); w.y = pg8::cvt_pk_bf16(v0[2], v0[3]); w.z = pg8::cvt_pk_bf16(v1[0], v1[1]); w.w = pg8::cvt_pk_bf16(v1[2], v1[3]);
                        *(pg8::u32x4*)(rowp + 32 * bj) = w; }
                }
        } else {
            bf16* base; int pitch, colt; int act = 0;
            if (pn == 0) { base = QG; pitch = 256; colt = 0; act = 1; }
            else if (pn == 1) { base = KG; pitch = 256; colt = 0; }
            else if (pn < 4) { base = VG; pitch = 512; colt = (pn - 2) * 256; }
            else if (pn < 6) { base = RG; pitch = 512; colt = (pn - 4) * 256; act = 2; }
            else { base = VD; pitch = 512; colt = (pn - 10) * 256; }
            const int col0 = colt + wc * 32 + 8 * fq;
#pragma unroll
            for (int ai = 0; ai < 2; ++ai)
#pragma unroll
                for (int m = 0; m < 4; ++m) { bf16* rowp = base + (size_t)(row0 + ai * 128 + m * 16) * pitch + col0;
#pragma unroll
                    for (int bj = 0; bj < 2; ++bj) { af4 v0 = acc[ai][bj][m][0], v1 = acc[ai][bj][m][1];
                        if (act == 1) { v0 = v0 * 0.125f; v1 = v1 * 0.125f; }
                        if (act == 2) {
#pragma unroll
                            for (int q = 0; q < 4; ++q) { v0[q] = v0[q] * sigmoidf_(v0[q]); v1[q] = v1[q] * sigmoidf_(v1[q]); } }
                        pg8::u32x4 w; w.x = pg8::cvt_pk_bf16(v0[0], v0[1]); w.y = pg8::cvt_pk_bf16(v0[2], v0[3]); w.z = pg8::cvt_pk_bf16(v1[0], v1[1]); w.w = pg8::cvt_pk_bf16(v1[2], v1[3]);
                        *(pg8::u32x4*)(rowp + bj * 128) = w; } }
        }
    }
};
struct EpiOutProj {
    static constexpr bool PERM = true;
    bf16* mix; const float* mod;
    __device__ __forceinline__ void operator()(const af4 (&acc)[2][2][4][2], const Unit& u, int wr, int wc, int fr, int fq) const {
        const int b = (u.pm * 256) / SEQ; const int col0 = u.pn * 256 + wc * 32 + 8 * fq;
        af4 gt[2][2];
#pragma unroll
        for (int bj = 0; bj < 2; ++bj)
#pragma unroll
            for (int n = 0; n < 2; ++n) gt[bj][n] = *(const af4*)(mod + (size_t)b * 6144 + 2048 + col0 + bj * 128 + 4 * n);
#pragma unroll
        for (int ai = 0; ai < 2; ++ai)
#pragma unroll
            for (int m = 0; m < 4; ++m) { bf16* rowp = mix + (size_t)(u.pm * 256 + ai * 128 + wr * 64 + m * 16 + fr) * D + col0;
#pragma unroll
                for (int bj = 0; bj < 2; ++bj) { const af4 v0 = acc[ai][bj][m][0] * gt[bj][0], v1 = acc[ai][bj][m][1] * gt[bj][1];
                    pg8::u32x4 w; w.x = pg8::cvt_pk_bf16(v0[0], v0[1]); w.y = pg8::cvt_pk_bf16(v0[2], v0[3]); w.z = pg8::cvt_pk_bf16(v1[0], v1[1]); w.w = pg8::cvt_pk_bf16(v1[2], v1[3]);
                    *(pg8::u32x4*)(rowp + bj * 128) = w; } }
    }
};
struct EpiSwiGLU {
    static constexpr bool PERM = false;
    unsigned char* Y; const float* bgu;
    __device__ __forceinline__ void operator()(const af4 (&acc)[2][2][4][2], const Unit& u, int wr, int wc, int fr, int fq) const {
        const int f0 = u.pn * 128 + wc * 32 + 4 * fq; const float* bb = bgu + (size_t)u.e * 2048 + f0;
        af4 bg[2], bu[2];
#pragma unroll
        for (int n = 0; n < 2; ++n) { bg[n] = *(const af4*)(bb + 16 * n); bu[n] = *(const af4*)(bb + 1024 + 16 * n); }
#pragma unroll
        for (int ai = 0; ai < 2; ++ai)
#pragma unroll
            for (int m = 0; m < 4; ++m) { unsigned char* rowp = Y + (size_t)(u.pm * 256 + ai * 128 + wr * 64 + m * 16 + fr) * FF + f0;
#pragma unroll
                for (int n = 0; n < 2; ++n) { const af4 g = acc[ai][0][m][n] * WSCALE_INV + bg[n], up = acc[ai][1][m][n] * WSCALE_INV + bu[n]; af4 y;
#pragma unroll
                    for (int q = 0; q < 4; ++q) { const float gg = fminf(g[q], 7.f), uu = fminf(fmaxf(up[q], -7.f), 7.f); y[q] = (uu + 1.f) * gg * sigmoidf_(1.702f * gg); }
                    *(unsigned*)(rowp + 16 * n) = pk4_fp8(y[0], y[1], y[2], y[3]); } }
    }
};
struct EpiDown {
    static constexpr bool PERM = true;
    unsigned char* Cn; const float* bd;
    __device__ __forceinline__ void operator()(const af4 (&acc)[2][2][4][2], const Unit& u, int wr, int wc, int fr, int fq) const {
        const int col0 = u.pn * 256 + wc * 32 + 8 * fq; const float* bb = bd + (size_t)u.e * 1024 + col0;
        af4 bv[2][2];
#pragma unroll
        for (int bj = 0; bj < 2; ++bj)
#pragma unroll
            for (int n = 0; n < 2; ++n) bv[bj][n] = *(const af4*)(bb + bj * 128 + 4 * n);
#pragma unroll
        for (int ai = 0; ai < 2; ++ai)
#pragma unroll
            for (int m = 0; m < 4; ++m) { const int row = u.pm * 256 + ai * 128 + wr * 64 + m * 16 + fr; unsigned char* rowp = Cn + (size_t)row * 1024 + col0;
#pragma unroll
                for (int bj = 0; bj < 2; ++bj) { const af4 v0 = acc[ai][bj][m][0] * WSCALE_INV + bv[bj][0], v1 = acc[ai][bj][m][1] * WSCALE_INV + bv[bj][1];
                    v2u w; w.x = pk4_fp8(v0[0], v0[1], v0[2], v0[3]); w.y = pk4_fp8(v1[0], v1[1], v1[2], v1[3]); *(v2u*)(rowp + bj * 128) = w; } }
    }
};

typedef float cf4 __attribute__((ext_vector_type(4)));
#define MFMA16(a, b, c) __builtin_amdgcn_mfma_f32_16x16x32_bf16((a), (b), (c), 0, 0, 0)
constexpr int GP = 72;
__device__ __forceinline__ void gla_a_unit(Frame& F, int chunk) {
    const int tid = F.tid, lane = F.lane, w = F.wave;
    const int bh = chunk >> 7, n = chunk & 127, b = bh >> 2, h = bh & 3;
    const size_t R0 = (size_t)b * SEQ + (size_t)n * 64;
    LAS float* gc = (LAS float*)F.lds;
    LAS float* segt = (LAS float*)(F.lds + 16384);
    LAS bf16* QEs = (LAS bf16*)(F.lds + 18432);
    LAS bf16* KEs = (LAS bf16*)(F.lds + 18432 + 9216);
    LAS bf16* KST = (LAS bf16*)(F.lds + 18432 + 2 * 9216);
    LAS bf16* VT = (LAS bf16*)(F.lds + 18432 + 3 * 9216);
    LAS bf16* AM = (LAS bf16*)(F.lds + 18432 + 3 * 9216 + 18432);
    const float* GK = wsp<const float>(F, WS_GK);
    { const int r = tid >> 3, d0 = (tid & 7) * 8; const float* gp = GK + (R0 + r) * 256 + h * 64 + d0;
      *(LAS f32x4*)(gc + r * 64 + d0) = *(const f32x4*)gp; *(LAS f32x4*)(gc + r * 64 + d0 + 4) = *(const f32x4*)(gp + 4); }
    __syncthreads();
    { const int seg = tid >> 6, d = tid & 63; float run = 0.f;
#pragma unroll
      for (int i = 0; i < 8; ++i) { run += gc[(seg * 8 + i) * 64 + d]; gc[(seg * 8 + i) * 64 + d] = run; }
      segt[seg * 64 + d] = run; }
    __syncthreads();
    { const int seg = tid >> 6, d = tid & 63; float off = 0.f;
      for (int s2 = 0; s2 < seg; ++s2) off += segt[s2 * 64 + d];
#pragma unroll
      for (int i = 0; i < 8; ++i) gc[(seg * 8 + i) * 64 + d] += off; }
    __syncthreads();
    { const int r = tid >> 3, d0 = (tid & 7) * 8;
      const v4u qv = *(const v4u*)(wsp<const bf16>(F, WS_QG) + (R0 + r) * 256 + h * 64 + d0);
      const v4u kv = *(const v4u*)(wsp<const bf16>(F, WS_KG) + (R0 + r) * 256 + h * 64 + d0);
      float qf[8], kf[8];
#pragma unroll
      for (int i = 0; i < 4; ++i) { qf[2 * i] = bflo(qv[i]); qf[2 * i + 1] = bfhi(qv[i]); kf[2 * i] = bflo(kv[i]); kf[2 * i + 1] = bfhi(kv[i]); }
      float qe[8], ke[8];
#pragma unroll
      for (int i = 0; i < 8; ++i) { const float g = gc[r * 64 + d0 + i], gl = gc[63 * 64 + d0 + i];
          qe[i] = qf[i] * __expf(g); ke[i] = kf[i] * __expf(-g); KST[(d0 + i) * GP + r] = (bf16)f2bf(kf[i] * __expf(gl - g)); }
      v4u qo, ko;
#pragma unroll
      for (int i = 0; i < 4; ++i) { qo[i] = pk2(qe[2 * i], qe[2 * i + 1]); ko[i] = pk2(ke[2 * i], ke[2 * i + 1]); }
      *(LAS v4u*)(QEs + r * GP + d0) = qo; *(LAS v4u*)(KEs + r * GP + d0) = ko;
      *(v4u*)(wsp<bf16>(F, WS_QE) + (R0 + r) * 256 + h * 64 + d0) = qo;
      const int e0 = (tid & 7) * 16;
      const v4u va = *(const v4u*)(wsp<const bf16>(F, WS_VG) + (R0 + r) * 512 + h * 128 + e0);
      const v4u vb = *(const v4u*)(wsp<const bf16>(F, WS_VG) + (R0 + r) * 512 + h * 128 + e0 + 8);
#pragma unroll
      for (int i = 0; i < 4; ++i) { VT[(e0 + 2 * i) * GP + r] = (bf16)(va[i] & 0xffffu); VT[(e0 + 2 * i + 1) * GP + r] = (bf16)(va[i] >> 16);
                                    VT[(e0 + 8 + 2 * i) * GP + r] = (bf16)(vb[i] & 0xffffu); VT[(e0 + 8 + 2 * i + 1) * GP + r] = (bf16)(vb[i] >> 16); }
      if (tid < 64) wsp<float>(F, WS_DEC)[(size_t)chunk * 64 + tid] = __expf(gc[63 * 64 + tid]);
    }
    __syncthreads();
    const int l15 = lane & 15, l4 = lane >> 4;
#pragma unroll
    for (int q = 0; q < 2; ++q) { const int tile = 2 * w + q, ti = tile >> 2, tj = tile & 3;
        cf4 a = {0.f, 0.f, 0.f, 0.f};
        if (tj <= ti) {
#pragma unroll
            for (int kk = 0; kk < 2; ++kk) { const bf16x8 fa = *(const LAS bf16x8*)(QEs + (16 * ti + l15) * GP + kk * 32 + 8 * l4); const bf16x8 fb = *(const LAS bf16x8*)(KEs + (16 * tj + l15) * GP + kk * 32 + 8 * l4); a = MFMA16(fa, fb, a); } }
#pragma unroll
        for (int r = 0; r < 4; ++r) { const int cr = 16 * ti + 4 * l4 + r, cj = 16 * tj + l15; AM[cr * GP + cj] = (bf16)f2bf(cj <= cr ? a[r] : 0.f); } }
    { float* UT = wsp<float>(F, WS_UT) + (size_t)chunk * 8192;
#pragma unroll
      for (int td = 0; td < 4; ++td) { cf4 a = {0.f, 0.f, 0.f, 0.f};
#pragma unroll
          for (int kk = 0; kk < 2; ++kk) { const bf16x8 fa = *(const LAS bf16x8*)(VT + (16 * w + l15) * GP + kk * 32 + 8 * l4); const bf16x8 fb = *(const LAS bf16x8*)(KST + (16 * td + l15) * GP + kk * 32 + 8 * l4); a = MFMA16(fa, fb, a); }
#pragma unroll
          for (int r = 0; r < 4; ++r) UT[(16 * w + 4 * l4 + r) * 64 + 16 * td + l15] = a[r]; } }
    __syncthreads();
    { float* OI = wsp<float>(F, WS_OI);
#pragma unroll
      for (int tc = 0; tc < 4; ++tc) { cf4 a = {0.f, 0.f, 0.f, 0.f};
#pragma unroll
          for (int kk = 0; kk < 2; ++kk) { const bf16x8 fa = *(const LAS bf16x8*)(AM + (16 * tc + l15) * GP + kk * 32 + 8 * l4); const bf16x8 fb = *(const LAS bf16x8*)(VT + (16 * w + l15) * GP + kk * 32 + 8 * l4); a = MFMA16(fa, fb, a); }
#pragma unroll
          for (int r = 0; r < 4; ++r) OI[(R0 + 16 * tc + 4 * l4 + r) * 512 + h * 128 + 16 * w + l15] = a[r]; } }
    __syncthreads();
}
__device__ __forceinline__ void gla_b_phase(Frame& F) {
    const float* UT = wsp<const float>(F, WS_UT); const float* DEC = wsp<const float>(F, WS_DEC); bf16* SP = wsp<bf16>(F, WS_SP);
    for (int gt = F.vcu * 512 + F.tid; gt < 16 * 8192; gt += F.G * 512) {
        const int bh = gt >> 13, ed = gt & 8191, d = gt & 63; float S = 0.f;
#pragma unroll 8
        for (int n = 0; n < 128; ++n) { const size_t ch = (size_t)bh * 128 + n; const float u = UT[ch * 8192 + ed], dc = DEC[ch * 64 + d]; SP[ch * 8192 + ed] = (bf16)f2bf(S); S = S * dc + u; }
    }
}
__device__ __forceinline__ void gla_c_unit(Frame& F, int unit) {
    const int tid = F.tid, lane = F.lane, w = F.wave;
    const int bh = unit >> 6, n2 = unit & 63, b = bh >> 2, h = bh & 3;
    const size_t R0 = (size_t)b * SEQ + (size_t)n2 * 128;
    LAS bf16* QEs = (LAS bf16*)F.lds;
    LAS bf16* SPs = (LAS bf16*)(F.lds + 18432);
    { const int r = tid >> 2, d0 = (tid & 3) * 16; const bf16* src = wsp<const bf16>(F, WS_QE) + (R0 + r) * 256 + h * 64 + d0;
      *(LAS v4u*)(QEs + r * GP + d0) = *(const v4u*)src; *(LAS v4u*)(QEs + r * GP + d0 + 8) = *(const v4u*)(src + 8);
      const bf16* sp = wsp<const bf16>(F, WS_SP) + ((size_t)bh * 128 + 2 * n2) * 8192;
      const int row = tid >> 1, dd = (tid & 1) * 32;
#pragma unroll
      for (int i = 0; i < 4; ++i) *(LAS v4u*)(SPs + row * GP + dd + 8 * i) = *(const v4u*)(sp + (size_t)row * 64 + dd + 8 * i); }
    __syncthreads();
    const int l15 = lane & 15, l4 = lane >> 4, c2 = w >> 2, tc = w & 3;
    cf4 a[8];
#pragma unroll
    for (int te = 0; te < 8; ++te) { a[te] = (cf4){0.f, 0.f, 0.f, 0.f};
#pragma unroll
        for (int kk = 0; kk < 2; ++kk) { const bf16x8 fa = *(const LAS bf16x8*)(QEs + (64 * c2 + 16 * tc + l15) * GP + kk * 32 + 8 * l4); const bf16x8 fb = *(const LAS bf16x8*)(SPs + (128 * c2 + 16 * te + l15) * GP + kk * 32 + 8 * l4); a[te] = MFMA16(fa, fb, a[te]); } }
    const float* OI = wsp<const float>(F, WS_OI); const bf16* RG = wsp<const bf16>(F, WS_RG); bf16* A2 = wsp<bf16>(F, WS_A2);
    float gg[8];
#pragma unroll
    for (int te = 0; te < 8; ++te) gg[te] = F.g_gla_out[16 * te + l15];
#pragma unroll
    for (int r = 0; r < 4; ++r) { const size_t row = R0 + 64 * c2 + 16 * tc + 4 * l4 + r; float ss = 0.f; float o[8];
#pragma unroll
        for (int te = 0; te < 8; ++te) { o[te] = a[te][r] + OI[row * 512 + h * 128 + 16 * te + l15]; ss += o[te] * o[te]; }
        ss += __shfl_xor(ss, 1); ss += __shfl_xor(ss, 2); ss += __shfl_xor(ss, 4); ss += __shfl_xor(ss, 8);
        const float rs = rsqrtf(ss * (1.f / 128.f) + EPS);
#pragma unroll
        for (int te = 0; te < 8; ++te) { const int e = 16 * te + l15; A2[row * 1024 + h * 128 + e] = (bf16)f2bf(o[te] * rs * gg[te] * bf2f(RG[row * 512 + h * 128 + e])); } }
    __syncthreads();
}

namespace att {
constexpr int KSLOT = 8192, VSLOT = 16384, NSLOT = 3;
constexpr int LDS_K = 0, LDS_V = NSLOT * KSLOT, LDS_TBL = LDS_V + NSLOT * VSLOT, LDS_WS = LDS_TBL + 1024, LDS_Q = LDS_WS + 8 * 256, LDS_END = LDS_Q + 8 * 4096;
static_assert(LDS_END <= RING_BYTES, "attention LDS");
__device__ __forceinline__ int crow(int r, int hi) { return (r & 3) + 8 * (r >> 2) + 4 * hi; }
__device__ __forceinline__ void glds16(const void* gsrc, unsigned lds_dst) { unsigned keep;
    asm volatile("s_mov_b32 %0, m0\n\ts_mov_b32 m0, %2\n\ts_nop 0\n\tglobal_load_lds_dwordx4 %1, off\n\ts_mov_b32 m0, %0" : "=&s"(keep) : "v"(gsrc), "s"(lds_dst) : "memory"); }
typedef float f32x2_t __attribute__((ext_vector_type(2))); typedef __bf16 bf16x2_t __attribute__((ext_vector_type(2)));
__device__ __forceinline__ unsigned cvtpk_s(float lo, float hi) { f32x2_t v = {lo, hi}; bf16x2_t b = __builtin_convertvector(v, bf16x2_t); return __builtin_bit_cast(unsigned, b); }
typedef short v4i16_t __attribute__((ext_vector_type(4)));
typedef LAS const char* lds_cptr;
__device__ __forceinline__ s16x4 vtr(lds_cptr p) { return __builtin_bit_cast(s16x4, __builtin_amdgcn_ds_read_tr16_b64_v4i16((LAS v4i16_t*)p)); }
#define MFMA32(a, b, c) __builtin_amdgcn_mfma_f32_32x32x16_bf16((a), (b), (c), 0, 0, 0)
#define ATT_WAIT_BAR(N) asm volatile("s_waitcnt vmcnt(" #N ") lgkmcnt(0)\n\ts_barrier" ::: "memory")

__device__ __forceinline__ void attn_map(f32x16 (&o)[4], int b, int h, int m, int qb, const bf16* QD, const bf16* KD, const bf16* VD, LAS unsigned char* shm) {
    int lane = threadIdx.x & 63; asm volatile("" : "+v"(lane));
    const int tid = threadIdx.x, r32 = lane & 31, hi = lane >> 5; const int wid = __builtin_amdgcn_readfirstlane(tid >> 6);
    const size_t rowbase = (size_t)b * SEQ; const int q0 = qb * 256;
    const bf16* Qw = QD + (rowbase + q0 + wid * 32) * 512 + (h * 2 + m) * 64;
    const bf16* Kh = KD + rowbase * 512 + (h * 2 + m) * 64; const bf16* Vh = VD + rowbase * 512 + h * 128;
    const unsigned lds0 = (unsigned)(uintptr_t)shm;
    const LAS float* tbl = (const LAS float*)(shm + LDS_TBL) + m * 128;
    LAS float* wsf = (LAS float*)(shm + LDS_WS) + wid * 64;
    const bf16* ksrc = Kh + (size_t)lane * 512 + wid * 8;
    const bf16* vsrc = Vh + (size_t)(16 * (wid & 3) + (lane >> 2)) * 512 + (wid >> 2) * 32 + (lane & 3) * 8;
    const unsigned kdst = lds0 + LDS_K + wid * 1024, vdst = lds0 + LDS_V + wid * 1024;
#define DMA_K(t, slot) glds16(ksrc + (size_t)(t) * 64 * 512, (unsigned)__builtin_amdgcn_readfirstlane(kdst + (slot) * KSLOT))
#define DMA_V(t, slot) do { glds16(vsrc + (size_t)(t) * 64 * 512, (unsigned)__builtin_amdgcn_readfirstlane(vdst + (slot) * VSLOT)); \
        glds16(vsrc + (size_t)(t) * 64 * 512 + 64, (unsigned)__builtin_amdgcn_readfirstlane(vdst + (slot) * VSLOT + 8192)); } while (0)
    const int NT = 4 * qb + 4;
    VM_WAIT();
    DMA_K(0, 0); DMA_V(0, 0); DMA_K(1, 1); DMA_K(2, 2);
    const lds_cptr qlds = (lds_cptr)shm + LDS_Q + wid * 4096 + lane * 16;
    { bf16x8 qr[4];
#pragma unroll
      for (int d0 = 0; d0 < 4; ++d0) qr[d0] = *(const bf16x8*)(Qw + (size_t)r32 * 512 + d0 * 16 + hi * 8);
      asm volatile("s_waitcnt vmcnt(0)" : "+v"(qr[0]), "+v"(qr[1]), "+v"(qr[2]), "+v"(qr[3]) :: "memory");
#pragma unroll
      for (int d0 = 0; d0 < 4; ++d0) *(LAS bf16x8*)(shm + LDS_Q + wid * 4096 + lane * 16 + d0 * 1024) = qr[d0]; }
#pragma unroll
    for (int d0 = 0; d0 < 4; ++d0) o[d0] = (f32x16){};
    float lsum = 0.f;
    const int qw0 = q0 + wid * 32, qabs = qw0 + r32;
    const lds_cptr shm3 = (lds_cptr)shm;
    const lds_cptr kp0 = shm3 + LDS_K + hi * 1024 + r32 * 16;
    const lds_cptr vp0 = shm3 + LDS_V + ((lane >> 4) & 1) * 32 + (lane & 3) * 8 + (4 * hi + ((lane & 15) >> 2)) * 64;
#define QK_TILE(C0, C1, kp) do { C0 = (f32x16){}; C1 = (f32x16){}; \
        _Pragma("unroll") for (int d0 = 0; d0 < 4; ++d0) { if (d0 == 2) __builtin_amdgcn_sched_barrier(0); const bf16x8 b0 = *(const LAS bf16x8*)((kp) + d0 * 2048); const bf16x8 b1 = *(const LAS bf16x8*)((kp) + d0 * 2048 + 512); \
            const bf16x8 qf_ = *(const LAS bf16x8*)(qlds + d0 * 1024); C0 = MFMA32(b0, qf_, C0); C1 = MFMA32(b1, qf_, C1); } } while (0)
#define MASK_BIAS(C0, C1, t) do { const int kvb_ = (t) * 64; if (kvb_ + 191 > qw0) { int dbase = qabs - kvb_ - 4 * hi; asm volatile("" : "+v"(dbase)); \
        _Pragma("unroll") for (int r = 0; r < 16; ++r) { const int d0_ = dbase - ((r & 3) + 8 * (r >> 2)); const int d1_ = d0_ - 32; \
            const float t0_ = tbl[min(max(d0_, 0), 127)], t1_ = tbl[min(max(d1_, 0), 127)]; \
            C0[r] = d0_ < 0 ? -INFINITY : C0[r] + t0_; C1[r] = d1_ < 0 ? -INFINITY : C1[r] + t1_; } } } while (0)
#define VLOAD(vf, vp, d0) do { _Pragma("unroll") for (int ks = 0; ks < 4; ++ks) { const s16x4 lo_ = vtr((vp) + (d0) * 4096 + ks * 1024), hh_ = vtr((vp) + (d0) * 4096 + ks * 1024 + 512); \
            vf[ks] = (bf16x8){lo_[0], lo_[1], lo_[2], lo_[3], hh_[0], hh_[1], hh_[2], hh_[3]}; } } while (0)
#define PV4(d0, vf) do { _Pragma("unroll") for (int ks = 0; ks < 4; ++ks) o[d0] = MFMA32(__builtin_bit_cast(bf16x8, pw[ks]), vf[ks], o[d0]); } while (0)
#define PACK_SUM(P0, P1) do { float sacc = 0.f; _Pragma("unroll") for (int r = 0; r < 16; ++r) sacc += P0[r] + P1[r]; lsum += sacc; \
        _Pragma("unroll") for (int i = 0; i < 4; ++i) { pw[0][i] = cvtpk_s(P0[2 * i], P0[2 * i + 1]); pw[1][i] = cvtpk_s(P0[8 + 2 * i], P0[9 + 2 * i]); pw[2][i] = cvtpk_s(P1[2 * i], P1[2 * i + 1]); pw[3][i] = cvtpk_s(P1[8 + 2 * i], P1[9 + 2 * i]); } } while (0)
#define EXP_PACK(C, pwa, pwb) do { float sacc = 0.f; _Pragma("unroll") for (int r = 0; r < 16; ++r) { C[r] = __builtin_amdgcn_exp2f(C[r]); sacc += C[r]; } lsum += sacc; \
        _Pragma("unroll") for (int i = 0; i < 4; ++i) { pwa[i] = cvtpk_s(C[2 * i], C[2 * i + 1]); pwb[i] = cvtpk_s(C[8 + 2 * i], C[9 + 2 * i]); } } while (0)
#define KLOAD(kf, kp) do { _Pragma("unroll") for (int d0 = 0; d0 < 4; ++d0) { kf[2 * d0] = *(const LAS bf16x8*)((kp) + d0 * 2048); kf[2 * d0 + 1] = *(const LAS bf16x8*)((kp) + d0 * 2048 + 512); } } while (0)
#define QLOAD(qf) do { _Pragma("unroll") for (int d0 = 0; d0 < 4; ++d0) qf[d0] = *(const LAS bf16x8*)(qlds + d0 * 1024); } while (0)
#define QK8(C0, C1, kf, qf) do { C0 = (f32x16){}; C1 = (f32x16){}; _Pragma("unroll") for (int d0 = 0; d0 < 4; ++d0) { C0 = MFMA32(kf[2 * d0], qf[d0], C0); C1 = MFMA32(kf[2 * d0 + 1], qf[d0], C1); } } while (0)
#define SB() __builtin_amdgcn_sched_barrier(0)
    f32x16 C0, C1; v4u pw[4], pwn[4]; bf16x8 va[4], vb[4], kf[8], qf[4];
    ATT_WAIT_BAR(0);
    KLOAD(kf, kp0); QLOAD(qf);
    ATT_WAIT_BAR(0);
    if (3 < NT) DMA_K(3, 0);
    DMA_V(1, 1);
    QK8(C0, C1, kf, qf);
    MASK_BIAS(C0, C1, 0);
    EXP_PACK(C0, pw[0], pw[1]); EXP_PACK(C1, pw[2], pw[3]);
    KLOAD(kf, kp0 + KSLOT);
    int ks_cur = 1, vs_prev = 0;
    for (int t = 1; t < NT; ++t) {
        if (t + 2 < NT) { ATT_WAIT_BAR(3); } else { ATT_WAIT_BAR(2); }
        { const int vs_new = (vs_prev == 0) ? 2 : vs_prev - 1;
          if (t + 3 < NT) DMA_K(t + 3, ks_cur);
          if (t + 1 < NT) DMA_V(t + 1, vs_new); }
        const int ks_next = (ks_cur == 2) ? 0 : ks_cur + 1;
        const lds_cptr vp = vp0 + vs_prev * VSLOT;
        SB();
        VLOAD(va, vp, 0); VLOAD(vb, vp, 1);
        SB();
        QK8(C0, C1, kf, qf);
        SB();
        MASK_BIAS(C0, C1, t);
        SB();
        PV4(0, va); PV4(1, vb);
        EXP_PACK(C0, pwn[0], pwn[1]);
        SB();
        VLOAD(va, vp, 2); VLOAD(vb, vp, 3);
        KLOAD(kf, kp0 + ks_next * KSLOT);
        SB();
        PV4(2, va); PV4(3, vb);
        EXP_PACK(C1, pwn[2], pwn[3]);
        SB();
#pragma unroll
        for (int i = 0; i < 4; ++i) pw[i] = pwn[i];
        ks_cur = ks_next; vs_prev = (vs_prev == 2) ? 0 : vs_prev + 1;
    }
    ATT_WAIT_BAR(0);
    { const lds_cptr vp = vp0 + vs_prev * VSLOT;
      VLOAD(va, vp, 0); VLOAD(vb, vp, 1); PV4(0, va); PV4(1, vb);
      VLOAD(va, vp, 2); VLOAD(vb, vp, 3); PV4(2, va); PV4(3, vb); }
    { auto rr = __builtin_amdgcn_permlane32_swap(__float_as_uint(lsum), __float_as_uint(lsum), false, false); lsum = __uint_as_float(rr[0]) + __uint_as_float(rr[1]); }
    if (hi == 0) wsf[r32] = lsum;
    LDS_WAIT();
#pragma unroll
    for (int r = 0; r < 16; ++r) { const float rl = 1.0f / wsf[crow(r, hi)];
#pragma unroll
        for (int d0 = 0; d0 < 4; ++d0) o[d0][r] *= rl; }
    ATT_WAIT_BAR(0);
#undef DMA_K
#undef DMA_V
#undef QK_TILE
#undef MASK_BIAS
#undef VLOAD
#undef PV4
#undef PACK_SUM
#undef EXP_PACK
#undef KLOAD
#undef QLOAD
#undef QK8
#undef SB
}
__device__ __forceinline__ int t5_bucket(int n) {
    if (n < 16) return n;
    const float nf = (float)n; int large = 16 + (int)(logf(nf / 16.f) / logf(8.f) * 16.f);
    return large < 31 ? large : 31;
}
__device__ __forceinline__ void attn_unit(Frame& F, int b, int h, int qb, float lam) {
    LAS unsigned char* shm = F.lds;
    int tid = F.tid; asm volatile("" : "+v"(tid));
    const int lane = tid & 63, r32 = lane & 31, hi = lane >> 5, wid = F.wave;
    if (tid < 256) { const int m = tid >> 7, d = tid & 127; const int col = h * 2 + m;
        ((LAS float*)(shm + LDS_TBL))[tid] = (F.rel_bias[t5_bucket(d) * 8 + col] - F.rel_bias[31 * 8 + col]) * LOG2E; }
    __syncthreads();
    const bf16* QD = wsp<const bf16>(F, WS_QD); const bf16* KD = wsp<const bf16>(F, WS_KD); const bf16* VD = wsp<const bf16>(F, WS_VD);
    float* stash = wsp<float>(F, WS_STASH) + (size_t)F.vcu * 32768 + tid * 64;
    f32x16 o[4];
#pragma nounroll
    for (int m = 0; m < 2; ++m) {
        attn_map(o, b, h, m, qb, QD, KD, VD, shm);
        if (m == 0) {
#pragma unroll
            for (int d0 = 0; d0 < 4; ++d0)
#pragma unroll
                for (int r = 0; r < 16; r += 4) *(f32x4*)(stash + d0 * 16 + r) = (f32x4){o[d0][r], o[d0][r + 1], o[d0][r + 2], o[d0][r + 3]};
        } else {
            float ss[16];
#pragma unroll
            for (int r = 0; r < 16; ++r) ss[r] = 0.f;
#pragma unroll
            for (int d0 = 0; d0 < 4; ++d0)
#pragma unroll
                for (int r4 = 0; r4 < 16; r4 += 4) { const f32x4 sv = *(const f32x4*)(stash + d0 * 16 + r4);
#pragma unroll
                    for (int q = 0; q < 4; ++q) { const int r = r4 + q; const float v = sv[q] - lam * o[d0][r]; o[d0][r] = v; ss[r] += v * v; } }
            float gs[4];
#pragma unroll
            for (int d0 = 0; d0 < 4; ++d0) gs[d0] = F.g_subln[32 * d0 + r32] * 0.8f;
            bf16* A2 = wsp<bf16>(F, WS_A2);
            const size_t rowb = (size_t)b * SEQ + (size_t)qb * 256 + wid * 32;
            bf16* a2b = A2 + (rowb + 4 * hi) * 1024 + 512 + h * 128 + r32; asm volatile("" : "+v"(a2b));
#pragma unroll
            for (int r = 0; r < 16; ++r) { float s = ss[r];
                s += __shfl_xor(s, 1); s += __shfl_xor(s, 2); s += __shfl_xor(s, 4); s += __shfl_xor(s, 8); s += __shfl_xor(s, 16);
                const float rs = rsqrtf(s * (1.f / 128.f) + EPS);
                bf16* rowp = a2b + (size_t)((r & 3) + 8 * (r >> 2)) * 1024;
#pragma unroll
                for (int d0 = 0; d0 < 4; ++d0) rowp[32 * d0] = (bf16)f2bf(o[d0][r] * rs * gs[d0]); }
        }
    }
    __syncthreads();
}
}

__device__ __forceinline__ void p7_phase(Frame& F, bool count = true) {
    const int tid = F.tid, lane = F.lane;
    LAS float* wr = (LAS float*)F.lds;
    LAS unsigned* hist = (LAS unsigned*)(F.lds + HIST_OFF);
    { f32x4 t[16]; const int k0 = tid >> 3, e4 = (tid & 7) * 4;
#pragma unroll
      for (int it = 0; it < 16; ++it) t[it] = *(const f32x4*)(F.w_router + (size_t)(k0 + 64 * it) * 32 + e4);
#pragma unroll
      for (int it = 0; it < 16; ++it)
#pragma unroll
          for (int q = 0; q < 4; ++q) wr[(e4 + q) * 1024 + k0 + 64 * it] = t[it][q]; }
    if (tid < 32) hist[tid] = 0u;
    __syncthreads();
    const float* MOD = wsp<const float>(F, WS_MOD);
    const int gw = F.vcu * NWAVES + F.wave, NGW = F.G * NWAVES; const int rpw = (T + NGW - 1) / NGW;
    int curb = -1; f32x4 gsc[4], shv[4], nx[4];
    v2u nm[4]; const bf16* MIX = wsp<const bf16>(F, WS_MIX);
    { const int m0 = (srow(gw, 0, NGW) < T) ? srow(gw, 0, NGW) : 0; const GAS f32x4* xr = (const GAS f32x4*)(F.x + (size_t)m0 * D) + lane; const GAS v2u* mr = (const GAS v2u*)(MIX + (size_t)m0 * D) + lane;
#pragma unroll
      for (int j = 0; j < 4; ++j) { nx[j] = xr[64 * j]; nm[j] = mr[64 * j]; } }
#pragma nounroll
    for (int i = 0; i < rpw; ++i) {
        const int m = srow(gw, i, NGW); if (m >= T) break;
        const int b = m / SEQ;
        if (b != curb) { curb = b;
#pragma unroll
            for (int j = 0; j < 4; ++j) { const int col = 256 * j + 4 * lane; const f32x4 g = *(const f32x4*)(F.g_norm2 + col);
                shv[j] = *(const f32x4*)(MOD + (size_t)b * 6144 + 3072 + col); gsc[j] = g * (*(const f32x4*)(MOD + (size_t)b * 6144 + 4096 + col) + 1.0f); } }
        f32x4 v[4]; float s = 0.f;
#pragma unroll
        for (int j = 0; j < 4; ++j) { v[j] = nx[j] + (f32x4){bflo(nm[j].x), bfhi(nm[j].x), bflo(nm[j].y), bfhi(nm[j].y)}; s += (v[j].x * v[j].x + v[j].y * v[j].y) + (v[j].z * v[j].z + v[j].w * v[j].w); }
        { const int mn_ = srow(gw, i + 1, NGW); const int m2 = (i + 1 < rpw && mn_ < T) ? mn_ : m; const GAS f32x4* xr = (const GAS f32x4*)(F.x + (size_t)m2 * D) + lane; const GAS v2u* mr = (const GAS v2u*)(MIX + (size_t)m2 * D) + lane;
#pragma unroll
          for (int j = 0; j < 4; ++j) { nx[j] = xr[64 * j]; nm[j] = mr[64 * j]; } }
        const float rstd = rsqrtf(wave_sum(s) * (1.f / D) + EPS);
        GAS unsigned* o4 = (GAS unsigned*)(wsp<unsigned char>(F, WS_XN) + (size_t)m * D) + lane;
#pragma unroll
        for (int j = 0; j < 4; ++j) { v[j] = v[j] * rstd * gsc[j] + shv[j]; o4[64 * j] = pk4_fp8(v[j].x, v[j].y, v[j].z, v[j].w); }
        float lg[32];
        { f32x4 wa[8], wb[8];
#define P7_LD(dst, eb) do { _Pragma("unroll") for (int q = 0; q < 8; ++q) dst[q] = *(const LAS f32x4*)(wr + ((eb) * 2 + (q >> 2)) * 1024 + 256 * (q & 3) + 4 * lane); } while (0)
#define P7_DOT(src, eb) do { _Pragma("unroll") for (int rr = 0; rr < 2; ++rr) { f32x2 a2 = {0.f, 0.f}; _Pragma("unroll") for (int j = 0; j < 4; ++j) { const f32x4 w = src[rr * 4 + j]; a2 += v[j].lo * w.lo; a2 += v[j].hi * w.hi; } lg[(eb) * 2 + rr] = a2.x + a2.y; } } while (0)
          P7_LD(wa, 0); __builtin_amdgcn_sched_barrier(0);
#pragma unroll
          for (int eb = 0; eb < 16; eb += 2) {
              P7_LD(wb, eb + 1); __builtin_amdgcn_sched_barrier(0);
              P7_DOT(wa, eb); __builtin_amdgcn_sched_barrier(0);
              if (eb + 2 < 16) { P7_LD(wa, eb + 2); __builtin_amdgcn_sched_barrier(0); }
              P7_DOT(wb, eb + 1); __builtin_amdgcn_sched_barrier(0);
          }
#undef P7_LD
#undef P7_DOT
        }
        const float myl = xreduce<32>(lg, lane) + F.b_router[lane >> 1];
        unsigned key; { const unsigned u = __builtin_bit_cast(unsigned, myl); const unsigned o = (u & 0x80000000u) ? ~u : (u | 0x80000000u); key = (o & ~31u) | (unsigned)(31 - (lane >> 1)); }
        int te[4]; float tv[4];
#pragma unroll
        for (int k = 0; k < 4; ++k) { const unsigned mx = wave_umax(key); te[k] = 31 - (int)(mx & 31u); tv[k] = lane_bcast(myl, 2 * te[k]); key = (key == mx) ? 0u : key; }
        float ex[4], es = 0.f;
#pragma unroll
        for (int k = 0; k < 4; ++k) { ex[k] = __expf(tv[k] - tv[0]); es += ex[k]; }
        if (lane < 4) { const int e = lane == 0 ? te[0] : lane == 1 ? te[1] : lane == 2 ? te[2] : te[3]; const float w = (lane == 0 ? ex[0] : lane == 1 ? ex[1] : lane == 2 ? ex[2] : ex[3]) / es;
            wsp<int>(F, WS_TOPE)[(size_t)m * 4 + lane] = e; wsp<float>(F, WS_TOPW)[(size_t)m * 4 + lane] = w; __hip_atomic_fetch_add(hist + e, 1u, __ATOMIC_RELAXED, __HIP_MEMORY_SCOPE_WORKGROUP); }
    }
    __syncthreads();
    if (tid < 32 && count) __hip_atomic_fetch_add(F.ctl + CW_CNT + tid, hist[tid], RLX_AGENT);
}
__device__ __forceinline__ void moe_tables(Frame& F, int& nMt) {
    LAS unsigned char* te = F.lds + TILEE_OFF;
    LAS unsigned* nt = (LAS unsigned*)(F.lds + HIST_OFF);
    if (F.tid < 32) nt[F.tid] = ((unsigned)__hip_atomic_load(F.ctl + CW_CNT + F.tid, RLX_AGENT) + 255u) >> 8;
    __syncthreads();
    { int start = 0, mine0 = -1, mine1 = -1; const int t0 = F.tid, t1 = F.tid + 512;
#pragma unroll 8
      for (int e = 0; e < NE; ++e) { const int n = (int)nt[e]; if (t0 >= start && t0 < start + n) mine0 = e; if (t1 >= start && t1 < start + n) mine1 = e; start += n; }
      if (mine0 >= 0) te[t0] = (unsigned char)mine0;
      if (mine1 >= 0) te[t1] = (unsigned char)mine1;
      if (F.tid == 0) F.MISC[16] = (unsigned)start; }
    __syncthreads();
    nMt = __builtin_amdgcn_readfirstlane((int)F.MISC[16]);
}
__device__ __forceinline__ void p8_phase(Frame& F) {
    const int tid = F.tid, lane = F.lane;
    LAS unsigned* hist = (LAS unsigned*)(F.lds + HIST_OFF);
    if (tid < 128) hist[tid] = 0u;
    __syncthreads();
    const int gw = F.vcu * NWAVES + F.wave, NGW = F.G * NWAVES; const int rpw = (T + NGW - 1) / NGW;
    const int* TOPE = wsp<const int>(F, WS_TOPE);
    const int mw0 = gw * rpw;
    for (int c = 0; c < rpw; c += 16) { const int m = mw0 + c + (lane >> 2); if (c + (lane >> 2) < rpw && m < T) __hip_atomic_fetch_add(hist + TOPE[(size_t)m * 4 + (lane & 3)], 1u, __ATOMIC_RELAXED, __HIP_MEMORY_SCOPE_WORKGROUP); }
    __syncthreads();
    if (tid < 32) hist[96 + tid] = (__hip_atomic_load(F.ctl + CW_CNT + tid, RLX_AGENT) + 255u) & ~255u;
    __syncthreads();
    if (tid < 32) { unsigned pstart = 0; for (int e = 0; e < tid; ++e) pstart += hist[96 + e];
        hist[32 + tid] = pstart + __hip_atomic_fetch_add(F.ctl + CW_FILL + tid, hist[tid], RLX_AGENT); }
    __syncthreads();
    const unsigned char* H2 = wsp<const unsigned char>(F, WS_XN); unsigned char* XS = wsp<unsigned char>(F, WS_XS);
    for (int c = 0; c < rpw; c += 16) {
        const int mr = mw0 + c + (lane >> 2); const bool ok = (c + (lane >> 2) < rpw) && (mr < T);
        int pos = 0;
        if (ok) { const int e = TOPE[(size_t)mr * 4 + (lane & 3)]; pos = (int)(hist[32 + e] + __hip_atomic_fetch_add(hist + 64 + e, 1u, __ATOMIC_RELAXED, __HIP_MEMORY_SCOPE_WORKGROUP));
            wsp<int>(F, WS_POS)[(size_t)mr * 4 + (lane & 3)] = pos; }
        v4u rowv[16];
#pragma unroll
        for (int i = 0; i < 16; ++i) { const int m = mw0 + c + i; const int mm = (c + i < rpw && m < T) ? m : mw0; rowv[i] = *(const v4u*)(H2 + (size_t)mm * D + lane * 16); }
#pragma unroll
        for (int i = 0; i < 16; ++i) { const int m = mw0 + c + i; const bool rok = (c + i < rpw) && (m < T);
#pragma unroll
            for (int k = 0; k < 4; ++k) { const int p = __shfl(pos, 4 * i + k); if (rok) *(v4u*)(XS + (size_t)p * D + lane * 16) = rowv[i]; } }
    }
}
__device__ __forceinline__ void p11_phase(Frame& F) {
    const int lane = F.lane;
    const float* MOD = wsp<const float>(F, WS_MOD); const unsigned char* CN = wsp<const unsigned char>(F, WS_CN); const int* POS = wsp<const int>(F, WS_POS);
    const int gw = F.vcu * NWAVES + F.wave, NGW = F.G * NWAVES; const int rpw = (T + NGW - 1) / NGW;
    const int nrow = (srow(gw, 0, NGW) < T) ? ((srow(gw, rpw - 1, NGW) < T) ? rpw : 0) : 0;
    int cnt = nrow; if (NGW * 16 != T) { cnt = 0; for (int i = 0; i < rpw; ++i) if (srow(gw, i, NGW) < T) ++cnt; }
    if (cnt == 0) return;
#define RW(i) srow(gw, ((i) < cnt ? (i) : cnt - 1), NGW)
    v4u ca[4], mx0, mx1; f32x4 xv[4]; int pn[4]; f32x4 wcur, wnxt; const float* TOPW = wsp<const float>(F, WS_TOPW); const bf16* MIXp = wsp<const bf16>(F, WS_MIX);
#define P11_LOAD(mm) do { _Pragma("unroll") for (int k = 0; k < 4; ++k) ca[k] = *(const v4u*)(CN + (size_t)pn[k] * D + lane * 16); \
        _Pragma("unroll") for (int q = 0; q < 4; ++q) xv[q] = *(const f32x4*)(F.x + (size_t)(mm) * D + lane * 16 + 4 * q); \
        { const v4u* ms_ = (const v4u*)(MIXp + (size_t)(mm) * D + lane * 16); mx0 = ms_[0]; mx1 = ms_[1]; } } while (0)
    { const int4 p4 = *(const int4*)(POS + (size_t)RW(0) * 4); pn[0] = p4.x; pn[1] = p4.y; pn[2] = p4.z; pn[3] = p4.w; }
    P11_LOAD(RW(0)); wcur = *(const f32x4*)(TOPW + (size_t)RW(0) * 4);
    { const int m2 = RW(1); const int4 p4 = *(const int4*)(POS + (size_t)m2 * 4); pn[0] = p4.x; pn[1] = p4.y; pn[2] = p4.z; pn[3] = p4.w; wnxt = *(const f32x4*)(TOPW + (size_t)m2 * 4); }
#pragma nounroll
    for (int i = 0; i < cnt; ++i) {
        const int m = RW(i);
        const int b = m / SEQ;
        float acc[16];
#pragma unroll
        for (int q = 0; q < 16; ++q) acc[q] = 0.f;
#pragma unroll
        for (int k = 0; k < 4; ++k) { const float wk = wcur[k];
#pragma unroll
            for (int q = 0; q < 4; ++q) { const int wq = (int)ca[k][q];
                acc[4 * q] += wk * __builtin_amdgcn_cvt_f32_fp8(wq, 0); acc[4 * q + 1] += wk * __builtin_amdgcn_cvt_f32_fp8(wq, 1);
                acc[4 * q + 2] += wk * __builtin_amdgcn_cvt_f32_fp8(wq, 2); acc[4 * q + 3] += wk * __builtin_amdgcn_cvt_f32_fp8(wq, 3); } }
        f32x4 ov[4]; const float* gt = MOD + (size_t)b * 6144 + 5120 + lane * 16;
#pragma unroll
        for (int q = 0; q < 4; ++q) { const f32x4 g = *(const f32x4*)(gt + 4 * q); const f32x4 av = {acc[4 * q], acc[4 * q + 1], acc[4 * q + 2], acc[4 * q + 3]};
            const unsigned ma = q < 2 ? mx0[2 * q] : mx1[2 * q - 4], mb = q < 2 ? mx0[2 * q + 1] : mx1[2 * q - 3];
            ov[q] = xv[q] + (f32x4){bflo(ma), bfhi(ma), bflo(mb), bfhi(mb)} + g * av; }
        P11_LOAD(RW(i + 1));
        wcur = wnxt;
        { const int m2 = RW(i + 2); const int4 p4 = *(const int4*)(POS + (size_t)m2 * 4); pn[0] = p4.x; pn[1] = p4.y; pn[2] = p4.z; pn[3] = p4.w; wnxt = *(const f32x4*)(TOPW + (size_t)m2 * 4); }
        float* orow = F.out + (size_t)m * D + lane * 16;
#pragma unroll
        for (int q = 0; q < 4; ++q) *(f32x4*)(orow + 4 * q) = ov[q];
    }
#undef RW
#undef P11_LOAD
}

constexpr int NPHASE = 12;
struct Args { const float* in[25]; float* out; unsigned char* ws; int ph_lo, ph_hi; };
__global__ void __launch_bounds__(NWAVES * 64, 2) fwd_kernel(Args args) {
    extern __shared__ __attribute__((aligned(16))) unsigned char lds[];
    Frame F;
    F.lds = (LAS unsigned char*)lds;
    F.MISC = (volatile LAS unsigned*)(F.lds + MISC_OFF);
    F.tid = threadIdx.x; F.lane = F.tid & 63; F.wave = __builtin_amdgcn_readfirstlane(F.tid >> 6);
    F.G = gridDim.x; { const int bx = blockIdx.x; F.vcu = (F.G % 8 == 0) ? (bx % 8) * (F.G / 8) + bx / 8 : bx; }
    F.ws = args.ws; F.ctl = (gu32*)(args.ws + WS_CTL); F.out = args.out;
    F.x = args.in[0]; F.c = args.in[1]; F.rel_bias = args.in[2]; F.w_ada = args.in[3]; F.b_ada = args.in[4]; F.g_norm1 = args.in[5]; F.w_in = args.in[6];
    F.w_gk_up = args.in[7]; F.b_gk_up = args.in[8]; F.g_gla_out = args.in[9]; F.g_qnorm = args.in[10]; F.g_knorm = args.in[11];
    F.lq1 = args.in[12]; F.lk1 = args.in[13]; F.lq2 = args.in[14]; F.lk2 = args.in[15]; F.g_subln = args.in[16]; F.w_out = args.in[17];
    F.g_norm2 = args.in[18]; F.w_router = args.in[19]; F.b_router = args.in[20]; F.w_gate_up = args.in[21]; F.b_gate_up = args.in[22]; F.w_down = args.in[23]; F.b_down = args.in[24];
    for (int u = F.tid; u < (LDS_BYTES - LDSCTL_OFF) / 4; u += NWAVES * 64) ((LAS unsigned*)(F.lds + LDSCTL_OFF))[u] = 0u;
    __syncthreads();
    const int lo = args.ph_lo, hi = args.ph_hi;
    const bool multi = (hi - lo) > 1;
    XcdBarrier bar; bar.bar = (unsigned*)(F.ctl + CW_BAR); bar.x = 0; bar.st = nullptr;
    if (multi) bar = xcd_barrier_post((unsigned*)(F.ctl + CW_BAR), F.MISC + 8);
#ifndef PHMASK
#define PHMASK 0xFFF
#endif
#define IN(k) (((PHMASK >> (k)) & 1) && lo <= (k) && (k) < hi)
#define SEAM(k) do { if (IN((k) + 1)) xcd_barrier(bar); } while (0)
#ifndef REPEAT_PH
#define REPEAT_PH 0
#endif
#define REPS(k) (((REPEAT_PH >> (k)) & 1) ? 2 : 1)

    if (IN(0)) { for (int rep_ = 0; rep_ < REPS(0); ++rep_) { if (rep_) xcd_barrier(bar); p0_phase(F); } SEAM(0); }
    if (IN(1)) { for (int rep_ = 0; rep_ < REPS(1); ++rep_) { if (rep_) xcd_barrier(bar); p1_phase(F); } SEAM(1); }
    if (IN(2)) {
        pg8::Gemm g{wsp<const bf16>(F, WS_XN), wsp<const bf16>(F, WS_WIN), T, NIN, D, 0};
        pg8::StaticOrder S; S.init(T / 256, NIN / 256, F.G, (int)blockIdx.x, nullptr, REPS(2));
        EpiInProj E{wsp<bf16>(F, WS_QG), wsp<bf16>(F, WS_KG), wsp<bf16>(F, WS_VG), wsp<bf16>(F, WS_RG), wsp<bf16>(F, WS_QD), wsp<bf16>(F, WS_KD), wsp<bf16>(F, WS_VD), F.g_qnorm, F.g_knorm};
        pg8::gemm_phase<EpiInProj, pg8::StaticOrder>(F.lds, g, S, E);
        SEAM(2);
    }
    if (IN(3)) { for (int rep_ = 0; rep_ < REPS(3); ++rep_) { if (rep_) xcd_barrier(bar); for (int c = F.vcu; c < NCHUNK; c += F.G) gla_a_unit(F, c); } SEAM(3); }
    if (IN(4)) { for (int rep_ = 0; rep_ < REPS(4); ++rep_) { if (rep_) xcd_barrier(bar); gla_b_phase(F); } SEAM(4); }
    if (IN(5)) for (int rep_ = 0; rep_ < REPS(5); ++rep_) { if (rep_) xcd_barrier(bar);
#ifndef NO_GLAC
        for (int u = F.vcu; u < NCHUNK / 2; u += F.G) gla_c_unit(F, u);
#endif
        float lam;
        { float a1 = F.lq1[F.lane] * F.lk1[F.lane], a2 = F.lq2[F.lane] * F.lk2[F.lane]; a1 = wave_sum(a1); a2 = wave_sum(a2); lam = __expf(a1) - __expf(a2) + 0.2f; }
#ifndef NO_ATT
        for (int p = F.vcu; p < 256; p += F.G) { const int bh = p >> 4, s = p & 15;
#pragma nounroll
            for (int j = 0; j < 2; ++j) att::attn_unit(F, bh >> 2, bh & 3, j ? s : 31 - s, lam); }
#endif
        SEAM(5);
    }
    if (IN(6)) {
        pg8::Gemm g{wsp<const bf16>(F, WS_A2), wsp<const bf16>(F, WS_WOUT), T, D, D, 0};
        pg8::StaticOrder S; S.init(T / 256, D / 256, F.G, (int)blockIdx.x, nullptr, REPS(6));
        EpiOutProj E{wsp<bf16>(F, WS_MIX), wsp<const float>(F, WS_MOD)};
        pg8::gemm_phase<EpiOutProj, pg8::StaticOrder>(F.lds, g, S, E);
        SEAM(6);
    }
    if (IN(7)) { for (int rep_ = 0; rep_ < REPS(7); ++rep_) { if (rep_) xcd_barrier(bar); p7_phase(F, rep_ == 0); } SEAM(7); }
    if (IN(8)) { p8_phase(F); SEAM(8); }
    if (IN(9)) {
        int nMt; moe_tables(F, nMt);
        pg8::Gemm g{wsp<const bf16>(F, WS_XS), wsp<const bf16>(F, WS_WGU), PMAX, 2048, D / 2, (size_t)2048 * 512};
        pg8::StaticOrder S; S.init(nMt, 8, F.G, (int)blockIdx.x, F.lds + TILEE_OFF, REPS(9));
        EpiSwiGLU E{wsp<unsigned char>(F, WS_Y), F.b_gate_up};
        pg8::gemm_phase<EpiSwiGLU, pg8::StaticOrder, true>(F.lds, g, S, E);
        SEAM(9);
    }
    if (IN(10)) {
        int nMt; moe_tables(F, nMt);
        pg8::Gemm g{wsp<const bf16>(F, WS_Y), wsp<const bf16>(F, WS_WD), PMAX, 1024, FF / 2, (size_t)1024 * 512};
        pg8::StaticOrder S; S.init(nMt, 4, F.G, (int)blockIdx.x, F.lds + TILEE_OFF, REPS(10));
        EpiDown E{wsp<unsigned char>(F, WS_CN), F.b_down};
        pg8::gemm_phase<EpiDown, pg8::StaticOrder, true>(F.lds, g, S, E);
        SEAM(10);
    }
    if (IN(11)) { p11_phase(F); }
#undef IN
#undef SEAM
}

extern "C" void kernel_launch(void* const* d_in, const int* in_sizes, int n_in, void* d_out, int out_size, void* d_ws, size_t ws_size, hipStream_t stream) {
    static int grid = 0;
    if (grid == 0) {
        if (n_in != 25 || in_sizes[0] != T * D || out_size != T * D || ws_size < WS_END) { fprintf(stderr, "kernel_launch: unexpected shapes (n_in %d, in0 %d, out %d, ws %zu); nothing launched\n", n_in, n_in > 0 ? in_sizes[0] : -1, out_size, ws_size); grid = -1; return; }
        int dev = 0, cus = 0, per_cu = 0;
        if (hipGetDevice(&dev) != hipSuccess || hipDeviceGetAttribute(&cus, hipDeviceAttributeMultiprocessorCount, dev) != hipSuccess) { grid = -1; return; }
        if (hipFuncSetAttribute((const void*)fwd_kernel, hipFuncAttributeMaxDynamicSharedMemorySize, LDS_BYTES) != hipSuccess) { fprintf(stderr, "kernel_launch: hipFuncSetAttribute failed\n"); grid = -1; return; }
        if (hipOccupancyMaxActiveBlocksPerMultiprocessor(&per_cu, (const void*)fwd_kernel, NWAVES * 64, LDS_BYTES) != hipSuccess || per_cu < 1)
            fprintf(stderr, "kernel_launch: note: occupancy query reports %d workgroups per CU\n", per_cu);
        (void)hipGetLastError();
        grid = cus;
    }
    if (grid < 0) return;
    if (hipMemsetAsync((char*)d_ws + WS_CTL, 0, CTL_ZERO_BYTES, stream) != hipSuccess) { fprintf(stderr, "kernel_launch: memset failed\n"); return; }
    Args a{};
    for (int i = 0; i < 25; ++i) a.in[i] = (const float*)d_in[i];
    a.out = (float*)d_out; a.ws = (unsigned char*)d_ws;
#if MK_N_LAUNCHES == 1
    a.ph_lo = 0; a.ph_hi = NPHASE;
    hipLaunchKernelGGL(fwd_kernel, dim3(grid), dim3(NWAVES * 64), LDS_BYTES, stream, a);
#else
    for (int p = 0; p < NPHASE; ++p) { a.ph_lo = p; a.ph_hi = p + 1; hipLaunchKernelGGL(fwd_kernel, dim3(grid), dim3(NWAVES * 64), LDS_BYTES, stream, a); }
#endif
    const hipError_t le = hipPeekAtLastError();
    if (le != hipSuccess) fprintf(stderr, "kernel_launch: launch failed: %s\n", hipGetErrorName(le));
}
```

```cpp
#include <hip/hip_runtime.h>
#include <cstdio>
#include <cstdint>

#ifndef MK_N_LAUNCHES
#define MK_N_LAUNCHES 1
#endif

namespace pg8 {
#define PG8_LAS __attribute__((address_space(3)))
typedef unsigned short bf16_t;
typedef short bf16x8 __attribute__((ext_vector_type(8)));
typedef float f32x4 __attribute__((ext_vector_type(4)));
typedef unsigned u32x4 __attribute__((ext_vector_type(4)));
typedef int i32x4 __attribute__((ext_vector_type(4)));
typedef int i32x8 __attribute__((ext_vector_type(8)));
typedef float f32x16 __attribute__((ext_vector_type(16)));
constexpr int BM = 256, BK = 64, HALF = 128, HTB = HALF * BK * 2, STAGE_BYTES = 8 * HTB, NXCD = 8, WGM = 8;

__host__ __device__ __forceinline__ int lds_byte(int r, int c) { const int st = (r >> 4) * 2 + (c >> 5), rr = r & 15, cc = c & 31, ob = rr * 64 + cc * 2; return st * 1024 + (ob ^ (((ob >> 9) & 1) << 5)); }
__host__ __device__ __forceinline__ void stage_rc(int b, int& R, int& C) { const int st = b / 1024, sb = b % 1024, swz = sb ^ (((sb >> 9) & 1) << 5); R = (st >> 1) * 16 + swz / 64; C = (st & 1) * 32 + (swz % 64) / 2; }
__host__ __device__ __forceinline__ int perm32(int rho) { const int n = rho >> 4, i = rho & 15; return 8 * (i >> 2) + 4 * n + (i & 3); }

struct Unit { int pm, pn, e; };
struct Gemm { const bf16_t* A; const bf16_t* Bt; int M, N, K; size_t estride; };

struct StaticOrder {
    int nM, nN, nwg, G, c, rep; const PG8_LAS unsigned char* tile_e;
    __device__ void init(int nM_, int nN_, int G_, int c_, const PG8_LAS unsigned char* te, int rep_ = 1) { nM = nM_; nN = nN_; nwg = nM * nN; G = G_; c = c_; tile_e = te; rep = rep_; }
    __device__ bool next(int i, Unit& u) const {
        long L = (long)i * G + c; if (L >= (long)nwg * rep) return false; if (rep > 1) L %= nwg;
        int wgid = (int)L; { const int q = nwg / NXCD, r = nwg % NXCD, xcd = wgid % NXCD, off = wgid / NXCD; wgid = (xcd < r ? xcd * (q + 1) : r * (q + 1) + (xcd - r) * q) + off; }
        const int nig = WGM * nN, gid = wgid / nig, fm = gid * WGM, gsz = (nM - fm) < WGM ? (nM - fm) : WGM;
        u.pm = fm + ((wgid % nig) % gsz); u.pn = (wgid % nig) / gsz; u.e = tile_e ? __builtin_amdgcn_readfirstlane((int)tile_e[u.pm]) : 0; return true;
    }
};

__device__ __forceinline__ unsigned cvt_pk_bf16(float lo, float hi) { unsigned r; asm volatile("v_cvt_pk_bf16_f32 %0, %1, %2" : "=v"(r) : "v"(lo), "v"(hi)); return r; }

template <class Epi, class Sched, bool FP8 = false>
__device__ __forceinline__ void gemm_phase(PG8_LAS unsigned char* lds, const Gemm g, const Sched& S, const Epi& E) {
    const int tid = threadIdx.x, wid = __builtin_amdgcn_readfirstlane(tid >> 6), lane = tid & 63, wr = wid >> 2, wc = wid & 3, fr = lane & 15, fq = lane >> 4;
    const int K = g.K, nt = K / BK;
    unsigned voffA[2], voffB[2];
#pragma unroll
    for (int i = 0; i < 2; ++i) { int R, C; stage_rc(tid * 16 + i * 8192, R, C); const int Rb = Epi::PERM ? ((R & ~31) + perm32(R & 31)) : R;
        voffA[i] = (unsigned)(R * K + C) * 2u; voffB[i] = (unsigned)(Rb * K + C) * 2u; }
    const size_t kstep = (size_t)(BK * 2);
    const size_t hstep = (size_t)HALF * K * 2;
    const size_t tstep = 2 * hstep;
    const size_t estep = g.estride * 2;
    const unsigned ldsw = (unsigned)wid * 1024u;
    const int aoff = lds_byte(wr * 64 + fr, fq * 8), boff = lds_byte(wc * 32 + fr, fq * 8);
#define PG8_SA(b, h) (((b) * 2 + (h)) * HTB)
#define PG8_SB(b, h) ((4 + (b) * 2 + (h)) * HTB)
#define PG8_STAGE(bufoff, gbase, voff) do { _Pragma("unroll") for (int _i = 0; _i < 2; ++_i) \
        __builtin_amdgcn_global_load_lds((const unsigned*)((const char*)(gbase) + (voff)[_i]), (PG8_LAS unsigned*)(lds + (bufoff) + ldsw + _i * 8192), 16, 0, 0); } while (0)
#define PG8_LDA(dst, b, h) do { _Pragma("unroll") for (int m = 0; m < 4; ++m) dst[m] = PG8_CAT2(*(const PG8_LAS i32x4*)(lds + PG8_SA(b, h) + aoff + m * 2048), *(const PG8_LAS i32x4*)(lds + PG8_SA(b, h) + aoff + m * 2048 + 1024)); } while (0)
#define PG8_LDB(dst, b, h) do { _Pragma("unroll") for (int n = 0; n < 2; ++n) dst[n] = PG8_CAT2(*(const PG8_LAS i32x4*)(lds + PG8_SB(b, h) + boff + n * 2048), *(const PG8_LAS i32x4*)(lds + PG8_SB(b, h) + boff + n * 2048 + 1024)); } while (0)
#define PG8_CAT2(x, y) __builtin_shufflevector((x), (y), 0, 1, 2, 3, 4, 5, 6, 7)
#define PG8_LO(x) __builtin_bit_cast(bf16x8, __builtin_shufflevector((x), (x), 0, 1, 2, 3))
#define PG8_HI(x) __builtin_bit_cast(bf16x8, __builtin_shufflevector((x), (x), 4, 5, 6, 7))
#define PG8_X4(v, m) ((f32x4){(v)[4 * (m)], (v)[4 * (m) + 1], (v)[4 * (m) + 2], (v)[4 * (m) + 3]})
#define PG8_INS(v, r, m) do { (v)[4 * (m)] = (r)[0]; (v)[4 * (m) + 1] = (r)[1]; (v)[4 * (m) + 2] = (r)[2]; (v)[4 * (m) + 3] = (r)[3]; } while (0)
#define PG8_MMA(ai, bj, At, Bt) do { __builtin_amdgcn_s_setprio(1); _Pragma("unroll") for (int m = 0; m < 4; ++m) _Pragma("unroll") for (int n = 0; n < 2; ++n) { \
        if constexpr (FP8) { const f32x4 r_ = __builtin_amdgcn_mfma_scale_f32_16x16x128_f8f6f4(Bt[n], At[m], PG8_X4(acc16[ai][bj][n], m), 0, 0, 0, 0x7F7F7F7F, 0, 0x7F7F7F7F); PG8_INS(acc16[ai][bj][n], r_, m); } \
        else { acc[ai][bj][m][n] = __builtin_amdgcn_mfma_f32_16x16x32_bf16(PG8_LO(Bt[n]), PG8_LO(At[m]), acc[ai][bj][m][n], 0, 0, 0); \
               acc[ai][bj][m][n] = __builtin_amdgcn_mfma_f32_16x16x32_bf16(PG8_HI(Bt[n]), PG8_HI(At[m]), acc[ai][bj][m][n], 0, 0, 0); } } \
        __builtin_amdgcn_s_setprio(0); } while (0)
#define PG8_WAIT_V(n) asm volatile("s_waitcnt vmcnt(" #n ")" ::: "memory")
#define PG8_WAIT_L(n) asm volatile("s_waitcnt lgkmcnt(" #n ")" ::: "memory")
#define PG8_BAR __builtin_amdgcn_s_barrier()
#define PG8_SCHED __builtin_amdgcn_sched_barrier(0)
    Unit cur, nxt; int ui = 0;
    if (!S.next(0, cur)) return;
    f32x4 acc[2][2][4][2];
#pragma unroll
    for (int a = 0; a < 2; ++a)
#pragma unroll
        for (int b = 0; b < 2; ++b)
#pragma unroll
            for (int m = 0; m < 4; ++m)
#pragma unroll
                for (int n = 0; n < 2; ++n) acc[a][b][m][n] = (f32x4){0.f, 0.f, 0.f, 0.f};
    f32x16 acc16[2][2][2];
#pragma unroll
    for (int a = 0; a < 2; ++a)
#pragma unroll
        for (int b = 0; b < 2; ++b)
#pragma unroll
            for (int n = 0; n < 2; ++n) acc16[a][b][n] = (f32x16){};
    i32x8 At[4], B0[2], B1[2];
    const char* cA = (const char*)g.A + (size_t)cur.pm * tstep; const char* cB = (const char*)g.Bt + (size_t)cur.e * estep + (size_t)cur.pn * tstep;
    PG8_STAGE(PG8_SB(0, 0), cB, voffB); PG8_STAGE(PG8_SB(0, 1), cB + hstep, voffB); PG8_STAGE(PG8_SA(0, 0), cA, voffA); PG8_STAGE(PG8_SA(0, 1), cA + hstep, voffA);
    if (wr == 1) PG8_BAR;
    PG8_WAIT_V(2); PG8_BAR;
    PG8_STAGE(PG8_SB(1, 0), cB + kstep, voffB); PG8_STAGE(PG8_SA(1, 0), cA + kstep, voffA); PG8_STAGE(PG8_SB(1, 1), cB + hstep + kstep, voffB);
    PG8_WAIT_V(6); PG8_BAR;
    for (;;) {
        const bool has_next = S.next(ui + 1, nxt);
        const char* nA = has_next ? (const char*)g.A + (size_t)nxt.pm * tstep : cA; const char* nB = has_next ? (const char*)g.Bt + (size_t)nxt.e * estep + (size_t)nxt.pn * tstep : cB;
#pragma nounroll
        for (int t = 0; t < nt; t += 2) {
            const bool last = (t == nt - 2);
            const char* a1 = cA + (size_t)(t + 1) * kstep;
            const char* a2 = last ? nA : cA + (size_t)(t + 2) * kstep; const char* b2 = last ? nB : cB + (size_t)(t + 2) * kstep;
            const char* a3 = a2 + kstep; const char* b3 = b2 + kstep;
            PG8_LDB(B0, 0, 0); PG8_LDB(B1, 0, 1); PG8_SCHED; PG8_LDA(At, 0, 0); PG8_STAGE(PG8_SA(1, 1), a1 + hstep, voffA);
            PG8_WAIT_V(8); PG8_WAIT_L(0); PG8_BAR; PG8_MMA(0, 0, At, B0); PG8_MMA(0, 1, At, B1); PG8_BAR; PG8_SCHED;
            PG8_LDA(At, 0, 1); PG8_STAGE(PG8_SB(0, 0), b2, voffB); PG8_STAGE(PG8_SB(0, 1), b2 + hstep, voffB); PG8_STAGE(PG8_SA(0, 0), a2, voffA);
            PG8_WAIT_V(8); PG8_WAIT_L(0); PG8_BAR; PG8_MMA(1, 0, At, B0); PG8_MMA(1, 1, At, B1); PG8_BAR; PG8_SCHED;
            PG8_LDB(B0, 1, 0); PG8_LDB(B1, 1, 1); PG8_SCHED; PG8_LDA(At, 1, 0); PG8_STAGE(PG8_SA(0, 1), a2 + hstep, voffA);
            PG8_WAIT_V(8); PG8_WAIT_L(0); PG8_BAR; PG8_MMA(0, 0, At, B0); PG8_MMA(0, 1, At, B1); PG8_BAR; PG8_SCHED;
            PG8_LDA(At, 1, 1); PG8_STAGE(PG8_SB(1, 0), b3, voffB); PG8_STAGE(PG8_SB(1, 1), b3 + hstep, voffB); PG8_STAGE(PG8_SA(1, 0), a3, voffA);
            PG8_WAIT_V(8); PG8_WAIT_L(0); PG8_BAR; PG8_MMA(1, 0, At, B0); PG8_MMA(1, 1, At, B1); PG8_BAR; PG8_SCHED;
        }
        if (wr == 0) PG8_BAR;
        if constexpr (FP8) {
#pragma unroll
            for (int a = 0; a < 2; ++a)
#pragma unroll
                for (int b = 0; b < 2; ++b)
#pragma unroll
                    for (int m = 0; m < 4; ++m)
#pragma unroll
                        for (int n = 0; n < 2; ++n) acc[a][b][m][n] = PG8_X4(acc16[a][b][n], m);
        }
        { int t2 = threadIdx.x; asm volatile("" : "+v"(t2)); E(acc, cur, wr, wc, t2 & 15, (t2 >> 4) & 3); }
        if (!has_next) break;
#pragma unroll
        for (int a = 0; a < 2; ++a)
#pragma unroll
            for (int b = 0; b < 2; ++b)
#pragma unroll
                for (int m = 0; m < 4; ++m)
#pragma unroll
                    for (int n = 0; n < 2; ++n) acc[a][b][m][n] = (f32x4){0.f, 0.f, 0.f, 0.f};
        if constexpr (FP8) {
#pragma unroll
            for (int a = 0; a < 2; ++a)
#pragma unroll
                for (int b = 0; b < 2; ++b)
#pragma unroll
                    for (int n = 0; n < 2; ++n) acc16[a][b][n] = (f32x16){};
        }
        cur = nxt; cA = nA; cB = nB; ++ui;
        if (wr == 1) PG8_BAR;
    }
    PG8_WAIT_V(0);
    PG8_BAR;
#undef PG8_SA
#undef PG8_SB
#undef PG8_STAGE
#undef PG8_LDA
#undef PG8_LDB
#undef PG8_MMA
#undef PG8_X4
#undef PG8_INS
#undef PG8_CAT2
#undef PG8_LO
#undef PG8_HI
#undef PG8_WAIT_V
#undef PG8_WAIT_L
#undef PG8_BAR
#undef PG8_SCHED
}
}

constexpr int NWAVES = 8;
constexpr int BATCH = 4, SEQ = 8192, D = 1024, T = BATCH * SEQ;
constexpr int INW = 3088, NIN = 3072;
constexpr int NE = 32, TOPK = 4, FF = 1024;
constexpr int PMAX = (T * TOPK / 256 + NE) * 256;
constexpr int NCHUNK = BATCH * 4 * (SEQ / 64);
constexpr float EPS = 1e-6f;
constexpr float LOG2E = 1.4426950408889634f;
constexpr float C2 = 0.125f * LOG2E;
constexpr float WSCALE = 32.f, WSCALE_INV = 1.f / 32.f;

constexpr size_t MiB = 1u << 20;
constexpr size_t WS_CTL = 0, CTL_ZERO_BYTES = 1 * MiB;
constexpr size_t WS_MODP = 1 * MiB;
constexpr size_t WS_MOD = 2 * MiB;
constexpr size_t WS_TOPE = 3 * MiB;
constexpr size_t WS_TOPW = 3 * MiB + 512 * 1024;
constexpr size_t WS_POS = 4 * MiB;
constexpr size_t WS_ROWW = 4 * MiB + 512 * 1024;
constexpr size_t WS_DEC = 6 * MiB;
constexpr size_t WS_WGU = 8 * MiB;
constexpr size_t WS_WD = 136 * MiB;
constexpr size_t WS_XN = 200 * MiB;
constexpr size_t WS_WIN = 264 * MiB;
constexpr size_t WS_WOUT = 270 * MiB;
constexpr size_t WS_GK = 272 * MiB;
constexpr size_t WS_QG = 304 * MiB;
constexpr size_t WS_KG = 320 * MiB;
constexpr size_t WS_VG = 336 * MiB;
constexpr size_t WS_RG = 368 * MiB;
constexpr size_t WS_QD = 400 * MiB;
constexpr size_t WS_KD = 432 * MiB;
constexpr size_t WS_VD = 464 * MiB;
constexpr size_t WS_UT = 496 * MiB;
constexpr size_t WS_SP = 560 * MiB;
constexpr size_t WS_OI = 592 * MiB;
constexpr size_t WS_QE = 656 * MiB;
constexpr size_t WS_A2 = 672 * MiB;
constexpr size_t WS_STASH = 736 * MiB;
constexpr size_t WS_XS = 264 * MiB;
constexpr size_t WS_Y = 400 * MiB;
constexpr size_t WS_CN = 536 * MiB;
constexpr size_t WS_MIX = 808 * MiB;
constexpr size_t WS_END = 872 * MiB;
static_assert(WS_XS + (size_t)PMAX * 1024 <= WS_Y && WS_Y + (size_t)PMAX * 1024 <= WS_CN && WS_CN + (size_t)PMAX * 1024 * 2 <= WS_MIX, "ws map");
constexpr int CW_BAR = 4096;
constexpr int CW_CNT = 16384;
constexpr int CW_FILL = 16384 + 64;

constexpr int RING_BYTES = 131072;
constexpr int LDSCTL_OFF = RING_BYTES, MISC_OFF = LDSCTL_OFF + 320;
constexpr int TILEE_OFF = MISC_OFF + 128;
constexpr int HIST_OFF = TILEE_OFF + 1024;
constexpr int LDS_BYTES = 147456;
static_assert(HIST_OFF + 512 <= LDS_BYTES, "LDS map");

#define GAS __attribute__((address_space(1)))
#define LAS __attribute__((address_space(3)))
typedef unsigned short bf16;
typedef unsigned v4u __attribute__((ext_vector_type(4)));
typedef unsigned v2u __attribute__((ext_vector_type(2)));
typedef float f32x4 __attribute__((ext_vector_type(4)));
typedef float f32x16 __attribute__((ext_vector_type(16)));
typedef short bf16x8 __attribute__((ext_vector_type(8)));
typedef short s16x4 __attribute__((ext_vector_type(4)));
typedef GAS unsigned gu32;
#define RLX_AGENT __ATOMIC_RELAXED, __HIP_MEMORY_SCOPE_AGENT
#define LDS_WAIT() asm volatile("s_waitcnt lgkmcnt(0)" ::: "memory")
#define VM_WAIT() asm volatile("s_waitcnt vmcnt(0)" ::: "memory")
__device__ __forceinline__ unsigned f2bf(float f) { unsigned u = __builtin_bit_cast(unsigned, f); return (u + 0x7fffu + ((u >> 16) & 1u)) >> 16; }
__device__ __forceinline__ unsigned pk2(float lo, float hi) { return f2bf(lo) | (f2bf(hi) << 16); }
__device__ __forceinline__ float bf2f(unsigned short h) { return __builtin_bit_cast(float, (unsigned)h << 16); }
__device__ __forceinline__ float bflo(unsigned u) { return __builtin_bit_cast(float, u << 16); }
__device__ __forceinline__ float bfhi(unsigned u) { return __builtin_bit_cast(float, u & 0xffff0000u); }
__device__ __forceinline__ float wave_sum(float v) {
#pragma unroll
    for (int o = 1; o < 64; o <<= 1) v += __shfl_xor(v, o);
    return v;
}
__device__ __forceinline__ float sigmoidf_(float x) { return 1.f / (1.f + __expf(-x)); }
typedef float f32x2 __attribute__((ext_vector_type(2)));
__device__ __forceinline__ unsigned wave_umax(unsigned v) {
    v = max(v, (unsigned)__builtin_amdgcn_update_dpp(0, (int)v, 0x111, 0xf, 0xf, true));
    v = max(v, (unsigned)__builtin_amdgcn_update_dpp(0, (int)v, 0x112, 0xf, 0xf, true));
    v = max(v, (unsigned)__builtin_amdgcn_update_dpp(0, (int)v, 0x114, 0xf, 0xf, true));
    v = max(v, (unsigned)__builtin_amdgcn_update_dpp(0, (int)v, 0x118, 0xf, 0xf, true));
    v = max(v, (unsigned)__builtin_amdgcn_update_dpp(0, (int)v, 0x142, 0xa, 0xf, false));
    v = max(v, (unsigned)__builtin_amdgcn_update_dpp(0, (int)v, 0x143, 0xc, 0xf, false));
    return (unsigned)__builtin_amdgcn_readlane((int)v, 63);
}
template <int CNT, int S, int N> __device__ __forceinline__ void xreduce_step(float (&v)[N], int lane) {
    if constexpr (CNT > 1) { constexpr int half = CNT / 2; const bool up = (lane & S) != 0;
#pragma unroll
        for (int i = 0; i < half; ++i) { const float send = up ? v[i] : v[i + half], keep = up ? v[i + half] : v[i]; v[i] = keep + __shfl_xor(send, S); }
        xreduce_step<half, S / 2, N>(v, lane); }
}
template <int S> __device__ __forceinline__ float xreduce_tail(float r) { if constexpr (S >= 1) { r += __shfl_xor(r, S); return xreduce_tail<S / 2>(r); } else return r; }
template <int N> __device__ __forceinline__ float xreduce(float (&v)[N], int lane) {
    xreduce_step<N, 32, N>(v, lane);
    return xreduce_tail<(N == 32 ? 1 : N == 16 ? 2 : N == 8 ? 4 : 8)>(v[0]);
}
__device__ __forceinline__ float lane_bcast(float v, int l) { return __builtin_bit_cast(float, __builtin_amdgcn_readlane(__builtin_bit_cast(int, v), l)); }

#define XB_TMO      128
#define XB_XCNT(j)  (256  + 64 * (j))
#define XB_XSUB(j)  (1280 + 64 * (j))
#define XB_XGEN(j)  (2304 + 64 * (j))
#define XB_TOP      3328
#define XB_TOPGEN   3392
#define XCD_BAR_WORDS 3456
#define XB_SPIN_CAP (1u << 18)
__device__ __forceinline__ unsigned xb_ld(unsigned* p)              { return __hip_atomic_load(p, __ATOMIC_RELAXED, __HIP_MEMORY_SCOPE_AGENT); }
__device__ __forceinline__ unsigned xb_add(unsigned* p, unsigned v) { return __hip_atomic_fetch_add(p, v, __ATOMIC_RELAXED, __HIP_MEMORY_SCOPE_AGENT); }
__device__ __forceinline__ unsigned xb_xcc_id() { return (unsigned)__builtin_amdgcn_s_getreg((3 << 11) | 20) & 0xFu; }
#define XB_SPIN(cond, bar) do { unsigned _sp = 0; while (cond) { __builtin_amdgcn_s_sleep(1); \
    if ((++_sp & 255u) == 0u) { if (xb_ld(&(bar)[XB_TMO])) break; if (_sp > XB_SPIN_CAP) { atomicAdd(&(bar)[XB_TMO], 1u); break; } } } } while (0)
struct XcdBarrier { unsigned* bar; unsigned x; volatile LAS unsigned* st; };
__device__ __forceinline__ XcdBarrier xcd_barrier_post(unsigned* bar, volatile LAS unsigned* st) {
    XcdBarrier b; b.bar = bar; b.x = xb_xcc_id(); b.st = st;
    if (threadIdx.x == 0) (void)xb_add(&bar[XB_XCNT(b.x)], 1u);
    return b;
}
__device__ __forceinline__ void xcd_barrier_complete(unsigned* bar, unsigned x, unsigned& nloc, unsigned& nx) {
    const unsigned G = gridDim.x * gridDim.y * gridDim.z;
    unsigned sum, cnt, mine, sp = 0u;
    for (;;) {
        sum = 0u; cnt = 0u; mine = 0u;
#pragma unroll
        for (unsigned j = 0; j < 16; ++j) { const unsigned c = xb_ld(&bar[XB_XCNT(j)]); sum += c; cnt += (c > 0u) ? 1u : 0u; mine = (j == x) ? c : mine; }
        if (sum == G) break;
        __builtin_amdgcn_s_sleep(1);
        if ((++sp & 255u) == 0u) { if (xb_ld(&bar[XB_TMO])) break; if (sp > XB_SPIN_CAP) { atomicAdd(&bar[XB_TMO], 1u); break; } }
    }
    nloc = mine > 0u ? mine : 1u; nx = cnt > 0u ? cnt : 1u;
}
__device__ __forceinline__ void xcd_barrier(const XcdBarrier& b) {
    asm volatile("s_waitcnt vmcnt(0)" ::: "memory");
    __syncthreads();
    if (threadIdx.x == 0) {
        unsigned* bar = b.bar;
        __builtin_amdgcn_s_waitcnt(0);
        unsigned nloc = b.st[0], nx = b.st[1];
        if (nloc == 0u) { xcd_barrier_complete(bar, b.x, nloc, nx); b.st[0] = nloc; b.st[1] = nx; }
        const unsigned old = xb_add(&bar[XB_XSUB(b.x)], 1u);
        const unsigned gen = old / nloc;
        if (old + 1u == (gen + 1u) * nloc) {
            __builtin_amdgcn_fence(__ATOMIC_RELEASE, "agent");
            asm volatile("s_waitcnt vmcnt(0)" ::: "memory");
            const unsigned og = xb_add(&bar[XB_TOP], 1u);
            const unsigned tg = og / nx;
            if (og + 1u == (tg + 1u) * nx) xb_add(&bar[XB_TOPGEN], 1u);
            else XB_SPIN(xb_ld(&bar[XB_TOPGEN]) == tg, bar);
            __builtin_amdgcn_fence(__ATOMIC_ACQUIRE, "agent");
            xb_add(&bar[XB_XGEN(b.x)], 1u);
            asm volatile("s_waitcnt vmcnt(0)" ::: "memory");
        } else {
            XB_SPIN(xb_ld(&bar[XB_XGEN(b.x)]) == gen, bar);
            __builtin_amdgcn_fence(__ATOMIC_ACQUIRE, "agent");
            asm volatile("s_waitcnt vmcnt(0)" ::: "memory");
        }
    }
    __syncthreads();
}

struct Frame {
    LAS unsigned char* lds;
    volatile LAS unsigned* MISC;
    gu32* ctl;
    int tid, lane, wave;
    int vcu, G;
    unsigned char* ws;
    const float *x, *c, *rel_bias, *w_ada, *b_ada, *g_norm1, *w_in, *w_gk_up, *b_gk_up, *g_gla_out, *g_qnorm, *g_knorm, *lq1, *lk1, *lq2, *lk2, *g_subln, *w_out,
                *g_norm2, *w_router, *b_router, *w_gate_up, *b_gate_up, *w_down, *b_down;
    float* out;
};
template <class Tp> __device__ __forceinline__ Tp* wsp(const Frame& F, size_t off) { return (Tp*)(F.ws + off); }

__device__ __forceinline__ void tr_item(const float* W, int ldw, int k0, int src0, bf16* WT, int K, int drow0, LAS float* scr, int lane) {
#pragma unroll 8
    for (int i = 0; i < 32; ++i) { const int kk = 2 * i + (lane >> 5); scr[kk * 33 + (lane & 31)] = W[(size_t)(k0 + kk) * ldw + src0 + (lane & 31)]; }
    LDS_WAIT(); asm volatile("" ::: "memory");
    const int c = lane & 7;
#pragma unroll
    for (int j = 0; j < 4; ++j) { const int n = (lane >> 3) + 8 * j; const LAS float* s = scr + (8 * c) * 33 + n;
        v4u o; o.x = pk2(s[0 * 33], s[1 * 33]); o.y = pk2(s[2 * 33], s[3 * 33]); o.z = pk2(s[4 * 33], s[5 * 33]); o.w = pk2(s[6 * 33], s[7 * 33]);
        *(GAS v4u*)(WT + (size_t)(drow0 + n) * K + k0 + 8 * c) = o; }
    LDS_WAIT(); asm volatile("" ::: "memory");
}
__device__ __forceinline__ unsigned pk4_fp8(float a, float b, float c, float d) { int p = __builtin_amdgcn_cvt_pk_fp8_f32(a, b, 0, false); p = __builtin_amdgcn_cvt_pk_fp8_f32(c, d, p, true); return (unsigned)p; }
__device__ __forceinline__ void tr_item_fp8(const float* W, int ldw, int k0, int src0, unsigned char* WT, int K, int drow0, float sc, LAS float* scr, int lane) {
    { float tmp[32]; const float* wp = W + (size_t)(k0 + (lane >> 5)) * ldw + src0 + (lane & 31);
#pragma unroll
      for (int i = 0; i < 32; ++i) tmp[i] = __builtin_nontemporal_load(wp + (size_t)(2 * i) * ldw);
#pragma unroll
      for (int i = 0; i < 32; ++i) scr[(2 * i + (lane >> 5)) * 33 + (lane & 31)] = tmp[i] * sc; }
    LDS_WAIT(); asm volatile("" ::: "memory");
    const int c = lane & 3;
#pragma unroll
    for (int j = 0; j < 2; ++j) { const int n = (lane >> 2) + 16 * j; const LAS float* s = scr + (16 * c) * 33 + n;
        v4u o;
#pragma unroll
        for (int q = 0; q < 4; ++q) o[q] = pk4_fp8(s[(4 * q) * 33], s[(4 * q + 1) * 33], s[(4 * q + 2) * 33], s[(4 * q + 3) * 33]);
        *(GAS v4u*)(WT + (size_t)(drow0 + n) * K + k0 + 16 * c) = o; }
    LDS_WAIT(); asm volatile("" ::: "memory");
}
__device__ __forceinline__ int win_src0(int ng) {
    const int pn = ng >> 3, gi = ng & 7, bj = gi >> 2, wc = gi & 3;
    if (pn < 6) return pn * 256 + gi * 32;
    if (pn < 10) { const int base = (pn < 8) ? 1552 : 2064; const int gq = 4 * ((pn - 6) & 1) + wc; return base + 64 * gq + 32 * bj; }
    return 2576 + (pn - 10) * 256 + gi * 32;
}
__device__ __forceinline__ void p0_phase(Frame& F) {
    LAS float* scr = (LAS float*)(F.lds + F.wave * 16384);
    const int gw = F.vcu * NWAVES + F.wave, NGW = F.G * NWAVES, lane = F.lane;
    for (int it = gw; it < 768; it += NGW) {
        const int cg = it % 96, ks = it / 96, j = cg * 64 + lane;
#pragma unroll
        for (int q = 0; q < 8; ++q) { const int idx = q * 64 + lane, b = idx >> 7, kk = idx & 127; const float cv = F.c[b * 1024 + ks * 128 + kk]; scr[idx] = cv * sigmoidf_(cv); }
        LDS_WAIT(); asm volatile("" ::: "memory");
        float a0 = 0.f, a1 = 0.f, a2 = 0.f, a3 = 0.f;
        const float* wp = F.w_ada + (size_t)(ks * 128) * 6144 + j;
#pragma unroll 32
        for (int kk = 0; kk < 128; ++kk) { const float w = wp[(size_t)kk * 6144]; a0 += scr[kk] * w; a1 += scr[128 + kk] * w; a2 += scr[256 + kk] * w; a3 += scr[384 + kk] * w; }
        float* mp = wsp<float>(F, WS_MODP) + (size_t)(ks * 4) * 6144 + j;
        mp[0] = a0; mp[6144] = a1; mp[2 * 6144] = a2; mp[3 * 6144] = a3;
        LDS_WAIT(); asm volatile("" ::: "memory");
    }
    constexpr int I_IN = 96 * 16, I_OUT = 32 * 16, I_GU = 32 * 64 * 16, I_D = 32 * 32 * 16;
    constexpr int NITEMS = I_IN + I_OUT + I_GU + I_D;
    for (int it = gw; it < NITEMS; it += NGW) {
        int r = it;
        if (r < I_IN) { const int kb = r / 96, ng = r % 96; tr_item(F.w_in, INW, kb * 64, win_src0(ng), wsp<bf16>(F, WS_WIN), 1024, ng * 32, scr, lane); continue; } r -= I_IN;
        if (r < I_OUT) { const int kb = r / 32, ng = r % 32; tr_item(F.w_out, 1024, kb * 64, ng * 32, wsp<bf16>(F, WS_WOUT), 1024, ng * 32, scr, lane); continue; } r -= I_OUT;
        if (r < I_GU) { const int e = r / 1024, q = r % 1024, kb = q / 64, dg = q % 64, pn = dg >> 3, gi = dg & 7, bj = gi >> 2, j32 = gi & 3;
            tr_item_fp8(F.w_gate_up + (size_t)e * 1024 * 2048, 2048, kb * 64, bj * 1024 + pn * 128 + j32 * 32, wsp<unsigned char>(F, WS_WGU) + (size_t)e * 2048 * 1024, 1024, dg * 32, WSCALE, scr, lane); continue; } r -= I_GU;
        { const int e = r / 512, q = r % 512, kb = q / 32, ng = q % 32;
            tr_item_fp8(F.w_down + (size_t)e * 1024 * 1024, 1024, kb * 64, ng * 32, wsp<unsigned char>(F, WS_WD) + (size_t)e * 1024 * 1024, 1024, ng * 32, WSCALE, scr, lane); }
    }
}

#ifndef SPREAD_ROWS
#define SPREAD_ROWS 0
#endif
__device__ __forceinline__ int srow(int gw, int i, int NGW) { return (SPREAD_ROWS && NGW * 16 == T) ? ((gw >> 9) * SEQ + i * 512 + (gw & 511)) : (gw * ((T + NGW - 1) / NGW) + i); }
__device__ __forceinline__ f32x4 mod_from_partials(const Frame& F, int b, int col) {
    const float* mp = wsp<const float>(F, WS_MODP) + (size_t)b * 6144 + col;
    f32x4 s = *(const f32x4*)(F.b_ada + col);
#pragma unroll
    for (int ks = 0; ks < 8; ++ks) s += *(const f32x4*)(mp + (size_t)ks * 4 * 6144);
    return s;
}
typedef float cf4p __attribute__((ext_vector_type(4)));
__device__ __forceinline__ void p1_phase(Frame& F) {
    const int tid = F.tid, lane = F.lane;
    constexpr int WLP = 1032;
    LAS bf16* wloT = (LAS bf16*)(F.lds);
    LAS bf16* wupT = (LAS bf16*)(F.lds + 36864);
    LAS float* bup = (LAS float*)(F.lds + 36864 + 16384);
    LAS float* tsc = (LAS float*)(F.lds + 36864 + 16384 + 1024) + F.wave * 288;
    { f32x4 t[8]; const int k0 = tid >> 2, r4 = (tid & 3) * 4;
#pragma unroll
      for (int it = 0; it < 8; ++it) t[it] = *(const f32x4*)(F.w_in + (size_t)(k0 + 128 * it) * INW + 1536 + r4);
#pragma unroll
      for (int it = 0; it < 8; ++it)
#pragma unroll
          for (int q = 0; q < 4; ++q) wloT[(r4 + q) * WLP + k0 + 128 * it] = (bf16)f2bf(t[it][q]); }
    { float t[8]; const int c = tid & 255, rh = tid >> 8;
#pragma unroll
      for (int j = 0; j < 8; ++j) t[j] = F.w_gk_up[(8 * rh + j) * 256 + c];
      v4u o; o.x = pk2(t[0], t[1]); o.y = pk2(t[2], t[3]); o.z = pk2(t[4], t[5]); o.w = pk2(t[6], t[7]);
      *(LAS v4u*)(wupT + c * 32 + 8 * rh) = o; *(LAS v4u*)(wupT + c * 32 + 16 + 8 * rh) = (v4u){0u, 0u, 0u, 0u}; }
    if (tid < 256) bup[tid] = F.b_gk_up[tid];
    { const int gt = F.vcu * 512 + tid; if (gt < 4 * 6144 / 4) { const int i = gt * 4, b = i / 6144, col = i % 6144; *(f32x4*)(wsp<float>(F, WS_MOD) + i) = mod_from_partials(F, b, col); } }
    __syncthreads();
    const int gw = F.vcu * NWAVES + F.wave, NGW = F.G * NWAVES;
    int curb = -1; f32x4 gsc[4], shv[4];
    for (int grp = gw; grp < T / 16; grp += NGW) {
#define ROWI(i) srow(grp, (i), T / 16)
        const int m0 = ROWI(0);
        f32x4 nx[4];
        { const GAS f32x4* xr = (const GAS f32x4*)(F.x + (size_t)m0 * D) + lane;
#pragma unroll
          for (int j = 0; j < 4; ++j) nx[j] = xr[64 * j]; }
        { const int b = m0 / SEQ;
          if (b != curb) { curb = b;
#pragma unroll
              for (int j = 0; j < 4; ++j) { const int col = 256 * j + 4 * lane; const f32x4 g = *(const f32x4*)(F.g_norm1 + col);
                  shv[j] = mod_from_partials(F, b, col); gsc[j] = g * (mod_from_partials(F, b, 1024 + col) + 1.0f); } } }
#pragma nounroll
        for (int i = 0; i < 16; ++i) {
            const int m = ROWI(i);
            f32x4 v[4]; float s = 0.f;
#pragma unroll
            for (int j = 0; j < 4; ++j) { v[j] = nx[j]; s += (v[j].x * v[j].x + v[j].y * v[j].y) + (v[j].z * v[j].z + v[j].w * v[j].w); }
            { const GAS f32x4* xr = (const GAS f32x4*)(F.x + (size_t)ROWI(i + 1 < 16 ? i + 1 : i) * D) + lane;
#pragma unroll
              for (int j = 0; j < 4; ++j) nx[j] = xr[64 * j]; }
            const float rstd = rsqrtf(wave_sum(s) * (1.f / D) + EPS);
            GAS v2u* o8 = (GAS v2u*)(wsp<bf16>(F, WS_XN) + (size_t)m * D) + lane;
#pragma unroll
            for (int j = 0; j < 4; ++j) { v[j] = v[j] * rstd * gsc[j] + shv[j]; v2u o; o.x = pk2(v[j].x, v[j].y); o.y = pk2(v[j].z, v[j].w); o8[64 * j] = o; }
        }
        __builtin_amdgcn_fence(__ATOMIC_RELEASE, "workgroup"); asm volatile("s_waitcnt vmcnt(0)" ::: "memory"); __builtin_amdgcn_fence(__ATOMIC_ACQUIRE, "workgroup");
        int lb = lane; asm volatile("" : "+v"(lb));
        const int l15 = lb & 15, q4 = lb >> 4;
        cf4p acc = {0.f, 0.f, 0.f, 0.f};
        { const bf16* arow = wsp<const bf16>(F, WS_XN) + (size_t)ROWI(l15) * D + 8 * q4; const LAS bf16* brow = wloT + l15 * WLP + 8 * q4;
#pragma unroll 4
          for (int sI = 0; sI < 32; ++sI) { const bf16x8 fa = *(const bf16x8*)(arow + 32 * sI); const bf16x8 fb = *(const LAS bf16x8*)(brow + 32 * sI);
              acc = __builtin_amdgcn_mfma_f32_16x16x32_bf16(fa, fb, acc, 0, 0, 0); } }
#pragma unroll
        for (int r = 0; r < 4; ++r) tsc[(4 * q4 + r) * 17 + l15] = acc[r];
        LDS_WAIT(); asm volatile("" ::: "memory");
        bf16x8 fa2;
        { float t8[8];
#pragma unroll
          for (int j = 0; j < 8; ++j) t8[j] = (q4 < 2) ? tsc[l15 * 17 + 8 * (q4 & 1) + j] : 0.f;
          v4u pk; pk.x = pk2(t8[0], t8[1]); pk.y = pk2(t8[2], t8[3]); pk.z = pk2(t8[4], t8[5]); pk.w = pk2(t8[6], t8[7]); fa2 = __builtin_bit_cast(bf16x8, pk); }
        float* GK = wsp<float>(F, WS_GK);
#pragma unroll 4
        for (int t = 0; t < 16; ++t) { const bf16x8 fb2 = *(const LAS bf16x8*)(wupT + (16 * t + l15) * 32 + 8 * q4);
            cf4p z = {0.f, 0.f, 0.f, 0.f}; z = __builtin_amdgcn_mfma_f32_16x16x32_bf16(fa2, fb2, z, 0, 0, 0);
            const float bb = bup[16 * t + l15];
#pragma unroll
            for (int r = 0; r < 4; ++r) { const float zz = z[r] + bb; GK[(size_t)ROWI(4 * q4 + r) * 256 + 16 * t + l15] = (fminf(zz, 0.f) - __logf(1.f + __expf(-fabsf(zz)))) * (1.f / 16.f); } }
        LDS_WAIT(); asm volatile("" ::: "memory");
#undef ROWI
    }
}

using pg8::Unit;
typedef pg8::f32x4 af4;
struct EpiInProj {
    static constexpr bool PERM = true;
    bf16 *QG, *KG, *VG, *RG, *QD, *KD, *VD; const float *gq, *gk;
    __device__ __forceinline__ void operator()(const af4 (&acc)[2][2][4][2], const Unit& u, int wr, int wc, int fr, int fq) const {
        const int pn = u.pn; const int row0 = u.pm * 256 + wr * 64 + fr;
        if (pn >= 6 && pn < 10) {
            const bool isq = pn < 8; bf16* base = isq ? QD : KD; const float* g = isq ? gq : gk; const float sc = isq ? C2 : 1.f;
            const int grp = 4 * ((pn - 6) & 1) + wc;
            af4 gv[2][2];
#pragma unroll
            for (int bj = 0; bj < 2; ++bj)
#pragma unroll
                for (int n = 0; n < 2; ++n) gv[bj][n] = *(const af4*)(g + 32 * bj + 8 * fq + 4 * n) * sc;
#pragma unroll
            for (int ai = 0; ai < 2; ++ai)
#pragma unroll
                for (int m = 0; m < 4; ++m) {
                    float ss = 0.f;
#pragma unroll
                    for (int bj = 0; bj < 2; ++bj)
#pragma unroll
                        for (int n = 0; n < 2; ++n) { const af4 v = acc[ai][bj][m][n]; ss += (v[0] * v[0] + v[1] * v[1]) + (v[2] * v[2] + v[3] * v[3]); }
                    ss += __shfl_xor(ss, 16); ss += __shfl_xor(ss, 32);
                    const float rs = rsqrtf(ss * (1.f / 64.f) + EPS);
                    bf16* rowp = base + (size_t)(row0 + ai * 128 + m * 16) * 512 + grp * 64 + 8 * fq;
#pragma unroll
                    for (int bj = 0; bj < 2; ++bj) { const af4 v0 = acc[ai][bj][m][0] * rs * gv[bj][0], v1 = acc[ai][bj][m][1] * rs * gv[bj][1];
                        pg8::u32x4 w; w.x = pg8::cvt_pk_bf16(v0[0], v0[1]); w.y = pg8::cvt_pk_bf16(v0[2], v0[3]); w.z = pg8::cvt_pk_bf16(v1[0], v1[1]); w.w = pg8::cvt_pk_bf16(v1[2], v1[3]);
                        *(pg8::u32x4*)(rowp + 32 * bj) = w; }
                }
        } else {
            bf16* base; int pitch, colt; int act = 0;
            if (pn == 0) { base = QG; pitch = 256; colt = 0; act = 1; }
            else if (pn == 1) { base = KG; pitch = 256; colt = 0; }
            else if (pn < 4) { base = VG; pitch = 512; colt = (pn - 2) * 256; }
            else if (pn < 6) { base = RG; pitch = 512; colt = (pn - 4) * 256; act = 2; }
            else { base = VD; pitch = 512; colt = (pn - 10) * 256; }
            const int col0 = colt + wc * 32 + 8 * fq;
#pragma unroll
            for (int ai = 0; ai < 2; ++ai)
#pragma unroll
                for (int m = 0; m < 4; ++m) { bf16* rowp = base + (size_t)(row0 + ai * 128 + m * 16) * pitch + col0;
#pragma unroll
                    for (int bj = 0; bj < 2; ++bj) { af4 v0 = acc[ai][bj][m][0], v1 = acc[ai][bj][m][1];
                        if (act == 1) { v0 = v0 * 0.125f; v1 = v1 * 0.125f; }
                        if (act == 2) {
#pragma unroll
                            for (int q = 0; q < 4; ++q) { v0[q] = v0[q] * sigmoidf_(v0[q]); v1[q] = v1[q] * sigmoidf_(v1[q]); } }
                        pg8::u32x4 w; w.x = pg8::cvt_pk_bf16(v0[0], v0[1]); w.y = pg8::cvt_pk_bf16(v0[2], v0[3]); w.z = pg8::cvt_pk_bf16(v1[0], v1[1]); w.w = pg8::cvt_pk_bf16(v1[2], v1[3]);
                        *(pg8::u32x4*)(rowp + bj * 128) = w; } }
        }
    }
};
struct EpiOutProj {
    static constexpr bool PERM = true;
    bf16* mix; const float* mod;
    __device__ __forceinline__ void operator()(const af4 (&acc)[2][2][4][2], const Unit& u, int wr, int wc, int fr, int fq) const {
        const int b = (u.pm * 256) / SEQ; const int col0 = u.pn * 256 + wc * 32 + 8 * fq;
        af4 gt[2][2];
#pragma unroll
        for (int bj = 0; bj < 2; ++bj)
#pragma unroll
            for (int n = 0; n < 2; ++n) gt[bj][n] = *(const af4*)(mod + (size_t)b * 6144 + 2048 + col0 + bj * 128 + 4 * n);
#pragma unroll
        for (int ai = 0; ai < 2; ++ai)
#pragma unroll
            for (int m = 0; m < 4; ++m) { bf16* rowp = mix + (size_t)(u.pm * 256 + ai * 128 + wr * 64 + m * 16 + fr) * D + col0;
#pragma unroll
                for (int bj = 0; bj < 2; ++bj) { const af4 v0 = acc[ai][bj][m][0] * gt[bj][0], v1 = acc[ai][bj][m][1] * gt[bj][1];
                    pg8::u32x4 w; w.x = pg8::cvt_pk_bf16(v0[0], v0[1]); w.y = pg8::cvt_pk_bf16(v0[2], v0[3]); w.z = pg8::cvt_pk_bf16(v1[0], v1[1]); w.w = pg8::cvt_pk_bf16(v1[2], v1[3]);
                    *(pg8::u32x4*)(rowp + bj * 128) = w; } }
    }
};
struct EpiSwiGLU {
    static constexpr bool PERM = false;
    unsigned char* Y; const float* bgu;
    __device__ __forceinline__ void operator()(const af4 (&acc)[2][2][4][2], const Unit& u, int wr, int wc, int fr, int fq) const {
        const int f0 = u.pn * 128 + wc * 32 + 4 * fq; const float* bb = bgu + (size_t)u.e * 2048 + f0;
        af4 bg[2], bu[2];
#pragma unroll
        for (int n = 0; n < 2; ++n) { bg[n] = *(const af4*)(bb + 16 * n); bu[n] = *(const af4*)(bb + 1024 + 16 * n); }
#pragma unroll
        for (int ai = 0; ai < 2; ++ai)
#pragma unroll
            for (int m = 0; m < 4; ++m) { unsigned char* rowp = Y + (size_t)(u.pm * 256 + ai * 128 + wr * 64 + m * 16 + fr) * FF + f0;
#pragma unroll
                for (int n = 0; n < 2; ++n) { const af4 g = acc[ai][0][m][n] * WSCALE_INV + bg[n], up = acc[ai][1][m][n] * WSCALE_INV + bu[n]; af4 y;
#pragma unroll
                    for (int q = 0; q < 4; ++q) { const float gg = fminf(g[q], 7.f), uu = fminf(fmaxf(up[q], -7.f), 7.f); y[q] = (uu + 1.f) * gg * sigmoidf_(1.702f * gg); }
                    *(unsigned*)(rowp + 16 * n) = pk4_fp8(y[0], y[1], y[2], y[3]); } }
    }
};
struct EpiDown {
    static constexpr bool PERM = true;
    unsigned char* Cn; const float* bd;
    __device__ __forceinline__ void operator()(const af4 (&acc)[2][2][4][2], const Unit& u, int wr, int wc, int fr, int fq) const {
        const int col0 = u.pn * 256 + wc * 32 + 8 * fq; const float* bb = bd + (size_t)u.e * 1024 + col0;
        af4 bv[2][2];
#pragma unroll
        for (int bj = 0; bj < 2; ++bj)
#pragma unroll
            for (int n = 0; n < 2; ++n) bv[bj][n] = *(const af4*)(bb + bj * 128 + 4 * n);
#pragma unroll
        for (int ai = 0; ai < 2; ++ai)
#pragma unroll
            for (int m = 0; m < 4; ++m) { const int row = u.pm * 256 + ai * 128 + wr * 64 + m * 16 + fr; unsigned char* rowp = Cn + (size_t)row * 1024 + col0;
#pragma unroll
                for (int bj = 0; bj < 2; ++bj) { const af4 v0 = acc[ai][bj][m][0] * WSCALE_INV + bv[bj][0], v1 = acc[ai][bj][m][1] * WSCALE_INV + bv[bj][1];
                    v2u w; w.x = pk4_fp8(v0[0], v0[1], v0[2], v0[3]); w.y = pk4_fp8(v1[0], v1[1], v1[2], v1[3]); *(v2u*)(rowp + bj * 128) = w; } }
    }
};

typedef float cf4 __attribute__((ext_vector_type(4)));
#define MFMA16(a, b, c) __builtin_amdgcn_mfma_f32_16x16x32_bf16((a), (b), (c), 0, 0, 0)
constexpr int GP = 72;
__device__ __forceinline__ void gla_a_unit(Frame& F, int chunk) {
    const int tid = F.tid, lane = F.lane, w = F.wave;
    const int bh = chunk >> 7, n = chunk & 127, b = bh >> 2, h = bh & 3;
    const size_t R0 = (size_t)b * SEQ + (size_t)n * 64;
    LAS float* gc = (LAS float*)F.lds;
    LAS float* segt = (LAS float*)(F.lds + 16384);
    LAS bf16* QEs = (LAS bf16*)(F.lds + 18432);
    LAS bf16* KEs = (LAS bf16*)(F.lds + 18432 + 9216);
    LAS bf16* KST = (LAS bf16*)(F.lds + 18432 + 2 * 9216);
    LAS bf16* VT = (LAS bf16*)(F.lds + 18432 + 3 * 9216);
    LAS bf16* AM = (LAS bf16*)(F.lds + 18432 + 3 * 9216 + 18432);
    const float* GK = wsp<const float>(F, WS_GK);
    { const int r = tid >> 3, d0 = (tid & 7) * 8; const float* gp = GK + (R0 + r) * 256 + h * 64 + d0;
      *(LAS f32x4*)(gc + r * 64 + d0) = *(const f32x4*)gp; *(LAS f32x4*)(gc + r * 64 + d0 + 4) = *(const f32x4*)(gp + 4); }
    __syncthreads();
    { const int seg = tid >> 6, d = tid & 63; float run = 0.f;
#pragma unroll
      for (int i = 0; i < 8; ++i) { run += gc[(seg * 8 + i) * 64 + d]; gc[(seg * 8 + i) * 64 + d] = run; }
      segt[seg * 64 + d] = run; }
    __syncthreads();
    { const int seg = tid >> 6, d = tid & 63; float off = 0.f;
      for (int s2 = 0; s2 < seg; ++s2) off += segt[s2 * 64 + d];
#pragma unroll
      for (int i = 0; i < 8; ++i) gc[(seg * 8 + i) * 64 + d] += off; }
    __syncthreads();
    { const int r = tid >> 3, d0 = (tid & 7) * 8;
      const v4u qv = *(const v4u*)(wsp<const bf16>(F, WS_QG) + (R0 + r) * 256 + h * 64 + d0);
      const v4u kv = *(const v4u*)(wsp<const bf16>(F, WS_KG) + (R0 + r) * 256 + h * 64 + d0);
      float qf[8], kf[8];
#pragma unroll
      for (int i = 0; i < 4; ++i) { qf[2 * i] = bflo(qv[i]); qf[2 * i + 1] = bfhi(qv[i]); kf[2 * i] = bflo(kv[i]); kf[2 * i + 1] = bfhi(kv[i]); }
      float qe[8], ke[8];
#pragma unroll
      for (int i = 0; i < 8; ++i) { const float g = gc[r * 64 + d0 + i], gl = gc[63 * 64 + d0 + i];
          qe[i] = qf[i] * __expf(g); ke[i] = kf[i] * __expf(-g); KST[(d0 + i) * GP + r] = (bf16)f2bf(kf[i] * __expf(gl - g)); }
      v4u qo, ko;
#pragma unroll
      for (int i = 0; i < 4; ++i) { qo[i] = pk2(qe[2 * i], qe[2 * i + 1]); ko[i] = pk2(ke[2 * i], ke[2 * i + 1]); }
      *(LAS v4u*)(QEs + r * GP + d0) = qo; *(LAS v4u*)(KEs + r * GP + d0) = ko;
      *(v4u*)(wsp<bf16>(F, WS_QE) + (R0 + r) * 256 + h * 64 + d0) = qo;
      const int e0 = (tid & 7) * 16;
      const v4u va = *(const v4u*)(wsp<const bf16>(F, WS_VG) + (R0 + r) * 512 + h * 128 + e0);
      const v4u vb = *(const v4u*)(wsp<const bf16>(F, WS_VG) + (R0 + r) * 512 + h * 128 + e0 + 8);
#pragma unroll
      for (int i = 0; i < 4; ++i) { VT[(e0 + 2 * i) * GP + r] = (bf16)(va[i] & 0xffffu); VT[(e0 + 2 * i + 1) * GP + r] = (bf16)(va[i] >> 16);
                                    VT[(e0 + 8 + 2 * i) * GP + r] = (bf16)(vb[i] & 0xffffu); VT[(e0 + 8 + 2 * i + 1) * GP + r] = (bf16)(vb[i] >> 16); }
      if (tid < 64) wsp<float>(F, WS_DEC)[(size_t)chunk * 64 + tid] = __expf(gc[63 * 64 + tid]);
    }
    __syncthreads();
    const int l15 = lane & 15, l4 = lane >> 4;
#pragma unroll
    for (int q = 0; q < 2; ++q) { const int tile = 2 * w + q, ti = tile >> 2, tj = tile & 3;
        cf4 a = {0.f, 0.f, 0.f, 0.f};
        if (tj <= ti) {
#pragma unroll
            for (int kk = 0; kk < 2; ++kk) { const bf16x8 fa = *(const LAS bf16x8*)(QEs + (16 * ti + l15) * GP + kk * 32 + 8 * l4); const bf16x8 fb = *(const LAS bf16x8*)(KEs + (16 * tj + l15) * GP + kk * 32 + 8 * l4); a = MFMA16(fa, fb, a); } }
#pragma unroll
        for (int r = 0; r < 4; ++r) { const int cr = 16 * ti + 4 * l4 + r, cj = 16 * tj + l15; AM[cr * GP + cj] = (bf16)f2bf(cj <= cr ? a[r] : 0.f); } }
    { float* UT = wsp<float>(F, WS_UT) + (size_t)chunk * 8192;
#pragma unroll
      for (int td = 0; td < 4; ++td) { cf4 a = {0.f, 0.f, 0.f, 0.f};
#pragma unroll
          for (int kk = 0; kk < 2; ++kk) { const bf16x8 fa = *(const LAS bf16x8*)(VT + (16 * w + l15) * GP + kk * 32 + 8 * l4); const bf16x8 fb = *(const LAS bf16x8*)(KST + (16 * td + l15) * GP + kk * 32 + 8 * l4); a = MFMA16(fa, fb, a); }
#pragma unroll
          for (int r = 0; r < 4; ++r) UT[(16 * w + 4 * l4 + r) * 64 + 16 * td + l15] = a[r]; } }
    __syncthreads();
    { float* OI = wsp<float>(F, WS_OI);
#pragma unroll
      for (int tc = 0; tc < 4; ++tc) { cf4 a = {0.f, 0.f, 0.f, 0.f};
#pragma unroll
          for (int kk = 0; kk < 2; ++kk) { const bf16x8 fa = *(const LAS bf16x8*)(AM + (16 * tc + l15) * GP + kk * 32 + 8 * l4); const bf16x8 fb = *(const LAS bf16x8*)(VT + (16 * w + l15) * GP + kk * 32 + 8 * l4); a = MFMA16(fa, fb, a); }
#pragma unroll
          for (int r = 0; r < 4; ++r) OI[(R0 + 16 * tc + 4 * l4 + r) * 512 + h * 128 + 16 * w + l15] = a[r]; } }
    __syncthreads();
}
__device__ __forceinline__ void gla_b_phase(Frame& F) {
    const float* UT = wsp<const float>(F, WS_UT); const float* DEC = wsp<const float>(F, WS_DEC); bf16* SP = wsp<bf16>(F, WS_SP);
    for (int gt = F.vcu * 512 + F.tid; gt < 16 * 8192; gt += F.G * 512) {
        const int bh = gt >> 13, ed = gt & 8191, d = gt & 63; float S = 0.f;
#pragma unroll 8
        for (int n = 0; n < 128; ++n) { const size_t ch = (size_t)bh * 128 + n; const float u = UT[ch * 8192 + ed], dc = DEC[ch * 64 + d]; SP[ch * 8192 + ed] = (bf16)f2bf(S); S = S * dc + u; }
    }
}
__device__ __forceinline__ void gla_c_unit(Frame& F, int unit) {
    const int tid = F.tid, lane = F.lane, w = F.wave;
    const int bh = unit >> 6, n2 = unit & 63, b = bh >> 2, h = bh & 3;
    const size_t R0 = (size_t)b * SEQ + (size_t)n2 * 128;
    LAS bf16* QEs = (LAS bf16*)F.lds;
    LAS bf16* SPs = (LAS bf16*)(F.lds + 18432);
    { const int r = tid >> 2, d0 = (tid & 3) * 16; const bf16* src = wsp<const bf16>(F, WS_QE) + (R0 + r) * 256 + h * 64 + d0;
      *(LAS v4u*)(QEs + r * GP + d0) = *(const v4u*)src; *(LAS v4u*)(QEs + r * GP + d0 + 8) = *(const v4u*)(src + 8);
      const bf16* sp = wsp<const bf16>(F, WS_SP) + ((size_t)bh * 128 + 2 * n2) * 8192;
      const int row = tid >> 1, dd = (tid & 1) * 32;
#pragma unroll
      for (int i = 0; i < 4; ++i) *(LAS v4u*)(SPs + row * GP + dd + 8 * i) = *(const v4u*)(sp + (size_t)row * 64 + dd + 8 * i); }
    __syncthreads();
    const int l15 = lane & 15, l4 = lane >> 4, c2 = w >> 2, tc = w & 3;
    cf4 a[8];
#pragma unroll
    for (int te = 0; te < 8; ++te) { a[te] = (cf4){0.f, 0.f, 0.f, 0.f};
#pragma unroll
        for (int kk = 0; kk < 2; ++kk) { const bf16x8 fa = *(const LAS bf16x8*)(QEs + (64 * c2 + 16 * tc + l15) * GP + kk * 32 + 8 * l4); const bf16x8 fb = *(const LAS bf16x8*)(SPs + (128 * c2 + 16 * te + l15) * GP + kk * 32 + 8 * l4); a[te] = MFMA16(fa, fb, a[te]); } }
    const float* OI = wsp<const float>(F, WS_OI); const bf16* RG = wsp<const bf16>(F, WS_RG); bf16* A2 = wsp<bf16>(F, WS_A2);
    float gg[8];
#pragma unroll
    for (int te = 0; te < 8; ++te) gg[te] = F.g_gla_out[16 * te + l15];
#pragma unroll
    for (int r = 0; r < 4; ++r) { const size_t row = R0 + 64 * c2 + 16 * tc + 4 * l4 + r; float ss = 0.f; float o[8];
#pragma unroll
        for (int te = 0; te < 8; ++te) { o[te] = a[te][r] + OI[row * 512 + h * 128 + 16 * te + l15]; ss += o[te] * o[te]; }
        ss += __shfl_xor(ss, 1); ss += __shfl_xor(ss, 2); ss += __shfl_xor(ss, 4); ss += __shfl_xor(ss, 8);
        const float rs = rsqrtf(ss * (1.f / 128.f) + EPS);
#pragma unroll
        for (int te = 0; te < 8; ++te) { const int e = 16 * te + l15; A2[row * 1024 + h * 128 + e] = (bf16)f2bf(o[te] * rs * gg[te] * bf2f(RG[row * 512 + h * 128 + e])); } }
    __syncthreads();
}

namespace att {
constexpr int KSLOT = 8192, VSLOT = 16384, NSLOT = 3;
constexpr int LDS_K = 0, LDS_V = NSLOT * KSLOT, LDS_TBL = LDS_V + NSLOT * VSLOT, LDS_WS = LDS_TBL + 1024, LDS_Q = LDS_WS + 8 * 256, LDS_END = LDS_Q + 8 * 4096;
static_assert(LDS_END <= RING_BYTES, "attention LDS");
__device__ __forceinline__ int crow(int r, int hi) { return (r & 3) + 8 * (r >> 2) + 4 * hi; }
__device__ __forceinline__ void glds16(const void* gsrc, unsigned lds_dst) { unsigned keep;
    asm volatile("s_mov_b32 %0, m0\n\ts_mov_b32 m0, %2\n\ts_nop 0\n\tglobal_load_lds_dwordx4 %1, off\n\ts_mov_b32 m0, %0" : "=&s"(keep) : "v"(gsrc), "s"(lds_dst) : "memory"); }
typedef float f32x2_t __attribute__((ext_vector_type(2))); typedef __bf16 bf16x2_t __attribute__((ext_vector_type(2)));
__device__ __forceinline__ unsigned cvtpk_s(float lo, float hi) { f32x2_t v = {lo, hi}; bf16x2_t b = __builtin_convertvector(v, bf16x2_t); return __builtin_bit_cast(unsigned, b); }
typedef short v4i16_t __attribute__((ext_vector_type(4)));
typedef LAS const char* lds_cptr;
__device__ __forceinline__ s16x4 vtr(lds_cptr p) { return __builtin_bit_cast(s16x4, __builtin_amdgcn_ds_read_tr16_b64_v4i16((LAS v4i16_t*)p)); }
#define MFMA32(a, b, c) __builtin_amdgcn_mfma_f32_32x32x16_bf16((a), (b), (c), 0, 0, 0)
#define ATT_WAIT_BAR(N) asm volatile("s_waitcnt vmcnt(" #N ") lgkmcnt(0)\n\ts_barrier" ::: "memory")

__device__ __forceinline__ void attn_map(f32x16 (&o)[4], int b, int h, int m, int qb, const bf16* QD, const bf16* KD, const bf16* VD, LAS unsigned char* shm) {
    int lane = threadIdx.x & 63; asm volatile("" : "+v"(lane));
    const int tid = threadIdx.x, r32 = lane & 31, hi = lane >> 5; const int wid = __builtin_amdgcn_readfirstlane(tid >> 6);
    const size_t rowbase = (size_t)b * SEQ; const int q0 = qb * 256;
    const bf16* Qw = QD + (rowbase + q0 + wid * 32) * 512 + (h * 2 + m) * 64;
    const bf16* Kh = KD + rowbase * 512 + (h * 2 + m) * 64; const bf16* Vh = VD + rowbase * 512 + h * 128;
    const unsigned lds0 = (unsigned)(uintptr_t)shm;
    const LAS float* tbl = (const LAS float*)(shm + LDS_TBL) + m * 128;
    LAS float* wsf = (LAS float*)(shm + LDS_WS) + wid * 64;
    const bf16* ksrc = Kh + (size_t)lane * 512 + wid * 8;
    const bf16* vsrc = Vh + (size_t)(16 * (wid & 3) + (lane >> 2)) * 512 + (wid >> 2) * 32 + (lane & 3) * 8;
    const unsigned kdst = lds0 + LDS_K + wid * 1024, vdst = lds0 + LDS_V + wid * 1024;
#define DMA_K(t, slot) glds16(ksrc + (size_t)(t) * 64 * 512, (unsigned)__builtin_amdgcn_readfirstlane(kdst + (slot) * KSLOT))
#define DMA_V(t, slot) do { glds16(vsrc + (size_t)(t) * 64 * 512, (unsigned)__builtin_amdgcn_readfirstlane(vdst + (slot) * VSLOT)); \
        glds16(vsrc + (size_t)(t) * 64 * 512 + 64, (unsigned)__builtin_amdgcn_readfirstlane(vdst + (slot) * VSLOT + 8192)); } while (0)
    const int NT = 4 * qb + 4;
    VM_WAIT();
    DMA_K(0, 0); DMA_V(0, 0); DMA_K(1, 1); DMA_K(2, 2);
    const lds_cptr qlds = (lds_cptr)shm + LDS_Q + wid * 4096 + lane * 16;
    { bf16x8 qr[4];
#pragma unroll
      for (int d0 = 0; d0 < 4; ++d0) qr[d0] = *(const bf16x8*)(Qw + (size_t)r32 * 512 + d0 * 16 + hi * 8);
      asm volatile("s_waitcnt vmcnt(0)" : "+v"(qr[0]), "+v"(qr[1]), "+v"(qr[2]), "+v"(qr[3]) :: "memory");
#pragma unroll
      for (int d0 = 0; d0 < 4; ++d0) *(LAS bf16x8*)(shm + LDS_Q + wid * 4096 + lane * 16 + d0 * 1024) = qr[d0]; }
#pragma unroll
    for (int d0 = 0; d0 < 4; ++d0) o[d0] = (f32x16){};
    float lsum = 0.f;
    const int qw0 = q0 + wid * 32, qabs = qw0 + r32;
    const lds_cptr shm3 = (lds_cptr)shm;
    const lds_cptr kp0 = shm3 + LDS_K + hi * 1024 + r32 * 16;
    const lds_cptr vp0 = shm3 + LDS_V + ((lane >> 4) & 1) * 32 + (lane & 3) * 8 + (4 * hi + ((lane & 15) >> 2)) * 64;
#define QK_TILE(C0, C1, kp) do { C0 = (f32x16){}; C1 = (f32x16){}; \
        _Pragma("unroll") for (int d0 = 0; d0 < 4; ++d0) { if (d0 == 2) __builtin_amdgcn_sched_barrier(0); const bf16x8 b0 = *(const LAS bf16x8*)((kp) + d0 * 2048); const bf16x8 b1 = *(const LAS bf16x8*)((kp) + d0 * 2048 + 512); \
            const bf16x8 qf_ = *(const LAS bf16x8*)(qlds + d0 * 1024); C0 = MFMA32(b0, qf_, C0); C1 = MFMA32(b1, qf_, C1); } } while (0)
#define MASK_BIAS(C0, C1, t) do { const int kvb_ = (t) * 64; if (kvb_ + 191 > qw0) { int dbase = qabs - kvb_ - 4 * hi; asm volatile("" : "+v"(dbase)); \
        _Pragma("unroll") for (int r = 0; r < 16; ++r) { const int d0_ = dbase - ((r & 3) + 8 * (r >> 2)); const int d1_ = d0_ - 32; \
            const float t0_ = tbl[min(max(d0_, 0), 127)], t1_ = tbl[min(max(d1_, 0), 127)]; \
            C0[r] = d0_ < 0 ? -INFINITY : C0[r] + t0_; C1[r] = d1_ < 0 ? -INFINITY : C1[r] + t1_; } } } while (0)
#define VLOAD(vf, vp, d0) do { _Pragma("unroll") for (int ks = 0; ks < 4; ++ks) { const s16x4 lo_ = vtr((vp) + (d0) * 4096 + ks * 1024), hh_ = vtr((vp) + (d0) * 4096 + ks * 1024 + 512); \
            vf[ks] = (bf16x8){lo_[0], lo_[1], lo_[2], lo_[3], hh_[0], hh_[1], hh_[2], hh_[3]}; } } while (0)
#define PV4(d0, vf) do { _Pragma("unroll") for (int ks = 0; ks < 4; ++ks) o[d0] = MFMA32(__builtin_bit_cast(bf16x8, pw[ks]), vf[ks], o[d0]); } while (0)
#define PACK_SUM(P0, P1) do { float sacc = 0.f; _Pragma("unroll") for (int r = 0; r < 16; ++r) sacc += P0[r] + P1[r]; lsum += sacc; \
        _Pragma("unroll") for (int i = 0; i < 4; ++i) { pw[0][i] = cvtpk_s(P0[2 * i], P0[2 * i + 1]); pw[1][i] = cvtpk_s(P0[8 + 2 * i], P0[9 + 2 * i]); pw[2][i] = cvtpk_s(P1[2 * i], P1[2 * i + 1]); pw[3][i] = cvtpk_s(P1[8 + 2 * i], P1[9 + 2 * i]); } } while (0)
#define EXP_PACK(C, pwa, pwb) do { float sacc = 0.f; _Pragma("unroll") for (int r = 0; r < 16; ++r) { C[r] = __builtin_amdgcn_exp2f(C[r]); sacc += C[r]; } lsum += sacc; \
        _Pragma("unroll") for (int i = 0; i < 4; ++i) { pwa[i] = cvtpk_s(C[2 * i], C[2 * i + 1]); pwb[i] = cvtpk_s(C[8 + 2 * i], C[9 + 2 * i]); } } while (0)
#define KLOAD(kf, kp) do { _Pragma("unroll") for (int d0 = 0; d0 < 4; ++d0) { kf[2 * d0] = *(const LAS bf16x8*)((kp) + d0 * 2048); kf[2 * d0 + 1] = *(const LAS bf16x8*)((kp) + d0 * 2048 + 512); } } while (0)
#define QLOAD(qf) do { _Pragma("unroll") for (int d0 = 0; d0 < 4; ++d0) qf[d0] = *(const LAS bf16x8*)(qlds + d0 * 1024); } while (0)
#define QK8(C0, C1, kf, qf) do { C0 = (f32x16){}; C1 = (f32x16){}; _Pragma("unroll") for (int d0 = 0; d0 < 4; ++d0) { C0 = MFMA32(kf[2 * d0], qf[d0], C0); C1 = MFMA32(kf[2 * d0 + 1], qf[d0], C1); } } while (0)
#define SB() __builtin_amdgcn_sched_barrier(0)
    f32x16 C0, C1; v4u pw[4], pwn[4]; bf16x8 va[4], vb[4], kf[8], qf[4];
    ATT_WAIT_BAR(0);
    KLOAD(kf, kp0); QLOAD(qf);
    ATT_WAIT_BAR(0);
    if (3 < NT) DMA_K(3, 0);
    DMA_V(1, 1);
    QK8(C0, C1, kf, qf);
    MASK_BIAS(C0, C1, 0);
    EXP_PACK(C0, pw[0], pw[1]); EXP_PACK(C1, pw[2], pw[3]);
    KLOAD(kf, kp0 + KSLOT);
    int ks_cur = 1, vs_prev = 0;
    for (int t = 1; t < NT; ++t) {
        if (t + 2 < NT) { ATT_WAIT_BAR(3); } else { ATT_WAIT_BAR(2); }
        { const int vs_new = (vs_prev == 0) ? 2 : vs_prev - 1;
          if (t + 3 < NT) DMA_K(t + 3, ks_cur);
          if (t + 1 < NT) DMA_V(t + 1, vs_new); }
        const int ks_next = (ks_cur == 2) ? 0 : ks_cur + 1;
        const lds_cptr vp = vp0 + vs_prev * VSLOT;
        SB();
        VLOAD(va, vp, 0); VLOAD(vb, vp, 1);
        SB();
        QK8(C0, C1, kf, qf);
        SB();
        MASK_BIAS(C0, C1, t);
        SB();
        PV4(0, va); PV4(1, vb);
        EXP_PACK(C0, pwn[0], pwn[1]);
        SB();
        VLOAD(va, vp, 2); VLOAD(vb, vp, 3);
        KLOAD(kf, kp0 + ks_next * KSLOT);
        SB();
        PV4(2, va); PV4(3, vb);
        EXP_PACK(C1, pwn[2], pwn[3]);
        SB();
#pragma unroll
        for (int i = 0; i < 4; ++i) pw[i] = pwn[i];
        ks_cur = ks_next; vs_prev = (vs_prev == 2) ? 0 : vs_prev + 1;
    }
    ATT_WAIT_BAR(0);
    { const lds_cptr vp = vp0 + vs_prev * VSLOT;
      VLOAD(va, vp, 0); VLOAD(vb, vp, 1); PV4(0, va); PV4(1, vb);
      VLOAD(va, vp, 2); VLOAD(vb, vp, 3); PV4(2, va); PV4(3, vb); }
    { auto rr = __builtin_amdgcn_permlane32_swap(__float_as_uint(lsum), __float_as_uint(lsum), false, false); lsum = __uint_as_float(rr[0]) + __uint_as_float(rr[1]); }
    if (hi == 0) wsf[r32] = lsum;
    LDS_WAIT();
#pragma unroll
    for (int r = 0; r < 16; ++r) { const float rl = 1.0f / wsf[crow(r, hi)];
#pragma unroll
        for (int d0 = 0; d0 < 4; ++d0) o[d0][r] *= rl; }
    ATT_WAIT_BAR(0);
#undef DMA_K
#undef DMA_V
#undef QK_TILE
#undef MASK_BIAS
#undef VLOAD
#undef PV4
#undef PACK_SUM
#undef EXP_PACK
#undef KLOAD
#undef QLOAD
#undef QK8
#undef SB
}
__device__ __forceinline__ int t5_bucket(int n) {
    if (n < 16) return n;
    const float nf = (float)n; int large = 16 + (int)(logf(nf / 16.f) / logf(8.f) * 16.f);
    return large < 31 ? large : 31;
}
__device__ __forceinline__ void attn_unit(Frame& F, int b, int h, int qb, float lam) {
    LAS unsigned char* shm = F.lds;
    int tid = F.tid; asm volatile("" : "+v"(tid));
    const int lane = tid & 63, r32 = lane & 31, hi = lane >> 5, wid = F.wave;
    if (tid < 256) { const int m = tid >> 7, d = tid & 127; const int col = h * 2 + m;
        ((LAS float*)(shm + LDS_TBL))[tid] = (F.rel_bias[t5_bucket(d) * 8 + col] - F.rel_bias[31 * 8 + col]) * LOG2E; }
    __syncthreads();
    const bf16* QD = wsp<const bf16>(F, WS_QD); const bf16* KD = wsp<const bf16>(F, WS_KD); const bf16* VD = wsp<const bf16>(F, WS_VD);
    float* stash = wsp<float>(F, WS_STASH) + (size_t)F.vcu * 32768 + tid * 64;
    f32x16 o[4];
#pragma nounroll
    for (int m = 0; m < 2; ++m) {
        attn_map(o, b, h, m, qb, QD, KD, VD, shm);
        if (m == 0) {
#pragma unroll
            for (int d0 = 0; d0 < 4; ++d0)
#pragma unroll
                for (int r = 0; r < 16; r += 4) *(f32x4*)(stash + d0 * 16 + r) = (f32x4){o[d0][r], o[d0][r + 1], o[d0][r + 2], o[d0][r + 3]};
        } else {
            float ss[16];
#pragma unroll
            for (int r = 0; r < 16; ++r) ss[r] = 0.f;
#pragma unroll
            for (int d0 = 0; d0 < 4; ++d0)
#pragma unroll
                for (int r4 = 0; r4 < 16; r4 += 4) { const f32x4 sv = *(const f32x4*)(stash + d0 * 16 + r4);
#pragma unroll
                    for (int q = 0; q < 4; ++q) { const int r = r4 + q; const float v = sv[q] - lam * o[d0][r]; o[d0][r] = v; ss[r] += v * v; } }
            float gs[4];
#pragma unroll
            for (int d0 = 0; d0 < 4; ++d0) gs[d0] = F.g_subln[32 * d0 + r32] * 0.8f;
            bf16* A2 = wsp<bf16>(F, WS_A2);
            const size_t rowb = (size_t)b * SEQ + (size_t)qb * 256 + wid * 32;
            bf16* a2b = A2 + (rowb + 4 * hi) * 1024 + 512 + h * 128 + r32; asm volatile("" : "+v"(a2b));
#pragma unroll
            for (int r = 0; r < 16; ++r) { float s = ss[r];
                s += __shfl_xor(s, 1); s += __shfl_xor(s, 2); s += __shfl_xor(s, 4); s += __shfl_xor(s, 8); s += __shfl_xor(s, 16);
                const float rs = rsqrtf(s * (1.f / 128.f) + EPS);
                bf16* rowp = a2b + (size_t)((r & 3) + 8 * (r >> 2)) * 1024;
#pragma unroll
                for (int d0 = 0; d0 < 4; ++d0) rowp[32 * d0] = (bf16)f2bf(o[d0][r] * rs * gs[d0]); }
        }
    }
    __syncthreads();
}
}

__device__ __forceinline__ void p7_phase(Frame& F, bool count = true) {
    const int tid = F.tid, lane = F.lane;
    LAS float* wr = (LAS float*)F.lds;
    LAS unsigned* hist = (LAS unsigned*)(F.lds + HIST_OFF);
    { f32x4 t[16]; const int k0 = tid >> 3, e4 = (tid & 7) * 4;
#pragma unroll
      for (int it = 0; it < 16; ++it) t[it] = *(const f32x4*)(F.w_router + (size_t)(k0 + 64 * it) * 32 + e4);
#pragma unroll
      for (int it = 0; it < 16; ++it)
#pragma unroll
          for (int q = 0; q < 4; ++q) wr[(e4 + q) * 1024 + k0 + 64 * it] = t[it][q]; }
    if (tid < 32) hist[tid] = 0u;
    __syncthreads();
    const float* MOD = wsp<const float>(F, WS_MOD);
    const int gw = F.vcu * NWAVES + F.wave, NGW = F.G * NWAVES; const int rpw = (T + NGW - 1) / NGW;
    int curb = -1; f32x4 gsc[4], shv[4], nx[4];
    v2u nm[4]; const bf16* MIX = wsp<const bf16>(F, WS_MIX);
    { const int m0 = (srow(gw, 0, NGW) < T) ? srow(gw, 0, NGW) : 0; const GAS f32x4* xr = (const GAS f32x4*)(F.x + (size_t)m0 * D) + lane; const GAS v2u* mr = (const GAS v2u*)(MIX + (size_t)m0 * D) + lane;
#pragma unroll
      for (int j = 0; j < 4; ++j) { nx[j] = xr[64 * j]; nm[j] = mr[64 * j]; } }
#pragma nounroll
    for (int i = 0; i < rpw; ++i) {
        const int m = srow(gw, i, NGW); if (m >= T) break;
        const int b = m / SEQ;
        if (b != curb) { curb = b;
#pragma unroll
            for (int j = 0; j < 4; ++j) { const int col = 256 * j + 4 * lane; const f32x4 g = *(const f32x4*)(F.g_norm2 + col);
                shv[j] = *(const f32x4*)(MOD + (size_t)b * 6144 + 3072 + col); gsc[j] = g * (*(const f32x4*)(MOD + (size_t)b * 6144 + 4096 + col) + 1.0f); } }
        f32x4 v[4]; float s = 0.f;
#pragma unroll
        for (int j = 0; j < 4; ++j) { v[j] = nx[j] + (f32x4){bflo(nm[j].x), bfhi(nm[j].x), bflo(nm[j].y), bfhi(nm[j].y)}; s += (v[j].x * v[j].x + v[j].y * v[j].y) + (v[j].z * v[j].z + v[j].w * v[j].w); }
        { const int mn_ = srow(gw, i + 1, NGW); const int m2 = (i + 1 < rpw && mn_ < T) ? mn_ : m; const GAS f32x4* xr = (const GAS f32x4*)(F.x + (size_t)m2 * D) + lane; const GAS v2u* mr = (const GAS v2u*)(MIX + (size_t)m2 * D) + lane;
#pragma unroll
          for (int j = 0; j < 4; ++j) { nx[j] = xr[64 * j]; nm[j] = mr[64 * j]; } }
        const float rstd = rsqrtf(wave_sum(s) * (1.f / D) + EPS);
        GAS unsigned* o4 = (GAS unsigned*)(wsp<unsigned char>(F, WS_XN) + (size_t)m * D) + lane;
#pragma unroll
        for (int j = 0; j < 4; ++j) { v[j] = v[j] * rstd * gsc[j] + shv[j]; o4[64 * j] = pk4_fp8(v[j].x, v[j].y, v[j].z, v[j].w); }
        float lg[32];
        { f32x4 wa[8], wb[8];
          const LAS float* wrA = wr + 4 * lane; const LAS float* wrB = wr + 16 * 1024 + 4 * lane; asm volatile("" : "+v"(wrA), "+v"(wrB));
#define P7_LD(dst, eb) do { _Pragma("unroll") for (int q = 0; q < 8; ++q) dst[q] = *(const LAS f32x4*)(((eb) < 8 ? wrA : wrB) + (((eb) & 7) * 2 + (q >> 2)) * 1024 + 256 * (q & 3)); } while (0)
#define P7_DOT(src, eb) do { _Pragma("unroll") for (int rr = 0; rr < 2; ++rr) { f32x2 a2 = {0.f, 0.f}; _Pragma("unroll") for (int j = 0; j < 4; ++j) { const f32x4 w = src[rr * 4 + j]; a2 += v[j].lo * w.lo; a2 += v[j].hi * w.hi; } lg[(eb) * 2 + rr] = a2.x + a2.y; } } while (0)
          P7_LD(wa, 0); __builtin_amdgcn_sched_barrier(0);
#pragma unroll
          for (int eb = 0; eb < 16; eb += 2) {
              P7_LD(wb, eb + 1); __builtin_amdgcn_sched_barrier(0);
              P7_DOT(wa, eb); __builtin_amdgcn_sched_barrier(0);
              if (eb + 2 < 16) { P7_LD(wa, eb + 2); __builtin_amdgcn_sched_barrier(0); }
              P7_DOT(wb, eb + 1); __builtin_amdgcn_sched_barrier(0);
          }
#undef P7_LD
#undef P7_DOT
        }
        const float myl = xreduce<32>(lg, lane) + F.b_router[lane >> 1];
        unsigned key; { const unsigned u = __builtin_bit_cast(unsigned, myl); const unsigned o = (u & 0x80000000u) ? ~u : (u | 0x80000000u); key = (o & ~31u) | (unsigned)(31 - (lane >> 1)); }
        int te[4]; float tv[4];
#pragma unroll
        for (int k = 0; k < 4; ++k) { const unsigned mx = wave_umax(key); te[k] = 31 - (int)(mx & 31u); tv[k] = lane_bcast(myl, 2 * te[k]); key = (key == mx) ? 0u : key; }
        float ex[4], es = 0.f;
#pragma unroll
        for (int k = 0; k < 4; ++k) { ex[k] = __expf(tv[k] - tv[0]); es += ex[k]; }
        if (lane < 4) { const int e = lane == 0 ? te[0] : lane == 1 ? te[1] : lane == 2 ? te[2] : te[3]; const float w = (lane == 0 ? ex[0] : lane == 1 ? ex[1] : lane == 2 ? ex[2] : ex[3]) / es;
            wsp<int>(F, WS_TOPE)[(size_t)m * 4 + lane] = e; wsp<float>(F, WS_TOPW)[(size_t)m * 4 + lane] = w; __hip_atomic_fetch_add(hist + e, 1u, __ATOMIC_RELAXED, __HIP_MEMORY_SCOPE_WORKGROUP); }
    }
    __syncthreads();
    if (tid < 32 && count) __hip_atomic_fetch_add(F.ctl + CW_CNT + tid, hist[tid], RLX_AGENT);
}
__device__ __forceinline__ void moe_tables(Frame& F, int& nMt) {
    LAS unsigned char* te = F.lds + TILEE_OFF;
    LAS unsigned* nt = (LAS unsigned*)(F.lds + HIST_OFF);
    if (F.tid < 32) nt[F.tid] = ((unsigned)__hip_atomic_load(F.ctl + CW_CNT + F.tid, RLX_AGENT) + 255u) >> 8;
    __syncthreads();
    { int start = 0, mine0 = -1, mine1 = -1; const int t0 = F.tid, t1 = F.tid + 512;
#pragma unroll 8
      for (int e = 0; e < NE; ++e) { const int n = (int)nt[e]; if (t0 >= start && t0 < start + n) mine0 = e; if (t1 >= start && t1 < start + n) mine1 = e; start += n; }
      if (mine0 >= 0) te[t0] = (unsigned char)mine0;
      if (mine1 >= 0) te[t1] = (unsigned char)mine1;
      if (F.tid == 0) F.MISC[16] = (unsigned)start; }
    __syncthreads();
    nMt = __builtin_amdgcn_readfirstlane((int)F.MISC[16]);
}
__device__ __forceinline__ void p8_phase(Frame& F) {
    const int tid = F.tid, lane = F.lane;
    LAS unsigned* hist = (LAS unsigned*)(F.lds + HIST_OFF);
    if (tid < 128) hist[tid] = 0u;
    __syncthreads();
    const int gw = F.vcu * NWAVES + F.wave, NGW = F.G * NWAVES; const int rpw = (T + NGW - 1) / NGW;
    const int* TOPE = wsp<const int>(F, WS_TOPE);
    const int mw0 = gw * rpw;
    for (int c = 0; c < rpw; c += 16) { const int m = mw0 + c + (lane >> 2); if (c + (lane >> 2) < rpw && m < T) __hip_atomic_fetch_add(hist + TOPE[(size_t)m * 4 + (lane & 3)], 1u, __ATOMIC_RELAXED, __HIP_MEMORY_SCOPE_WORKGROUP); }
    __syncthreads();
    if (tid < 32) hist[96 + tid] = (__hip_atomic_load(F.ctl + CW_CNT + tid, RLX_AGENT) + 255u) & ~255u;
    __syncthreads();
    if (tid < 32) { unsigned pstart = 0; for (int e = 0; e < tid; ++e) pstart += hist[96 + e];
        hist[32 + tid] = pstart + __hip_atomic_fetch_add(F.ctl + CW_FILL + tid, hist[tid], RLX_AGENT); }
    __syncthreads();
    const unsigned char* H2 = wsp<const unsigned char>(F, WS_XN); unsigned char* XS = wsp<unsigned char>(F, WS_XS);
    for (int c = 0; c < rpw; c += 16) {
        const int mr = mw0 + c + (lane >> 2); const bool ok = (c + (lane >> 2) < rpw) && (mr < T);
        int pos = 0;
        if (ok) { const int e = TOPE[(size_t)mr * 4 + (lane & 3)]; pos = (int)(hist[32 + e] + __hip_atomic_fetch_add(hist + 64 + e, 1u, __ATOMIC_RELAXED, __HIP_MEMORY_SCOPE_WORKGROUP));
            wsp<int>(F, WS_POS)[(size_t)mr * 4 + (lane & 3)] = pos; }
        v4u rowv[16];
#pragma unroll
        for (int i = 0; i < 16; ++i) { const int m = mw0 + c + i; const int mm = (c + i < rpw && m < T) ? m : mw0; rowv[i] = *(const v4u*)(H2 + (size_t)mm * D + lane * 16); }
#pragma unroll
        for (int i = 0; i < 16; ++i) { const int m = mw0 + c + i; const bool rok = (c + i < rpw) && (m < T);
#pragma unroll
            for (int k = 0; k < 4; ++k) { const int p = __shfl(pos, 4 * i + k); if (rok) *(v4u*)(XS + (size_t)p * D + lane * 16) = rowv[i]; } }
    }
}
__device__ __forceinline__ void p11_phase(Frame& F) {
    const int lane = F.lane;
    const float* MOD = wsp<const float>(F, WS_MOD); const unsigned char* CN = wsp<const unsigned char>(F, WS_CN); const int* POS = wsp<const int>(F, WS_POS);
    const int gw = F.vcu * NWAVES + F.wave, NGW = F.G * NWAVES; const int rpw = (T + NGW - 1) / NGW;
    const int nrow = (srow(gw, 0, NGW) < T) ? ((srow(gw, rpw - 1, NGW) < T) ? rpw : 0) : 0;
    int cnt = nrow; if (NGW * 16 != T) { cnt = 0; for (int i = 0; i < rpw; ++i) if (srow(gw, i, NGW) < T) ++cnt; }
    if (cnt == 0) return;
#define RW(i) srow(gw, ((i) < cnt ? (i) : cnt - 1), NGW)
    v4u ca[4], mx0, mx1; f32x4 xv[4]; int pn[4]; f32x4 wcur, wnxt; const float* TOPW = wsp<const float>(F, WS_TOPW); const bf16* MIXp = wsp<const bf16>(F, WS_MIX);
#define P11_LOAD(mm) do { _Pragma("unroll") for (int k = 0; k < 4; ++k) ca[k] = *(const v4u*)(CN + (size_t)pn[k] * D + lane * 16); \
        _Pragma("unroll") for (int q = 0; q < 4; ++q) xv[q] = *(const f32x4*)(F.x + (size_t)(mm) * D + lane * 16 + 4 * q); \
        { const v4u* ms_ = (const v4u*)(MIXp + (size_t)(mm) * D + lane * 16); mx0 = ms_[0]; mx1 = ms_[1]; } } while (0)
    { const int4 p4 = *(const int4*)(POS + (size_t)RW(0) * 4); pn[0] = p4.x; pn[1] = p4.y; pn[2] = p4.z; pn[3] = p4.w; }
    P11_LOAD(RW(0)); wcur = *(const f32x4*)(TOPW + (size_t)RW(0) * 4);
    { const int m2 = RW(1); const int4 p4 = *(const int4*)(POS + (size_t)m2 * 4); pn[0] = p4.x; pn[1] = p4.y; pn[2] = p4.z; pn[3] = p4.w; wnxt = *(const f32x4*)(TOPW + (size_t)m2 * 4); }
#pragma nounroll
    for (int i = 0; i < cnt; ++i) {
        const int m = RW(i);
        const int b = m / SEQ;
        float acc[16];
#pragma unroll
        for (int q = 0; q < 16; ++q) acc[q] = 0.f;
#pragma unroll
        for (int k = 0; k < 4; ++k) { const float wk = wcur[k];
#pragma unroll
            for (int q = 0; q < 4; ++q) { const int wq = (int)ca[k][q];
                acc[4 * q] += wk * __builtin_amdgcn_cvt_f32_fp8(wq, 0); acc[4 * q + 1] += wk * __builtin_amdgcn_cvt_f32_fp8(wq, 1);
                acc[4 * q + 2] += wk * __builtin_amdgcn_cvt_f32_fp8(wq, 2); acc[4 * q + 3] += wk * __builtin_amdgcn_cvt_f32_fp8(wq, 3); } }
        f32x4 ov[4]; const float* gt = MOD + (size_t)b * 6144 + 5120 + lane * 16;
#pragma unroll
        for (int q = 0; q < 4; ++q) { const f32x4 g = *(const f32x4*)(gt + 4 * q); const f32x4 av = {acc[4 * q], acc[4 * q + 1], acc[4 * q + 2], acc[4 * q + 3]};
            const unsigned ma = q < 2 ? mx0[2 * q] : mx1[2 * q - 4], mb = q < 2 ? mx0[2 * q + 1] : mx1[2 * q - 3];
            ov[q] = xv[q] + (f32x4){bflo(ma), bfhi(ma), bflo(mb), bfhi(mb)} + g * av; }
        P11_LOAD(RW(i + 1));
        wcur = wnxt;
        { const int m2 = RW(i + 2); const int4 p4 = *(const int4*)(POS + (size_t)m2 * 4); pn[0] = p4.x; pn[1] = p4.y; pn[2] = p4.z; pn[3] = p4.w; wnxt = *(const f32x4*)(TOPW + (size_t)m2 * 4); }
        float* orow = F.out + (size_t)m * D + lane * 16;
#pragma unroll
        for (int q = 0; q < 4; ++q) *(f32x4*)(orow + 4 * q) = ov[q];
    }
#undef RW
#undef P11_LOAD
}

constexpr int NPHASE = 12;
struct Args { const float* in[25]; float* out; unsigned char* ws; int ph_lo, ph_hi; };
__global__ void __launch_bounds__(NWAVES * 64, 2) fwd_kernel(Args args) {
    extern __shared__ __attribute__((aligned(16))) unsigned char lds[];
    Frame F;
    F.lds = (LAS unsigned char*)lds;
    F.MISC = (volatile LAS unsigned*)(F.lds + MISC_OFF);
    F.tid = threadIdx.x; F.lane = F.tid & 63; F.wave = __builtin_amdgcn_readfirstlane(F.tid >> 6);
    F.G = gridDim.x; { const int bx = blockIdx.x; F.vcu = (F.G % 8 == 0) ? (bx % 8) * (F.G / 8) + bx / 8 : bx; }
    F.ws = args.ws; F.ctl = (gu32*)(args.ws + WS_CTL); F.out = args.out;
    F.x = args.in[0]; F.c = args.in[1]; F.rel_bias = args.in[2]; F.w_ada = args.in[3]; F.b_ada = args.in[4]; F.g_norm1 = args.in[5]; F.w_in = args.in[6];
    F.w_gk_up = args.in[7]; F.b_gk_up = args.in[8]; F.g_gla_out = args.in[9]; F.g_qnorm = args.in[10]; F.g_knorm = args.in[11];
    F.lq1 = args.in[12]; F.lk1 = args.in[13]; F.lq2 = args.in[14]; F.lk2 = args.in[15]; F.g_subln = args.in[16]; F.w_out = args.in[17];
    F.g_norm2 = args.in[18]; F.w_router = args.in[19]; F.b_router = args.in[20]; F.w_gate_up = args.in[21]; F.b_gate_up = args.in[22]; F.w_down = args.in[23]; F.b_down = args.in[24];
    for (int u = F.tid; u < (LDS_BYTES - LDSCTL_OFF) / 4; u += NWAVES * 64) ((LAS unsigned*)(F.lds + LDSCTL_OFF))[u] = 0u;
    __syncthreads();
    const int lo = args.ph_lo, hi = args.ph_hi;
    const bool multi = (hi - lo) > 1;
    XcdBarrier bar; bar.bar = (unsigned*)(F.ctl + CW_BAR); bar.x = 0; bar.st = nullptr;
    if (multi) bar = xcd_barrier_post((unsigned*)(F.ctl + CW_BAR), F.MISC + 8);
#ifndef PHMASK
#define PHMASK 0xFFF
#endif
#define IN(k) (((PHMASK >> (k)) & 1) && lo <= (k) && (k) < hi)
#define SEAM(k) do { if (IN((k) + 1)) xcd_barrier(bar); } while (0)
#ifndef REPEAT_PH
#define REPEAT_PH 0
#endif
#define REPS(k) (((REPEAT_PH >> (k)) & 1) ? 2 : 1)

    if (IN(0)) { for (int rep_ = 0; rep_ < REPS(0); ++rep_) { if (rep_) xcd_barrier(bar); p0_phase(F); } SEAM(0); }
    if (IN(1)) { for (int rep_ = 0; rep_ < REPS(1); ++rep_) { if (rep_) xcd_barrier(bar); p1_phase(F); } SEAM(1); }
    if (IN(2)) {
        pg8::Gemm g{wsp<const bf16>(F, WS_XN), wsp<const bf16>(F, WS_WIN), T, NIN, D, 0};
        pg8::StaticOrder S; S.init(T / 256, NIN / 256, F.G, (int)blockIdx.x, nullptr, REPS(2));
        EpiInProj E{wsp<bf16>(F, WS_QG), wsp<bf16>(F, WS_KG), wsp<bf16>(F, WS_VG), wsp<bf16>(F, WS_RG), wsp<bf16>(F, WS_QD), wsp<bf16>(F, WS_KD), wsp<bf16>(F, WS_VD), F.g_qnorm, F.g_knorm};
        pg8::gemm_phase<EpiInProj, pg8::StaticOrder>(F.lds, g, S, E);
        SEAM(2);
    }
    if (IN(3)) { for (int rep_ = 0; rep_ < REPS(3); ++rep_) { if (rep_) xcd_barrier(bar); for (int c = F.vcu; c < NCHUNK; c += F.G) gla_a_unit(F, c); } SEAM(3); }
    if (IN(4)) { for (int rep_ = 0; rep_ < REPS(4); ++rep_) { if (rep_) xcd_barrier(bar); gla_b_phase(F); } SEAM(4); }
    if (IN(5)) for (int rep_ = 0; rep_ < REPS(5); ++rep_) { if (rep_) xcd_barrier(bar);
#ifndef NO_GLAC
        for (int u = F.vcu; u < NCHUNK / 2; u += F.G) gla_c_unit(F, u);
#endif
        float lam;
        { float a1 = F.lq1[F.lane] * F.lk1[F.lane], a2 = F.lq2[F.lane] * F.lk2[F.lane]; a1 = wave_sum(a1); a2 = wave_sum(a2); lam = __expf(a1) - __expf(a2) + 0.2f; }
#ifndef NO_ATT
        for (int p = F.vcu; p < 256; p += F.G) { const int bh = p >> 4, s = p & 15;
#pragma nounroll
            for (int j = 0; j < 2; ++j) att::attn_unit(F, bh >> 2, bh & 3, j ? s : 31 - s, lam); }
#endif
        SEAM(5);
    }
    if (IN(6)) {
        pg8::Gemm g{wsp<const bf16>(F, WS_A2), wsp<const bf16>(F, WS_WOUT), T, D, D, 0};
        pg8::StaticOrder S; S.init(T / 256, D / 256, F.G, (int)blockIdx.x, nullptr, REPS(6));
        EpiOutProj E{wsp<bf16>(F, WS_MIX), wsp<const float>(F, WS_MOD)};
        pg8::gemm_phase<EpiOutProj, pg8::StaticOrder>(F.lds, g, S, E);
        SEAM(6);
    }
    if (IN(7)) { for (int rep_ = 0; rep_ < REPS(7); ++rep_) { if (rep_) xcd_barrier(bar); p7_phase(F, rep_ == 0); } SEAM(7); }
    if (IN(8)) { p8_phase(F); SEAM(8); }
    if (IN(9)) {
        int nMt; moe_tables(F, nMt);
        pg8::Gemm g{wsp<const bf16>(F, WS_XS), wsp<const bf16>(F, WS_WGU), PMAX, 2048, D / 2, (size_t)2048 * 512};
        pg8::StaticOrder S; S.init(nMt, 8, F.G, (int)blockIdx.x, F.lds + TILEE_OFF, REPS(9));
        EpiSwiGLU E{wsp<unsigned char>(F, WS_Y), F.b_gate_up};
        pg8::gemm_phase<EpiSwiGLU, pg8::StaticOrder, true>(F.lds, g, S, E);
        SEAM(9);
    }
    if (IN(10)) {
        int nMt; moe_tables(F, nMt);
        pg8::Gemm g{wsp<const bf16>(F, WS_Y), wsp<const bf16>(F, WS_WD), PMAX, 1024, FF / 2, (size_t)1024 * 512};
        pg8::StaticOrder S; S.init(nMt, 4, F.G, (int)blockIdx.x, F.lds + TILEE_OFF, REPS(10));
        EpiDown E{wsp<unsigned char>(F, WS_CN), F.b_down};
        pg8::gemm_phase<EpiDown, pg8::StaticOrder, true>(F.lds, g, S, E);
        SEAM(10);
    }
    if (IN(11)) { p11_phase(F); }
#undef IN
#undef SEAM
}

extern "C" void kernel_launch(void* const* d_in, const int* in_sizes, int n_in, void* d_out, int out_size, void* d_ws, size_t ws_size, hipStream_t stream) {
    static int grid = 0;
    if (grid == 0) {
        if (n_in != 25 || in_sizes[0] != T * D || out_size != T * D || ws_size < WS_END) { fprintf(stderr, "kernel_launch: unexpected shapes (n_in %d, in0 %d, out %d, ws %zu); nothing launched\n", n_in, n_in > 0 ? in_sizes[0] : -1, out_size, ws_size); grid = -1; return; }
        int dev = 0, cus = 0, per_cu = 0;
        if (hipGetDevice(&dev) != hipSuccess || hipDeviceGetAttribute(&cus, hipDeviceAttributeMultiprocessorCount, dev) != hipSuccess) { grid = -1; return; }
        if (hipFuncSetAttribute((const void*)fwd_kernel, hipFuncAttributeMaxDynamicSharedMemorySize, LDS_BYTES) != hipSuccess) { fprintf(stderr, "kernel_launch: hipFuncSetAttribute failed\n"); grid = -1; return; }
        if (hipOccupancyMaxActiveBlocksPerMultiprocessor(&per_cu, (const void*)fwd_kernel, NWAVES * 64, LDS_BYTES) != hipSuccess || per_cu < 1)
            fprintf(stderr, "kernel_launch: note: occupancy query reports %d workgroups per CU\n", per_cu);
        (void)hipGetLastError();
        grid = cus;
    }
    if (grid < 0) return;
    if (hipMemsetAsync((char*)d_ws + WS_CTL, 0, CTL_ZERO_BYTES, stream) != hipSuccess) { fprintf(stderr, "kernel_launch: memset failed\n"); return; }
    Args a{};
    for (int i = 0; i < 25; ++i) a.in[i] = (const float*)d_in[i];
    a.out = (float*)d_out; a.ws = (unsigned char*)d_ws;
#if MK_N_LAUNCHES == 1
    a.ph_lo = 0; a.ph_hi = NPHASE;
    hipLaunchKernelGGL(fwd_kernel, dim3(grid), dim3(NWAVES * 64), LDS_BYTES, stream, a);
#else
    for (int p = 0; p < NPHASE; ++p) { a.ph_lo = p; a.ph_hi = p + 1; hipLaunchKernelGGL(fwd_kernel, dim3(grid), dim3(NWAVES * 64), LDS_BYTES, stream, a); }
#endif
    const hipError_t le = hipPeekAtLastError();
    if (le != hipSuccess) fprintf(stderr, "kernel_launch: launch failed: %s\n", hipGetErrorName(le));
}
```

```cpp
#include <hip/hip_runtime.h>
#include <cstdio>
#include <cstdint>

#ifndef MK_N_LAUNCHES
#define MK_N_LAUNCHES 1
#endif

namespace pg8 {
#define PG8_LAS __attribute__((address_space(3)))
typedef unsigned short bf16_t;
typedef short bf16x8 __attribute__((ext_vector_type(8)));
typedef float f32x4 __attribute__((ext_vector_type(4)));
typedef unsigned u32x4 __attribute__((ext_vector_type(4)));
typedef int i32x4 __attribute__((ext_vector_type(4)));
typedef int i32x8 __attribute__((ext_vector_type(8)));
typedef float f32x16 __attribute__((ext_vector_type(16)));
constexpr int BM = 256, BK = 64, HALF = 128, HTB = HALF * BK * 2, STAGE_BYTES = 8 * HTB, NXCD = 8, WGM = 8;

__host__ __device__ __forceinline__ int lds_byte(int r, int c) { const int st = (r >> 4) * 2 + (c >> 5), rr = r & 15, cc = c & 31, ob = rr * 64 + cc * 2; return st * 1024 + (ob ^ (((ob >> 9) & 1) << 5)); }
__host__ __device__ __forceinline__ void stage_rc(int b, int& R, int& C) { const int st = b / 1024, sb = b % 1024, swz = sb ^ (((sb >> 9) & 1) << 5); R = (st >> 1) * 16 + swz / 64; C = (st & 1) * 32 + (swz % 64) / 2; }
__host__ __device__ __forceinline__ int perm32(int rho) { const int n = rho >> 4, i = rho & 15; return 8 * (i >> 2) + 4 * n + (i & 3); }

struct Unit { int pm, pn, e; };
struct Gemm { const bf16_t* A; const bf16_t* Bt; int M, N, K; size_t estride; };

struct StaticOrder {
    int nM, nN, nwg, G, c, rep; const PG8_LAS unsigned char* tile_e;
    __device__ void init(int nM_, int nN_, int G_, int c_, const PG8_LAS unsigned char* te, int rep_ = 1) { nM = nM_; nN = nN_; nwg = nM * nN; G = G_; c = c_; tile_e = te; rep = rep_; }
    __device__ bool next(int i, Unit& u) const {
        long L = (long)i * G + c; if (L >= (long)nwg * rep) return false; if (rep > 1) L %= nwg;
        int wgid = (int)L; { const int q = nwg / NXCD, r = nwg % NXCD, xcd = wgid % NXCD, off = wgid / NXCD; wgid = (xcd < r ? xcd * (q + 1) : r * (q + 1) + (xcd - r) * q) + off; }
        const int nig = WGM * nN, gid = wgid / nig, fm = gid * WGM, gsz = (nM - fm) < WGM ? (nM - fm) : WGM;
        u.pm = fm + ((wgid % nig) % gsz); u.pn = (wgid % nig) / gsz; u.e = tile_e ? __builtin_amdgcn_readfirstlane((int)tile_e[u.pm]) : 0; return true;
    }
};

__device__ __forceinline__ unsigned cvt_pk_bf16(float lo, float hi) { unsigned r; asm volatile("v_cvt_pk_bf16_f32 %0, %1, %2" : "=v"(r) : "v"(lo), "v"(hi)); return r; }

template <class Epi, class Sched, bool FP8 = false>
__device__ __forceinline__ void gemm_phase(PG8_LAS unsigned char* lds, const Gemm g, const Sched& S, const Epi& E) {
    const int tid = threadIdx.x, wid = __builtin_amdgcn_readfirstlane(tid >> 6), lane = tid & 63, wr = wid >> 2, wc = wid & 3, fr = lane & 15, fq = lane >> 4;
    const int K = g.K, nt = K / BK;
    unsigned voffA[2], voffB[2];
#pragma unroll
    for (int i = 0; i < 2; ++i) { int R, C; stage_rc(tid * 16 + i * 8192, R, C); const int Rb = Epi::PERM ? ((R & ~31) + perm32(R & 31)) : R;
        voffA[i] = (unsigned)(R * K + C) * 2u; voffB[i] = (unsigned)(Rb * K + C) * 2u; }
    const size_t kstep = (size_t)(BK * 2);
    const size_t hstep = (size_t)HALF * K * 2;
    const size_t tstep = 2 * hstep;
    const size_t estep = g.estride * 2;
    const unsigned ldsw = (unsigned)wid * 1024u;
    const int aoff = lds_byte(wr * 64 + fr, fq * 8), boff = lds_byte(wc * 32 + fr, fq * 8);
#define PG8_SA(b, h) (((b) * 2 + (h)) * HTB)
#define PG8_SB(b, h) ((4 + (b) * 2 + (h)) * HTB)
#define PG8_STAGE(bufoff, gbase, voff) do { _Pragma("unroll") for (int _i = 0; _i < 2; ++_i) \
        __builtin_amdgcn_global_load_lds((const unsigned*)((const char*)(gbase) + (voff)[_i]), (PG8_LAS unsigned*)(lds + (bufoff) + ldsw + _i * 8192), 16, 0, 0); } while (0)
#define PG8_LDA(dst, b, h) do { _Pragma("unroll") for (int m = 0; m < 4; ++m) dst[m] = PG8_CAT2(*(const PG8_LAS i32x4*)(lds + PG8_SA(b, h) + aoff + m * 2048), *(const PG8_LAS i32x4*)(lds + PG8_SA(b, h) + aoff + m * 2048 + 1024)); } while (0)
#define PG8_LDB(dst, b, h) do { _Pragma("unroll") for (int n = 0; n < 2; ++n) dst[n] = PG8_CAT2(*(const PG8_LAS i32x4*)(lds + PG8_SB(b, h) + boff + n * 2048), *(const PG8_LAS i32x4*)(lds + PG8_SB(b, h) + boff + n * 2048 + 1024)); } while (0)
#define PG8_CAT2(x, y) __builtin_shufflevector((x), (y), 0, 1, 2, 3, 4, 5, 6, 7)
#define PG8_LO(x) __builtin_bit_cast(bf16x8, __builtin_shufflevector((x), (x), 0, 1, 2, 3))
#define PG8_HI(x) __builtin_bit_cast(bf16x8, __builtin_shufflevector((x), (x), 4, 5, 6, 7))
#define PG8_X4(v, m) ((f32x4){(v)[4 * (m)], (v)[4 * (m) + 1], (v)[4 * (m) + 2], (v)[4 * (m) + 3]})
#define PG8_INS(v, r, m) do { (v)[4 * (m)] = (r)[0]; (v)[4 * (m) + 1] = (r)[1]; (v)[4 * (m) + 2] = (r)[2]; (v)[4 * (m) + 3] = (r)[3]; } while (0)
#define PG8_MMA(ai, bj, At, Bt) do { __builtin_amdgcn_s_setprio(1); _Pragma("unroll") for (int m = 0; m < 4; ++m) _Pragma("unroll") for (int n = 0; n < 2; ++n) { \
        if constexpr (FP8) { const f32x4 r_ = __builtin_amdgcn_mfma_scale_f32_16x16x128_f8f6f4(Bt[n], At[m], PG8_X4(acc16[ai][bj][n], m), 0, 0, 0, 0x7F7F7F7F, 0, 0x7F7F7F7F); PG8_INS(acc16[ai][bj][n], r_, m); } \
        else { acc[ai][bj][m][n] = __builtin_amdgcn_mfma_f32_16x16x32_bf16(PG8_LO(Bt[n]), PG8_LO(At[m]), acc[ai][bj][m][n], 0, 0, 0); \
               acc[ai][bj][m][n] = __builtin_amdgcn_mfma_f32_16x16x32_bf16(PG8_HI(Bt[n]), PG8_HI(At[m]), acc[ai][bj][m][n], 0, 0, 0); } } \
        __builtin_amdgcn_s_setprio(0); } while (0)
#define PG8_WAIT_V(n) asm volatile("s_waitcnt vmcnt(" #n ")" ::: "memory")
#define PG8_WAIT_L(n) asm volatile("s_waitcnt lgkmcnt(" #n ")" ::: "memory")
#define PG8_BAR __builtin_amdgcn_s_barrier()
#define PG8_SCHED __builtin_amdgcn_sched_barrier(0)
    Unit cur, nxt; int ui = 0;
    if (!S.next(0, cur)) return;
    f32x4 acc[2][2][4][2];
#pragma unroll
    for (int a = 0; a < 2; ++a)
#pragma unroll
        for (int b = 0; b < 2; ++b)
#pragma unroll
            for (int m = 0; m < 4; ++m)
#pragma unroll
                for (int n = 0; n < 2; ++n) acc[a][b][m][n] = (f32x4){0.f, 0.f, 0.f, 0.f};
    f32x16 acc16[2][2][2];
#pragma unroll
    for (int a = 0; a < 2; ++a)
#pragma unroll
        for (int b = 0; b < 2; ++b)
#pragma unroll
            for (int n = 0; n < 2; ++n) acc16[a][b][n] = (f32x16){};
    i32x8 At[4], B0[2], B1[2];
    const char* cA = (const char*)g.A + (size_t)cur.pm * tstep; const char* cB = (const char*)g.Bt + (size_t)cur.e * estep + (size_t)cur.pn * tstep;
    PG8_STAGE(PG8_SB(0, 0), cB, voffB); PG8_STAGE(PG8_SB(0, 1), cB + hstep, voffB); PG8_STAGE(PG8_SA(0, 0), cA, voffA); PG8_STAGE(PG8_SA(0, 1), cA + hstep, voffA);
    if (wr == 1) PG8_BAR;
    PG8_WAIT_V(2); PG8_BAR;
    PG8_STAGE(PG8_SB(1, 0), cB + kstep, voffB); PG8_STAGE(PG8_SA(1, 0), cA + kstep, voffA); PG8_STAGE(PG8_SB(1, 1), cB + hstep + kstep, voffB);
    PG8_WAIT_V(6); PG8_BAR;
    for (;;) {
        const bool has_next = S.next(ui + 1, nxt);
        const char* nA = has_next ? (const char*)g.A + (size_t)nxt.pm * tstep : cA; const char* nB = has_next ? (const char*)g.Bt + (size_t)nxt.e * estep + (size_t)nxt.pn * tstep : cB;
#pragma nounroll
        for (int t = 0; t < nt; t += 2) {
            const bool last = (t == nt - 2);
            const char* a1 = cA + (size_t)(t + 1) * kstep;
            const char* a2 = last ? nA : cA + (size_t)(t + 2) * kstep; const char* b2 = last ? nB : cB + (size_t)(t + 2) * kstep;
            const char* a3 = a2 + kstep; const char* b3 = b2 + kstep;
            PG8_LDB(B0, 0, 0); PG8_LDB(B1, 0, 1); PG8_SCHED; PG8_LDA(At, 0, 0); PG8_STAGE(PG8_SA(1, 1), a1 + hstep, voffA);
            PG8_WAIT_V(8); PG8_WAIT_L(0); PG8_BAR; PG8_MMA(0, 0, At, B0); PG8_MMA(0, 1, At, B1); PG8_BAR; PG8_SCHED;
            PG8_LDA(At, 0, 1); PG8_STAGE(PG8_SB(0, 0), b2, voffB); PG8_STAGE(PG8_SB(0, 1), b2 + hstep, voffB); PG8_STAGE(PG8_SA(0, 0), a2, voffA);
            PG8_WAIT_V(8); PG8_WAIT_L(0); PG8_BAR; PG8_MMA(1, 0, At, B0); PG8_MMA(1, 1, At, B1); PG8_BAR; PG8_SCHED;
            PG8_LDB(B0, 1, 0); PG8_LDB(B1, 1, 1); PG8_SCHED; PG8_LDA(At, 1, 0); PG8_STAGE(PG8_SA(0, 1), a2 + hstep, voffA);
            PG8_WAIT_V(8); PG8_WAIT_L(0); PG8_BAR; PG8_MMA(0, 0, At, B0); PG8_MMA(0, 1, At, B1); PG8_BAR; PG8_SCHED;
            PG8_LDA(At, 1, 1); PG8_STAGE(PG8_SB(1, 0), b3, voffB); PG8_STAGE(PG8_SB(1, 1), b3 + hstep, voffB); PG8_STAGE(PG8_SA(1, 0), a3, voffA);
            PG8_WAIT_V(8); PG8_WAIT_L(0); PG8_BAR; PG8_MMA(1, 0, At, B0); PG8_MMA(1, 1, At, B1); PG8_BAR; PG8_SCHED;
        }
        if (wr == 0) PG8_BAR;
        if constexpr (FP8) {
#pragma unroll
            for (int a = 0; a < 2; ++a)
#pragma unroll
                for (int b = 0; b < 2; ++b)
#pragma unroll
                    for (int m = 0; m < 4; ++m)
#pragma unroll
                        for (int n = 0; n < 2; ++n) acc[a][b][m][n] = PG8_X4(acc16[a][b][n], m);
        }
        { int t2 = threadIdx.x; asm volatile("" : "+v"(t2)); E(acc, cur, wr, wc, t2 & 15, (t2 >> 4) & 3); }
        if (!has_next) break;
#pragma unroll
        for (int a = 0; a < 2; ++a)
#pragma unroll
            for (int b = 0; b < 2; ++b)
#pragma unroll
                for (int m = 0; m < 4; ++m)
#pragma unroll
                    for (int n = 0; n < 2; ++n) acc[a][b][m][n] = (f32x4){0.f, 0.f, 0.f, 0.f};
        if constexpr (FP8) {
#pragma unroll
            for (int a = 0; a < 2; ++a)
#pragma unroll
                for (int b = 0; b < 2; ++b)
#pragma unroll
                    for (int n = 0; n < 2; ++n) acc16[a][b][n] = (f32x16){};
        }
        cur = nxt; cA = nA; cB = nB; ++ui;
        if (wr == 1) PG8_BAR;
    }
    PG8_WAIT_V(0);
    PG8_BAR;
#undef PG8_SA
#undef PG8_SB
#undef PG8_STAGE
#undef PG8_LDA
#undef PG8_LDB
#undef PG8_MMA
#undef PG8_X4
#undef PG8_INS
#undef PG8_CAT2
#undef PG8_LO
#undef PG8_HI
#undef PG8_WAIT_V
#undef PG8_WAIT_L
#undef PG8_BAR
#undef PG8_SCHED
}
}

constexpr int NWAVES = 8;
constexpr int BATCH = 4, SEQ = 8192, D = 1024, T = BATCH * SEQ;
constexpr int INW = 3088, NIN = 3072;
constexpr int NE = 32, TOPK = 4, FF = 1024;
constexpr int PMAX = (T * TOPK / 256 + NE) * 256;
constexpr int NCHUNK = BATCH * 4 * (SEQ / 64);
constexpr float EPS = 1e-6f;
constexpr float LOG2E = 1.4426950408889634f;
constexpr float C2 = 0.125f * LOG2E;
constexpr float WSCALE = 32.f, WSCALE_INV = 1.f / 32.f;

constexpr size_t MiB = 1u << 20;
constexpr size_t WS_CTL = 0, CTL_ZERO_BYTES = 1 * MiB;
constexpr size_t WS_MODP = 1 * MiB;
constexpr size_t WS_MOD = 2 * MiB;
constexpr size_t WS_TOPE = 3 * MiB;
constexpr size_t WS_TOPW = 3 * MiB + 512 * 1024;
constexpr size_t WS_POS = 4 * MiB;
constexpr size_t WS_ROWW = 4 * MiB + 512 * 1024;
constexpr size_t WS_DEC = 6 * MiB;
constexpr size_t WS_WGU = 8 * MiB;
constexpr size_t WS_WD = 136 * MiB;
constexpr size_t WS_XN = 200 * MiB;
constexpr size_t WS_WIN = 264 * MiB;
constexpr size_t WS_WOUT = 270 * MiB;
constexpr size_t WS_GK = 272 * MiB;
constexpr size_t WS_QG = 304 * MiB;
constexpr size_t WS_KG = 320 * MiB;
constexpr size_t WS_VG = 336 * MiB;
constexpr size_t WS_RG = 368 * MiB;
constexpr size_t WS_QD = 400 * MiB;
constexpr size_t WS_KD = 432 * MiB;
constexpr size_t WS_VD = 464 * MiB;
constexpr size_t WS_UT = 496 * MiB;
constexpr size_t WS_SP = 560 * MiB;
constexpr size_t WS_OI = 592 * MiB;
constexpr size_t WS_QE = 656 * MiB;
constexpr size_t WS_A2 = 672 * MiB;
constexpr size_t WS_STASH = 736 * MiB;
constexpr size_t WS_XS = 264 * MiB;
constexpr size_t WS_Y = 400 * MiB;
constexpr size_t WS_CN = 536 * MiB;
constexpr size_t WS_MIX = 808 * MiB;
constexpr size_t WS_END = 872 * MiB;
static_assert(WS_XS + (size_t)PMAX * 1024 <= WS_Y && WS_Y + (size_t)PMAX * 1024 <= WS_CN && WS_CN + (size_t)PMAX * 1024 * 2 <= WS_MIX, "ws map");
constexpr int CW_BAR = 4096;
constexpr int CW_CNT = 16384;
constexpr int CW_FILL = 16384 + 64;

constexpr int RING_BYTES = 131072;
constexpr int LDSCTL_OFF = RING_BYTES, MISC_OFF = LDSCTL_OFF + 320;
constexpr int TILEE_OFF = MISC_OFF + 128;
constexpr int HIST_OFF = TILEE_OFF + 1024;
constexpr int LDS_BYTES = 147456;
static_assert(HIST_OFF + 512 <= LDS_BYTES, "LDS map");

#define GAS __attribute__((address_space(1)))
#define LAS __attribute__((address_space(3)))
typedef unsigned short bf16;
typedef unsigned v4u __attribute__((ext_vector_type(4)));
typedef unsigned v2u __attribute__((ext_vector_type(2)));
typedef float f32x4 __attribute__((ext_vector_type(4)));
typedef float f32x16 __attribute__((ext_vector_type(16)));
typedef short bf16x8 __attribute__((ext_vector_type(8)));
typedef short s16x4 __attribute__((ext_vector_type(4)));
typedef GAS unsigned gu32;
#define RLX_AGENT __ATOMIC_RELAXED, __HIP_MEMORY_SCOPE_AGENT
#define LDS_WAIT() asm volatile("s_waitcnt lgkmcnt(0)" ::: "memory")
#define VM_WAIT() asm volatile("s_waitcnt vmcnt(0)" ::: "memory")
__device__ __forceinline__ unsigned f2bf(float f) { unsigned u = __builtin_bit_cast(unsigned, f); return (u + 0x7fffu + ((u >> 16) & 1u)) >> 16; }
__device__ __forceinline__ unsigned pk2(float lo, float hi) { return f2bf(lo) | (f2bf(hi) << 16); }
__device__ __forceinline__ float bf2f(unsigned short h) { return __builtin_bit_cast(float, (unsigned)h << 16); }
__device__ __forceinline__ float bflo(unsigned u) { return __builtin_bit_cast(float, u << 16); }
__device__ __forceinline__ float bfhi(unsigned u) { return __builtin_bit_cast(float, u & 0xffff0000u); }
__device__ __forceinline__ float wave_sum(float v) {
#pragma unroll
    for (int o = 1; o < 64; o <<= 1) v += __shfl_xor(v, o);
    return v;
}
__device__ __forceinline__ float sigmoidf_(float x) { return __builtin_amdgcn_rcpf(1.f + __builtin_amdgcn_exp2f(-1.4426950408889634f * x)); }
typedef float f32x2 __attribute__((ext_vector_type(2)));
__device__ __forceinline__ unsigned wave_umax(unsigned v) {
    v = max(v, (unsigned)__builtin_amdgcn_update_dpp(0, (int)v, 0x111, 0xf, 0xf, true));
    v = max(v, (unsigned)__builtin_amdgcn_update_dpp(0, (int)v, 0x112, 0xf, 0xf, true));
    v = max(v, (unsigned)__builtin_amdgcn_update_dpp(0, (int)v, 0x114, 0xf, 0xf, true));
    v = max(v, (unsigned)__builtin_amdgcn_update_dpp(0, (int)v, 0x118, 0xf, 0xf, true));
    v = max(v, (unsigned)__builtin_amdgcn_update_dpp(0, (int)v, 0x142, 0xa, 0xf, false));
    v = max(v, (unsigned)__builtin_amdgcn_update_dpp(0, (int)v, 0x143, 0xc, 0xf, false));
    return (unsigned)__builtin_amdgcn_readlane((int)v, 63);
}
template <int CNT, int S, int N> __device__ __forceinline__ void xreduce_step(float (&v)[N], int lane) {
    if constexpr (CNT > 1) { constexpr int half = CNT / 2; const bool up = (lane & S) != 0;
#pragma unroll
        for (int i = 0; i < half; ++i) { const float send = up ? v[i] : v[i + half], keep = up ? v[i + half] : v[i]; v[i] = keep + __shfl_xor(send, S); }
        xreduce_step<half, S / 2, N>(v, lane); }
}
template <int S> __device__ __forceinline__ float xreduce_tail(float r) { if constexpr (S >= 1) { r += __shfl_xor(r, S); return xreduce_tail<S / 2>(r); } else return r; }
template <int N> __device__ __forceinline__ float xreduce(float (&v)[N], int lane) {
    xreduce_step<N, 32, N>(v, lane);
    return xreduce_tail<(N == 32 ? 1 : N == 16 ? 2 : N == 8 ? 4 : 8)>(v[0]);
}
__device__ __forceinline__ float lane_bcast(float v, int l) { return __builtin_bit_cast(float, __builtin_amdgcn_readlane(__builtin_bit_cast(int, v), l)); }

#define XB_TMO      128
#define XB_XCNT(j)  (256  + 64 * (j))
#define XB_XSUB(j)  (1280 + 64 * (j))
#define XB_XGEN(j)  (2304 + 64 * (j))
#define XB_TOP      3328
#define XB_TOPGEN   3392
#define XCD_BAR_WORDS 3456
#define XB_SPIN_CAP (1u << 18)
__device__ __forceinline__ unsigned xb_ld(unsigned* p)              { return __hip_atomic_load(p, __ATOMIC_RELAXED, __HIP_MEMORY_SCOPE_AGENT); }
__device__ __forceinline__ unsigned xb_add(unsigned* p, unsigned v) { return __hip_atomic_fetch_add(p, v, __ATOMIC_RELAXED, __HIP_MEMORY_SCOPE_AGENT); }
__device__ __forceinline__ unsigned xb_xcc_id() { return (unsigned)__builtin_amdgcn_s_getreg((3 << 11) | 20) & 0xFu; }
#define XB_SPIN(cond, bar) do { unsigned _sp = 0; while (cond) { __builtin_amdgcn_s_sleep(1); \
    if ((++_sp & 255u) == 0u) { if (xb_ld(&(bar)[XB_TMO])) break; if (_sp > XB_SPIN_CAP) { atomicAdd(&(bar)[XB_TMO], 1u); break; } } } } while (0)
struct XcdBarrier { unsigned* bar; unsigned x; volatile LAS unsigned* st; };
__device__ __forceinline__ XcdBarrier xcd_barrier_post(unsigned* bar, volatile LAS unsigned* st) {
    XcdBarrier b; b.bar = bar; b.x = xb_xcc_id(); b.st = st;
    if (threadIdx.x == 0) (void)xb_add(&bar[XB_XCNT(b.x)], 1u);
    return b;
}
__device__ __forceinline__ void xcd_barrier_complete(unsigned* bar, unsigned x, unsigned& nloc, unsigned& nx) {
    const unsigned G = gridDim.x * gridDim.y * gridDim.z;
    unsigned sum, cnt, mine, sp = 0u;
    for (;;) {
        sum = 0u; cnt = 0u; mine = 0u;
#pragma unroll
        for (unsigned j = 0; j < 16; ++j) { const unsigned c = xb_ld(&bar[XB_XCNT(j)]); sum += c; cnt += (c > 0u) ? 1u : 0u; mine = (j == x) ? c : mine; }
        if (sum == G) break;
        __builtin_amdgcn_s_sleep(1);
        if ((++sp & 255u) == 0u) { if (xb_ld(&bar[XB_TMO])) break; if (sp > XB_SPIN_CAP) { atomicAdd(&bar[XB_TMO], 1u); break; } }
    }
    nloc = mine > 0u ? mine : 1u; nx = cnt > 0u ? cnt : 1u;
}
__device__ __forceinline__ void xcd_barrier(const XcdBarrier& b) {
    asm volatile("s_waitcnt vmcnt(0)" ::: "memory");
    __syncthreads();
    if (threadIdx.x == 0) {
        unsigned* bar = b.bar;
        __builtin_amdgcn_s_waitcnt(0);
        unsigned nloc = b.st[0], nx = b.st[1];
        if (nloc == 0u) { xcd_barrier_complete(bar, b.x, nloc, nx); b.st[0] = nloc; b.st[1] = nx; }
        const unsigned old = xb_add(&bar[XB_XSUB(b.x)], 1u);
        const unsigned gen = old / nloc;
        if (old + 1u == (gen + 1u) * nloc) {
            __builtin_amdgcn_fence(__ATOMIC_RELEASE, "agent");
            asm volatile("s_waitcnt vmcnt(0)" ::: "memory");
            const unsigned og = xb_add(&bar[XB_TOP], 1u);
            const unsigned tg = og / nx;
            if (og + 1u == (tg + 1u) * nx) xb_add(&bar[XB_TOPGEN], 1u);
            else XB_SPIN(xb_ld(&bar[XB_TOPGEN]) == tg, bar);
            __builtin_amdgcn_fence(__ATOMIC_ACQUIRE, "agent");
            xb_add(&bar[XB_XGEN(b.x)], 1u);
            asm volatile("s_waitcnt vmcnt(0)" ::: "memory");
        } else {
            XB_SPIN(xb_ld(&bar[XB_XGEN(b.x)]) == gen, bar);
            __builtin_amdgcn_fence(__ATOMIC_ACQUIRE, "agent");
            asm volatile("s_waitcnt vmcnt(0)" ::: "memory");
        }
    }
    __syncthreads();
}

struct Frame {
    LAS unsigned char* lds;
    volatile LAS unsigned* MISC;
    gu32* ctl;
    int tid, lane, wave;
    int vcu, G;
    unsigned char* ws;
    const float *x, *c, *rel_bias, *w_ada, *b_ada, *g_norm1, *w_in, *w_gk_up, *b_gk_up, *g_gla_out, *g_qnorm, *g_knorm, *lq1, *lk1, *lq2, *lk2, *g_subln, *w_out,
                *g_norm2, *w_router, *b_router, *w_gate_up, *b_gate_up, *w_down, *b_down;
    float* out;
};
template <class Tp> __device__ __forceinline__ Tp* wsp(const Frame& F, size_t off) { return (Tp*)(F.ws + off); }

__device__ __forceinline__ void tr_item(const float* W, int ldw, int k0, int src0, bf16* WT, int K, int drow0, LAS float* scr, int lane) {
#pragma unroll 8
    for (int i = 0; i < 32; ++i) { const int kk = 2 * i + (lane >> 5); scr[kk * 33 + (lane & 31)] = W[(size_t)(k0 + kk) * ldw + src0 + (lane & 31)]; }
    LDS_WAIT(); asm volatile("" ::: "memory");
    const int c = lane & 7;
#pragma unroll
    for (int j = 0; j < 4; ++j) { const int n = (lane >> 3) + 8 * j; const LAS float* s = scr + (8 * c) * 33 + n;
        v4u o; o.x = pk2(s[0 * 33], s[1 * 33]); o.y = pk2(s[2 * 33], s[3 * 33]); o.z = pk2(s[4 * 33], s[5 * 33]); o.w = pk2(s[6 * 33], s[7 * 33]);
        *(GAS v4u*)(WT + (size_t)(drow0 + n) * K + k0 + 8 * c) = o; }
    LDS_WAIT(); asm volatile("" ::: "memory");
}
__device__ __forceinline__ unsigned pk4_fp8(float a, float b, float c, float d) { int p = __builtin_amdgcn_cvt_pk_fp8_f32(a, b, 0, false); p = __builtin_amdgcn_cvt_pk_fp8_f32(c, d, p, true); return (unsigned)p; }
__device__ __forceinline__ void tr_item_fp8(const float* W, int ldw, int k0, int src0, unsigned char* WT, int K, int drow0, float sc, LAS float* scr, int lane) {
    { float tmp[32]; const float* wp = W + (size_t)(k0 + (lane >> 5)) * ldw + src0 + (lane & 31);
#pragma unroll
      for (int i = 0; i < 32; ++i) tmp[i] = __builtin_nontemporal_load(wp + (size_t)(2 * i) * ldw);
#pragma unroll
      for (int i = 0; i < 32; ++i) scr[(2 * i + (lane >> 5)) * 33 + (lane & 31)] = tmp[i] * sc; }
    LDS_WAIT(); asm volatile("" ::: "memory");
    const int c = lane & 3;
#pragma unroll
    for (int j = 0; j < 2; ++j) { const int n = (lane >> 2) + 16 * j; const LAS float* s = scr + (16 * c) * 33 + n;
        v4u o;
#pragma unroll
        for (int q = 0; q < 4; ++q) o[q] = pk4_fp8(s[(4 * q) * 33], s[(4 * q + 1) * 33], s[(4 * q + 2) * 33], s[(4 * q + 3) * 33]);
        *(GAS v4u*)(WT + (size_t)(drow0 + n) * K + k0 + 16 * c) = o; }
    LDS_WAIT(); asm volatile("" ::: "memory");
}
__device__ __forceinline__ int win_src0(int ng) {
    const int pn = ng >> 3, gi = ng & 7, bj = gi >> 2, wc = gi & 3;
    if (pn < 6) return pn * 256 + gi * 32;
    if (pn < 10) { const int base = (pn < 8) ? 1552 : 2064; const int gq = 4 * ((pn - 6) & 1) + wc; return base + 64 * gq + 32 * bj; }
    return 2576 + (pn - 10) * 256 + gi * 32;
}
__device__ __forceinline__ void p0_phase(Frame& F) {
    LAS float* scr = (LAS float*)(F.lds + F.wave * 16384);
    const int gw = F.vcu * NWAVES + F.wave, NGW = F.G * NWAVES, lane = F.lane;
    for (int it = gw; it < 768; it += NGW) {
        const int cg = it % 96, ks = it / 96, j = cg * 64 + lane;
#pragma unroll
        for (int q = 0; q < 8; ++q) { const int idx = q * 64 + lane, b = idx >> 7, kk = idx & 127; const float cv = F.c[b * 1024 + ks * 128 + kk]; scr[idx] = cv * sigmoidf_(cv); }
        LDS_WAIT(); asm volatile("" ::: "memory");
        float a0 = 0.f, a1 = 0.f, a2 = 0.f, a3 = 0.f;
        const float* wp = F.w_ada + (size_t)(ks * 128) * 6144 + j;
#pragma unroll 32
        for (int kk = 0; kk < 128; ++kk) { const float w = wp[(size_t)kk * 6144]; a0 += scr[kk] * w; a1 += scr[128 + kk] * w; a2 += scr[256 + kk] * w; a3 += scr[384 + kk] * w; }
        float* mp = wsp<float>(F, WS_MODP) + (size_t)(ks * 4) * 6144 + j;
        mp[0] = a0; mp[6144] = a1; mp[2 * 6144] = a2; mp[3 * 6144] = a3;
        LDS_WAIT(); asm volatile("" ::: "memory");
    }
    constexpr int I_IN = 96 * 16, I_OUT = 32 * 16, I_GU = 32 * 64 * 16, I_D = 32 * 32 * 16;
    constexpr int NITEMS = I_IN + I_OUT + I_GU + I_D;
    for (int it = gw; it < NITEMS; it += NGW) {
        int r = it;
        if (r < I_IN) { const int kb = r / 96, ng = r % 96; tr_item(F.w_in, INW, kb * 64, win_src0(ng), wsp<bf16>(F, WS_WIN), 1024, ng * 32, scr, lane); continue; } r -= I_IN;
        if (r < I_OUT) { const int kb = r / 32, ng = r % 32; tr_item(F.w_out, 1024, kb * 64, ng * 32, wsp<bf16>(F, WS_WOUT), 1024, ng * 32, scr, lane); continue; } r -= I_OUT;
        if (r < I_GU) { const int e = r / 1024, q = r % 1024, kb = q / 64, dg = q % 64, pn = dg >> 3, gi = dg & 7, bj = gi >> 2, j32 = gi & 3;
            tr_item_fp8(F.w_gate_up + (size_t)e * 1024 * 2048, 2048, kb * 64, bj * 1024 + pn * 128 + j32 * 32, wsp<unsigned char>(F, WS_WGU) + (size_t)e * 2048 * 1024, 1024, dg * 32, WSCALE, scr, lane); continue; } r -= I_GU;
        { const int e = r / 512, q = r % 512, kb = q / 32, ng = q % 32;
            tr_item_fp8(F.w_down + (size_t)e * 1024 * 1024, 1024, kb * 64, ng * 32, wsp<unsigned char>(F, WS_WD) + (size_t)e * 1024 * 1024, 1024, ng * 32, WSCALE, scr, lane); }
    }
}

#ifndef SPREAD_ROWS
#define SPREAD_ROWS 0
#endif
__device__ __forceinline__ int srow(int gw, int i, int NGW) { return (SPREAD_ROWS && NGW * 16 == T) ? ((gw >> 9) * SEQ + i * 512 + (gw & 511)) : (gw * ((T + NGW - 1) / NGW) + i); }
__device__ __forceinline__ f32x4 mod_from_partials(const Frame& F, int b, int col) {
    const float* mp = wsp<const float>(F, WS_MODP) + (size_t)b * 6144 + col;
    f32x4 s = *(const f32x4*)(F.b_ada + col);
#pragma unroll
    for (int ks = 0; ks < 8; ++ks) s += *(const f32x4*)(mp + (size_t)ks * 4 * 6144);
    return s;
}
typedef float cf4p __attribute__((ext_vector_type(4)));
__device__ __forceinline__ void p1_phase(Frame& F) {
    const int tid = F.tid, lane = F.lane;
    constexpr int WLP = 1032;
    LAS bf16* wloT = (LAS bf16*)(F.lds);
    LAS bf16* wupT = (LAS bf16*)(F.lds + 36864);
    LAS float* bup = (LAS float*)(F.lds + 36864 + 16384);
    LAS float* tsc = (LAS float*)(F.lds + 36864 + 16384 + 1024) + F.wave * 288;
    { f32x4 t[8]; const int k0 = tid >> 2, r4 = (tid & 3) * 4;
#pragma unroll
      for (int it = 0; it < 8; ++it) t[it] = *(const f32x4*)(F.w_in + (size_t)(k0 + 128 * it) * INW + 1536 + r4);
#pragma unroll
      for (int it = 0; it < 8; ++it)
#pragma unroll
          for (int q = 0; q < 4; ++q) wloT[(r4 + q) * WLP + k0 + 128 * it] = (bf16)f2bf(t[it][q]); }
    { float t[8]; const int c = tid & 255, rh = tid >> 8;
#pragma unroll
      for (int j = 0; j < 8; ++j) t[j] = F.w_gk_up[(8 * rh + j) * 256 + c];
      v4u o; o.x = pk2(t[0], t[1]); o.y = pk2(t[2], t[3]); o.z = pk2(t[4], t[5]); o.w = pk2(t[6], t[7]);
      *(LAS v4u*)(wupT + c * 32 + 8 * rh) = o; *(LAS v4u*)(wupT + c * 32 + 16 + 8 * rh) = (v4u){0u, 0u, 0u, 0u}; }
    if (tid < 256) bup[tid] = F.b_gk_up[tid];
    { const int gt = F.vcu * 512 + tid; if (gt < 4 * 6144 / 4) { const int i = gt * 4, b = i / 6144, col = i % 6144; *(f32x4*)(wsp<float>(F, WS_MOD) + i) = mod_from_partials(F, b, col); } }
    __syncthreads();
    const int gw = F.vcu * NWAVES + F.wave, NGW = F.G * NWAVES;
    int curb = -1; f32x4 gsc[4], shv[4];
    for (int grp = gw; grp < T / 16; grp += NGW) {
#define ROWI(i) srow(grp, (i), T / 16)
        const int m0 = ROWI(0);
        f32x4 nx[4];
        { const GAS f32x4* xr = (const GAS f32x4*)(F.x + (size_t)m0 * D) + lane;
#pragma unroll
          for (int j = 0; j < 4; ++j) nx[j] = xr[64 * j]; }
        { const int b = m0 / SEQ;
          if (b != curb) { curb = b;
#pragma unroll
              for (int j = 0; j < 4; ++j) { const int col = 256 * j + 4 * lane; const f32x4 g = *(const f32x4*)(F.g_norm1 + col);
                  shv[j] = mod_from_partials(F, b, col); gsc[j] = g * (mod_from_partials(F, b, 1024 + col) + 1.0f); } } }
#pragma nounroll
        for (int i = 0; i < 16; ++i) {
            const int m = ROWI(i);
            f32x4 v[4]; float s = 0.f;
#pragma unroll
            for (int j = 0; j < 4; ++j) { v[j] = nx[j]; s += (v[j].x * v[j].x + v[j].y * v[j].y) + (v[j].z * v[j].z + v[j].w * v[j].w); }
            { const GAS f32x4* xr = (const GAS f32x4*)(F.x + (size_t)ROWI(i + 1 < 16 ? i + 1 : i) * D) + lane;
#pragma unroll
              for (int j = 0; j < 4; ++j) nx[j] = xr[64 * j]; }
            const float rstd = rsqrtf(wave_sum(s) * (1.f / D) + EPS);
            GAS v2u* o8 = (GAS v2u*)(wsp<bf16>(F, WS_XN) + (size_t)m * D) + lane;
#pragma unroll
            for (int j = 0; j < 4; ++j) { v[j] = v[j] * rstd * gsc[j] + shv[j]; v2u o; o.x = pk2(v[j].x, v[j].y); o.y = pk2(v[j].z, v[j].w); o8[64 * j] = o; }
        }
        __builtin_amdgcn_fence(__ATOMIC_RELEASE, "workgroup"); asm volatile("s_waitcnt vmcnt(0)" ::: "memory"); __builtin_amdgcn_fence(__ATOMIC_ACQUIRE, "workgroup");
        int lb = lane; asm volatile("" : "+v"(lb));
        const int l15 = lb & 15, q4 = lb >> 4;
        cf4p acc = {0.f, 0.f, 0.f, 0.f};
        { const bf16* arow = wsp<const bf16>(F, WS_XN) + (size_t)ROWI(l15) * D + 8 * q4; const LAS bf16* brow = wloT + l15 * WLP + 8 * q4;
#pragma unroll 4
          for (int sI = 0; sI < 32; ++sI) { const bf16x8 fa = *(const bf16x8*)(arow + 32 * sI); const bf16x8 fb = *(const LAS bf16x8*)(brow + 32 * sI);
              acc = __builtin_amdgcn_mfma_f32_16x16x32_bf16(fa, fb, acc, 0, 0, 0); } }
#pragma unroll
        for (int r = 0; r < 4; ++r) tsc[(4 * q4 + r) * 17 + l15] = acc[r];
        LDS_WAIT(); asm volatile("" ::: "memory");
        bf16x8 fa2;
        { float t8[8];
#pragma unroll
          for (int j = 0; j < 8; ++j) t8[j] = (q4 < 2) ? tsc[l15 * 17 + 8 * (q4 & 1) + j] : 0.f;
          v4u pk; pk.x = pk2(t8[0], t8[1]); pk.y = pk2(t8[2], t8[3]); pk.z = pk2(t8[4], t8[5]); pk.w = pk2(t8[6], t8[7]); fa2 = __builtin_bit_cast(bf16x8, pk); }
        float* GK = wsp<float>(F, WS_GK);
#pragma unroll 4
        for (int t = 0; t < 16; ++t) { const bf16x8 fb2 = *(const LAS bf16x8*)(wupT + (16 * t + l15) * 32 + 8 * q4);
            cf4p z = {0.f, 0.f, 0.f, 0.f}; z = __builtin_amdgcn_mfma_f32_16x16x32_bf16(fa2, fb2, z, 0, 0, 0);
            const float bb = bup[16 * t + l15];
#pragma unroll
            for (int r = 0; r < 4; ++r) { const float zz = z[r] + bb; GK[(size_t)ROWI(4 * q4 + r) * 256 + 16 * t + l15] = (fminf(zz, 0.f) - __logf(1.f + __expf(-fabsf(zz)))) * (1.f / 16.f); } }
        LDS_WAIT(); asm volatile("" ::: "memory");
#undef ROWI
    }
}

using pg8::Unit;
typedef pg8::f32x4 af4;
struct EpiInProj {
    static constexpr bool PERM = true;
    bf16 *QG, *KG, *VG, *RG, *QD, *KD, *VD; const float *gq, *gk;
    __device__ __forceinline__ void operator()(const af4 (&acc)[2][2][4][2], const Unit& u, int wr, int wc, int fr, int fq) const {
        const int pn = u.pn; const int row0 = u.pm * 256 + wr * 64 + fr;
        if (pn >= 6 && pn < 10) {
            const bool isq = pn < 8; bf16* base = isq ? QD : KD; const float* g = isq ? gq : gk; const float sc = isq ? C2 : 1.f;
            const int grp = 4 * ((pn - 6) & 1) + wc;
            af4 gv[2][2];
#pragma unroll
            for (int bj = 0; bj < 2; ++bj)
#pragma unroll
                for (int n = 0; n < 2; ++n) gv[bj][n] = *(const af4*)(g + 32 * bj + 8 * fq + 4 * n) * sc;
#pragma unroll
            for (int ai = 0; ai < 2; ++ai)
#pragma unroll
                for (int m = 0; m < 4; ++m) {
                    float ss = 0.f;
#pragma unroll
                    for (int bj = 0; bj < 2; ++bj)
#pragma unroll
                        for (int n = 0; n < 2; ++n) { const af4 v = acc[ai][bj][m][n]; ss += (v[0] * v[0] + v[1] * v[1]) + (v[2] * v[2] + v[3] * v[3]); }
                    ss += __shfl_xor(ss, 16); ss += __shfl_xor(ss, 32);
                    const float rs = rsqrtf(ss * (1.f / 64.f) + EPS);
                    bf16* rowp = base + (size_t)(row0 + ai * 128 + m * 16) * 512 + grp * 64 + 8 * fq;
#pragma unroll
                    for (int bj = 0; bj < 2; ++bj) { const af4 v0 = acc[ai][bj][m][0] * rs * gv[bj][0], v1 = acc[ai][bj][m][1] * rs * gv[bj][1];
                        pg8::u32x4 w; w.x = pg8::cvt_pk_bf16(v0[0], v0[1]); w.y = pg8::cvt_pk_bf16(v0[2], v0[3]); w.z = pg8::cvt_pk_bf16(v1[0], v1[1]); w.w = pg8::cvt_pk_bf16(v1[2], v1[3]);
                        *(pg8::u32x4*)(rowp + 32 * bj) = w; }
                }
        } else {
            bf16* base; int pitch, colt; int act = 0;
            if (pn == 0) { base = QG; pitch = 256; colt = 0; act = 1; }
            else if (pn == 1) { base = KG; pitch = 256; colt = 0; }
            else if (pn < 4) { base = VG; pitch = 512; colt = (pn - 2) * 256; }
            else if (pn < 6) { base = RG; pitch = 512; colt = (pn - 4) * 256; act = 2; }
            else { base = VD; pitch = 512; colt = (pn - 10) * 256; }
            const int col0 = colt + wc * 32 + 8 * fq;
#pragma unroll
            for (int ai = 0; ai < 2; ++ai)
#pragma unroll
                for (int m = 0; m < 4; ++m) { bf16* rowp = base + (size_t)(row0 + ai * 128 + m * 16) * pitch + col0;
#pragma unroll
                    for (int bj = 0; bj < 2; ++bj) { af4 v0 = acc[ai][bj][m][0], v1 = acc[ai][bj][m][1];
                        if (act == 1) { v0 = v0 * 0.125f; v1 = v1 * 0.125f; }
                        if (act == 2) {
#pragma unroll
                            for (int q = 0; q < 4; ++q) { v0[q] = v0[q] * sigmoidf_(v0[q]); v1[q] = v1[q] * sigmoidf_(v1[q]); } }
                        pg8::u32x4 w; w.x = pg8::cvt_pk_bf16(v0[0], v0[1]); w.y = pg8::cvt_pk_bf16(v0[2], v0[3]); w.z = pg8::cvt_pk_bf16(v1[0], v1[1]); w.w = pg8::cvt_pk_bf16(v1[2], v1[3]);
                        *(pg8::u32x4*)(rowp + bj * 128) = w; } }
        }
    }
};
struct EpiOutProj {
    static constexpr bool PERM = true;
    bf16* mix; const float* mod;
    __device__ __forceinline__ void operator()(const af4 (&acc)[2][2][4][2], const Unit& u, int wr, int wc, int fr, int fq) const {
        const int b = (u.pm * 256) / SEQ; const int col0 = u.pn * 256 + wc * 32 + 8 * fq;
        af4 gt[2][2];
#pragma unroll
        for (int bj = 0; bj < 2; ++bj)
#pragma unroll
            for (int n = 0; n < 2; ++n) gt[bj][n] = *(const af4*)(mod + (size_t)b * 6144 + 2048 + col0 + bj * 128 + 4 * n);
#pragma unroll
        for (int ai = 0; ai < 2; ++ai)
#pragma unroll
            for (int m = 0; m < 4; ++m) { bf16* rowp = mix + (size_t)(u.pm * 256 + ai * 128 + wr * 64 + m * 16 + fr) * D + col0;
#pragma unroll
                for (int bj = 0; bj < 2; ++bj) { const af4 v0 = acc[ai][bj][m][0] * gt[bj][0], v1 = acc[ai][bj][m][1] * gt[bj][1];
                    pg8::u32x4 w; w.x = pg8::cvt_pk_bf16(v0[0], v0[1]); w.y = pg8::cvt_pk_bf16(v0[2], v0[3]); w.z = pg8::cvt_pk_bf16(v1[0], v1[1]); w.w = pg8::cvt_pk_bf16(v1[2], v1[3]);
                    *(pg8::u32x4*)(rowp + bj * 128) = w; } }
    }
};
struct EpiSwiGLU {
    static constexpr bool PERM = false;
    unsigned char* Y; const float* bgu;
    __device__ __forceinline__ void operator()(const af4 (&acc)[2][2][4][2], const Unit& u, int wr, int wc, int fr, int fq) const {
        const int f0 = u.pn * 128 + wc * 32 + 4 * fq; const float* bb = bgu + (size_t)u.e * 2048 + f0;
        af4 bg[2], bu[2];
#pragma unroll
        for (int n = 0; n < 2; ++n) { bg[n] = *(const af4*)(bb + 16 * n); bu[n] = *(const af4*)(bb + 1024 + 16 * n); }
#pragma unroll
        for (int ai = 0; ai < 2; ++ai)
#pragma unroll
            for (int m = 0; m < 4; ++m) { unsigned char* rowp = Y + (size_t)(u.pm * 256 + ai * 128 + wr * 64 + m * 16 + fr) * FF + f0;
#pragma unroll
                for (int n = 0; n < 2; ++n) { const af4 g = acc[ai][0][m][n] * WSCALE_INV + bg[n], up = acc[ai][1][m][n] * WSCALE_INV + bu[n]; af4 y;
#pragma unroll
                    for (int q = 0; q < 4; ++q) { const float gg = fminf(g[q], 7.f), uu = fminf(fmaxf(up[q], -7.f), 7.f); y[q] = (uu + 1.f) * gg * sigmoidf_(1.702f * gg); }
                    *(unsigned*)(rowp + 16 * n) = pk4_fp8(y[0], y[1], y[2], y[3]); } }
    }
};
struct EpiDown {
    static constexpr bool PERM = true;
    unsigned char* Cn; const float* bd;
    __device__ __forceinline__ void operator()(const af4 (&acc)[2][2][4][2], const Unit& u, int wr, int wc, int fr, int fq) const {
        const int col0 = u.pn * 256 + wc * 32 + 8 * fq; const float* bb = bd + (size_t)u.e * 1024 + col0;
        af4 bv[2][2];
#pragma unroll
        for (int bj = 0; bj < 2; ++bj)
#pragma unroll
            for (int n = 0; n < 2; ++n) bv[bj][n] = *(const af4*)(bb + bj * 128 + 4 * n);
#pragma unroll
        for (int ai = 0; ai < 2; ++ai)
#pragma unroll
            for (int m = 0; m < 4; ++m) { const int row = u.pm * 256 + ai * 128 + wr * 64 + m * 16 + fr; unsigned char* rowp = Cn + (size_t)row * 1024 + col0;
#pragma unroll
                for (int bj = 0; bj < 2; ++bj) { const af4 v0 = acc[ai][bj][m][0] * WSCALE_INV + bv[bj][0], v1 = acc[ai][bj][m][1] * WSCALE_INV + bv[bj][1];
                    v2u w; w.x = pk4_fp8(v0[0], v0[1], v0[2], v0[3]); w.y = pk4_fp8(v1[0], v1[1], v1[2], v1[3]); *(v2u*)(rowp + bj * 128) = w; } }
    }
};

typedef float cf4 __attribute__((ext_vector_type(4)));
#define MFMA16(a, b, c) __builtin_amdgcn_mfma_f32_16x16x32_bf16((a), (b), (c), 0, 0, 0)
constexpr int GP = 72;
__device__ __forceinline__ void gla_a_unit(Frame& F, int chunk) {
    const int tid = F.tid, lane = F.lane, w = F.wave;
    const int bh = chunk >> 7, n = chunk & 127, b = bh >> 2, h = bh & 3;
    const size_t R0 = (size_t)b * SEQ + (size_t)n * 64;
    LAS float* gc = (LAS float*)F.lds;
    LAS float* segt = (LAS float*)(F.lds + 16384);
    LAS bf16* QEs = (LAS bf16*)(F.lds + 18432);
    LAS bf16* KEs = (LAS bf16*)(F.lds + 18432 + 9216);
    LAS bf16* KST = (LAS bf16*)(F.lds + 18432 + 2 * 9216);
    LAS bf16* VT = (LAS bf16*)(F.lds + 18432 + 3 * 9216);
    LAS bf16* AM = (LAS bf16*)(F.lds + 18432 + 3 * 9216 + 18432);
    const float* GK = wsp<const float>(F, WS_GK);
    { const int r = tid >> 3, d0 = (tid & 7) * 8; const float* gp = GK + (R0 + r) * 256 + h * 64 + d0;
      *(LAS f32x4*)(gc + r * 64 + d0) = *(const f32x4*)gp; *(LAS f32x4*)(gc + r * 64 + d0 + 4) = *(const f32x4*)(gp + 4); }
    __syncthreads();
    { const int seg = tid >> 6, d = tid & 63; float run = 0.f;
#pragma unroll
      for (int i = 0; i < 8; ++i) { run += gc[(seg * 8 + i) * 64 + d]; gc[(seg * 8 + i) * 64 + d] = run; }
      segt[seg * 64 + d] = run; }
    __syncthreads();
    { const int seg = tid >> 6, d = tid & 63; float off = 0.f;
      for (int s2 = 0; s2 < seg; ++s2) off += segt[s2 * 64 + d];
#pragma unroll
      for (int i = 0; i < 8; ++i) gc[(seg * 8 + i) * 64 + d] += off; }
    __syncthreads();
    { const int r = tid >> 3, d0 = (tid & 7) * 8;
      const v4u qv = *(const v4u*)(wsp<const bf16>(F, WS_QG) + (R0 + r) * 256 + h * 64 + d0);
      const v4u kv = *(const v4u*)(wsp<const bf16>(F, WS_KG) + (R0 + r) * 256 + h * 64 + d0);
      float qf[8], kf[8];
#pragma unroll
      for (int i = 0; i < 4; ++i) { qf[2 * i] = bflo(qv[i]); qf[2 * i + 1] = bfhi(qv[i]); kf[2 * i] = bflo(kv[i]); kf[2 * i + 1] = bfhi(kv[i]); }
      float qe[8], ke[8];
#pragma unroll
      for (int i = 0; i < 8; ++i) { const float g = gc[r * 64 + d0 + i], gl = gc[63 * 64 + d0 + i];
          qe[i] = qf[i] * __expf(g); ke[i] = kf[i] * __expf(-g); KST[(d0 + i) * GP + r] = (bf16)f2bf(kf[i] * __expf(gl - g)); }
      v4u qo, ko;
#pragma unroll
      for (int i = 0; i < 4; ++i) { qo[i] = pk2(qe[2 * i], qe[2 * i + 1]); ko[i] = pk2(ke[2 * i], ke[2 * i + 1]); }
      *(LAS v4u*)(QEs + r * GP + d0) = qo; *(LAS v4u*)(KEs + r * GP + d0) = ko;
      *(v4u*)(wsp<bf16>(F, WS_QE) + (R0 + r) * 256 + h * 64 + d0) = qo;
      const int e0 = (tid & 7) * 16;
      const v4u va = *(const v4u*)(wsp<const bf16>(F, WS_VG) + (R0 + r) * 512 + h * 128 + e0);
      const v4u vb = *(const v4u*)(wsp<const bf16>(F, WS_VG) + (R0 + r) * 512 + h * 128 + e0 + 8);
#pragma unroll
      for (int i = 0; i < 4; ++i) { VT[(e0 + 2 * i) * GP + r] = (bf16)(va[i] & 0xffffu); VT[(e0 + 2 * i + 1) * GP + r] = (bf16)(va[i] >> 16);
                                    VT[(e0 + 8 + 2 * i) * GP + r] = (bf16)(vb[i] & 0xffffu); VT[(e0 + 8 + 2 * i + 1) * GP + r] = (bf16)(vb[i] >> 16); }
      if (tid < 64) wsp<float>(F, WS_DEC)[(size_t)chunk * 64 + tid] = __expf(gc[63 * 64 + tid]);
    }
    __syncthreads();
    const int l15 = lane & 15, l4 = lane >> 4;
#pragma unroll
    for (int q = 0; q < 2; ++q) { const int tile = 2 * w + q, ti = tile >> 2, tj = tile & 3;
        cf4 a = {0.f, 0.f, 0.f, 0.f};
        if (tj <= ti) {
#pragma unroll
            for (int kk = 0; kk < 2; ++kk) { const bf16x8 fa = *(const LAS bf16x8*)(QEs + (16 * ti + l15) * GP + kk * 32 + 8 * l4); const bf16x8 fb = *(const LAS bf16x8*)(KEs + (16 * tj + l15) * GP + kk * 32 + 8 * l4); a = MFMA16(fa, fb, a); } }
#pragma unroll
        for (int r = 0; r < 4; ++r) { const int cr = 16 * ti + 4 * l4 + r, cj = 16 * tj + l15; AM[cr * GP + cj] = (bf16)f2bf(cj <= cr ? a[r] : 0.f); } }
    { float* UT = wsp<float>(F, WS_UT) + (size_t)chunk * 8192;
#pragma unroll
      for (int td = 0; td < 4; ++td) { cf4 a = {0.f, 0.f, 0.f, 0.f};
#pragma unroll
          for (int kk = 0; kk < 2; ++kk) { const bf16x8 fa = *(const LAS bf16x8*)(VT + (16 * w + l15) * GP + kk * 32 + 8 * l4); const bf16x8 fb = *(const LAS bf16x8*)(KST + (16 * td + l15) * GP + kk * 32 + 8 * l4); a = MFMA16(fa, fb, a); }
#pragma unroll
          for (int r = 0; r < 4; ++r) UT[(16 * w + 4 * l4 + r) * 64 + 16 * td + l15] = a[r]; } }
    __syncthreads();
    { float* OI = wsp<float>(F, WS_OI);
#pragma unroll
      for (int tc = 0; tc < 4; ++tc) { cf4 a = {0.f, 0.f, 0.f, 0.f};
#pragma unroll
          for (int kk = 0; kk < 2; ++kk) { const bf16x8 fa = *(const LAS bf16x8*)(AM + (16 * tc + l15) * GP + kk * 32 + 8 * l4); const bf16x8 fb = *(const LAS bf16x8*)(VT + (16 * w + l15) * GP + kk * 32 + 8 * l4); a = MFMA16(fa, fb, a); }
#pragma unroll
          for (int r = 0; r < 4; ++r) OI[(R0 + 16 * tc + 4 * l4 + r) * 512 + h * 128 + 16 * w + l15] = a[r]; } }
    __syncthreads();
}
__device__ __forceinline__ void gla_b_phase(Frame& F) {
    const float* UT = wsp<const float>(F, WS_UT); const float* DEC = wsp<const float>(F, WS_DEC); bf16* SP = wsp<bf16>(F, WS_SP);
    for (int gt = F.vcu * 512 + F.tid; gt < 16 * 8192; gt += F.G * 512) {
        const int bh = gt >> 13, ed = gt & 8191, d = gt & 63; float S = 0.f;
#pragma unroll 1
        for (int n0 = 0; n0 < 128; n0 += 32) {
            float u[32], dc[32];
#pragma unroll
            for (int i = 0; i < 32; ++i) { const size_t ch = (size_t)bh * 128 + n0 + i; u[i] = UT[ch * 8192 + ed]; dc[i] = DEC[ch * 64 + d]; }
#pragma unroll
            for (int i = 0; i < 32; ++i) { const size_t ch = (size_t)bh * 128 + n0 + i; SP[ch * 8192 + ed] = (bf16)f2bf(S); S = S * dc[i] + u[i]; } }
    }
}
__device__ __forceinline__ void gla_c_unit(Frame& F, int unit) {
    const int tid = F.tid, lane = F.lane, w = F.wave;
    const int bh = unit >> 6, n2 = unit & 63, b = bh >> 2, h = bh & 3;
    const size_t R0 = (size_t)b * SEQ + (size_t)n2 * 128;
    LAS bf16* QEs = (LAS bf16*)F.lds;
    LAS bf16* SPs = (LAS bf16*)(F.lds + 18432);
    const int l15 = lane & 15, l4 = lane >> 4, c2 = w >> 2, tc = w & 3;
    const float* OI = wsp<const float>(F, WS_OI); const bf16* RG = wsp<const bf16>(F, WS_RG); bf16* A2 = wsp<bf16>(F, WS_A2);
    float oi[4][8]; unsigned short rg[4][8];
    const size_t rowq = R0 + 64 * c2 + 16 * tc + 4 * l4;
#pragma unroll
    for (int r = 0; r < 4; ++r)
#pragma unroll
        for (int te = 0; te < 8; ++te) { oi[r][te] = OI[(rowq + r) * 512 + h * 128 + 16 * te + l15]; rg[r][te] = RG[(rowq + r) * 512 + h * 128 + 16 * te + l15]; }
    { const int r = tid >> 2, d0 = (tid & 3) * 16; const bf16* src = wsp<const bf16>(F, WS_QE) + (R0 + r) * 256 + h * 64 + d0;
      const v4u q0 = *(const v4u*)src, q1 = *(const v4u*)(src + 8);
      const bf16* sp = wsp<const bf16>(F, WS_SP) + ((size_t)bh * 128 + 2 * n2) * 8192;
      const int row = tid >> 1, dd = (tid & 1) * 32;
      v4u sv[4];
#pragma unroll
      for (int i = 0; i < 4; ++i) sv[i] = *(const v4u*)(sp + (size_t)row * 64 + dd + 8 * i);
      *(LAS v4u*)(QEs + r * GP + d0) = q0; *(LAS v4u*)(QEs + r * GP + d0 + 8) = q1;
#pragma unroll
      for (int i = 0; i < 4; ++i) *(LAS v4u*)(SPs + row * GP + dd + 8 * i) = sv[i]; }
    __syncthreads();
    cf4 a[8];
#pragma unroll
    for (int te = 0; te < 8; ++te) { a[te] = (cf4){0.f, 0.f, 0.f, 0.f};
#pragma unroll
        for (int kk = 0; kk < 2; ++kk) { const bf16x8 fa = *(const LAS bf16x8*)(QEs + (64 * c2 + 16 * tc + l15) * GP + kk * 32 + 8 * l4); const bf16x8 fb = *(const LAS bf16x8*)(SPs + (128 * c2 + 16 * te + l15) * GP + kk * 32 + 8 * l4); a[te] = MFMA16(fa, fb, a[te]); } }
    float gg[8];
#pragma unroll
    for (int te = 0; te < 8; ++te) gg[te] = F.g_gla_out[16 * te + l15];
#pragma unroll
    for (int r = 0; r < 4; ++r) { const size_t row = rowq + r; float ss = 0.f; float o[8];
#pragma unroll
        for (int te = 0; te < 8; ++te) { o[te] = a[te][r] + oi[r][te]; ss += o[te] * o[te]; }
        ss += __shfl_xor(ss, 1); ss += __shfl_xor(ss, 2); ss += __shfl_xor(ss, 4); ss += __shfl_xor(ss, 8);
        const float rs = rsqrtf(ss * (1.f / 128.f) + EPS);
#pragma unroll
        for (int te = 0; te < 8; ++te) { const int e = 16 * te + l15; A2[row * 1024 + h * 128 + e] = (bf16)f2bf(o[te] * rs * gg[te] * bf2f(rg[r][te])); } }
    __syncthreads();
}

namespace att {
constexpr int KSLOT = 8192, VSLOT = 16384, NSLOT = 3;
constexpr int LDS_K = 0, LDS_V = NSLOT * KSLOT, LDS_TBL = LDS_V + NSLOT * VSLOT, LDS_WS = LDS_TBL + 1024, LDS_Q = LDS_WS + 8 * 256, LDS_END = LDS_Q + 8 * 4096;
static_assert(LDS_END <= RING_BYTES, "attention LDS");
__device__ __forceinline__ int crow(int r, int hi) { return (r & 3) + 8 * (r >> 2) + 4 * hi; }
__device__ __forceinline__ void glds16(const void* gsrc, unsigned lds_dst) { unsigned keep;
    asm volatile("s_mov_b32 %0, m0\n\ts_mov_b32 m0, %2\n\ts_nop 0\n\tglobal_load_lds_dwordx4 %1, off\n\ts_mov_b32 m0, %0" : "=&s"(keep) : "v"(gsrc), "s"(lds_dst) : "memory"); }
typedef float f32x2_t __attribute__((ext_vector_type(2))); typedef __bf16 bf16x2_t __attribute__((ext_vector_type(2)));
__device__ __forceinline__ unsigned cvtpk_s(float lo, float hi) { f32x2_t v = {lo, hi}; bf16x2_t b = __builtin_convertvector(v, bf16x2_t); return __builtin_bit_cast(unsigned, b); }
typedef short v4i16_t __attribute__((ext_vector_type(4)));
typedef LAS const char* lds_cptr;
__device__ __forceinline__ s16x4 vtr(lds_cptr p) { return __builtin_bit_cast(s16x4, __builtin_amdgcn_ds_read_tr16_b64_v4i16((LAS v4i16_t*)p)); }
#define MFMA32(a, b, c) __builtin_amdgcn_mfma_f32_32x32x16_bf16((a), (b), (c), 0, 0, 0)
#define ATT_WAIT_BAR(N) asm volatile("s_waitcnt vmcnt(" #N ") lgkmcnt(0)\n\ts_barrier" ::: "memory")

__device__ __forceinline__ void attn_map(f32x16 (&o)[4], int b, int h, int m, int qb, const bf16* QD, const bf16* KD, const bf16* VD, LAS unsigned char* shm) {
    int lane = threadIdx.x & 63; asm volatile("" : "+v"(lane));
    const int tid = threadIdx.x, r32 = lane & 31, hi = lane >> 5; const int wid = __builtin_amdgcn_readfirstlane(tid >> 6);
    const size_t rowbase = (size_t)b * SEQ; const int q0 = qb * 256;
    const bf16* Qw = QD + (rowbase + q0 + wid * 32) * 512 + (h * 2 + m) * 64;
    const bf16* Kh = KD + rowbase * 512 + (h * 2 + m) * 64; const bf16* Vh = VD + rowbase * 512 + h * 128;
    const unsigned lds0 = (unsigned)(uintptr_t)shm;
    const LAS float* tbl = (const LAS float*)(shm + LDS_TBL) + m * 128;
    LAS float* wsf = (LAS float*)(shm + LDS_WS) + wid * 64;
    const bf16* ksrc = Kh + (size_t)lane * 512 + wid * 8;
    const bf16* vsrc = Vh + (size_t)(16 * (wid & 3) + (lane >> 2)) * 512 + (wid >> 2) * 32 + (lane & 3) * 8;
    const unsigned kdst = lds0 + LDS_K + wid * 1024, vdst = lds0 + LDS_V + wid * 1024;
#define DMA_K(t, slot) glds16(ksrc + (size_t)(t) * 64 * 512, (unsigned)__builtin_amdgcn_readfirstlane(kdst + (slot) * KSLOT))
#define DMA_V(t, slot) do { glds16(vsrc + (size_t)(t) * 64 * 512, (unsigned)__builtin_amdgcn_readfirstlane(vdst + (slot) * VSLOT)); \
        glds16(vsrc + (size_t)(t) * 64 * 512 + 64, (unsigned)__builtin_amdgcn_readfirstlane(vdst + (slot) * VSLOT + 8192)); } while (0)
    const int NT = 4 * qb + 4;
    VM_WAIT();
    DMA_K(0, 0); DMA_V(0, 0); DMA_K(1, 1); DMA_K(2, 2);
    const lds_cptr qlds = (lds_cptr)shm + LDS_Q + wid * 4096 + lane * 16;
    { bf16x8 qr[4];
#pragma unroll
      for (int d0 = 0; d0 < 4; ++d0) qr[d0] = *(const bf16x8*)(Qw + (size_t)r32 * 512 + d0 * 16 + hi * 8);
      asm volatile("s_waitcnt vmcnt(0)" : "+v"(qr[0]), "+v"(qr[1]), "+v"(qr[2]), "+v"(qr[3]) :: "memory");
#pragma unroll
      for (int d0 = 0; d0 < 4; ++d0) *(LAS bf16x8*)(shm + LDS_Q + wid * 4096 + lane * 16 + d0 * 1024) = qr[d0]; }
#pragma unroll
    for (int d0 = 0; d0 < 4; ++d0) o[d0] = (f32x16){};
    float lsum = 0.f;
    const int qw0 = q0 + wid * 32, qabs = qw0 + r32;
    const lds_cptr shm3 = (lds_cptr)shm;
    const lds_cptr kp0 = shm3 + LDS_K + hi * 1024 + r32 * 16;
    const lds_cptr vp0 = shm3 + LDS_V + ((lane >> 4) & 1) * 32 + (lane & 3) * 8 + (4 * hi + ((lane & 15) >> 2)) * 64;
#define QK_TILE(C0, C1, kp) do { C0 = (f32x16){}; C1 = (f32x16){}; \
        _Pragma("unroll") for (int d0 = 0; d0 < 4; ++d0) { if (d0 == 2) __builtin_amdgcn_sched_barrier(0); const bf16x8 b0 = *(const LAS bf16x8*)((kp) + d0 * 2048); const bf16x8 b1 = *(const LAS bf16x8*)((kp) + d0 * 2048 + 512); \
            const bf16x8 qf_ = *(const LAS bf16x8*)(qlds + d0 * 1024); C0 = MFMA32(b0, qf_, C0); C1 = MFMA32(b1, qf_, C1); } } while (0)
#define MASK_BIAS(C0, C1, t) do { const int kvb_ = (t) * 64; if (kvb_ + 191 > qw0) { int dbase = qabs - kvb_ - 4 * hi; asm volatile("" : "+v"(dbase)); \
        _Pragma("unroll") for (int r = 0; r < 16; ++r) { const int d0_ = dbase - ((r & 3) + 8 * (r >> 2)); const int d1_ = d0_ - 32; \
            const float t0_ = tbl[min(max(d0_, 0), 127)], t1_ = tbl[min(max(d1_, 0), 127)]; \
            C0[r] = d0_ < 0 ? -INFINITY : C0[r] + t0_; C1[r] = d1_ < 0 ? -INFINITY : C1[r] + t1_; } } } while (0)
#define VLOAD(vf, vp, d0) do { _Pragma("unroll") for (int ks = 0; ks < 4; ++ks) { const s16x4 lo_ = vtr((vp) + (d0) * 4096 + ks * 1024), hh_ = vtr((vp) + (d0) * 4096 + ks * 1024 + 512); \
            vf[ks] = (bf16x8){lo_[0], lo_[1], lo_[2], lo_[3], hh_[0], hh_[1], hh_[2], hh_[3]}; } } while (0)
#define PV4(d0, vf) do { _Pragma("unroll") for (int ks = 0; ks < 4; ++ks) o[d0] = MFMA32(__builtin_bit_cast(bf16x8, pw[ks]), vf[ks], o[d0]); } while (0)
#define PACK_SUM(P0, P1) do { float sacc = 0.f; _Pragma("unroll") for (int r = 0; r < 16; ++r) sacc += P0[r] + P1[r]; lsum += sacc; \
        _Pragma("unroll") for (int i = 0; i < 4; ++i) { pw[0][i] = cvtpk_s(P0[2 * i], P0[2 * i + 1]); pw[1][i] = cvtpk_s(P0[8 + 2 * i], P0[9 + 2 * i]); pw[2][i] = cvtpk_s(P1[2 * i], P1[2 * i + 1]); pw[3][i] = cvtpk_s(P1[8 + 2 * i], P1[9 + 2 * i]); } } while (0)
#define EXP_PACK(C, pwa, pwb) do { float sacc = 0.f; _Pragma("unroll") for (int r = 0; r < 16; ++r) { C[r] = __builtin_amdgcn_exp2f(C[r]); sacc += C[r]; } lsum += sacc; \
        _Pragma("unroll") for (int i = 0; i < 4; ++i) { pwa[i] = cvtpk_s(C[2 * i], C[2 * i + 1]); pwb[i] = cvtpk_s(C[8 + 2 * i], C[9 + 2 * i]); } } while (0)
#define KLOAD(kf, kp) do { _Pragma("unroll") for (int d0 = 0; d0 < 4; ++d0) { kf[2 * d0] = *(const LAS bf16x8*)((kp) + d0 * 2048); kf[2 * d0 + 1] = *(const LAS bf16x8*)((kp) + d0 * 2048 + 512); } } while (0)
#define QLOAD(qf) do { _Pragma("unroll") for (int d0 = 0; d0 < 4; ++d0) qf[d0] = *(const LAS bf16x8*)(qlds + d0 * 1024); } while (0)
#define QK8(C0, C1, kf, qf) do { C0 = (f32x16){}; C1 = (f32x16){}; _Pragma("unroll") for (int d0 = 0; d0 < 4; ++d0) { C0 = MFMA32(kf[2 * d0], qf[d0], C0); C1 = MFMA32(kf[2 * d0 + 1], qf[d0], C1); } } while (0)
#define SB() __builtin_amdgcn_sched_barrier(0)
    f32x16 C0, C1; v4u pw[4], pwn[4]; bf16x8 va[4], vb[4], kf[8], qf[4];
    ATT_WAIT_BAR(0);
    KLOAD(kf, kp0); QLOAD(qf);
    ATT_WAIT_BAR(0);
    if (3 < NT) DMA_K(3, 0);
    DMA_V(1, 1);
    QK8(C0, C1, kf, qf);
    MASK_BIAS(C0, C1, 0);
    EXP_PACK(C0, pw[0], pw[1]); EXP_PACK(C1, pw[2], pw[3]);
    KLOAD(kf, kp0 + KSLOT);
    int ks_cur = 1, vs_prev = 0;
    for (int t = 1; t < NT; ++t) {
        if (t + 2 < NT) { ATT_WAIT_BAR(3); } else { ATT_WAIT_BAR(2); }
        { const int vs_new = (vs_prev == 0) ? 2 : vs_prev - 1;
          if (t + 3 < NT) DMA_K(t + 3, ks_cur);
          if (t + 1 < NT) DMA_V(t + 1, vs_new); }
        const int ks_next = (ks_cur == 2) ? 0 : ks_cur + 1;
        const lds_cptr vp = vp0 + vs_prev * VSLOT;
        SB();
        VLOAD(va, vp, 0); VLOAD(vb, vp, 1);
        SB();
        QK8(C0, C1, kf, qf);
        SB();
        MASK_BIAS(C0, C1, t);
        SB();
        PV4(0, va); PV4(1, vb);
        EXP_PACK(C0, pwn[0], pwn[1]);
        SB();
        VLOAD(va, vp, 2); VLOAD(vb, vp, 3);
        KLOAD(kf, kp0 + ks_next * KSLOT);
        SB();
        PV4(2, va); PV4(3, vb);
        EXP_PACK(C1, pwn[2], pwn[3]);
        SB();
#pragma unroll
        for (int i = 0; i < 4; ++i) pw[i] = pwn[i];
        ks_cur = ks_next; vs_prev = (vs_prev == 2) ? 0 : vs_prev + 1;
    }
    ATT_WAIT_BAR(0);
    { const lds_cptr vp = vp0 + vs_prev * VSLOT;
      VLOAD(va, vp, 0); VLOAD(vb, vp, 1); PV4(0, va); PV4(1, vb);
      VLOAD(va, vp, 2); VLOAD(vb, vp, 3); PV4(2, va); PV4(3, vb); }
    { auto rr = __builtin_amdgcn_permlane32_swap(__float_as_uint(lsum), __float_as_uint(lsum), false, false); lsum = __uint_as_float(rr[0]) + __uint_as_float(rr[1]); }
    if (hi == 0) wsf[r32] = lsum;
    LDS_WAIT();
#pragma unroll
    for (int r = 0; r < 16; ++r) { const float rl = 1.0f / wsf[crow(r, hi)];
#pragma unroll
        for (int d0 = 0; d0 < 4; ++d0) o[d0][r] *= rl; }
    ATT_WAIT_BAR(0);
#undef DMA_K
#undef DMA_V
#undef QK_TILE
#undef MASK_BIAS
#undef VLOAD
#undef PV4
#undef PACK_SUM
#undef EXP_PACK
#undef KLOAD
#undef QLOAD
#undef QK8
#undef SB
}
__device__ __forceinline__ int t5_bucket(int n) {
    if (n < 16) return n;
    const float nf = (float)n; int large = 16 + (int)(logf(nf / 16.f) / logf(8.f) * 16.f);
    return large < 31 ? large : 31;
}
__device__ __forceinline__ void attn_unit(Frame& F, int b, int h, int qb, float lam) {
    LAS unsigned char* shm = F.lds;
    int tid = F.tid; asm volatile("" : "+v"(tid));
    const int lane = tid & 63, r32 = lane & 31, hi = lane >> 5, wid = F.wave;
    if (tid < 256) { const int m = tid >> 7, d = tid & 127; const int col = h * 2 + m;
        ((LAS float*)(shm + LDS_TBL))[tid] = (F.rel_bias[t5_bucket(d) * 8 + col] - F.rel_bias[31 * 8 + col]) * LOG2E; }
    __syncthreads();
    const bf16* QD = wsp<const bf16>(F, WS_QD); const bf16* KD = wsp<const bf16>(F, WS_KD); const bf16* VD = wsp<const bf16>(F, WS_VD);
    float* stash = wsp<float>(F, WS_STASH) + (size_t)F.vcu * 32768 + tid * 64;
    f32x16 o[4];
#pragma nounroll
    for (int m = 0; m < 2; ++m) {
        attn_map(o, b, h, m, qb, QD, KD, VD, shm);
        if (m == 0) {
#pragma unroll
            for (int d0 = 0; d0 < 4; ++d0)
#pragma unroll
                for (int r = 0; r < 16; r += 4) *(f32x4*)(stash + d0 * 16 + r) = (f32x4){o[d0][r], o[d0][r + 1], o[d0][r + 2], o[d0][r + 3]};
        } else {
            float ss[16];
#pragma unroll
            for (int r = 0; r < 16; ++r) ss[r] = 0.f;
#pragma unroll
            for (int d0 = 0; d0 < 4; ++d0)
#pragma unroll
                for (int r4 = 0; r4 < 16; r4 += 4) { const f32x4 sv = *(const f32x4*)(stash + d0 * 16 + r4);
#pragma unroll
                    for (int q = 0; q < 4; ++q) { const int r = r4 + q; const float v = sv[q] - lam * o[d0][r]; o[d0][r] = v; ss[r] += v * v; } }
            float gs[4];
#pragma unroll
            for (int d0 = 0; d0 < 4; ++d0) gs[d0] = F.g_subln[32 * d0 + r32] * 0.8f;
            bf16* A2 = wsp<bf16>(F, WS_A2);
            const size_t rowb = (size_t)b * SEQ + (size_t)qb * 256 + wid * 32;
            bf16* a2b = A2 + (rowb + 4 * hi) * 1024 + 512 + h * 128 + r32; asm volatile("" : "+v"(a2b));
#pragma unroll
            for (int r = 0; r < 16; ++r) { float s = ss[r];
                s += __shfl_xor(s, 1); s += __shfl_xor(s, 2); s += __shfl_xor(s, 4); s += __shfl_xor(s, 8); s += __shfl_xor(s, 16);
                const float rs = rsqrtf(s * (1.f / 128.f) + EPS);
                bf16* rowp = a2b + (size_t)((r & 3) + 8 * (r >> 2)) * 1024;
#pragma unroll
                for (int d0 = 0; d0 < 4; ++d0) rowp[32 * d0] = (bf16)f2bf(o[d0][r] * rs * gs[d0]); }
        }
    }
    __syncthreads();
}
}

__device__ __forceinline__ void p7_phase(Frame& F, bool count = true) {
    const int tid = F.tid, lane = F.lane;
    LAS float* wr = (LAS float*)F.lds;
    LAS unsigned* hist = (LAS unsigned*)(F.lds + HIST_OFF);
    { f32x4 t[16]; const int k0 = tid >> 3, e4 = (tid & 7) * 4;
#pragma unroll
      for (int it = 0; it < 16; ++it) t[it] = *(const f32x4*)(F.w_router + (size_t)(k0 + 64 * it) * 32 + e4);
#pragma unroll
      for (int it = 0; it < 16; ++it)
#pragma unroll
          for (int q = 0; q < 4; ++q) wr[(e4 + q) * 1024 + k0 + 64 * it] = t[it][q]; }
    if (tid < 32) hist[tid] = 0u;
    __syncthreads();
    const float* MOD = wsp<const float>(F, WS_MOD);
    const int gw = F.vcu * NWAVES + F.wave, NGW = F.G * NWAVES; const int rpw = (T + NGW - 1) / NGW;
    int curb = -1; f32x4 gsc[4], shv[4], nx[4];
    v2u nm[4]; const bf16* MIX = wsp<const bf16>(F, WS_MIX);
    { const int m0 = (srow(gw, 0, NGW) < T) ? srow(gw, 0, NGW) : 0; const GAS f32x4* xr = (const GAS f32x4*)(F.x + (size_t)m0 * D) + lane; const GAS v2u* mr = (const GAS v2u*)(MIX + (size_t)m0 * D) + lane;
#pragma unroll
      for (int j = 0; j < 4; ++j) { nx[j] = xr[64 * j]; nm[j] = mr[64 * j]; } }
#pragma nounroll
    for (int i = 0; i < rpw; ++i) {
        const int m = srow(gw, i, NGW); if (m >= T) break;
        const int b = m / SEQ;
        if (b != curb) { curb = b;
#pragma unroll
            for (int j = 0; j < 4; ++j) { const int col = 256 * j + 4 * lane; const f32x4 g = *(const f32x4*)(F.g_norm2 + col);
                shv[j] = *(const f32x4*)(MOD + (size_t)b * 6144 + 3072 + col); gsc[j] = g * (*(const f32x4*)(MOD + (size_t)b * 6144 + 4096 + col) + 1.0f); } }
        f32x4 v[4]; float s = 0.f;
#pragma unroll
        for (int j = 0; j < 4; ++j) { v[j] = nx[j] + (f32x4){bflo(nm[j].x), bfhi(nm[j].x), bflo(nm[j].y), bfhi(nm[j].y)}; s += (v[j].x * v[j].x + v[j].y * v[j].y) + (v[j].z * v[j].z + v[j].w * v[j].w); }
        { const int mn_ = srow(gw, i + 1, NGW); const int m2 = (i + 1 < rpw && mn_ < T) ? mn_ : m; const GAS f32x4* xr = (const GAS f32x4*)(F.x + (size_t)m2 * D) + lane; const GAS v2u* mr = (const GAS v2u*)(MIX + (size_t)m2 * D) + lane;
#pragma unroll
          for (int j = 0; j < 4; ++j) { nx[j] = xr[64 * j]; nm[j] = mr[64 * j]; } }
        const float rstd = rsqrtf(wave_sum(s) * (1.f / D) + EPS);
        GAS unsigned* o4 = (GAS unsigned*)(wsp<unsigned char>(F, WS_XN) + (size_t)m * D) + lane;
#pragma unroll
        for (int j = 0; j < 4; ++j) { v[j] = v[j] * rstd * gsc[j] + shv[j]; o4[64 * j] = pk4_fp8(v[j].x, v[j].y, v[j].z, v[j].w); }
        float lg[32];
        { f32x4 wa[8], wb[8];
          const LAS float* wrA = wr + 4 * lane; const LAS float* wrB = wr + 16 * 1024 + 4 * lane; asm volatile("" : "+v"(wrA), "+v"(wrB));
#define P7_LD(dst, eb) do { _Pragma("unroll") for (int q = 0; q < 8; ++q) dst[q] = *(const LAS f32x4*)(((eb) < 8 ? wrA : wrB) + (((eb) & 7) * 2 + (q >> 2)) * 1024 + 256 * (q & 3)); } while (0)
#define P7_DOT(src, eb) do { _Pragma("unroll") for (int rr = 0; rr < 2; ++rr) { f32x2 a2 = {0.f, 0.f}; _Pragma("unroll") for (int j = 0; j < 4; ++j) { const f32x4 w = src[rr * 4 + j]; a2 += v[j].lo * w.lo; a2 += v[j].hi * w.hi; } lg[(eb) * 2 + rr] = a2.x + a2.y; } } while (0)
          P7_LD(wa, 0); __builtin_amdgcn_sched_barrier(0);
#pragma unroll
          for (int eb = 0; eb < 16; eb += 2) {
              P7_LD(wb, eb + 1); __builtin_amdgcn_sched_barrier(0);
              P7_DOT(wa, eb); __builtin_amdgcn_sched_barrier(0);
              if (eb + 2 < 16) { P7_LD(wa, eb + 2); __builtin_amdgcn_sched_barrier(0); }
              P7_DOT(wb, eb + 1); __builtin_amdgcn_sched_barrier(0);
          }
#undef P7_LD
#undef P7_DOT
        }
        const float myl = xreduce<32>(lg, lane) + F.b_router[lane >> 1];
        unsigned key; { const unsigned u = __builtin_bit_cast(unsigned, myl); const unsigned o = (u & 0x80000000u) ? ~u : (u | 0x80000000u); key = (o & ~31u) | (unsigned)(31 - (lane >> 1)); }
        int te[4]; float tv[4];
#pragma unroll
        for (int k = 0; k < 4; ++k) { const unsigned mx = wave_umax(key); te[k] = 31 - (int)(mx & 31u); tv[k] = lane_bcast(myl, 2 * te[k]); key = (key == mx) ? 0u : key; }
        float ex[4], es = 0.f;
#pragma unroll
        for (int k = 0; k < 4; ++k) { ex[k] = __expf(tv[k] - tv[0]); es += ex[k]; }
        if (lane < 4) { const int e = lane == 0 ? te[0] : lane == 1 ? te[1] : lane == 2 ? te[2] : te[3]; const float w = (lane == 0 ? ex[0] : lane == 1 ? ex[1] : lane == 2 ? ex[2] : ex[3]) / es;
            wsp<int>(F, WS_TOPE)[(size_t)m * 4 + lane] = e; wsp<float>(F, WS_TOPW)[(size_t)m * 4 + lane] = w; __hip_atomic_fetch_add(hist + e, 1u, __ATOMIC_RELAXED, __HIP_MEMORY_SCOPE_WORKGROUP); }
    }
    __syncthreads();
    if (tid < 32 && count) __hip_atomic_fetch_add(F.ctl + CW_CNT + tid, hist[tid], RLX_AGENT);
}
__device__ __forceinline__ void moe_tables(Frame& F, int& nMt) {
    LAS unsigned char* te = F.lds + TILEE_OFF;
    LAS unsigned* nt = (LAS unsigned*)(F.lds + HIST_OFF);
    if (F.tid < 32) nt[F.tid] = ((unsigned)__hip_atomic_load(F.ctl + CW_CNT + F.tid, RLX_AGENT) + 255u) >> 8;
    __syncthreads();
    { int start = 0, mine0 = -1, mine1 = -1; const int t0 = F.tid, t1 = F.tid + 512;
#pragma unroll 8
      for (int e = 0; e < NE; ++e) { const int n = (int)nt[e]; if (t0 >= start && t0 < start + n) mine0 = e; if (t1 >= start && t1 < start + n) mine1 = e; start += n; }
      if (mine0 >= 0) te[t0] = (unsigned char)mine0;
      if (mine1 >= 0) te[t1] = (unsigned char)mine1;
      if (F.tid == 0) F.MISC[16] = (unsigned)start; }
    __syncthreads();
    nMt = __builtin_amdgcn_readfirstlane((int)F.MISC[16]);
}
__device__ __forceinline__ void p8_phase(Frame& F) {
    const int tid = F.tid, lane = F.lane;
    LAS unsigned* hist = (LAS unsigned*)(F.lds + HIST_OFF);
    if (tid < 128) hist[tid] = 0u;
    __syncthreads();
    const int gw = F.vcu * NWAVES + F.wave, NGW = F.G * NWAVES; const int rpw = (T + NGW - 1) / NGW;
    const int* TOPE = wsp<const int>(F, WS_TOPE);
    const int mw0 = gw * rpw;
    for (int c = 0; c < rpw; c += 16) { const int m = mw0 + c + (lane >> 2); if (c + (lane >> 2) < rpw && m < T) __hip_atomic_fetch_add(hist + TOPE[(size_t)m * 4 + (lane & 3)], 1u, __ATOMIC_RELAXED, __HIP_MEMORY_SCOPE_WORKGROUP); }
    __syncthreads();
    if (tid < 32) hist[96 + tid] = (__hip_atomic_load(F.ctl + CW_CNT + tid, RLX_AGENT) + 255u) & ~255u;
    __syncthreads();
    if (tid < 32) { unsigned pstart = 0; for (int e = 0; e < tid; ++e) pstart += hist[96 + e];
        hist[32 + tid] = pstart + __hip_atomic_fetch_add(F.ctl + CW_FILL + tid, hist[tid], RLX_AGENT); }
    __syncthreads();
    const unsigned char* H2 = wsp<const unsigned char>(F, WS_XN); unsigned char* XS = wsp<unsigned char>(F, WS_XS);
    for (int c = 0; c < rpw; c += 16) {
        const int mr = mw0 + c + (lane >> 2); const bool ok = (c + (lane >> 2) < rpw) && (mr < T);
        int pos = 0;
        if (ok) { const int e = TOPE[(size_t)mr * 4 + (lane & 3)]; pos = (int)(hist[32 + e] + __hip_atomic_fetch_add(hist + 64 + e, 1u, __ATOMIC_RELAXED, __HIP_MEMORY_SCOPE_WORKGROUP));
            wsp<int>(F, WS_POS)[(size_t)mr * 4 + (lane & 3)] = pos; }
        v4u rowv[16];
#pragma unroll
        for (int i = 0; i < 16; ++i) { const int m = mw0 + c + i; const int mm = (c + i < rpw && m < T) ? m : mw0; rowv[i] = *(const v4u*)(H2 + (size_t)mm * D + lane * 16); }
#pragma unroll
        for (int i = 0; i < 16; ++i) { const int m = mw0 + c + i; const bool rok = (c + i < rpw) && (m < T);
#pragma unroll
            for (int k = 0; k < 4; ++k) { const int p = __shfl(pos, 4 * i + k); if (rok) *(v4u*)(XS + (size_t)p * D + lane * 16) = rowv[i]; } }
    }
}
__device__ __forceinline__ void p11_phase(Frame& F) {
    const int lane = F.lane;
    const float* MOD = wsp<const float>(F, WS_MOD); const unsigned char* CN = wsp<const unsigned char>(F, WS_CN); const int* POS = wsp<const int>(F, WS_POS);
    const int gw = F.vcu * NWAVES + F.wave, NGW = F.G * NWAVES; const int rpw = (T + NGW - 1) / NGW;
    const int nrow = (srow(gw, 0, NGW) < T) ? ((srow(gw, rpw - 1, NGW) < T) ? rpw : 0) : 0;
    int cnt = nrow; if (NGW * 16 != T) { cnt = 0; for (int i = 0; i < rpw; ++i) if (srow(gw, i, NGW) < T) ++cnt; }
    if (cnt == 0) return;
#define RW(i) srow(gw, ((i) < cnt ? (i) : cnt - 1), NGW)
    v4u ca[4], mx0, mx1; f32x4 xv[4]; int pn[4]; f32x4 wcur, wnxt; const float* TOPW = wsp<const float>(F, WS_TOPW); const bf16* MIXp = wsp<const bf16>(F, WS_MIX);
#define P11_LOAD(mm) do { _Pragma("unroll") for (int k = 0; k < 4; ++k) ca[k] = *(const v4u*)(CN + (size_t)pn[k] * D + lane * 16); \
        _Pragma("unroll") for (int q = 0; q < 4; ++q) xv[q] = *(const f32x4*)(F.x + (size_t)(mm) * D + lane * 16 + 4 * q); \
        { const v4u* ms_ = (const v4u*)(MIXp + (size_t)(mm) * D + lane * 16); mx0 = ms_[0]; mx1 = ms_[1]; } } while (0)
    { const int4 p4 = *(const int4*)(POS + (size_t)RW(0) * 4); pn[0] = p4.x; pn[1] = p4.y; pn[2] = p4.z; pn[3] = p4.w; }
    P11_LOAD(RW(0)); wcur = *(const f32x4*)(TOPW + (size_t)RW(0) * 4);
    { const int m2 = RW(1); const int4 p4 = *(const int4*)(POS + (size_t)m2 * 4); pn[0] = p4.x; pn[1] = p4.y; pn[2] = p4.z; pn[3] = p4.w; wnxt = *(const f32x4*)(TOPW + (size_t)m2 * 4); }
#pragma nounroll
    for (int i = 0; i < cnt; ++i) {
        const int m = RW(i);
        const int b = m / SEQ;
        float acc[16];
#pragma unroll
        for (int q = 0; q < 16; ++q) acc[q] = 0.f;
#pragma unroll
        for (int k = 0; k < 4; ++k) { const float wk = wcur[k];
#pragma unroll
            for (int q = 0; q < 4; ++q) { const int wq = (int)ca[k][q];
                acc[4 * q] += wk * __builtin_amdgcn_cvt_f32_fp8(wq, 0); acc[4 * q + 1] += wk * __builtin_amdgcn_cvt_f32_fp8(wq, 1);
                acc[4 * q + 2] += wk * __builtin_amdgcn_cvt_f32_fp8(wq, 2); acc[4 * q + 3] += wk * __builtin_amdgcn_cvt_f32_fp8(wq, 3); } }
        f32x4 ov[4]; const float* gt = MOD + (size_t)b * 6144 + 5120 + lane * 16;
#pragma unroll
        for (int q = 0; q < 4; ++q) { const f32x4 g = *(const f32x4*)(gt + 4 * q); const f32x4 av = {acc[4 * q], acc[4 * q + 1], acc[4 * q + 2], acc[4 * q + 3]};
            const unsigned ma = q < 2 ? mx0[2 * q] : mx1[2 * q - 4], mb = q < 2 ? mx0[2 * q + 1] : mx1[2 * q - 3];
            ov[q] = xv[q] + (f32x4){bflo(ma), bfhi(ma), bflo(mb), bfhi(mb)} + g * av; }
        P11_LOAD(RW(i + 1));
        wcur = wnxt;
        { const int m2 = RW(i + 2); const int4 p4 = *(const int4*)(POS + (size_t)m2 * 4); pn[0] = p4.x; pn[1] = p4.y; pn[2] = p4.z; pn[3] = p4.w; wnxt = *(const f32x4*)(TOPW + (size_t)m2 * 4); }
        float* orow = F.out + (size_t)m * D + lane * 16;
#pragma unroll
        for (int q = 0; q < 4; ++q) *(f32x4*)(orow + 4 * q) = ov[q];
    }
#undef RW
#undef P11_LOAD
}

constexpr int NPHASE = 12;
struct Args { const float* in[25]; float* out; unsigned char* ws; int ph_lo, ph_hi; };
__global__ void __launch_bounds__(NWAVES * 64, 2) fwd_kernel(Args args) {
    extern __shared__ __attribute__((aligned(16))) unsigned char lds[];
    Frame F;
    F.lds = (LAS unsigned char*)lds;
    F.MISC = (volatile LAS unsigned*)(F.lds + MISC_OFF);
    F.tid = threadIdx.x; F.lane = F.tid & 63; F.wave = __builtin_amdgcn_readfirstlane(F.tid >> 6);
    F.G = gridDim.x; { const int bx = blockIdx.x; F.vcu = (F.G % 8 == 0) ? (bx % 8) * (F.G / 8) + bx / 8 : bx; }
    F.ws = args.ws; F.ctl = (gu32*)(args.ws + WS_CTL); F.out = args.out;
    F.x = args.in[0]; F.c = args.in[1]; F.rel_bias = args.in[2]; F.w_ada = args.in[3]; F.b_ada = args.in[4]; F.g_norm1 = args.in[5]; F.w_in = args.in[6];
    F.w_gk_up = args.in[7]; F.b_gk_up = args.in[8]; F.g_gla_out = args.in[9]; F.g_qnorm = args.in[10]; F.g_knorm = args.in[11];
    F.lq1 = args.in[12]; F.lk1 = args.in[13]; F.lq2 = args.in[14]; F.lk2 = args.in[15]; F.g_subln = args.in[16]; F.w_out = args.in[17];
    F.g_norm2 = args.in[18]; F.w_router = args.in[19]; F.b_router = args.in[20]; F.w_gate_up = args.in[21]; F.b_gate_up = args.in[22]; F.w_down = args.in[23]; F.b_down = args.in[24];
    for (int u = F.tid; u < (LDS_BYTES - LDSCTL_OFF) / 4; u += NWAVES * 64) ((LAS unsigned*)(F.lds + LDSCTL_OFF))[u] = 0u;
    __syncthreads();
    const int lo = args.ph_lo, hi = args.ph_hi;
    const bool multi = (hi - lo) > 1;
    XcdBarrier bar; bar.bar = (unsigned*)(F.ctl + CW_BAR); bar.x = 0; bar.st = nullptr;
    if (multi) bar = xcd_barrier_post((unsigned*)(F.ctl + CW_BAR), F.MISC + 8);
#ifndef PHMASK
#define PHMASK 0xFFF
#endif
#define IN(k) (((PHMASK >> (k)) & 1) && lo <= (k) && (k) < hi)
#define SEAM(k) do { if (IN((k) + 1)) xcd_barrier(bar); } while (0)
#ifndef REPEAT_PH
#define REPEAT_PH 0
#endif
#define REPS(k) (((REPEAT_PH >> (k)) & 1) ? 2 : 1)

    if (IN(0)) { for (int rep_ = 0; rep_ < REPS(0); ++rep_) { if (rep_) xcd_barrier(bar); p0_phase(F); } SEAM(0); }
    if (IN(1)) { for (int rep_ = 0; rep_ < REPS(1); ++rep_) { if (rep_) xcd_barrier(bar); p1_phase(F); } SEAM(1); }
    if (IN(2)) {
        pg8::Gemm g{wsp<const bf16>(F, WS_XN), wsp<const bf16>(F, WS_WIN), T, NIN, D, 0};
        pg8::StaticOrder S; S.init(T / 256, NIN / 256, F.G, (int)blockIdx.x, nullptr, REPS(2));
        EpiInProj E{wsp<bf16>(F, WS_QG), wsp<bf16>(F, WS_KG), wsp<bf16>(F, WS_VG), wsp<bf16>(F, WS_RG), wsp<bf16>(F, WS_QD), wsp<bf16>(F, WS_KD), wsp<bf16>(F, WS_VD), F.g_qnorm, F.g_knorm};
        pg8::gemm_phase<EpiInProj, pg8::StaticOrder>(F.lds, g, S, E);
        SEAM(2);
    }
    if (IN(3)) { for (int rep_ = 0; rep_ < REPS(3); ++rep_) { if (rep_) xcd_barrier(bar); for (int c = F.vcu; c < NCHUNK; c += F.G) gla_a_unit(F, c); } SEAM(3); }
    if (IN(4)) { for (int rep_ = 0; rep_ < REPS(4); ++rep_) { if (rep_) xcd_barrier(bar); gla_b_phase(F); } SEAM(4); }
    if (IN(5)) for (int rep_ = 0; rep_ < REPS(5); ++rep_) { if (rep_) xcd_barrier(bar);
#ifndef NO_GLAC
        for (int u = F.vcu; u < NCHUNK / 2; u += F.G) gla_c_unit(F, u);
#endif
        float lam;
        { float a1 = F.lq1[F.lane] * F.lk1[F.lane], a2 = F.lq2[F.lane] * F.lk2[F.lane]; a1 = wave_sum(a1); a2 = wave_sum(a2); lam = __expf(a1) - __expf(a2) + 0.2f; }
#ifndef NO_ATT
        for (int p = F.vcu; p < 256; p += F.G) { const int bh = p >> 4, s = p & 15;
#pragma nounroll
            for (int j = 0; j < 2; ++j) att::attn_unit(F, bh >> 2, bh & 3, j ? s : 31 - s, lam); }
#endif
        SEAM(5);
    }
    if (IN(6)) {
        pg8::Gemm g{wsp<const bf16>(F, WS_A2), wsp<const bf16>(F, WS_WOUT), T, D, D, 0};
        pg8::StaticOrder S; S.init(T / 256, D / 256, F.G, (int)blockIdx.x, nullptr, REPS(6));
        EpiOutProj E{wsp<bf16>(F, WS_MIX), wsp<const float>(F, WS_MOD)};
        pg8::gemm_phase<EpiOutProj, pg8::StaticOrder>(F.lds, g, S, E);
        SEAM(6);
    }
    if (IN(7)) { for (int rep_ = 0; rep_ < REPS(7); ++rep_) { if (rep_) xcd_barrier(bar); p7_phase(F, rep_ == 0); } SEAM(7); }
    if (IN(8)) { p8_phase(F); SEAM(8); }
    if (IN(9)) {
        int nMt; moe_tables(F, nMt);
        pg8::Gemm g{wsp<const bf16>(F, WS_XS), wsp<const bf16>(F, WS_WGU), PMAX, 2048, D / 2, (size_t)2048 * 512};
        pg8::StaticOrder S; S.init(nMt, 8, F.G, (int)blockIdx.x, F.lds + TILEE_OFF, REPS(9));
        EpiSwiGLU E{wsp<unsigned char>(F, WS_Y), F.b_gate_up};
        pg8::gemm_phase<EpiSwiGLU, pg8::StaticOrder, true>(F.lds, g, S, E);
        SEAM(9);
    }
    if (IN(10)) {
        int nMt; moe_tables(F, nMt);
        pg8::Gemm g{wsp<const bf16>(F, WS_Y), wsp<const bf16>(F, WS_WD), PMAX, 1024, FF / 2, (size_t)1024 * 512};
        pg8::StaticOrder S; S.init(nMt, 4, F.G, (int)blockIdx.x, F.lds + TILEE_OFF, REPS(10));
        EpiDown E{wsp<unsigned char>(F, WS_CN), F.b_down};
        pg8::gemm_phase<EpiDown, pg8::StaticOrder, true>(F.lds, g, S, E);
        SEAM(10);
    }
    if (IN(11)) { p11_phase(F); }
#undef IN
#undef SEAM
}

extern "C" void kernel_launch(void* const* d_in, const int* in_sizes, int n_in, void* d_out, int out_size, void* d_ws, size_t ws_size, hipStream_t stream) {
    static int grid = 0;
    if (grid == 0) {
        if (n_in != 25 || in_sizes[0] != T * D || out_size != T * D || ws_size < WS_END) { fprintf(stderr, "kernel_launch: unexpected shapes (n_in %d, in0 %d, out %d, ws %zu); nothing launched\n", n_in, n_in > 0 ? in_sizes[0] : -1, out_size, ws_size); grid = -1; return; }
        int dev = 0, cus = 0, per_cu = 0;
        if (hipGetDevice(&dev) != hipSuccess || hipDeviceGetAttribute(&cus, hipDeviceAttributeMultiprocessorCount, dev) != hipSuccess) { grid = -1; return; }
        if (hipFuncSetAttribute((const void*)fwd_kernel, hipFuncAttributeMaxDynamicSharedMemorySize, LDS_BYTES) != hipSuccess) { fprintf(stderr, "kernel_launch: hipFuncSetAttribute failed\n"); grid = -1; return; }
        if (hipOccupancyMaxActiveBlocksPerMultiprocessor(&per_cu, (const void*)fwd_kernel, NWAVES * 64, LDS_BYTES) != hipSuccess || per_cu < 1)
            fprintf(stderr, "kernel_launch: note: occupancy query reports %d workgroups per CU\n", per_cu);
        (void)hipGetLastError();
        grid = cus;
    }
    if (grid < 0) return;
    if (hipMemsetAsync((char*)d_ws + WS_CTL, 0, CTL_ZERO_BYTES, stream) != hipSuccess) { fprintf(stderr, "kernel_launch: memset failed\n"); return; }
    Args a{};
    for (int i = 0; i < 25; ++i) a.in[i] = (const float*)d_in[i];
    a.out = (float*)d_out; a.ws = (unsigned char*)d_ws;
#if MK_N_LAUNCHES == 1
    a.ph_lo = 0; a.ph_hi = NPHASE;
    hipLaunchKernelGGL(fwd_kernel, dim3(grid), dim3(NWAVES * 64), LDS_BYTES, stream, a);
#else
    for (int p = 0; p < NPHASE; ++p) { a.ph_lo = p; a.ph_hi = p + 1; hipLaunchKernelGGL(fwd_kernel, dim3(grid), dim3(NWAVES * 64), LDS_BYTES, stream, a); }
#endif
    const hipError_t le = hipPeekAtLastError();
    if (le != hipSuccess) fprintf(stderr, "kernel_launch: launch failed: %s\n", hipGetErrorName(le));
}
```
